# Optimizing an MI355X kernel written in HIP

```python
import math
import jax
import jax.numpy as jnp
from jax import lax
import numpy as np

D_MODEL = 1024
BATCH = 2
SEQ = 16384
DEPTH = 4

GRID_W = 64
CTX_LEN = 256
N_MIXERS = 3
N_RWKV = (DEPTH + 2) // N_MIXERS
N_HYENA = (DEPTH + 1) // N_MIXERS
N_MLA = DEPTH // N_MIXERS
N_MOD = 6
NORM_EPS = 1e-6
RWKV_HEAD = 64
RWKV_HEADS = D_MODEL // RWKV_HEAD
DECAY_LORA = 64
AAA_LORA = 64
MV_LORA = 32
GATE_LORA = 160
GN_EPS = 64e-5
FILTER_EMB = 33
FILTER_WIDTH = 64
FILTER_OUT_SCALE = 0.004
FAST_DECAY = math.log(1e-2) / 0.3
SLOW_DECAY = math.log(1e-2) / 1.5
MLA_HEADS = 8
QK_NOPE = 128
QK_ROPE = 64
QK_HEAD = QK_NOPE + QK_ROPE
V_HEAD = 128
Q_LORA = 384
KV_LORA = 256
ROPE_THETA = 10000.0
Q_BLOCK = 128
N_EXPERTS = 32
TOP_K = 4
D_EXPERT = 1024
SWIGLU_LIMIT = 7.0
SWIGLU_ALPHA = 1.702
MOE_BLOCK = 256

kernel_name = 'hybrid_rwkv7_hyena_mla_moe_dit'


def _rms_norm(x, g):
    xf = x.astype(jnp.float32)
    y = xf * lax.rsqrt(jnp.mean(xf * xf, axis=-1, keepdims=True) + NORM_EPS)
    return (y * g.astype(jnp.float32)).astype(x.dtype)


def _pad_seq(x):
    return jnp.pad(x, ((0, 0), (1, 1), (0, 0)))


def _centred_shift(x):
    xp = _pad_seq(x)
    return 0.5 * (xp[:, :-2] + xp[:, 2:]) - x


def _dwconv3(x, w, b):
    xp = _pad_seq(x)
    return xp[:, :-2] * w[0] + xp[:, 1:-1] * w[1] + xp[:, 2:] * w[2] + b


def _split_heads(t, n_heads):
    b, l, ch = t.shape
    return t.reshape(b, l, n_heads, ch // n_heads)


def _rwkv_project(h, p, v_first, vres):
    xx = _centred_shift(h)
    xr, xw, xk, xv, xa, xg = [h + xx * p['mu'][m] for m in range(6)]
    r = xr @ p['w_rkv'][0]
    k = xk @ p['w_rkv'][1]
    v = xv @ p['w_rkv'][2]
    if vres is not None:
        v0, v1, v2 = vres
        v = v + (v_first - v) * jax.nn.sigmoid(v0 + (xv @ v1) @ v2)
    g = jax.nn.sigmoid(xg @ p['g1']) @ p['g2']
    kk = _split_heads(k * p['k_k'], RWKV_HEADS).astype(jnp.float32)
    kk = kk / jnp.maximum(jnp.sqrt(jnp.sum(kk * kk, axis=-1, keepdims=True)), 1e-12)
    dirs = []
    for d in range(2):
        w_log = -jax.nn.softplus(-(p['w0'][d] + jnp.tanh(xw @ p['w1'][d]) @ p['w2'][d])) - 0.5
        decay = jnp.exp(-jnp.exp(w_log.astype(jnp.float32)))
        a = jax.nn.sigmoid(p['a0'][d] + (xa @ p['a1'][d]) @ p['a2'][d])
        k_d = k * (1.0 + (a - 1.0) * p['k_a'])
        dirs.append((_split_heads(decay, RWKV_HEADS), _split_heads(a, RWKV_HEADS), _split_heads(k_d, RWKV_HEADS)))
    return {'r': _split_heads(r, RWKV_HEADS), 'v': _split_heads(v, RWKV_HEADS), 'v_raw': v,
            'kk': kk, 'g': g, 'dirs': dirs}


def _wkv_scan(state, r, decay, kk, a, k, v, reverse):
    def step(s, inp):
        r_t, w_t, kk_t, a_t, k_t, v_t = inp
        sa = jnp.einsum('bhvk,bhk->bhv', s, -kk_t)
        s = (s * w_t[:, :, None, :]
             + sa[..., :, None] * (kk_t * a_t)[..., None, :]
             + v_t[..., :, None] * k_t[..., None, :])
        return s, jnp.einsum('bhvk,bhk->bhv', s, r_t)
    xs = tuple(jnp.swapaxes(t, 0, 1) for t in (r, decay, kk, a, k, v))
    state, ys = lax.scan(step, state, xs, reverse=reverse)
    return state, jnp.swapaxes(ys, 0, 1)


def _rwkv_readout(y, s, p):
    b, l, nh, hd = y.shape
    mean = jnp.mean(y, axis=-1, keepdims=True)
    var = jnp.mean(jnp.square(y - mean), axis=-1, keepdims=True)
    yn = ((y - mean) * lax.rsqrt(var + GN_EPS)).reshape(b, l, nh * hd).astype(s['g'].dtype)
    yn = yn * p['ln_g'] + p['ln_b']
    bonus = sum(jnp.sum(s['r'] * k_h * p['r_k'], axis=-1, keepdims=True) for (_, _, k_h) in s['dirs'])
    bonus = (bonus * s['v']).reshape(b, l, nh * hd)
    return ((yn + bonus) * s['g']) @ p['w_o']


def _rwkv_mixer(h_lat, h_ctx, p, v_first, vres, need_ctx):
    vf_c, vf_l = v_first if vres is not None else (None, None)
    pc = _rwkv_project(h_ctx, p, vf_c, vres)
    pl = _rwkv_project(h_lat, p, vf_l, vres)
    s0 = jnp.zeros((h_lat.shape[0], RWKV_HEADS, RWKV_HEAD, RWKV_HEAD), jnp.float32)
    y_lat = 0.0
    y_ctx = 0.0
    for d, rev in enumerate((False, True)):
        dec_c, a_c, k_c = pc['dirs'][d]
        s_c, yc = _wkv_scan(s0, pc['r'], dec_c, pc['kk'], a_c, k_c, pc['v'], rev)
        dec_l, a_l, k_l = pl['dirs'][d]
        _, yl = _wkv_scan(s_c, pl['r'], dec_l, pl['kk'], a_l, k_l, pl['v'], rev)
        y_ctx = y_ctx + yc
        y_lat = y_lat + yl
    out_lat = _rwkv_readout(y_lat, pl, p)
    out_ctx = _rwkv_readout(y_ctx, pc, p) if need_ctx else None
    return out_ctx, out_lat, (pc['v_raw'], pl['v_raw'])


def _hyena_filters(length, p):
    t = jnp.linspace(0.0, 1.0, length, dtype=jnp.float32)[:, None]
    bands = (FILTER_EMB - 1) // 2
    f = jnp.linspace(1e-4, bands - 1, bands, dtype=jnp.float32)[None, :]
    ang = 2.0 * math.pi * f * jnp.arange(length, dtype=jnp.float32)[:, None] / length
    z = jnp.concatenate([t, jnp.cos(ang), -jnp.sin(ang)], axis=-1)
    hdn = jnp.sin(p['f_freq'][0] * (z @ p['f_w1'] + p['f_b1']))
    hdn = jnp.sin(p['f_freq'][1] * (hdn @ p['f_w2'] + p['f_b2']))
    hdn = jnp.sin(p['f_freq'][2] * (hdn @ p['f_w3'] + p['f_b3']))
    filt = (hdn @ p['f_wout']).astype(jnp.float32)
    deltas = jnp.abs(jnp.linspace(FAST_DECAY, SLOW_DECAY, D_MODEL, dtype=jnp.float32))
    window = jnp.exp(-t * deltas)
    return filt[:, :D_MODEL] * window, filt[:, D_MODEL:] * window


def _two_sided_long_conv(z, h_fwd, h_bwd):
    length = z.shape[1]
    filt2 = jnp.concatenate([h_fwd, jnp.zeros_like(h_fwd[:1]), h_bwd[1:][::-1]], axis=0)
    f_hat = jnp.fft.rfft(filt2, n=2 * length, axis=0)
    z_hat = jnp.fft.rfft(z.astype(jnp.float32), n=2 * length, axis=1)
    return jnp.fft.irfft(z_hat * f_hat[None], n=2 * length, axis=1)[:, :length].astype(z.dtype)


def _hyena_stream(h, p):
    u = _dwconv3(h @ p['w_in'] + p['b_in'], p['short_w'], p['short_b'])
    x0, x1, v = jnp.split(u, 3, axis=-1)
    h_fwd, h_bwd = _hyena_filters(h.shape[1], p)
    z = v * x1
    z = _two_sided_long_conv(z, h_fwd, h_bwd) + z * p['bias']
    return (x0 * z) @ p['w_out'] + p['b_out']


def _rope_1d(x, pos):
    d = x.shape[-1]
    inv = ROPE_THETA ** (-jnp.arange(0, d, 2, dtype=jnp.float32) / d)
    ang = pos.astype(jnp.float32)[:, None] * inv[None, :]
    cos = jnp.cos(ang)[:, None, :]
    sin = jnp.sin(ang)[:, None, :]
    x1, x2 = jnp.split(x, 2, axis=-1)
    return jnp.concatenate([x1 * cos - x2 * sin, x1 * sin + x2 * cos], axis=-1).astype(x.dtype)


def _axial_rope(x, row, col):
    half = x.shape[-1] // 2
    return jnp.concatenate([_rope_1d(x[..., :half], row), _rope_1d(x[..., half:], col)], axis=-1)


def _mla_project(h, p, rope_pos):
    b, l, _ = h.shape
    q_c, kv_c, k_pe = jnp.split(h @ p['w_a'], [Q_LORA, Q_LORA + KV_LORA], axis=-1)
    q = _split_heads(_rms_norm(q_c, p['q_norm_g']) @ p['w_qb'], MLA_HEADS)
    kv = _split_heads(_rms_norm(kv_c, p['kv_norm_g']) @ p['w_kvb'], MLA_HEADS)
    k_nope, v = jnp.split(kv, [QK_NOPE], axis=-1)
    k = jnp.concatenate([k_nope, jnp.broadcast_to(k_pe[:, :, None, :], (b, l, MLA_HEADS, QK_ROPE))], axis=-1)
    q = _rms_norm(q, p['qn_g'])
    k = _rms_norm(k, p['kn_g'])
    if rope_pos is not None:
        row, col = rope_pos
        q = jnp.concatenate([q[..., :QK_NOPE], _axial_rope(q[..., QK_NOPE:], row, col)], axis=-1)
        k = jnp.concatenate([k[..., :QK_NOPE], _axial_rope(k[..., QK_NOPE:], row, col)], axis=-1)
    return q, k, v


def _attend(q, k, v):
    s = jnp.einsum('bqhd,bkhd->bhqk', q, k).astype(jnp.float32) * (QK_HEAD ** -0.5)
    pr = jax.nn.softmax(s, axis=-1).astype(v.dtype)
    return jnp.einsum('bhqk,bkhd->bqhd', pr, v)


def _mla_mixer(h_lat, h_ctx, p, rope_pos, need_ctx):
    q_c, k_c, v_c = _mla_project(h_ctx, p, None)
    q_l, k_l, v_l = _mla_project(h_lat, p, rope_pos)
    b, s, nh, dq = q_l.shape
    k_all = jnp.concatenate([k_c, k_l], axis=1)
    v_all = jnp.concatenate([v_c, v_l], axis=1)
    q_blocks = jnp.swapaxes(q_l.reshape(b, s // Q_BLOCK, Q_BLOCK, nh, dq), 0, 1)
    o_l = lax.map(lambda qb: _attend(qb, k_all, v_all), q_blocks)
    out_lat = jnp.swapaxes(o_l, 0, 1).reshape(b, s, nh * V_HEAD) @ p['w_o']
    out_ctx = _attend(q_c, k_c, v_c).reshape(b, h_ctx.shape[1], nh * V_HEAD) @ p['w_o'] if need_ctx else None
    return out_ctx, out_lat


def _moe(h, router_w, router_b, w_in, b_in, w_out, b_out):
    n_tok, d = h.shape
    n_assign = n_tok * TOP_K
    logits = (h @ router_w + router_b).astype(jnp.float32)
    top_val, top_idx = lax.top_k(logits, TOP_K)
    gates = jax.nn.softmax(top_val, axis=-1).astype(h.dtype).reshape(n_assign)
    flat_e = top_idx.reshape(n_assign)
    order = jnp.argsort(flat_e)
    e_sorted = flat_e[order]
    tok_sorted = order // TOP_K
    counts = jnp.zeros((N_EXPERTS,), jnp.int32).at[flat_e].add(1)
    padded = (counts + MOE_BLOCK - 1) // MOE_BLOCK * MOE_BLOCK
    start = jnp.cumsum(counts) - counts
    pad_end = jnp.cumsum(padded)
    pad_start = pad_end - padded
    dest = pad_start[e_sorted] + jnp.arange(n_assign, dtype=jnp.int32) - start[e_sorted]
    n_blocks = -(-n_assign // MOE_BLOCK) + N_EXPERTS
    row_tok = jnp.zeros((n_blocks * MOE_BLOCK,), jnp.int32).at[dest].set(tok_sorted)
    block_e = jnp.minimum(jnp.searchsorted(pad_end, jnp.arange(n_blocks, dtype=jnp.int32) * MOE_BLOCK, side='right'), N_EXPERTS - 1)
    xb = h[row_tok].reshape(n_blocks, MOE_BLOCK, d)

    def expert_block(args):
        xe, e = args
        gu = xe @ w_in[e] + b_in[e]
        glu = jnp.minimum(gu[:, :D_EXPERT], SWIGLU_LIMIT)
        lin = jnp.clip(gu[:, D_EXPERT:], -SWIGLU_LIMIT, SWIGLU_LIMIT)
        return (glu * jax.nn.sigmoid(SWIGLU_ALPHA * glu) * (lin + 1.0)) @ w_out[e] + b_out[e]

    yb = lax.map(expert_block, (xb, block_e)).reshape(n_blocks * MOE_BLOCK, d)
    return jax.ops.segment_sum(yb[dest] * gates[order][:, None], tok_sorted, num_segments=n_tok)


def setup_inputs(seed: int = 0) -> dict:
    key = jax.random.key(seed)
    keys = iter(jax.random.split(key, 64))
    f32 = jnp.float32
    D, H, N, E, F = D_MODEL, RWKV_HEADS, RWKV_HEAD, N_EXPERTS, D_EXPERT

    def nrm(shape, scale):
        return jax.random.normal(next(keys), shape, f32) * scale

    def gain(shape):
        return 1.0 + nrm(shape, 0.02)

    def unif(shape, lo, hi):
        return jax.random.uniform(next(keys), shape, f32, lo, hi)

    return {
        'x': nrm((BATCH, SEQ, D), 1.0),
        'c': nrm((BATCH, D), 1.0),
        'ctx': nrm((BATCH, CTX_LEN, D), 1.0),
        'c_ctx': nrm((D,), 1.0),
        'ada_w': nrm((DEPTH, D, N_MOD * D), 0.5 * D ** -0.5),
        'ada_b': nrm((DEPTH, N_MOD * D), 0.02),
        'norm_mix_g': gain((DEPTH, D)),
        'norm_ffn_g': gain((DEPTH, D)),
        'rwkv_mu': unif((N_RWKV, 6, D), 0.0, 1.0),
        'rwkv_w_rkv': nrm((N_RWKV, 3, D, D), D ** -0.5),
        'rwkv_w0': unif((N_RWKV, 2, D), -6.0, -1.0),
        'rwkv_w1': nrm((N_RWKV, 2, D, DECAY_LORA), D ** -0.5),
        'rwkv_w2': nrm((N_RWKV, 2, DECAY_LORA, D), 0.5 * DECAY_LORA ** -0.5),
        'rwkv_a0': nrm((N_RWKV, 2, D), 0.1),
        'rwkv_a1': nrm((N_RWKV, 2, D, AAA_LORA), D ** -0.5),
        'rwkv_a2': nrm((N_RWKV, 2, AAA_LORA, D), 0.5 * AAA_LORA ** -0.5),
        'rwkv_g1': nrm((N_RWKV, D, GATE_LORA), D ** -0.5),
        'rwkv_g2': nrm((N_RWKV, GATE_LORA, D), GATE_LORA ** -0.5),
        'rwkv_k_k': 0.85 + nrm((N_RWKV, D), 0.02),
        'rwkv_k_a': gain((N_RWKV, D)),
        'rwkv_r_k': nrm((N_RWKV, H, N), 0.1),
        'rwkv_ln_g': gain((N_RWKV, D)),
        'rwkv_ln_b': nrm((N_RWKV, D), 0.02),
        'rwkv_w_o': nrm((N_RWKV, D, D), D ** -0.5),
        'rwkv_v0': 1.0 + nrm((N_RWKV - 1, D), 0.1),
        'rwkv_v1': nrm((N_RWKV - 1, D, MV_LORA), D ** -0.5),
        'rwkv_v2': nrm((N_RWKV - 1, MV_LORA, D), 0.5 * MV_LORA ** -0.5),
        'hy_w_in': nrm((N_HYENA, D, 3 * D), D ** -0.5),
        'hy_b_in': nrm((N_HYENA, 3 * D), 0.02),
        'hy_short_w': nrm((N_HYENA, 3, 3 * D), 3 ** -0.5),
        'hy_short_b': nrm((N_HYENA, 3 * D), 0.02),
        'hy_f_w1': nrm((N_HYENA, FILTER_EMB, FILTER_WIDTH), FILTER_EMB ** -0.5),
        'hy_f_b1': nrm((N_HYENA, FILTER_WIDTH), 0.1),
        'hy_f_w2': nrm((N_HYENA, FILTER_WIDTH, FILTER_WIDTH), FILTER_WIDTH ** -0.5),
        'hy_f_b2': nrm((N_HYENA, FILTER_WIDTH), 0.1),
        'hy_f_w3': nrm((N_HYENA, FILTER_WIDTH, FILTER_WIDTH), FILTER_WIDTH ** -0.5),
        'hy_f_b3': nrm((N_HYENA, FILTER_WIDTH), 0.1),
        'hy_f_freq': 1.0 + nrm((N_HYENA, 3, FILTER_WIDTH), 0.1),
        'hy_f_wout': nrm((N_HYENA, FILTER_WIDTH, 2 * D), FILTER_OUT_SCALE),
        'hy_bias': nrm((N_HYENA, D), 1.0),
        'hy_w_out': nrm((N_HYENA, D, D), D ** -0.5),
        'hy_b_out': nrm((N_HYENA, D), 0.02),
        'mla_w_a': nrm((N_MLA, D, Q_LORA + KV_LORA + QK_ROPE), D ** -0.5),
        'mla_q_norm_g': gain((N_MLA, Q_LORA)),
        'mla_kv_norm_g': gain((N_MLA, KV_LORA)),
        'mla_w_qb': nrm((N_MLA, Q_LORA, MLA_HEADS * QK_HEAD), Q_LORA ** -0.5),
        'mla_w_kvb': nrm((N_MLA, KV_LORA, MLA_HEADS * (QK_NOPE + V_HEAD)), KV_LORA ** -0.5),
        'mla_qn_g': gain((N_MLA, QK_HEAD)),
        'mla_kn_g': gain((N_MLA, QK_HEAD)),
        'mla_w_o': nrm((N_MLA, MLA_HEADS * V_HEAD, D), (MLA_HEADS * V_HEAD) ** -0.5),
        'moe_router_w': nrm((DEPTH, D, E), D ** -0.5),
        'moe_router_b': nrm((DEPTH, E), 0.01),
        'moe_w_in': nrm((DEPTH, E, D, 2 * F), D ** -0.5),
        'moe_b_in': nrm((DEPTH, E, 2 * F), 0.01),
        'moe_w_out': nrm((DEPTH, E, F, D), F ** -0.5),
        'moe_b_out': nrm((DEPTH, E, D), 0.01),
    }


def reference(x, c, ctx, c_ctx, ada_w, ada_b, norm_mix_g, norm_ffn_g,
              rwkv_mu, rwkv_w_rkv, rwkv_w0, rwkv_w1, rwkv_w2, rwkv_a0, rwkv_a1, rwkv_a2,
              rwkv_g1, rwkv_g2, rwkv_k_k, rwkv_k_a, rwkv_r_k, rwkv_ln_g, rwkv_ln_b, rwkv_w_o,
              rwkv_v0, rwkv_v1, rwkv_v2,
              hy_w_in, hy_b_in, hy_short_w, hy_short_b, hy_f_w1, hy_f_b1, hy_f_w2, hy_f_b2,
              hy_f_w3, hy_f_b3, hy_f_freq, hy_f_wout, hy_bias, hy_w_out, hy_b_out,
              mla_w_a, mla_q_norm_g, mla_kv_norm_g, mla_w_qb, mla_w_kvb, mla_qn_g, mla_kn_g, mla_w_o,
              moe_router_w, moe_router_b, moe_w_in, moe_b_in, moe_w_out, moe_b_out):
    _, s_len, _ = x.shape
    ROWS = s_len // GRID_W
    row = jnp.repeat(jnp.arange(ROWS, dtype=jnp.int32), GRID_W)
    col = jnp.tile(jnp.arange(GRID_W, dtype=jnp.int32), ROWS)
    silu_c = jax.nn.silu(c)
    silu_cc = jax.nn.silu(c_ctx)
    xc = ctx
    v_first = None
    for i in range(DEPTH):
        need_ctx = i < DEPTH - 1
        j = i // N_MIXERS
        kind = i % N_MIXERS
        mod_l = (silu_c @ ada_w[i] + ada_b[i])[:, None, :]
        mod_c = (silu_cc @ ada_w[i] + ada_b[i])[None, None, :]
        sh1, sc1, g1, sh2, sc2, g2 = jnp.split(mod_l, N_MOD, axis=-1)
        csh1, csc1, cg1, csh2, csc2, cg2 = jnp.split(mod_c, N_MOD, axis=-1)
        h_l = _rms_norm(x, norm_mix_g[i]) * (1.0 + sc1) + sh1
        h_c = _rms_norm(xc, norm_mix_g[i]) * (1.0 + csc1) + csh1
        if kind == 0:
            p = {'mu': rwkv_mu[j], 'w_rkv': rwkv_w_rkv[j], 'w0': rwkv_w0[j], 'w1': rwkv_w1[j],
                 'w2': rwkv_w2[j], 'a0': rwkv_a0[j], 'a1': rwkv_a1[j], 'a2': rwkv_a2[j],
                 'g1': rwkv_g1[j], 'g2': rwkv_g2[j], 'k_k': rwkv_k_k[j], 'k_a': rwkv_k_a[j],
                 'r_k': rwkv_r_k[j], 'ln_g': rwkv_ln_g[j], 'ln_b': rwkv_ln_b[j], 'w_o': rwkv_w_o[j]}
            vres = None if j == 0 else (rwkv_v0[j - 1], rwkv_v1[j - 1], rwkv_v2[j - 1])
            y_c, y_l, v_cur = _rwkv_mixer(h_l, h_c, p, v_first, vres, need_ctx)
            if j == 0:
                v_first = v_cur
        elif kind == 1:
            p = {'w_in': hy_w_in[j], 'b_in': hy_b_in[j], 'short_w': hy_short_w[j], 'short_b': hy_short_b[j],
                 'f_w1': hy_f_w1[j], 'f_b1': hy_f_b1[j], 'f_w2': hy_f_w2[j], 'f_b2': hy_f_b2[j],
                 'f_w3': hy_f_w3[j], 'f_b3': hy_f_b3[j], 'f_freq': hy_f_freq[j], 'f_wout': hy_f_wout[j],
                 'bias': hy_bias[j], 'w_out': hy_w_out[j], 'b_out': hy_b_out[j]}
            y_l = _hyena_stream(h_l, p)
            y_c = _hyena_stream(h_c, p) if need_ctx else None
        else:
            p = {'w_a': mla_w_a[j], 'q_norm_g': mla_q_norm_g[j], 'kv_norm_g': mla_kv_norm_g[j],
                 'w_qb': mla_w_qb[j], 'w_kvb': mla_w_kvb[j], 'qn_g': mla_qn_g[j], 'kn_g': mla_kn_g[j],
                 'w_o': mla_w_o[j]}
            y_c, y_l = _mla_mixer(h_l, h_c, p, (row, col), need_ctx)
        x = x + g1 * y_l
        h2_l = _rms_norm(x, norm_ffn_g[i]) * (1.0 + sc2) + sh2
        moe_p = (moe_router_w[i], moe_router_b[i], moe_w_in[i], moe_b_in[i], moe_w_out[i], moe_b_out[i])
        if need_ctx:
            xc = xc + cg1 * y_c
            h2_c = _rms_norm(xc, norm_ffn_g[i]) * (1.0 + csc2) + csh2
            n_c = h2_c.shape[0] * h2_c.shape[1]
            f = _moe(jnp.concatenate([h2_c.reshape(-1, D_MODEL), h2_l.reshape(-1, D_MODEL)], axis=0), *moe_p)
            xc = xc + cg2 * f[:n_c].reshape(xc.shape)
            x = x + g2 * f[n_c:].reshape(x.shape)
        else:
            x = x + g2 * _moe(h2_l.reshape(-1, D_MODEL), *moe_p).reshape(x.shape)
    return x
```

```cpp
#define NLAYERS 4
#define HAVE_HYENA 1
#define HAVE_MLA 1
#define SELFTEST 0
#include <hip/hip_runtime.h>
#include <cstdio>
#include <cstdint>

#define XB_TMO      128
#define XB_XCNT(j)  (256  + 64 * (j))
#define XB_XSUB(j)  (1280 + 64 * (j))
#define XB_XGEN(j)  (2304 + 64 * (j))
#define XB_TOP      3328
#define XB_TOPGEN   3392
#define XCD_BAR_WORDS 3456
#define XB_SPIN_CAP (1u << 22)
#define LAS __attribute__((address_space(3)))

__device__ __forceinline__ unsigned xb_ld(unsigned* p)              { return __hip_atomic_load(p, __ATOMIC_RELAXED, __HIP_MEMORY_SCOPE_AGENT); }
__device__ __forceinline__ unsigned xb_add(unsigned* p, unsigned v) { return __hip_atomic_fetch_add(p, v, __ATOMIC_RELAXED, __HIP_MEMORY_SCOPE_AGENT); }
__device__ __forceinline__ unsigned xb_xcc_id() { return (unsigned)__builtin_amdgcn_s_getreg((3 << 11) | 20) & 0xFu; }
#define XB_SPIN(cond, bar) do { unsigned _sp = 0; while (cond) { __builtin_amdgcn_s_sleep(1); \
    if ((++_sp & 255u) == 0u) { if (xb_ld(&(bar)[XB_TMO])) break; if (_sp > XB_SPIN_CAP) { atomicAdd(&(bar)[XB_TMO], 1u); break; } } } } while (0)

struct XcdBarrier { unsigned* bar; unsigned x; volatile LAS unsigned* st; };

__device__ __forceinline__ XcdBarrier xcd_barrier_post(unsigned* bar, volatile LAS unsigned* st) {
    XcdBarrier b; b.bar = bar; b.x = xb_xcc_id(); b.st = st;
    if (threadIdx.x == 0) (void)xb_add(&bar[XB_XCNT(b.x)], 1u);
    return b;
}
__device__ __forceinline__ void xcd_barrier_complete(unsigned* bar, unsigned x, unsigned& nloc, unsigned& nx) {
    const unsigned G = gridDim.x * gridDim.y * gridDim.z;
    unsigned sum, cnt, mine, sp = 0u;
    for (;;) {
        sum = 0u; cnt = 0u; mine = 0u;
#pragma unroll
        for (unsigned j = 0; j < 16; ++j) { const unsigned c = xb_ld(&bar[XB_XCNT(j)]); sum += c; cnt += (c > 0u) ? 1u : 0u; mine = (j == x) ? c : mine; }
        if (sum == G) break;
        __builtin_amdgcn_s_sleep(1);
        if ((++sp & 255u) == 0u) { if (xb_ld(&bar[XB_TMO])) break; if (sp > XB_SPIN_CAP) { atomicAdd(&bar[XB_TMO], 1u); break; } }
    }
    nloc = mine > 0u ? mine : 1u; nx = cnt > 0u ? cnt : 1u;
}
__device__ __forceinline__ void xcd_barrier(const XcdBarrier& b) {
    asm volatile("s_waitcnt vmcnt(0)" ::: "memory");
    __syncthreads();
    if (threadIdx.x == 0) {
        unsigned* bar = b.bar;
        __builtin_amdgcn_s_waitcnt(0);
        unsigned nloc = b.st[0], nx = b.st[1];
        if (nloc == 0u) { xcd_barrier_complete(bar, b.x, nloc, nx); b.st[0] = nloc; b.st[1] = nx; }
        const unsigned old = xb_add(&bar[XB_XSUB(b.x)], 1u);
        const unsigned gen = old / nloc;
        if (old + 1u == (gen + 1u) * nloc) {
            __builtin_amdgcn_fence(__ATOMIC_RELEASE, "agent");
            asm volatile("s_waitcnt vmcnt(0)" ::: "memory");
            const unsigned og = xb_add(&bar[XB_TOP], 1u);
            const unsigned tg = og / nx;
            if (og + 1u == (tg + 1u) * nx) xb_add(&bar[XB_TOPGEN], 1u);
            else XB_SPIN(xb_ld(&bar[XB_TOPGEN]) == tg, bar);
            __builtin_amdgcn_fence(__ATOMIC_ACQUIRE, "agent");
            xb_add(&bar[XB_XGEN(b.x)], 1u);
            asm volatile("s_waitcnt vmcnt(0)" ::: "memory");
        } else {
            XB_SPIN(xb_ld(&bar[XB_XGEN(b.x)]) == gen, bar);
            __builtin_amdgcn_fence(__ATOMIC_ACQUIRE, "agent");
            asm volatile("s_waitcnt vmcnt(0)" ::: "memory");
        }
    }
    __syncthreads();
}

typedef unsigned short bf16_t;
typedef short bf16x8 __attribute__((ext_vector_type(8)));
typedef float f32x4 __attribute__((ext_vector_type(4)));
typedef float f32x16 __attribute__((ext_vector_type(16)));
typedef unsigned u32x4 __attribute__((ext_vector_type(4)));
typedef unsigned u32x2 __attribute__((ext_vector_type(2)));

constexpr int NT = 512;
constexpr int LDS_BYTES = 147456;
constexpr int LDS_CTL = 0;
constexpr int LDS_USER = 256;
constexpr int D = 1024, BATCH = 2, SEQ = 16384, CTX = 256, DEPTH = 4;
constexpr int RPB = CTX + SEQ;
constexpr int T = BATCH * RPB;
constexpr int NEXP = 32, TOPK = 4, DEXP = 1024;
constexpr int MAXROWS = T * TOPK + NEXP * 256;

enum { I_X = 0, I_C, I_CTX, I_CCTX, I_ADAW, I_ADAB, I_NMIX, I_NFFN,
       I_RMU, I_RWRKV, I_RW0, I_RW1, I_RW2, I_RA0, I_RA1, I_RA2, I_RG1, I_RG2, I_RKK, I_RKA, I_RRK, I_RLNG, I_RLNB, I_RWO, I_RV0, I_RV1, I_RV2,
       I_HWIN, I_HBIN, I_HSW, I_HSB, I_HFW1, I_HFB1, I_HFW2, I_HFB2, I_HFW3, I_HFB3, I_HFREQ, I_HFWOUT, I_HBIAS, I_HWOUT, I_HBOUT,
       I_MWA, I_MQNG, I_MKVNG, I_MWQB, I_MWKVB, I_MQN, I_MKN, I_MWO,
       I_ERW, I_ERB, I_EWIN, I_EBIN, I_EWOUT, I_EBOUT, N_IN };

struct Args { const float* in[56]; float* out; unsigned char* ws; };

constexpr size_t al256(size_t x) { return (x + 255) & ~(size_t)255; }
constexpr size_t WS_BAR    = 0;
constexpr size_t WS_CNT    = 16384;
constexpr size_t WS_ZERO_BYTES = 32768;
constexpr size_t WS_MOD    = 32768;
constexpr size_t WS_TW1    = al256(WS_MOD + (size_t)4 * 3 * 6144 * 4);
constexpr size_t WS_TW2    = WS_TW1 + 16384 * 8;
constexpr size_t WS_RWT    = WS_TW2 + 16384 * 8;
constexpr size_t WS_X      = WS_RWT + (size_t)4 * 32 * 1024 * 4;
constexpr size_t WS_H      = WS_X + (size_t)T * D * 4;
constexpr size_t WS_ASGE   = WS_H + (size_t)T * D * 2;
constexpr size_t WS_ASGG   = WS_ASGE + (size_t)T * 4 * 4;
constexpr size_t WS_TOKL   = WS_ASGG + (size_t)T * 4 * 4;
constexpr size_t WS_ACT    = WS_TOKL + (size_t)NEXP * T * 4;
constexpr size_t WS_YB     = WS_ACT + (size_t)MAXROWS * D * 2;
constexpr size_t WS_RKVT   = WS_YB + (size_t)MAXROWS * D * 2;
constexpr size_t WS_RWOT   = WS_RKVT + (size_t)6 * D * D * 2;
constexpr size_t WS_L1T    = WS_RWOT + (size_t)2 * D * D * 2;
constexpr size_t WS_W2T    = WS_L1T + (size_t)2 * 640 * D * 2;
constexpr size_t WS_A2T    = WS_W2T + (size_t)4 * D * 64 * 2;
constexpr size_t WS_G2T    = WS_A2T + (size_t)4 * D * 64 * 2;
constexpr size_t WS_V2T    = WS_G2T + (size_t)2 * D * 192 * 2;
constexpr size_t WS_HYINT  = WS_V2T + (size_t)D * 64 * 2;
constexpr size_t WS_HYOUTT = WS_HYINT + (size_t)3072 * D * 2;
constexpr size_t WS_MWAT   = WS_HYOUTT + (size_t)D * D * 2;
constexpr size_t WS_MWQBT  = WS_MWAT + (size_t)768 * D * 2;
constexpr size_t WS_MWKVBT = WS_MWQBT + (size_t)1536 * 384 * 2;
constexpr size_t WS_MWOT   = WS_MWKVBT + (size_t)2048 * 256 * 2;
constexpr size_t WS_EWINT  = WS_MWOT + (size_t)D * D * 2;
constexpr size_t WS_EWOUTT = WS_EWINT + (size_t)4 * 32 * 2048 * D * 2;
constexpr size_t WS_VFIRST = WS_EWOUTT + (size_t)4 * 32 * D * D * 2;
constexpr size_t WS_MIX    = WS_VFIRST + (size_t)T * D * 4;
constexpr size_t TD4 = (size_t)T * D * 4;
constexpr size_t RW_R   = WS_MIX;
constexpr size_t RW_K   = RW_R + TD4;
constexpr size_t RW_V   = RW_K + TD4;
constexpr size_t RW_G   = RW_V + TD4;
constexpr size_t RW_WD0 = RW_G + TD4;
constexpr size_t RW_WD1 = RW_WD0 + TD4;
constexpr size_t RW_AD0 = RW_WD1 + TD4;
constexpr size_t RW_AD1 = RW_AD0 + TD4;
constexpr size_t RW_Y0  = RW_AD1 + TD4;
constexpr size_t RW_Y1  = RW_Y0 + TD4;
constexpr size_t RW_HL  = RW_Y1 + TD4;
constexpr size_t RW_Z   = RW_HL + (size_t)T * 640 * 2;
constexpr size_t RW_END = RW_Z + (size_t)T * D * 2;

__device__ __forceinline__ int otid() { int t = threadIdx.x; asm volatile("" : "+v"(t)); return t; }
__device__ __forceinline__ unsigned cvt_pk_bf16(float lo, float hi) { unsigned r; asm("v_cvt_pk_bf16_f32 %0, %1, %2" : "=v"(r) : "v"(lo), "v"(hi)); return r; }
__device__ __forceinline__ float bf_lo(unsigned u) { return __uint_as_float(u << 16); }
__device__ __forceinline__ float bf_hi(unsigned u) { return __uint_as_float(u & 0xffff0000u); }
__device__ __forceinline__ float wave_sum(float v) {
#pragma unroll
    for (int o = 32; o >= 1; o >>= 1) v += __shfl_xor(v, o);
    return v;
}
template <int CTRL> __device__ __forceinline__ float dpp_f(float v) { return __int_as_float(__builtin_amdgcn_update_dpp(0, __float_as_int(v), CTRL, 0xf, 0xf, false)); }
__device__ __forceinline__ float row16_sum(float v) {
    v += dpp_f<0x128>(v); v += dpp_f<0x124>(v); v += dpp_f<0x122>(v); v += dpp_f<0x121>(v); return v;
}
__device__ __forceinline__ float sin_acc(float x) {
    const float k = rintf(x * 0.15915494309189535f);
    float r = fmaf(-k, 6.28125f, x); r = fmaf(-k, 1.9353071795864769e-3f, r);
    const float pi = 3.14159265358979f;
    r = r > 0.5f * pi ? pi - r : (r < -0.5f * pi ? -pi - r : r);
    const float r2 = r * r;
    float p = -2.5052108e-8f; p = fmaf(p, r2, 2.7557319e-6f); p = fmaf(p, r2, -1.9841270e-4f); p = fmaf(p, r2, 8.3333333e-3f); p = fmaf(p, r2, -1.6666667e-1f);
    return fmaf(r * r2, p, r);
}
__device__ __forceinline__ float cos_acc(float x) { return sin_acc(x + 1.57079632679489662f); }
__device__ __forceinline__ float sigmoidf_(float x) { return 1.f / (1.f + __expf(-x)); }
__device__ __forceinline__ int mod_index(int row) { const int b = row / RPB; return (row - b * RPB) < CTX ? 2 : b; }

constexpr int G_A_BYTES = 256 * 64 * 2, G_B_BYTES = 128 * 64 * 2, G_BUF = G_A_BYTES + G_B_BYTES, G_LDS = 2 * G_BUF;
__device__ __forceinline__ int gswz(int row, int ch) { return row * 128 + ((ch ^ ((row >> 1) & 7)) << 4); }

struct ALoadPlain {
    const bf16_t* A; int lda;
    __device__ __forceinline__ u32x4 load(int row, int k) const { return *(const u32x4*)(A + (size_t)row * lda + k); }
};

template <class AL, class EP>
__device__ __forceinline__ void gemm_tile(const AL& al, const bf16_t* __restrict__ Bt, int ldb, int nk, unsigned char* lds, const EP& ep, int m0, int n0) {
    const int tid = otid(), lane = tid & 63, wid = tid >> 6, wm = wid >> 1, wn = wid & 1, fr = lane & 15, fq = lane >> 4;
    f32x4 acc[4][4];
#pragma unroll
    for (int i = 0; i < 4; ++i)
#pragma unroll
        for (int j = 0; j < 4; ++j) acc[i][j] = (f32x4){0.f, 0.f, 0.f, 0.f};
    u32x4 ra[4], rb[2];
    const int srow = tid >> 3, sch = tid & 7;
    {
#pragma unroll
        for (int i = 0; i < 4; ++i) ra[i] = al.load(m0 + srow + i * 64, sch * 8);
#pragma unroll
        for (int i = 0; i < 2; ++i) rb[i] = *(const u32x4*)(Bt + (size_t)(n0 + srow + i * 64) * ldb + sch * 8);
#pragma unroll
        for (int i = 0; i < 4; ++i) *(u32x4*)(lds + gswz(srow + i * 64, sch)) = ra[i];
#pragma unroll
        for (int i = 0; i < 2; ++i) *(u32x4*)(lds + G_A_BYTES + gswz(srow + i * 64, sch)) = rb[i];
    }
    __syncthreads();
    for (int kt = 0; kt < nk; ++kt) {
        const bool more = (kt + 1 < nk);
        if (more) {
#pragma unroll
            for (int i = 0; i < 4; ++i) ra[i] = al.load(m0 + srow + i * 64, (kt + 1) * 64 + sch * 8);
#pragma unroll
            for (int i = 0; i < 2; ++i) rb[i] = *(const u32x4*)(Bt + (size_t)(n0 + srow + i * 64) * ldb + (kt + 1) * 64 + sch * 8);
        }
        const unsigned char* base = lds + (kt & 1) * G_BUF;
#pragma unroll
        for (int ks = 0; ks < 2; ++ks) {
            bf16x8 af[4], bfr[4];
#pragma unroll
            for (int mi = 0; mi < 4; ++mi) af[mi] = *(const bf16x8*)(base + gswz(wm * 64 + mi * 16 + fr, ks * 4 + fq));
#pragma unroll
            for (int ni = 0; ni < 4; ++ni) bfr[ni] = *(const bf16x8*)(base + G_A_BYTES + gswz(wn * 64 + ni * 16 + fr, ks * 4 + fq));
#pragma unroll
            for (int mi = 0; mi < 4; ++mi)
#pragma unroll
                for (int ni = 0; ni < 4; ++ni) acc[mi][ni] = __builtin_amdgcn_mfma_f32_16x16x32_bf16(bfr[ni], af[mi], acc[mi][ni], 0, 0, 0);
        }
        if (more) {
            unsigned char* nb = lds + ((kt + 1) & 1) * G_BUF;
#pragma unroll
            for (int i = 0; i < 4; ++i) *(u32x4*)(nb + gswz(srow + i * 64, sch)) = ra[i];
#pragma unroll
            for (int i = 0; i < 2; ++i) *(u32x4*)(nb + G_A_BYTES + gswz(srow + i * 64, sch)) = rb[i];
        }
        __syncthreads();
    }
    ep(acc, m0 + wm * 64, n0 + wn * 64, fr, fq);
}
template <class F> struct EpiElem {
    F f;
    __device__ __forceinline__ void operator()(const f32x4 (&acc)[4][4], int rbase, int cbase, int fr, int fq) const {
#pragma unroll
        for (int mi = 0; mi < 4; ++mi)
#pragma unroll
            for (int ni = 0; ni < 4; ++ni) f(rbase + mi * 16 + fr, cbase + ni * 16 + fq * 4, acc[mi][ni]);
    }
};
template <class F> __device__ __forceinline__ EpiElem<F> make_epi(F f) { return EpiElem<F>{f}; }
struct TJob { int in_idx, src_off, K, N, Kpad, Npad, batch, sbs, dbs, perm; size_t dst; };
constexpr int NJOBS = 21;
__constant__ TJob g_jobs[NJOBS] = {
    { I_RWRKV, 0,             1024, 1024, 1024, 1024, 6,   1024 * 1024, 1024 * 1024, 0, WS_RKVT },
    { I_RWO,   0,             1024, 1024, 1024, 1024, 2,   1024 * 1024, 1024 * 1024, 0, WS_RWOT },
    { I_RW1,   0,             1024, 64,   1024, 64,   2,   1024 * 64,   64 * 1024,   0, WS_L1T + (size_t)0 * 1024 * 2 },
    { I_RW1,   2 * 1024 * 64, 1024, 64,   1024, 64,   2,   1024 * 64,   64 * 1024,   0, WS_L1T + (size_t)640 * 1024 * 2 },
    { I_RA1,   0,             1024, 64,   1024, 64,   2,   1024 * 64,   64 * 1024,   0, WS_L1T + (size_t)128 * 1024 * 2 },
    { I_RA1,   2 * 1024 * 64, 1024, 64,   1024, 64,   2,   1024 * 64,   64 * 1024,   0, WS_L1T + (size_t)(640 + 128) * 1024 * 2 },
    { I_RG1,   0,             1024, 160,  1024, 256,  1,   0,           0,           0, WS_L1T + (size_t)256 * 1024 * 2 },
    { I_RG1,   1024 * 160,    1024, 160,  1024, 256,  1,   0,           0,           0, WS_L1T + (size_t)(640 + 256) * 1024 * 2 },
    { I_RV1,   0,             1024, 32,   1024, 128,  1,   0,           0,           0, WS_L1T + (size_t)(640 + 512) * 1024 * 2 },
    { I_RW2,   0,             64,   1024, 64,   1024, 4,   64 * 1024,   1024 * 64,   0, WS_W2T },
    { I_RA2,   0,             64,   1024, 64,   1024, 4,   64 * 1024,   1024 * 64,   0, WS_A2T },
    { I_RG2,   0,             160,  1024, 192,  1024, 2,   160 * 1024,  1024 * 192,  0, WS_G2T },
    { I_RV2,   0,             32,   1024, 64,   1024, 1,   0,           0,           0, WS_V2T },
    { I_HWIN,  0,             1024, 3072, 1024, 3072, 1,   0,           0,           0, WS_HYINT },
    { I_HWOUT, 0,             1024, 1024, 1024, 1024, 1,   0,           0,           0, WS_HYOUTT },
    { I_MWA,   0,             1024, 704,  1024, 768,  1,   0,           0,           0, WS_MWAT },
    { I_MWQB,  0,             384,  1536, 384,  1536, 1,   0,           0,           0, WS_MWQBT },
    { I_MWKVB, 0,             256,  2048, 256,  2048, 1,   0,           0,           0, WS_MWKVBT },
    { I_MWO,   0,             1024, 1024, 1024, 1024, 1,   0,           0,           0, WS_MWOT },
    { I_EWIN,  0,             1024, 2048, 1024, 2048, 128, 1024 * 2048, 2048 * 1024, 1, WS_EWINT },
    { I_EWOUT, 0,             1024, 1024, 1024, 1024, 128, 1024 * 1024, 1024 * 1024, 0, WS_EWOUTT },
};
__device__ __forceinline__ int swiglu_perm(int np) { const int nt = np >> 7, wn = (np >> 6) & 1, ni = (np >> 4) & 3, i = np & 15; return ((ni >= 2) ? 1024 : 0) + nt * 64 + wn * 32 + (ni & 1) * 16 + i; }

__device__ __forceinline__ void phase_prologue(const Args& a, unsigned char* lds) {
    const int tid = otid(), nb = gridDim.x, bid = blockIdx.x;
    float* lt = (float*)(lds + LDS_USER);
    int base = 0;
    for (int j = 0; j < NJOBS; ++j) {
        const TJob jb = g_jobs[j];
        const int tk = jb.Kpad >> 6, tn = jb.Npad >> 6, per = tk * tn, total = jb.batch * per;
        int t = (bid - base % nb + nb) % nb;
        for (; t < total; t += nb) {
            const int bi = t / per, r = t - bi * per, ti_n = r / tk, ti_k = r - ti_n * tk;
            const float* src = a.in[jb.in_idx] + jb.src_off + (size_t)bi * jb.sbs;
            bf16_t* dst = (bf16_t*)(a.ws + jb.dst) + (size_t)bi * jb.dbs;
            const int k0 = ti_k * 64, n0 = ti_n * 64;
#pragma unroll
            for (int i = 0; i < 2; ++i) {
                const int item = tid + i * 512, kl = item >> 4, n4 = (item & 15) * 4, k = k0 + kl, np = n0 + n4;
                float4 v = make_float4(0.f, 0.f, 0.f, 0.f);
                if (k < jb.K && np < jb.N) { const int col = jb.perm ? swiglu_perm(np) : np; v = *(const float4*)(src + (size_t)k * jb.N + col); }
                float* p = lt + kl * 65 + n4; p[0] = v.x; p[1] = v.y; p[2] = v.z; p[3] = v.w;
            }
            __syncthreads();
            {
                const int nl = tid >> 3, kc = tid & 7;
                float f[8];
#pragma unroll
                for (int q = 0; q < 8; ++q) f[q] = lt[(kc * 8 + q) * 65 + nl];
                u32x4 o = { cvt_pk_bf16(f[0], f[1]), cvt_pk_bf16(f[2], f[3]), cvt_pk_bf16(f[4], f[5]), cvt_pk_bf16(f[6], f[7]) };
                *(u32x4*)(dst + (size_t)(n0 + nl) * jb.Kpad + k0 + kc * 8) = o;
            }
            __syncthreads();
        }
        base += total;
    }
    for (int u = bid; u < 4 * 96; u += nb) {
        const int l = u / 96, cg = u - l * 96, kg = tid >> 6, cl = tid & 63, col = cg * 64 + cl;
        const float* w = a.in[I_ADAW] + (size_t)l * 1024 * 6144 + col;
        float s0 = 0.f, s1 = 0.f, s2 = 0.f;
        for (int k = kg * 128; k < kg * 128 + 128; ++k) {
            const float wv = w[(size_t)k * 6144];
            float c0 = a.in[I_C][k], c1 = a.in[I_C][1024 + k], c2 = a.in[I_CCTX][k];
            c0 = c0 / (1.f + __expf(-c0)); c1 = c1 / (1.f + __expf(-c1)); c2 = c2 / (1.f + __expf(-c2));
            s0 += c0 * wv; s1 += c1 * wv; s2 += c2 * wv;
        }
        lt[(kg * 3 + 0) * 64 + cl] = s0; lt[(kg * 3 + 1) * 64 + cl] = s1; lt[(kg * 3 + 2) * 64 + cl] = s2;
        __syncthreads();
        if (tid < 192) {
            const int m = tid >> 6;
            float s = a.in[I_ADAB][l * 6144 + col];
#pragma unroll
            for (int g = 0; g < 8; ++g) s += lt[(g * 3 + m) * 64 + cl];
            ((float*)(a.ws + WS_MOD))[((size_t)l * 3 + m) * 6144 + col] = s;
        }
        __syncthreads();
    }
    for (int i = bid * NT + tid; i < 16384; i += nb * NT) {
        float s, c;
        sincospif((float)i / 8192.0f, &s, &c);  ((float2*)(a.ws + WS_TW1))[i] = make_float2(c, -s);
        sincospif((float)i / 16384.0f, &s, &c); ((float2*)(a.ws + WS_TW2))[i] = make_float2(c, -s);
    }
    for (int i = bid * NT + tid; i < 4 * 32 * 1024; i += nb * NT) {
        const int l = i >> 15, e = (i >> 10) & 31, col = i & 1023;
        ((float*)(a.ws + WS_RWT))[i] = a.in[I_ERW][(size_t)l * 32768 + col * 32 + e];
    }
}


template <bool SRC_IN, bool COMBINE, bool ROUTER, bool FINAL>
__device__ __forceinline__ void phase_norm(const Args& a, unsigned char* lds, int layer) {
    const int tid = otid(), lane = tid & 63, wid = tid >> 6;
    float* X = (float*)(a.ws + WS_X);
    int* padstart = (int*)(lds + LDS_USER);
    float* rwt = (float*)(lds + LDS_USER + 256);
    if (COMBINE) {
        if (tid == 0) {
            const int* cnt = (const int*)(a.ws + WS_CNT) + (layer - 1) * 32;
            int acc = 0;
            for (int e = 0; e < 32; ++e) { padstart[e] = acc; acc += ((cnt[e] + 255) >> 8) << 8; }
        }
    }
    if (ROUTER) {
        const float4* src = (const float4*)(a.ws + WS_RWT) + (size_t)layer * 8192;
        for (int i = tid; i < 8192; i += NT) ((float4*)rwt)[i] = src[i];
    }
    if (COMBINE || ROUTER) __syncthreads();
    const float* modbase = (const float*)(a.ws + WS_MOD);
    for (int row = blockIdx.x * 8 + wid; row < T; row += gridDim.x * 8) {
        const int b = row / RPB, within = row - b * RPB, midx = within < CTX ? 2 : b;
        float4 xv[4];
        if (SRC_IN) {
            const float* src = within < CTX ? a.in[I_CTX] + ((size_t)b * CTX + within) * D : a.in[I_X] + ((size_t)b * SEQ + (within - CTX)) * D;
#pragma unroll
            for (int q = 0; q < 4; ++q) { xv[q] = *(const float4*)(src + q * 256 + lane * 4); *(float4*)(X + (size_t)row * D + q * 256 + lane * 4) = xv[q]; }
        } else {
#pragma unroll
            for (int q = 0; q < 4; ++q) xv[q] = *(const float4*)(X + (size_t)row * D + q * 256 + lane * 4);
        }
        if (COMBINE) {
            const int* ae = (const int*)(a.ws + WS_ASGE) + (size_t)row * 4;
            const float* ag = (const float*)(a.ws + WS_ASGG) + (size_t)row * 4;
            float4 f[4];
#pragma unroll
            for (int q = 0; q < 4; ++q) f[q] = make_float4(0.f, 0.f, 0.f, 0.f);
#pragma unroll
            for (int k = 0; k < 4; ++k) {
                const int es = ae[k]; const float gate = ag[k];
                const size_t yrow = (size_t)padstart[es >> 24] + (es & 0xffffff);
                const bf16_t* yb = (const bf16_t*)(a.ws + WS_YB) + yrow * D;
#pragma unroll
                for (int q = 0; q < 4; ++q) {
                    const u32x2 u = *(const u32x2*)(yb + q * 256 + lane * 4);
                    f[q].x += gate * bf_lo(u[0]); f[q].y += gate * bf_hi(u[0]); f[q].z += gate * bf_lo(u[1]); f[q].w += gate * bf_hi(u[1]);
                }
            }
            const float* g2 = modbase + ((size_t)(layer - 1) * 3 + midx) * 6144 + 5 * 1024;
#pragma unroll
            for (int q = 0; q < 4; ++q) {
                const float4 g = *(const float4*)(g2 + q * 256 + lane * 4);
                xv[q].x += g.x * f[q].x; xv[q].y += g.y * f[q].y; xv[q].z += g.z * f[q].z; xv[q].w += g.w * f[q].w;
                if (!FINAL) *(float4*)(X + (size_t)row * D + q * 256 + lane * 4) = xv[q];
            }
        }
        if (FINAL) {
            if (within >= CTX) {
                float* o = a.out + ((size_t)b * SEQ + (within - CTX)) * D;
#pragma unroll
                for (int q = 0; q < 4; ++q) *(float4*)(o + q * 256 + lane * 4) = xv[q];
            }
            continue;
        }
        float ss = 0.f;
#pragma unroll
        for (int q = 0; q < 4; ++q) ss += xv[q].x * xv[q].x + xv[q].y * xv[q].y + xv[q].z * xv[q].z + xv[q].w * xv[q].w;
        ss = wave_sum(ss);
        const float rstd = rsqrtf(ss * (1.f / 1024.f) + 1e-6f);
        const float* gn = a.in[ROUTER ? I_NFFN : I_NMIX] + layer * 1024;
        const float* mod = modbase + ((size_t)layer * 3 + midx) * 6144 + (ROUTER ? 3 * 1024 : 0);
        float4 hv[4];
#pragma unroll
        for (int q = 0; q < 4; ++q) {
            const int c = q * 256 + lane * 4;
            const float4 g = *(const float4*)(gn + c), sh = *(const float4*)(mod + c), sc = *(const float4*)(mod + 1024 + c);
            hv[q].x = xv[q].x * rstd * g.x * (1.f + sc.x) + sh.x; hv[q].y = xv[q].y * rstd * g.y * (1.f + sc.y) + sh.y;
            hv[q].z = xv[q].z * rstd * g.z * (1.f + sc.z) + sh.z; hv[q].w = xv[q].w * rstd * g.w * (1.f + sc.w) + sh.w;
            u32x2 o = { cvt_pk_bf16(hv[q].x, hv[q].y), cvt_pk_bf16(hv[q].z, hv[q].w) };
            *(u32x2*)((bf16_t*)(a.ws + WS_H) + (size_t)row * D + c) = o;
        }
        if (ROUTER) {
            float p[32];
#pragma unroll
            for (int e = 0; e < 32; ++e) {
                float s = 0.f;
#pragma unroll
                for (int q = 0; q < 4; ++q) { const float4 w = *(const float4*)(rwt + e * 1024 + q * 256 + lane * 4); s += hv[q].x * w.x + hv[q].y * w.y + hv[q].z * w.z + hv[q].w * w.w; }
                p[e] = s;
            }
#pragma unroll
            for (int i = 0; i < 16; ++i) { const bool hi = lane & 32; const float snd = hi ? p[i] : p[i + 16], kp = hi ? p[i + 16] : p[i]; p[i] = kp + __shfl_xor(snd, 32); }
#pragma unroll
            for (int i = 0; i < 8; ++i)  { const bool hi = lane & 16; const float snd = hi ? p[i] : p[i + 8],  kp = hi ? p[i + 8]  : p[i]; p[i] = kp + __shfl_xor(snd, 16); }
#pragma unroll
            for (int i = 0; i < 4; ++i)  { const bool hi = lane & 8;  const float snd = hi ? p[i] : p[i + 4],  kp = hi ? p[i + 4]  : p[i]; p[i] = kp + __shfl_xor(snd, 8); }
#pragma unroll
            for (int i = 0; i < 2; ++i)  { const bool hi = lane & 4;  const float snd = hi ? p[i] : p[i + 2],  kp = hi ? p[i + 2]  : p[i]; p[i] = kp + __shfl_xor(snd, 4); }
            { const bool hi = lane & 2; const float snd = hi ? p[0] : p[1], kp = hi ? p[1] : p[0]; p[0] = kp + __shfl_xor(snd, 2); }
            p[0] += __shfl_xor(p[0], 1);
            const int myE = ((lane >> 5) & 1) * 16 + ((lane >> 4) & 1) * 8 + ((lane >> 3) & 1) * 4 + ((lane >> 2) & 1) * 2 + ((lane >> 1) & 1);
            float v = p[0] + a.in[I_ERB][layer * 32 + myE];
            float tv[4]; int ti[4];
#pragma unroll
            for (int r = 0; r < 4; ++r) {
                float bv = v; int bi = myE;
#pragma unroll
                for (int o = 32; o >= 1; o >>= 1) { const float ov = __shfl_xor(bv, o); const int oi = __shfl_xor(bi, o); if (ov > bv || (ov == bv && oi < bi)) { bv = ov; bi = oi; } }
                tv[r] = bv; ti[r] = bi;
                if (myE == bi) v = -INFINITY;
            }
            {
                const float e1 = __expf(tv[1] - tv[0]), e2 = __expf(tv[2] - tv[0]), e3 = __expf(tv[3] - tv[0]);
                const float inv = 1.f / (1.f + e1 + e2 + e3);
                const int   me = lane == 0 ? ti[0] : (lane == 1 ? ti[1] : (lane == 2 ? ti[2] : ti[3]));
                const float mg = lane == 0 ? inv : (lane == 1 ? e1 * inv : (lane == 2 ? e2 * inv : e3 * inv));
                if (lane < 4) {
                    int* cnt = (int*)(a.ws + WS_CNT) + layer * 32;
                    const int slot = atomicAdd(&cnt[me], 1);
                    ((int*)(a.ws + WS_TOKL))[(size_t)me * T + slot] = row;
                    ((int*)(a.ws + WS_ASGE))[(size_t)row * 4 + lane] = (me << 24) | slot;
                    ((float*)(a.ws + WS_ASGG))[(size_t)row * 4 + lane] = mg;
                }
            }
        }
    }
}
struct ALoadMix {
    const bf16_t* H; const float* mu;
    __device__ __forceinline__ u32x4 load(int row, int k) const {
        const int within = row % RPB;
        const bool first = (within == 0) || (within == CTX), last = (within == CTX - 1) || (within == RPB - 1);
        const bf16_t* p = H + (size_t)row * D + k;
        const u32x4 c = *(const u32x4*)p;
        u32x4 pv = {0u, 0u, 0u, 0u}, nv = {0u, 0u, 0u, 0u};
        if (!first) pv = *(const u32x4*)(p - D);
        if (!last)  nv = *(const u32x4*)(p + D);
        const float4 m0 = *(const float4*)(mu + k), m1 = *(const float4*)(mu + k + 4);
        const float mm[8] = { m0.x, m0.y, m0.z, m0.w, m1.x, m1.y, m1.z, m1.w };
        u32x4 o;
#pragma unroll
        for (int i = 0; i < 4; ++i) {
            const float h0 = bf_lo(c[i]), h1 = bf_hi(c[i]);
            const float x0 = h0 + (0.5f * (bf_lo(pv[i]) + bf_lo(nv[i])) - h0) * mm[2 * i];
            const float x1 = h1 + (0.5f * (bf_hi(pv[i]) + bf_hi(nv[i])) - h1) * mm[2 * i + 1];
            o[i] = cvt_pk_bf16(x0, x1);
        }
        return o;
    }
};

__device__ __forceinline__ void phase_rwkv_proj1(const Args& a, unsigned char* lds, int j) {
    unsigned char* gl = lds + LDS_USER;
    const bf16_t* H = (const bf16_t*)(a.ws + WS_H);
    const int nl = (j == 0) ? 4 : 5, NU = 24 + nl;
    const float* mu = a.in[I_RMU] + (size_t)j * 6 * D;
    for (int u = blockIdx.x; u < 130 * NU; u += gridDim.x) {
        const int mt = u / NU, s = u - mt * NU, m0 = mt * 256;
        if (s < 24) {
            const int g = s >> 3, nt = s & 7;
            const int mi = (g == 0) ? 0 : (g == 1 ? 2 : 3);
            float* out = (float*)(a.ws + (g == 0 ? RW_R : (g == 1 ? RW_K : (j == 0 ? WS_VFIRST : RW_V))));
            const bf16_t* Bt = (const bf16_t*)(a.ws + WS_RKVT) + (size_t)(j * 3 + g) * D * D;
            ALoadMix al{ H, mu + mi * D };
            gemm_tile(al, Bt, D, 16, gl, make_epi([=](int row, int col, const f32x4& v) { *(f32x4*)(out + (size_t)row * D + col) = v; }), m0, nt * 128);
        } else {
            const int nt = s - 24;
            const int mi = (nt == 0) ? 1 : (nt == 1 ? 4 : (nt < 4 ? 5 : 3));
            const bf16_t* Bt = (const bf16_t*)(a.ws + WS_L1T) + (size_t)j * 640 * D;
            bf16_t* HL = (bf16_t*)(a.ws + RW_HL);
            ALoadMix al{ H, mu + mi * D };
            gemm_tile(al, Bt, D, 16, gl, make_epi([=](int row, int col, const f32x4& v) {
                float o[4];
#pragma unroll
                for (int i = 0; i < 4; ++i) { float x = v[i]; if (nt == 0) x = tanhf(x); else if (nt == 2 || nt == 3) x = sigmoidf_(x); o[i] = x; }
                u32x2 w = { cvt_pk_bf16(o[0], o[1]), cvt_pk_bf16(o[2], o[3]) };
                *(u32x2*)(HL + (size_t)row * 640 + col) = w;
            }), m0, nt * 128);
        }
    }
}
__device__ __forceinline__ void phase_rwkv_proj2(const Args& a, unsigned char* lds, int j) {
    unsigned char* gl = lds + LDS_USER;
    const bf16_t* HL = (const bf16_t*)(a.ws + RW_HL);
    const int NG = (j == 0) ? 5 : 6;
    for (int u = blockIdx.x; u < 130 * 8 * NG; u += gridDim.x) {
        const int mt = u / (8 * NG), s = u - mt * 8 * NG, g = s >> 3, nt = s & 7, m0 = mt * 256, n0 = nt * 128;
        if (g < 2) {
            const int d = g;
            float* out = (float*)(a.ws + (d == 0 ? RW_WD0 : RW_WD1));
            const float* w0 = a.in[I_RW0] + (size_t)(j * 2 + d) * D;
            ALoadPlain al{ HL + d * 64, 640 };
            gemm_tile(al, (const bf16_t*)(a.ws + WS_W2T) + (size_t)(j * 2 + d) * D * 64, 64, 1, gl, make_epi([=](int row, int col, const f32x4& v) {
                const float4 b = *(const float4*)(w0 + col); const float bb[4] = { b.x, b.y, b.z, b.w };
                f32x4 o;
#pragma unroll
                for (int i = 0; i < 4; ++i) {
                    const float z = -(bb[i] + v[i]);
                    const float sp = fmaxf(z, 0.f) + log1pf(__expf(-fabsf(z)));
                    const float wl = -sp - 0.5f;
                    o[i] = __expf(-__expf(wl));
                }
                *(f32x4*)(out + (size_t)row * D + col) = o;
            }), m0, n0);
        } else if (g < 4) {
            const int d = g - 2;
            float* out = (float*)(a.ws + (d == 0 ? RW_AD0 : RW_AD1));
            const float* a0 = a.in[I_RA0] + (size_t)(j * 2 + d) * D;
            ALoadPlain al{ HL + 128 + d * 64, 640 };
            gemm_tile(al, (const bf16_t*)(a.ws + WS_A2T) + (size_t)(j * 2 + d) * D * 64, 64, 1, gl, make_epi([=](int row, int col, const f32x4& v) {
                const float4 b = *(const float4*)(a0 + col);
                f32x4 o = { sigmoidf_(b.x + v[0]), sigmoidf_(b.y + v[1]), sigmoidf_(b.z + v[2]), sigmoidf_(b.w + v[3]) };
                *(f32x4*)(out + (size_t)row * D + col) = o;
            }), m0, n0);
        } else if (g == 4) {
            float* out = (float*)(a.ws + RW_G);
            ALoadPlain al{ HL + 256, 640 };
            gemm_tile(al, (const bf16_t*)(a.ws + WS_G2T) + (size_t)j * D * 192, 192, 3, gl, make_epi([=](int row, int col, const f32x4& v) { *(f32x4*)(out + (size_t)row * D + col) = v; }), m0, n0);
        } else {
            float* V = (float*)(a.ws + RW_V);
            const float* VF = (const float*)(a.ws + WS_VFIRST);
            const float* v0 = a.in[I_RV0];
            ALoadPlain al{ HL + 512, 640 };
            gemm_tile(al, (const bf16_t*)(a.ws + WS_V2T), 64, 1, gl, make_epi([=](int row, int col, const f32x4& v) {
                const float4 b = *(const float4*)(v0 + col);
                const f32x4 cur = *(const f32x4*)(V + (size_t)row * D + col), vf = *(const f32x4*)(VF + (size_t)row * D + col);
                f32x4 o = { cur[0] + (vf[0] - cur[0]) * sigmoidf_(b.x + v[0]), cur[1] + (vf[1] - cur[1]) * sigmoidf_(b.y + v[1]),
                            cur[2] + (vf[2] - cur[2]) * sigmoidf_(b.z + v[2]), cur[3] + (vf[3] - cur[3]) * sigmoidf_(b.w + v[3]) };
                *(f32x4*)(V + (size_t)row * D + col) = o;
            }), m0, n0);
        }
    }
}
constexpr int WK_CH = 32;
constexpr int WK_VEC = 5 * WK_CH * 64 * 4, WK_VQ = WK_CH * 16 * 4, WK_BUF = WK_VEC + WK_VQ;
__device__ __forceinline__ void phase_wkv(const Args& a, unsigned char* lds, int j) {
    const int tid = otid(), lane = tid & 63, wid = tid >> 6;
    unsigned char* base = lds + LDS_USER;
    float* ybuf = (float*)(base + 2 * WK_BUF);
    const float* R = (const float*)(a.ws + RW_R); const float* K = (const float*)(a.ws + RW_K);
    const float* V = (const float*)(a.ws + (j == 0 ? WS_VFIRST : RW_V));
    for (int unit = blockIdx.x; unit < 256; unit += gridDim.x) {
        const int chain = unit >> 2, qv = unit & 3, b = chain >> 5, h = (chain >> 1) & 15, d = chain & 1;
        const float* WD = (const float*)(a.ws + (d == 0 ? RW_WD0 : RW_WD1));
        const float* AD = (const float*)(a.ws + (d == 0 ? RW_AD0 : RW_AD1));
        float* Y = (float*)(a.ws + (d == 0 ? RW_Y0 : RW_Y1));
        const int ch0 = h * 64;
        const float kkw = a.in[I_RKK][j * D + ch0 + lane], kaw = a.in[I_RKA][j * D + ch0 + lane];
        auto rowof = [&](int t) -> size_t { const int p = (d == 0) ? t : ((t < CTX) ? (CTX - 1 - t) : (RPB + CTX - 1 - t)); return (size_t)b * RPB + p; };
        auto stage = [&](int c, int buf) {
            float* vec = (float*)(base + buf * WK_BUF); float* vq = (float*)(base + buf * WK_BUF + WK_VEC);
            const int sw = wid - 4;
#pragma unroll 2
            for (int i = 0; i < 8; ++i) {
                const int s = sw * 8 + i; const size_t row = rowof(c * WK_CH + s); const size_t o = row * D + ch0 + lane;
                const float r = R[o], k = K[o], w = WD[o], av = AD[o];
                const float kkv = k * kkw;
                const float n2 = wave_sum(kkv * kkv);
                const float kk = kkv / fmaxf(sqrtf(n2), 1e-12f);
                vec[(0 * WK_CH + s) * 64 + lane] = r; vec[(1 * WK_CH + s) * 64 + lane] = w; vec[(2 * WK_CH + s) * 64 + lane] = kk;
                vec[(3 * WK_CH + s) * 64 + lane] = kk * av; vec[(4 * WK_CH + s) * 64 + lane] = k * (1.f + (av - 1.f) * kaw);
                if (lane < 16) vq[s * 16 + lane] = V[row * D + ch0 + qv * 16 + lane];
            }
        };
        auto yout = [&](int c, int buf) {
            const int st = tid - 256;
#pragma unroll
            for (int i = 0; i < 2; ++i) { const int idx = st + i * 256, s = idx >> 4, i16 = idx & 15; Y[rowof(c * WK_CH + s) * D + ch0 + qv * 16 + i16] = ybuf[buf * 512 + idx]; }
        };
        constexpr int NCH = RPB / WK_CH;
        float S0 = 0.f, S1 = 0.f, S2 = 0.f, S3 = 0.f;
        const int vl = (wid & 3) * 4 + (lane >> 4), k0 = (lane & 15) * 4;
        if (wid >= 4) stage(0, 0);
        __syncthreads();
        for (int c = 0; c < NCH; ++c) {
            if (wid >= 4) {
                if (c + 1 < NCH) stage(c + 1, (c + 1) & 1);
                if (c > 0) yout(c - 1, (c - 1) & 1);
            } else {
                const float* vec = (const float*)(base + (c & 1) * WK_BUF); const float* vq = (const float*)(base + (c & 1) * WK_BUF + WK_VEC);
                float* yb = ybuf + (c & 1) * 512;
#pragma unroll 4
                for (int s = 0; s < WK_CH; ++s) {
                    const float4 r4 = *(const float4*)(vec + (0 * WK_CH + s) * 64 + k0), w4 = *(const float4*)(vec + (1 * WK_CH + s) * 64 + k0);
                    const float4 kk4 = *(const float4*)(vec + (2 * WK_CH + s) * 64 + k0), ka4 = *(const float4*)(vec + (3 * WK_CH + s) * 64 + k0);
                    const float4 kd4 = *(const float4*)(vec + (4 * WK_CH + s) * 64 + k0);
                    const float vv = vq[s * 16 + vl];
                    float sa = S0 * kk4.x + S1 * kk4.y + S2 * kk4.z + S3 * kk4.w;
                    sa = -row16_sum(sa);
                    S0 = S0 * w4.x + sa * ka4.x + vv * kd4.x; S1 = S1 * w4.y + sa * ka4.y + vv * kd4.y;
                    S2 = S2 * w4.z + sa * ka4.z + vv * kd4.z; S3 = S3 * w4.w + sa * ka4.w + vv * kd4.w;
                    float y = S0 * r4.x + S1 * r4.y + S2 * r4.z + S3 * r4.w;
                    y = row16_sum(y);
                    if ((lane & 15) == 0) yb[s * 16 + vl] = y;
                }
            }
            __syncthreads();
        }
        if (wid >= 4) yout(NCH - 1, (NCH - 1) & 1);
        __syncthreads();
    }
}
__device__ __forceinline__ void phase_rwkv_readout(const Args& a, int j) {
    const int tid = otid(), lane = tid & 63, wid = tid >> 6;
    const float* R = (const float*)(a.ws + RW_R); const float* K = (const float*)(a.ws + RW_K);
    const float* V = (const float*)(a.ws + (j == 0 ? WS_VFIRST : RW_V)); const float* G = (const float*)(a.ws + RW_G);
    const float* A0 = (const float*)(a.ws + RW_AD0); const float* A1 = (const float*)(a.ws + RW_AD1);
    const float* Y0 = (const float*)(a.ws + RW_Y0); const float* Y1 = (const float*)(a.ws + RW_Y1);
    bf16_t* Z = (bf16_t*)(a.ws + RW_Z);
    const float* lng = a.in[I_RLNG] + j * D; const float* lnb = a.in[I_RLNB] + j * D; const float* rk = a.in[I_RRK] + j * D; const float* ka = a.in[I_RKA] + j * D;
    for (int row = blockIdx.x * 8 + wid; row < T; row += gridDim.x * 8) {
#pragma unroll
        for (int q = 0; q < 4; ++q) {
            const int c = q * 256 + lane * 4; const size_t o = (size_t)row * D + c;
            const float4 y0 = *(const float4*)(Y0 + o), y1 = *(const float4*)(Y1 + o);
            const float y[4] = { y0.x + y1.x, y0.y + y1.y, y0.z + y1.z, y0.w + y1.w };
            const float mean = row16_sum(y[0] + y[1] + y[2] + y[3]) * (1.f / 64.f);
            float dv = 0.f;
#pragma unroll
            for (int i = 0; i < 4; ++i) dv += (y[i] - mean) * (y[i] - mean);
            const float rs = rsqrtf(row16_sum(dv) * (1.f / 64.f) + 64e-5f);
            const float4 r4 = *(const float4*)(R + o), k4 = *(const float4*)(K + o), v4 = *(const float4*)(V + o), g4 = *(const float4*)(G + o);
            const float4 a04 = *(const float4*)(A0 + o), a14 = *(const float4*)(A1 + o);
            const float4 lg = *(const float4*)(lng + c), lb = *(const float4*)(lnb + c), rk4 = *(const float4*)(rk + c), ka4 = *(const float4*)(ka + c);
            const float rr[4] = { r4.x, r4.y, r4.z, r4.w }, kk[4] = { k4.x, k4.y, k4.z, k4.w }, vv[4] = { v4.x, v4.y, v4.z, v4.w }, gg[4] = { g4.x, g4.y, g4.z, g4.w };
            const float aa[4] = { a04.x + a14.x, a04.y + a14.y, a04.z + a14.z, a04.w + a14.w };
            const float lgv[4] = { lg.x, lg.y, lg.z, lg.w }, lbv[4] = { lb.x, lb.y, lb.z, lb.w }, rkv[4] = { rk4.x, rk4.y, rk4.z, rk4.w }, kav[4] = { ka4.x, ka4.y, ka4.z, ka4.w };
            float bp = 0.f;
#pragma unroll
            for (int i = 0; i < 4; ++i) bp += rr[i] * kk[i] * rkv[i] * (2.f + (aa[i] - 2.f) * kav[i]);
            const float bonus = row16_sum(bp);
            float o4[4];
#pragma unroll
            for (int i = 0; i < 4; ++i) o4[i] = ((y[i] - mean) * rs * lgv[i] + lbv[i] + bonus * vv[i]) * gg[i];
            u32x2 w = { cvt_pk_bf16(o4[0], o4[1]), cvt_pk_bf16(o4[2], o4[3]) };
            *(u32x2*)(Z + o) = w;
        }
    }
}
__device__ __forceinline__ void phase_outproj(const Args& a, unsigned char* lds, int layer, const bf16_t* A, const bf16_t* Bt, const float* bias) {
    unsigned char* gl = lds + LDS_USER;
    float* X = (float*)(a.ws + WS_X);
    const float* modbase = (const float*)(a.ws + WS_MOD) + (size_t)layer * 3 * 6144 + 2 * 1024;
    for (int u = blockIdx.x; u < 130 * 8; u += gridDim.x) {
        const int mt = u >> 3, nt = u & 7;
        ALoadPlain al{ A, D };
        gemm_tile(al, Bt, D, 16, gl, make_epi([=](int row, int col, const f32x4& v) {
            const float4 g = *(const float4*)(modbase + (size_t)mod_index(row) * 6144 + col);
            float4 bv = make_float4(0.f, 0.f, 0.f, 0.f);
            if (bias) bv = *(const float4*)(bias + col);
            f32x4 x = *(f32x4*)(X + (size_t)row * D + col);
            x[0] += g.x * (v[0] + bv.x); x[1] += g.y * (v[1] + bv.y); x[2] += g.z * (v[2] + bv.z); x[3] += g.w * (v[3] + bv.w);
            *(f32x4*)(X + (size_t)row * D + col) = x;
        }), mt * 256, nt * 128);
    }
}

struct ALoadGather {
    const bf16_t* H; const int* tl; int rowbase, cnt;
    __device__ __forceinline__ u32x4 load(int row, int k) const {
        int idx = row - rowbase; idx = idx < cnt ? idx : cnt - 1;
        return *(const u32x4*)(H + (size_t)tl[idx] * D + k);
    }
};
__device__ __forceinline__ void moe_tiles(const Args& a, int layer, int* tp) {
    if (threadIdx.x == 0) {
        const int* cnt = (const int*)(a.ws + WS_CNT) + layer * 32;
        int acc = 0;
        for (int e = 0; e < 32; ++e) { tp[e] = acc; acc += (cnt[e] + 255) >> 8; }
        tp[32] = acc;
    }
    __syncthreads();
}
__device__ __forceinline__ void phase_moe1(const Args& a, unsigned char* lds, int layer) {
    int* tp = (int*)(lds + LDS_USER); unsigned char* gl = lds + LDS_USER + 256;
    moe_tiles(a, layer, tp);
    const int total = tp[32];
    const int* cnt = (const int*)(a.ws + WS_CNT) + layer * 32;
    bf16_t* ACT = (bf16_t*)(a.ws + WS_ACT);
    for (int u = blockIdx.x; u < total * 16; u += gridDim.x) {
        const int rt = u >> 4, nt = u & 15;
        int e = 0;
        while (tp[e + 1] <= rt) ++e;
        const int tile = rt - tp[e], ce = cnt[e];
        const float* bin = a.in[I_EBIN] + ((size_t)layer * 32 + e) * 2048;
        ALoadGather al{ (const bf16_t*)(a.ws + WS_H), (const int*)(a.ws + WS_TOKL) + (size_t)e * T, tp[e] * 256, ce };
        const bf16_t* Bt = (const bf16_t*)(a.ws + WS_EWINT) + ((size_t)layer * 32 + e) * 2048 * D;
        auto ep = [=](const f32x4 (&acc)[4][4], int rbase, int cbase, int fr, int fq) {
#pragma unroll
            for (int mi = 0; mi < 4; ++mi)
#pragma unroll
                for (int ni = 0; ni < 2; ++ni) {
                    const int row = rbase + mi * 16 + fr, colg = (cbase >> 1) + ni * 16 + fq * 4;
                    const float4 bg = *(const float4*)(bin + colg), bl = *(const float4*)(bin + 1024 + colg);
                    const float bgv[4] = { bg.x, bg.y, bg.z, bg.w }, blv[4] = { bl.x, bl.y, bl.z, bl.w };
                    float o[4];
#pragma unroll
                    for (int i = 0; i < 4; ++i) {
                        const float glu = fminf(acc[mi][ni][i] + bgv[i], 7.f);
                        const float lin = fminf(fmaxf(acc[mi][ni + 2][i] + blv[i], -7.f), 7.f);
                        o[i] = glu * sigmoidf_(1.702f * glu) * (lin + 1.f);
                    }
                    u32x2 w = { cvt_pk_bf16(o[0], o[1]), cvt_pk_bf16(o[2], o[3]) };
                    *(u32x2*)(ACT + (size_t)row * D + colg) = w;
                }
        };
        gemm_tile(al, Bt, D, 16, gl, ep, rt * 256, nt * 128);
    }
}
__device__ __forceinline__ void phase_moe2(const Args& a, unsigned char* lds, int layer) {
    int* tp = (int*)(lds + LDS_USER); unsigned char* gl = lds + LDS_USER + 256;
    moe_tiles(a, layer, tp);
    const int total = tp[32];
    bf16_t* YB = (bf16_t*)(a.ws + WS_YB);
    for (int u = blockIdx.x; u < total * 8; u += gridDim.x) {
        const int rt = u >> 3, nt = u & 7;
        int e = 0;
        while (tp[e + 1] <= rt) ++e;
        const float* bout = a.in[I_EBOUT] + ((size_t)layer * 32 + e) * D;
        ALoadPlain al{ (const bf16_t*)(a.ws + WS_ACT), D };
        const bf16_t* Bt = (const bf16_t*)(a.ws + WS_EWOUTT) + ((size_t)layer * 32 + e) * D * D;
        gemm_tile(al, Bt, D, 16, gl, make_epi([=](int row, int col, const f32x4& v) {
            const float4 bv = *(const float4*)(bout + col);
            u32x2 w = { cvt_pk_bf16(v[0] + bv.x, v[1] + bv.y), cvt_pk_bf16(v[2] + bv.z, v[3] + bv.w) };
            *(u32x2*)(YB + (size_t)row * D + col) = w;
        }), rt * 256, nt * 128);
    }
}

constexpr size_t HY_UU   = WS_MIX;
constexpr size_t HY_X0   = HY_UU + (size_t)T * 3072 * 2;
constexpr size_t HY_X0ZB = HY_X0 + (size_t)T * D * 2;
constexpr size_t HY_P    = HY_X0ZB + (size_t)T * D * 2;
constexpr size_t HY_ZT   = HY_P + (size_t)T * D * 2;
constexpr size_t HY_ZC   = HY_ZT + (size_t)D * 2 * SEQ * 4;
constexpr size_t HY_HF   = HY_ZC + (size_t)2 * CTX * D * 4;
constexpr size_t HY_HB   = HY_HF + (size_t)D * SEQ * 4;
constexpr size_t HY_HFC  = HY_HB + (size_t)D * SEQ * 4;
constexpr size_t HY_HBC  = HY_HFC + (size_t)CTX * D * 4;
constexpr size_t HY_FS   = HY_HBC + (size_t)CTX * D * 4;
constexpr size_t HY_U    = HY_FS + (size_t)2 * D * SEQ * 8;
constexpr size_t HY_END  = HY_U + (size_t)2 * D * 2 * SEQ * 4;
constexpr int FFT_N = 16384;

__device__ __forceinline__ float2 cmul(float2 a, float2 b) { return make_float2(a.x * b.x - a.y * b.y, a.x * b.y + a.y * b.x); }
__device__ __forceinline__ float2 cmulc(float2 a, float2 b) { return make_float2(a.x * b.x + a.y * b.y, a.y * b.x - a.x * b.y); }

__device__ __forceinline__ void fft_fwd(float2* x, const float2* tw) {
    const int tid = otid();
#pragma unroll 1
    for (int lq = 12; lq >= 0; lq -= 2) {
        const int q = 1 << lq, tws = FFT_N >> (lq + 2);
#pragma unroll 2
        for (int i = 0; i < 8; ++i) {
            const int u = tid + i * 512, j = u & (q - 1), B = (u >> lq) << (lq + 2);
            float2* p = x + B + j;
            const float2 a0 = p[0], a1 = p[q], a2 = p[2 * q], a3 = p[3 * q];
            const float2 t0 = make_float2(a0.x + a2.x, a0.y + a2.y), t1 = make_float2(a0.x - a2.x, a0.y - a2.y);
            const float2 t2 = make_float2(a1.x + a3.x, a1.y + a3.y);
            const float2 d = make_float2(a1.x - a3.x, a1.y - a3.y), t3 = make_float2(d.y, -d.x);
            const float2 y0 = make_float2(t0.x + t2.x, t0.y + t2.y), y1 = make_float2(t1.x + t3.x, t1.y + t3.y);
            const float2 y2 = make_float2(t0.x - t2.x, t0.y - t2.y), y3 = make_float2(t1.x - t3.x, t1.y - t3.y);
            if (q > 1) {
                const float2 w1 = tw[j * tws], w2 = tw[2 * j * tws], w3 = tw[3 * j * tws];
                p[0] = y0; p[q] = cmul(y1, w1); p[2 * q] = cmul(y2, w2); p[3 * q] = cmul(y3, w3);
            } else { p[0] = y0; p[1] = y1; p[2] = y2; p[3] = y3; }
        }
        __syncthreads();
    }
}
__device__ __forceinline__ void fft_inv(float2* x, const float2* tw) {
    const int tid = otid();
#pragma unroll 1
    for (int lq = 0; lq <= 12; lq += 2) {
        const int q = 1 << lq, tws = FFT_N >> (lq + 2);
#pragma unroll 2
        for (int i = 0; i < 8; ++i) {
            const int u = tid + i * 512, j = u & (q - 1), B = (u >> lq) << (lq + 2);
            float2* p = x + B + j;
            float2 b0 = p[0], b1 = p[q], b2 = p[2 * q], b3 = p[3 * q];
            if (q > 1) { const float2 w1 = tw[j * tws], w2 = tw[2 * j * tws], w3 = tw[3 * j * tws]; b1 = cmulc(b1, w1); b2 = cmulc(b2, w2); b3 = cmulc(b3, w3); }
            const float2 t0 = make_float2(b0.x + b2.x, b0.y + b2.y), t1 = make_float2(b0.x - b2.x, b0.y - b2.y);
            const float2 t2 = make_float2(b1.x + b3.x, b1.y + b3.y);
            const float2 d = make_float2(b1.x - b3.x, b1.y - b3.y), t3 = make_float2(-d.y, d.x);
            p[0] = make_float2(t0.x + t2.x, t0.y + t2.y); p[q] = make_float2(t1.x + t3.x, t1.y + t3.y);
            p[2 * q] = make_float2(t0.x - t2.x, t0.y - t2.y); p[3 * q] = make_float2(t1.x - t3.x, t1.y - t3.y);
        }
        __syncthreads();
    }
}

__device__ __forceinline__ void phase_hy_filters(const Args& a, unsigned char* lds) {
    const int tid = otid();
    float* zemb = (float*)(lds + LDS_USER);
    float* hA = zemb + 64 * 36;
    float* hB = hA + 64 * 68;
    const float* w1 = a.in[I_HFW1]; const float* b1 = a.in[I_HFB1]; const float* w2 = a.in[I_HFW2]; const float* b2 = a.in[I_HFB2];
    const float* w3 = a.in[I_HFW3]; const float* b3 = a.in[I_HFB3]; const float* fr = a.in[I_HFREQ]; const float* wo = a.in[I_HFWOUT];
    for (int u = blockIdx.x; u < 260; u += gridDim.x) {
        const bool isctx = u >= 256;
        const int Lh = isctx ? CTX : SEQ, n0 = (isctx ? (u - 256) : u) * 64;
        for (int it = tid; it < 64 * 33; it += NT) {
            const int p = it / 33, e = it - p * 33, n = n0 + p;
            float v;
            if (e == 0) v = (float)n / (float)(Lh - 1);
            else {
                const int bi = (e - 1) & 15;
                const float f = 1e-4f + (float)bi * ((15.0f - 1e-4f) / 15.0f);
                const float ang = 2.0f * 3.14159265358979323846f * f * (float)n / (float)Lh;
                v = (e <= 16) ? cos_acc(ang) : -sin_acc(ang);
            }
            zemb[p * 36 + e] = v;
        }
        __syncthreads();
        {
            const int p = tid & 63, h0 = (tid >> 6) * 8;
            float acc[8];
#pragma unroll
            for (int i = 0; i < 8; ++i) acc[i] = b1[h0 + i];
#pragma unroll 1
            for (int k = 0; k < 33; ++k) { const float zv = zemb[p * 36 + k];
#pragma unroll
                for (int i = 0; i < 8; ++i) acc[i] += zv * w1[k * 64 + h0 + i]; }
#pragma unroll
            for (int i = 0; i < 8; ++i) hA[p * 68 + h0 + i] = sin_acc(fr[h0 + i] * acc[i]);
            __syncthreads();
#pragma unroll
            for (int i = 0; i < 8; ++i) acc[i] = b2[h0 + i];
#pragma unroll 2
            for (int k = 0; k < 64; ++k) { const float hv = hA[p * 68 + k];
#pragma unroll
                for (int i = 0; i < 8; ++i) acc[i] += hv * w2[k * 64 + h0 + i]; }
#pragma unroll
            for (int i = 0; i < 8; ++i) hB[p * 68 + h0 + i] = sin_acc(fr[64 + h0 + i] * acc[i]);
            __syncthreads();
#pragma unroll
            for (int i = 0; i < 8; ++i) acc[i] = b3[h0 + i];
#pragma unroll 2
            for (int k = 0; k < 64; ++k) { const float hv = hB[p * 68 + k];
#pragma unroll
                for (int i = 0; i < 8; ++i) acc[i] += hv * w3[k * 64 + h0 + i]; }
            __syncthreads();
#pragma unroll
            for (int i = 0; i < 8; ++i) hA[p * 68 + h0 + i] = sin_acc(fr[128 + h0 + i] * acc[i]);
            __syncthreads();
        }
        {
            const int c0 = tid * 4;
            const int ch = c0 & 1023;
            float dl[4];
#pragma unroll
            for (int jj = 0; jj < 4; ++jj) dl[jj] = fabsf(-15.350567286626973f + (float)(ch + jj) * ((-3.0701134573253946f + 15.350567286626973f) / 1023.0f));
#pragma unroll 1
            for (int half = 0; half < 4; ++half) {
                float acc[4][16];
#pragma unroll
                for (int jj = 0; jj < 4; ++jj)
#pragma unroll
                    for (int p = 0; p < 16; ++p) acc[jj][p] = 0.f;
#pragma unroll 1
                for (int k = 0; k < 64; k += 4) {
                    float4 wv[4];
#pragma unroll
                    for (int kk = 0; kk < 4; ++kk) wv[kk] = *(const float4*)(wo + (size_t)(k + kk) * 2048 + c0);
#pragma unroll
                    for (int p = 0; p < 16; ++p) {
                        const float4 hv = *(const float4*)(hA + (half * 16 + p) * 68 + k);
                        acc[0][p] += hv.x * wv[0].x + hv.y * wv[1].x + hv.z * wv[2].x + hv.w * wv[3].x;
                        acc[1][p] += hv.x * wv[0].y + hv.y * wv[1].y + hv.z * wv[2].y + hv.w * wv[3].y;
                        acc[2][p] += hv.x * wv[0].z + hv.y * wv[1].z + hv.z * wv[2].z + hv.w * wv[3].z;
                        acc[3][p] += hv.x * wv[0].w + hv.y * wv[1].w + hv.z * wv[2].w + hv.w * wv[3].w;
                    }
                }
                if (!isctx) {
                    float* dst = (float*)(a.ws + (c0 < 1024 ? HY_HF : HY_HB));
#pragma unroll
                    for (int jj = 0; jj < 4; ++jj) {
#pragma unroll
                        for (int p4 = 0; p4 < 4; ++p4) {
                            float o[4];
#pragma unroll
                            for (int pp = 0; pp < 4; ++pp) { const int n = n0 + half * 16 + p4 * 4 + pp; o[pp] = acc[jj][p4 * 4 + pp] * __expf(-((float)n / (float)(SEQ - 1)) * dl[jj]); }
                            *(float4*)(dst + (size_t)(ch + jj) * SEQ + n0 + half * 16 + p4 * 4) = make_float4(o[0], o[1], o[2], o[3]);
                        }
                    }
                } else {
                    float* dst = (float*)(a.ws + (c0 < 1024 ? HY_HFC : HY_HBC));
#pragma unroll
                    for (int p = 0; p < 16; ++p) {
                        const int n = n0 + half * 16 + p; const float tn = (float)n / (float)(CTX - 1);
                        *(float4*)(dst + (size_t)n * D + ch) = make_float4(acc[0][p] * __expf(-tn * dl[0]), acc[1][p] * __expf(-tn * dl[1]), acc[2][p] * __expf(-tn * dl[2]), acc[3][p] * __expf(-tn * dl[3]));
                    }
                }
            }
        }
        __syncthreads();
    }
}
__device__ __forceinline__ void phase_hy_filter_fft(const Args& a, unsigned char* lds) {
    const int tid = otid();
    float2* x = (float2*)(lds + LDS_USER);
    const float2* tw1 = (const float2*)(a.ws + WS_TW1); const float2* tw2 = (const float2*)(a.ws + WS_TW2);
    for (int u = blockIdx.x; u < 2048; u += gridDim.x) {
        const int c = u >> 1, par = u & 1;
        const float* hf = (const float*)(a.ws + HY_HF) + (size_t)c * SEQ; const float* hb = (const float*)(a.ws + HY_HB) + (size_t)c * SEQ;
        for (int n = tid; n < SEQ; n += NT) {
            const float f0 = hf[n], f1 = (n == 0) ? 0.f : hb[SEQ - n];
            if (par == 0) x[n] = make_float2(f0 + f1, 0.f);
            else { const float2 w = tw2[n]; const float dd = f0 - f1; x[n] = make_float2(dd * w.x, dd * w.y); }
        }
        __syncthreads();
        fft_fwd(x, tw1);
        float2* dst = (float2*)(a.ws + HY_FS) + ((size_t)par * D + c) * SEQ;
        for (int n = tid; n < SEQ; n += NT) dst[n] = x[n];
        __syncthreads();
    }
}
__device__ __forceinline__ void phase_hy_in(const Args& a, unsigned char* lds) {
    unsigned char* gl = lds + LDS_USER;
    bf16_t* UU = (bf16_t*)(a.ws + HY_UU);
    const float* bin = a.in[I_HBIN];
    for (int u = blockIdx.x; u < 130 * 24; u += gridDim.x) {
        const int mt = u / 24, nt = u - mt * 24;
        ALoadPlain al{ (const bf16_t*)(a.ws + WS_H), D };
        gemm_tile(al, (const bf16_t*)(a.ws + WS_HYINT), D, 16, gl, make_epi([=](int row, int col, const f32x4& v) {
            const float4 b = *(const float4*)(bin + col);
            u32x2 w = { cvt_pk_bf16(v[0] + b.x, v[1] + b.y), cvt_pk_bf16(v[2] + b.z, v[3] + b.w) };
            *(u32x2*)(UU + (size_t)row * 3072 + col) = w;
        }), mt * 256, nt * 128);
    }
}
__device__ __forceinline__ void phase_hy_short(const Args& a, unsigned char* lds) {
    const int tid = otid();
    float* zt = (float*)(lds + LDS_USER);
    const bf16_t* UU = (const bf16_t*)(a.ws + HY_UU);
    const float* sw = a.in[I_HSW]; const float* sb = a.in[I_HSB]; const float* bias = a.in[I_HBIAS];
    for (int u = blockIdx.x; u < 520 * 4; u += gridDim.x) {
        const int rb = u >> 2, cc = u & 3, row0 = rb * 64, b = row0 / RPB, within0 = row0 - b * RPB;
        const bool isctx = within0 < CTX;
        const int c4 = tid & 63, rg = tid >> 6, cl = c4 * 4, c = cc * 256 + cl;
        float wt[3][3][4], bs[3][4];
#pragma unroll
        for (int g = 0; g < 3; ++g) {
#pragma unroll
            for (int tp = 0; tp < 3; ++tp) { const float4 w = *(const float4*)(sw + (size_t)tp * 3072 + g * 1024 + c); wt[g][tp][0] = w.x; wt[g][tp][1] = w.y; wt[g][tp][2] = w.z; wt[g][tp][3] = w.w; }
            const float4 bb = *(const float4*)(sb + g * 1024 + c); bs[g][0] = bb.x; bs[g][1] = bb.y; bs[g][2] = bb.z; bs[g][3] = bb.w;
        }
        const float4 bi4 = *(const float4*)(bias + c); const float bi[4] = { bi4.x, bi4.y, bi4.z, bi4.w };
        auto ld = [&](int row, int g, float (&o)[4]) {
            const int w = row - b * RPB;
            const bool valid = isctx ? (w >= 0 && w < CTX) : (w >= CTX && w < RPB);
            if (valid) { const u32x2 v = *(const u32x2*)(UU + (size_t)row * 3072 + g * 1024 + c); o[0] = bf_lo(v[0]); o[1] = bf_hi(v[0]); o[2] = bf_lo(v[1]); o[3] = bf_hi(v[1]); }
            else { o[0] = o[1] = o[2] = o[3] = 0.f; }
        };
        float pv[3][4], cv[3][4], nv[3][4];
        const int r0 = row0 + rg * 8;
#pragma unroll
        for (int g = 0; g < 3; ++g) { ld(r0 - 1, g, pv[g]); ld(r0, g, cv[g]); }
#pragma unroll 1
        for (int i = 0; i < 8; ++i) {
            const int row = r0 + i;
#pragma unroll
            for (int g = 0; g < 3; ++g) ld(row + 1, g, nv[g]);
            float uo[3][4];
#pragma unroll
            for (int g = 0; g < 3; ++g)
#pragma unroll
                for (int q = 0; q < 4; ++q) uo[g][q] = pv[g][q] * wt[g][0][q] + cv[g][q] * wt[g][1][q] + nv[g][q] * wt[g][2][q] + bs[g][q];
            float z[4], xz[4];
#pragma unroll
            for (int q = 0; q < 4; ++q) { z[q] = uo[2][q] * uo[1][q]; xz[q] = uo[0][q] * z[q] * bi[q]; }
            u32x2 o0 = { cvt_pk_bf16(uo[0][0], uo[0][1]), cvt_pk_bf16(uo[0][2], uo[0][3]) }, o1 = { cvt_pk_bf16(xz[0], xz[1]), cvt_pk_bf16(xz[2], xz[3]) };
            *(u32x2*)((bf16_t*)(a.ws + HY_X0) + (size_t)row * D + c) = o0;
            *(u32x2*)((bf16_t*)(a.ws + HY_X0ZB) + (size_t)row * D + c) = o1;
            if (isctx) *(float4*)((float*)(a.ws + HY_ZC) + ((size_t)b * CTX + (within0 + rg * 8 + i)) * D + c) = make_float4(z[0], z[1], z[2], z[3]);
            else {
#pragma unroll
                for (int q = 0; q < 4; ++q) zt[(cl + q) * 65 + rg * 8 + i] = z[q];
            }
#pragma unroll
            for (int g = 0; g < 3; ++g)
#pragma unroll
                for (int q = 0; q < 4; ++q) { pv[g][q] = cv[g][q]; cv[g][q] = nv[g][q]; }
        }
        __syncthreads();
        if (!isctx) {
            const int t0 = within0 - CTX;
#pragma unroll
            for (int i = 0; i < 8; ++i) {
                const int idx = tid + i * 512, ch = idx >> 4, t4 = (idx & 15) * 4;
                const float* s = zt + ch * 65 + t4;
                *(float4*)((float*)(a.ws + HY_ZT) + ((size_t)(cc * 256 + ch) * 2 + b) * SEQ + t0 + t4) = make_float4(s[0], s[1], s[2], s[3]);
            }
        }
        __syncthreads();
    }
}
__device__ __forceinline__ void phase_hy_fftconv(const Args& a, unsigned char* lds) {
    const int tid = otid();
    float2* x = (float2*)(lds + LDS_USER);
    const float2* tw1 = (const float2*)(a.ws + WS_TW1); const float2* tw2 = (const float2*)(a.ws + WS_TW2);
    for (int u = blockIdx.x; u < 2048; u += gridDim.x) {
        const int c = u >> 1, par = u & 1;
        const float* z0 = (const float*)(a.ws + HY_ZT) + (size_t)c * 2 * SEQ; const float* z1 = z0 + SEQ;
        for (int n = tid; n < SEQ; n += NT) {
            float2 v = make_float2(z0[n], z1[n]);
            if (par) v = cmul(v, tw2[n]);
            x[n] = v;
        }
        __syncthreads();
        fft_fwd(x, tw1);
        const float2* fs = (const float2*)(a.ws + HY_FS) + ((size_t)par * D + c) * SEQ;
        for (int n = tid; n < SEQ; n += NT) x[n] = cmul(x[n], fs[n]);
        __syncthreads();
        fft_inv(x, tw1);
        float* u0 = (float*)(a.ws + HY_U) + ((size_t)par * D + c) * 2 * SEQ; float* u1 = u0 + SEQ;
        for (int n = tid; n < SEQ; n += NT) { const float2 v = x[n]; u0[n] = v.x; u1[n] = v.y; }
        __syncthreads();
    }
}
__device__ __forceinline__ void phase_hy_combine(const Args& a, unsigned char* lds) {
    const int tid = otid();
    float* tile = (float*)(lds + LDS_USER);
    const float2* tw2 = (const float2*)(a.ws + WS_TW2);
    bf16_t* P = (bf16_t*)(a.ws + HY_P);
    const bf16_t* X0 = (const bf16_t*)(a.ws + HY_X0); const bf16_t* X0ZB = (const bf16_t*)(a.ws + HY_X0ZB);
    for (int u = blockIdx.x; u < 128; u += gridDim.x) {
        const int b = u >> 6, tg = (u >> 1) & 31, c = (u & 1) * 512 + tid, t0 = tg * 8;
        const float* z = (const float*)(a.ws + HY_ZC) + (size_t)b * CTX * D + c;
        const float* hf = (const float*)(a.ws + HY_HFC) + c; const float* hb = (const float*)(a.ws + HY_HBC) + c;
        float w[8], acc[8];
#pragma unroll
        for (int i = 0; i < 8; ++i) { acc[i] = 0.f; w[i] = hf[(size_t)(t0 + i) * D]; }
#pragma unroll 1
        for (int s = 0; s < CTX; ++s) {
            const float zv = z[(size_t)s * D];
#pragma unroll
            for (int i = 0; i < 8; ++i) acc[i] += w[i] * zv;
#pragma unroll
            for (int i = 7; i >= 1; --i) w[i] = w[i - 1];
            const int s1 = s + 1;
            w[0] = (s1 <= t0) ? hf[(size_t)(t0 - s1) * D] : ((s1 - t0) < CTX ? hb[(size_t)(s1 - t0) * D] : 0.f);
        }
#pragma unroll
        for (int i = 0; i < 8; ++i) {
            const size_t row = (size_t)b * RPB + t0 + i;
            const float x0 = __uint_as_float((unsigned)X0[row * D + c] << 16), xz = __uint_as_float((unsigned)X0ZB[row * D + c] << 16);
            P[row * D + c] = (bf16_t)(cvt_pk_bf16(x0 * acc[i] + xz, 0.f) & 0xffffu);
        }
    }
    for (int u = blockIdx.x; u < 256 * 8; u += gridDim.x) {
        const int tb = u >> 3, cc = u & 7, t0 = tb * 64, c0 = cc * 128;
#pragma unroll
        for (int i = 0; i < 4; ++i) {
            const int idx = tid + i * 512, ch = idx >> 4, t4 = (idx & 15) * 4;
            const float* ue = (const float*)(a.ws + HY_U) + ((size_t)0 * D + c0 + ch) * 2 * SEQ + t0 + t4;
            const float* uo = (const float*)(a.ws + HY_U) + ((size_t)1 * D + c0 + ch) * 2 * SEQ + t0 + t4;
            const float4 er = *(const float4*)ue, ei = *(const float4*)(ue + SEQ), orr = *(const float4*)uo, oi = *(const float4*)(uo + SEQ);
            const float4 wa = *(const float4*)(tw2 + t0 + t4), wb = *(const float4*)(tw2 + t0 + t4 + 2);
            const float e_r[4] = { er.x, er.y, er.z, er.w }, e_i[4] = { ei.x, ei.y, ei.z, ei.w }, o_r[4] = { orr.x, orr.y, orr.z, orr.w }, o_i[4] = { oi.x, oi.y, oi.z, oi.w };
            const float wr[4] = { wa.x, wa.z, wb.x, wb.z }, wi[4] = { wa.y, wa.w, wb.y, wb.w };
#pragma unroll
            for (int q = 0; q < 4; ++q) {
                const float cr = wr[q], ci = -wi[q];
                const float yr = (e_r[q] + (o_r[q] * cr - o_i[q] * ci)) * (1.f / 32768.f), yi = (e_i[q] + (o_r[q] * ci + o_i[q] * cr)) * (1.f / 32768.f);
                tile[(0 * 64 + t4 + q) * 129 + ch] = yr; tile[(1 * 64 + t4 + q) * 129 + ch] = yi;
            }
        }
        __syncthreads();
#pragma unroll
        for (int i = 0; i < 4; ++i) {
            const int idx = tid + i * 512, b = idx >> 10, t = (idx >> 4) & 63, c8 = (idx & 15) * 8;
            const size_t row = (size_t)b * RPB + CTX + t0 + t;
            const u32x4 x0 = *(const u32x4*)(X0 + row * D + c0 + c8), xz = *(const u32x4*)(X0ZB + row * D + c0 + c8);
            const float* y = tile + (b * 64 + t) * 129 + c8;
            u32x4 o;
#pragma unroll
            for (int q = 0; q < 4; ++q) o[q] = cvt_pk_bf16(bf_lo(x0[q]) * y[2 * q] + bf_lo(xz[q]), bf_hi(x0[q]) * y[2 * q + 1] + bf_hi(xz[q]));
            *(u32x4*)(P + row * D + c0 + c8) = o;
        }
        __syncthreads();
    }
}
constexpr size_t ML_QKVA = WS_MIX;
constexpr size_t ML_QC   = ML_QKVA + (size_t)T * 768 * 4;
constexpr size_t ML_KVC  = ML_QC + (size_t)T * 384 * 2;
constexpr size_t ML_QF   = ML_KVC + (size_t)T * 256 * 2;
constexpr size_t ML_KVF  = ML_QF + (size_t)T * 1536 * 4;
constexpr size_t ML_Q    = ML_KVF + (size_t)T * 2048 * 4;
constexpr size_t ML_K    = ML_Q + (size_t)T * 1536 * 2;
constexpr size_t ML_VT   = ML_K + (size_t)T * 1536 * 2;
constexpr size_t ML_O    = ML_VT + (size_t)T * 1024 * 2;
constexpr size_t ML_END  = ML_O + (size_t)T * 1024 * 2;

__device__ __forceinline__ void phase_mla_a(const Args& a, unsigned char* lds) {
    unsigned char* gl = lds + LDS_USER;
    float* out = (float*)(a.ws + ML_QKVA);
    for (int u = blockIdx.x; u < 130 * 6; u += gridDim.x) {
        const int mt = u / 6, nt = u - mt * 6;
        ALoadPlain al{ (const bf16_t*)(a.ws + WS_H), D };
        gemm_tile(al, (const bf16_t*)(a.ws + WS_MWAT), D, 16, gl, make_epi([=](int row, int col, const f32x4& v) { *(f32x4*)(out + (size_t)row * 768 + col) = v; }), mt * 256, nt * 128);
    }
}
__device__ __forceinline__ void phase_mla_norm(const Args& a) {
    const int tid = otid(), lane = tid & 63, wid = tid >> 6;
    const float* qg = a.in[I_MQNG]; const float* kg = a.in[I_MKVNG];
    for (int row = blockIdx.x * 8 + wid; row < T; row += gridDim.x * 8) {
        const float* src = (const float*)(a.ws + ML_QKVA) + (size_t)row * 768;
        const float4 q0 = *(const float4*)(src + lane * 4);
        float4 q1 = make_float4(0.f, 0.f, 0.f, 0.f);
        if (lane < 32) q1 = *(const float4*)(src + 256 + lane * 4);
        float ss = q0.x * q0.x + q0.y * q0.y + q0.z * q0.z + q0.w * q0.w + q1.x * q1.x + q1.y * q1.y + q1.z * q1.z + q1.w * q1.w;
        ss = wave_sum(ss);
        const float rq = rsqrtf(ss * (1.f / 384.f) + 1e-6f);
        bf16_t* qc = (bf16_t*)(a.ws + ML_QC) + (size_t)row * 384;
        { const float4 g = *(const float4*)(qg + lane * 4); u32x2 o = { cvt_pk_bf16(q0.x * rq * g.x, q0.y * rq * g.y), cvt_pk_bf16(q0.z * rq * g.z, q0.w * rq * g.w) }; *(u32x2*)(qc + lane * 4) = o; }
        if (lane < 32) { const float4 g = *(const float4*)(qg + 256 + lane * 4); u32x2 o = { cvt_pk_bf16(q1.x * rq * g.x, q1.y * rq * g.y), cvt_pk_bf16(q1.z * rq * g.z, q1.w * rq * g.w) }; *(u32x2*)(qc + 256 + lane * 4) = o; }
        const float4 k0 = *(const float4*)(src + 384 + lane * 4);
        float s2 = k0.x * k0.x + k0.y * k0.y + k0.z * k0.z + k0.w * k0.w;
        s2 = wave_sum(s2);
        const float rk = rsqrtf(s2 * (1.f / 256.f) + 1e-6f);
        { const float4 g = *(const float4*)(kg + lane * 4); u32x2 o = { cvt_pk_bf16(k0.x * rk * g.x, k0.y * rk * g.y), cvt_pk_bf16(k0.z * rk * g.z, k0.w * rk * g.w) }; *(u32x2*)((bf16_t*)(a.ws + ML_KVC) + (size_t)row * 256 + lane * 4) = o; }
    }
}
__device__ __forceinline__ void phase_mla_b(const Args& a, unsigned char* lds) {
    unsigned char* gl = lds + LDS_USER;
    for (int u = blockIdx.x; u < 130 * 28; u += gridDim.x) {
        const int mt = u / 28, s = u - mt * 28;
        if (s < 12) {
            float* out = (float*)(a.ws + ML_QF);
            ALoadPlain al{ (const bf16_t*)(a.ws + ML_QC), 384 };
            gemm_tile(al, (const bf16_t*)(a.ws + WS_MWQBT), 384, 6, gl, make_epi([=](int row, int col, const f32x4& v) { *(f32x4*)(out + (size_t)row * 1536 + col) = v; }), mt * 256, s * 128);
        } else {
            float* out = (float*)(a.ws + ML_KVF);
            ALoadPlain al{ (const bf16_t*)(a.ws + ML_KVC), 256 };
            gemm_tile(al, (const bf16_t*)(a.ws + WS_MWKVBT), 256, 4, gl, make_epi([=](int row, int col, const f32x4& v) { *(f32x4*)(out + (size_t)row * 2048 + col) = v; }), mt * 256, (s - 12) * 128);
        }
    }
}
__device__ __forceinline__ void phase_mla_rope(const Args& a, unsigned char* lds) {
    const int tid = otid();
    bf16_t* vt = (bf16_t*)(lds + LDS_USER);
    const float* qn = a.in[I_MQN]; const float* kn = a.in[I_MKN];
    const float QSCALE = 0.07216878364870322f * 1.4426950408889634f;
    for (int u = blockIdx.x; u < 520 * 8; u += gridDim.x) {
        const int rb = u >> 3, h = u & 7, row0 = rb * 64, b = row0 / RPB, within0 = row0 - b * RPB;
        const bool lat = within0 >= CTX;
#pragma unroll 1
        for (int pass = 0; pass < 2; ++pass) {
            const int rl = pass * 32 + (tid >> 4), g = tid & 15, row = row0 + rl;
            const int tpos = within0 + rl - CTX;
            float cs[4], sn[4];
            {
                const float inv = exp2f(-(float)g * (13.287712379549449f / 16.f));
                const float ar = (float)(tpos >> 6) * inv, ac = (float)(tpos & 63) * inv;
                cs[0] = lat ? cos_acc(ar) : 1.f; sn[0] = lat ? sin_acc(ar) : 0.f; cs[1] = lat ? cos_acc(ac) : 1.f; sn[1] = lat ? sin_acc(ac) : 0.f;
            }
            {
                const float* src = (const float*)(a.ws + ML_QF) + (size_t)row * 1536 + h * 192;
                const float4 n0 = *(const float4*)(src + g * 8), n1 = *(const float4*)(src + g * 8 + 4);
                float r0 = src[128 + g], r1 = src[144 + g], c0 = src[160 + g], c1 = src[176 + g];
                float ss = n0.x * n0.x + n0.y * n0.y + n0.z * n0.z + n0.w * n0.w + n1.x * n1.x + n1.y * n1.y + n1.z * n1.z + n1.w * n1.w + r0 * r0 + r1 * r1 + c0 * c0 + c1 * c1;
                ss = row16_sum(ss);
                const float rs = rsqrtf(ss * (1.f / 192.f) + 1e-6f) * QSCALE;
                const float4 g0 = *(const float4*)(qn + g * 8), g1 = *(const float4*)(qn + g * 8 + 4);
                bf16_t* dst = (bf16_t*)(a.ws + ML_Q) + (size_t)row * 1536 + h * 192;
                u32x4 o = { cvt_pk_bf16(n0.x * rs * g0.x, n0.y * rs * g0.y), cvt_pk_bf16(n0.z * rs * g0.z, n0.w * rs * g0.w), cvt_pk_bf16(n1.x * rs * g1.x, n1.y * rs * g1.y), cvt_pk_bf16(n1.z * rs * g1.z, n1.w * rs * g1.w) };
                *(u32x4*)(dst + g * 8) = o;
                r0 *= rs * qn[128 + g]; r1 *= rs * qn[144 + g]; c0 *= rs * qn[160 + g]; c1 *= rs * qn[176 + g];
                const unsigned pr = cvt_pk_bf16(r0 * cs[0] - r1 * sn[0], r0 * sn[0] + r1 * cs[0]), pc = cvt_pk_bf16(c0 * cs[1] - c1 * sn[1], c0 * sn[1] + c1 * cs[1]);
                dst[128 + g] = (bf16_t)(pr & 0xffffu); dst[144 + g] = (bf16_t)(pr >> 16); dst[160 + g] = (bf16_t)(pc & 0xffffu); dst[176 + g] = (bf16_t)(pc >> 16);
            }
            {
                const float* src = (const float*)(a.ws + ML_KVF) + (size_t)row * 2048 + h * 256;
                const float* pe = (const float*)(a.ws + ML_QKVA) + (size_t)row * 768 + 640;
                const float4 n0 = *(const float4*)(src + g * 8), n1 = *(const float4*)(src + g * 8 + 4);
                float r0 = pe[g], r1 = pe[16 + g], c0 = pe[32 + g], c1 = pe[48 + g];
                float ss = n0.x * n0.x + n0.y * n0.y + n0.z * n0.z + n0.w * n0.w + n1.x * n1.x + n1.y * n1.y + n1.z * n1.z + n1.w * n1.w + r0 * r0 + r1 * r1 + c0 * c0 + c1 * c1;
                ss = row16_sum(ss);
                const float rs = rsqrtf(ss * (1.f / 192.f) + 1e-6f);
                const float4 g0 = *(const float4*)(kn + g * 8), g1 = *(const float4*)(kn + g * 8 + 4);
                bf16_t* dst = (bf16_t*)(a.ws + ML_K) + (size_t)row * 1536 + h * 192;
                u32x4 o = { cvt_pk_bf16(n0.x * rs * g0.x, n0.y * rs * g0.y), cvt_pk_bf16(n0.z * rs * g0.z, n0.w * rs * g0.w), cvt_pk_bf16(n1.x * rs * g1.x, n1.y * rs * g1.y), cvt_pk_bf16(n1.z * rs * g1.z, n1.w * rs * g1.w) };
                *(u32x4*)(dst + g * 8) = o;
                r0 *= rs * kn[128 + g]; r1 *= rs * kn[144 + g]; c0 *= rs * kn[160 + g]; c1 *= rs * kn[176 + g];
                const unsigned pr = cvt_pk_bf16(r0 * cs[0] - r1 * sn[0], r0 * sn[0] + r1 * cs[0]), pc = cvt_pk_bf16(c0 * cs[1] - c1 * sn[1], c0 * sn[1] + c1 * cs[1]);
                dst[128 + g] = (bf16_t)(pr & 0xffffu); dst[144 + g] = (bf16_t)(pr >> 16); dst[160 + g] = (bf16_t)(pc & 0xffffu); dst[176 + g] = (bf16_t)(pc >> 16);
                const float4 v0 = *(const float4*)(src + 128 + g * 8), v1 = *(const float4*)(src + 128 + g * 8 + 4);
                const unsigned p0 = cvt_pk_bf16(v0.x, v0.y), p1 = cvt_pk_bf16(v0.z, v0.w), p2 = cvt_pk_bf16(v1.x, v1.y), p3 = cvt_pk_bf16(v1.z, v1.w);
                bf16_t* vd = vt + (g * 8) * 72 + rl;
                vd[0 * 72] = (bf16_t)(p0 & 0xffffu); vd[1 * 72] = (bf16_t)(p0 >> 16); vd[2 * 72] = (bf16_t)(p1 & 0xffffu); vd[3 * 72] = (bf16_t)(p1 >> 16);
                vd[4 * 72] = (bf16_t)(p2 & 0xffffu); vd[5 * 72] = (bf16_t)(p2 >> 16); vd[6 * 72] = (bf16_t)(p3 & 0xffffu); vd[7 * 72] = (bf16_t)(p3 >> 16);
            }
        }
        __syncthreads();
        {
            bf16_t* VT = (bf16_t*)(a.ws + ML_VT) + ((size_t)(b * 8 + h) * 128) * RPB + within0;
#pragma unroll
            for (int i = 0; i < 2; ++i) {
                const int idx = tid + i * 512, d = idx >> 3, c = idx & 7;
                *(u32x4*)(VT + (size_t)d * RPB + c * 8) = *(const u32x4*)(vt + d * 72 + c * 8);
            }
        }
        __syncthreads();
    }
}
constexpr int AT_KROW = 400, AT_VROW = 136, AT_KB = 64 * AT_KROW, AT_VB = 128 * AT_VROW, AT_BUF = AT_KB + AT_VB;
__device__ __forceinline__ void phase_mla_attn(const Args& a, unsigned char* lds) {
    const int tid = otid(), lane = tid & 63, wid = tid >> 6, ln = lane & 31, hk = lane >> 5;
    unsigned char* base = lds + LDS_USER;
    const bf16_t* Qg = (const bf16_t*)(a.ws + ML_Q); const bf16_t* Kg = (const bf16_t*)(a.ws + ML_K); const bf16_t* VTg = (const bf16_t*)(a.ws + ML_VT);
    bf16_t* Og = (bf16_t*)(a.ws + ML_O);
    for (int u = blockIdx.x; u < 1024 + 16; u += gridDim.x) {
        int b, h, qrow0, nkeys;
        if (u < 1024) { b = u >> 9; h = (u >> 6) & 7; qrow0 = b * RPB + CTX + (u & 63) * 256; nkeys = RPB; }
        else { const int v = u - 1024; b = v >> 3; h = v & 7; qrow0 = b * RPB; nkeys = CTX; }
        const int ntiles = nkeys >> 6;
        const bf16_t* Kb = Kg + (size_t)b * RPB * 1536 + h * 192;
        const bf16_t* Vb = VTg + (size_t)(b * 8 + h) * 128 * RPB;
        bf16x8 qf[12];
        {
            const bf16_t* qp = Qg + (size_t)(qrow0 + wid * 32 + ln) * 1536 + h * 192 + hk * 8;
#pragma unroll
            for (int ks = 0; ks < 12; ++ks) qf[ks] = *(const bf16x8*)(qp + ks * 16);
        }
        f32x16 o[4];
#pragma unroll
        for (int i = 0; i < 4; ++i)
#pragma unroll
            for (int r = 0; r < 16; ++r) o[i][r] = 0.f;
        float mrun = -INFINITY, lrun = 0.f;
        u32x4 rk[3];
        auto gloadK = [&](int t) {
            const int k0 = t * 64;
#pragma unroll
            for (int i = 0; i < 3; ++i) { const int id = tid + i * 512, key = id / 24, c = id - key * 24; rk[i] = *(const u32x4*)(Kb + (size_t)(k0 + key) * 1536 + c * 8); }
        };
        auto gloadV = [&](int t) {
            const int k0 = t * 64;
#pragma unroll
            for (int i = 0; i < 2; ++i) { const int id = tid + i * 512, d = id >> 3, c = id & 7; rk[i] = *(const u32x4*)(Vb + (size_t)d * RPB + k0 + c * 8); }
        };
        auto lstoreK = [&](int buf) {
            unsigned char* kb = base + buf * AT_BUF;
#pragma unroll
            for (int i = 0; i < 3; ++i) { const int id = tid + i * 512, key = id / 24, c = id - key * 24; *(u32x4*)(kb + key * AT_KROW + c * 16) = rk[i]; }
        };
        auto lstoreV = [&](int buf) {
            unsigned char* vb = base + buf * AT_BUF + AT_KB;
#pragma unroll
            for (int i = 0; i < 2; ++i) { const int id = tid + i * 512, d = id >> 3, c = id & 7; *(u32x2*)(vb + d * AT_VROW + c * 16) = (u32x2){ rk[i][0], rk[i][1] }; *(u32x2*)(vb + d * AT_VROW + c * 16 + 8) = (u32x2){ rk[i][2], rk[i][3] }; }
        };
        gloadK(0); lstoreK(0); gloadV(0); lstoreV(0);
        __syncthreads();
        for (int t = 0; t < ntiles; ++t) {
            const bool more = t + 1 < ntiles;
            if (more) gloadK(t + 1);
            const unsigned char* kb = base + (t & 1) * AT_BUF; const unsigned char* vb = kb + AT_KB;
            f32x16 s0, s1;
#pragma unroll
            for (int r = 0; r < 16; ++r) { s0[r] = 0.f; s1[r] = 0.f; }
#pragma unroll
            for (int ks = 0; ks < 12; ++ks) {
                const bf16x8 k0f = *(const bf16x8*)(kb + ln * AT_KROW + ks * 32 + hk * 16);
                const bf16x8 k1f = *(const bf16x8*)(kb + (32 + ln) * AT_KROW + ks * 32 + hk * 16);
                s0 = __builtin_amdgcn_mfma_f32_32x32x16_bf16(k0f, qf[ks], s0, 0, 0, 0);
                s1 = __builtin_amdgcn_mfma_f32_32x32x16_bf16(k1f, qf[ks], s1, 0, 0, 0);
            }
            if (more) { lstoreK((t + 1) & 1); gloadV(t + 1); }
            float mx = s0[0];
#pragma unroll
            for (int r = 1; r < 16; ++r) mx = fmaxf(mx, s0[r]);
#pragma unroll
            for (int r = 0; r < 16; ++r) mx = fmaxf(mx, s1[r]);
            mx = fmaxf(mx, __shfl_xor(mx, 32));
            const float mnew = fmaxf(mrun, mx);
            if (__any(mnew > mrun)) {
                const float alpha = exp2f(mrun - mnew);
                lrun *= alpha;
#pragma unroll
                for (int i = 0; i < 4; ++i)
#pragma unroll
                    for (int r = 0; r < 16; ++r) o[i][r] *= alpha;
                mrun = mnew;
            }
            float ps = 0.f;
#pragma unroll
            for (int r = 0; r < 16; ++r) { s0[r] = exp2f(s0[r] - mrun); ps += s0[r]; }
#pragma unroll
            for (int r = 0; r < 16; ++r) { s1[r] = exp2f(s1[r] - mrun); ps += s1[r]; }
            lrun += ps;
#pragma unroll
            for (int kb2 = 0; kb2 < 2; ++kb2) {
#pragma unroll
                for (int s = 0; s < 2; ++s) {
                    u32x4 pw;
                    if (kb2 == 0) pw = (u32x4){ cvt_pk_bf16(s0[8 * s + 0], s0[8 * s + 1]), cvt_pk_bf16(s0[8 * s + 2], s0[8 * s + 3]), cvt_pk_bf16(s0[8 * s + 4], s0[8 * s + 5]), cvt_pk_bf16(s0[8 * s + 6], s0[8 * s + 7]) };
                    else          pw = (u32x4){ cvt_pk_bf16(s1[8 * s + 0], s1[8 * s + 1]), cvt_pk_bf16(s1[8 * s + 2], s1[8 * s + 3]), cvt_pk_bf16(s1[8 * s + 4], s1[8 * s + 5]), cvt_pk_bf16(s1[8 * s + 6], s1[8 * s + 7]) };
                    const bf16x8 pf = __builtin_bit_cast(bf16x8, pw);
                    const int koff = (kb2 * 32 + s * 16 + hk * 4) * 2;
#pragma unroll
                    for (int db = 0; db < 4; ++db) {
                        const unsigned char* vp = vb + (db * 32 + ln) * AT_VROW + koff;
                        const u32x2 va = *(const u32x2*)vp, vc = *(const u32x2*)(vp + 16);
                        const bf16x8 vf = __builtin_bit_cast(bf16x8, ((u32x4){ va[0], va[1], vc[0], vc[1] }));
                        o[db] = __builtin_amdgcn_mfma_f32_32x32x16_bf16(vf, pf, o[db], 0, 0, 0);
                    }
                }
            }
            if (more) lstoreV((t + 1) & 1);
            __syncthreads();
        }
        const float ltot = lrun + __shfl_xor(lrun, 32);
        const float inv = 1.f / ltot;
        bf16_t* op = Og + (size_t)(qrow0 + wid * 32 + ln) * 1024 + h * 128;
#pragma unroll
        for (int db = 0; db < 4; ++db)
#pragma unroll
            for (int r4 = 0; r4 < 4; ++r4) {
                const int d = db * 32 + 8 * r4 + 4 * hk;
                u32x2 w = { cvt_pk_bf16(o[db][4 * r4 + 0] * inv, o[db][4 * r4 + 1] * inv), cvt_pk_bf16(o[db][4 * r4 + 2] * inv, o[db][4 * r4 + 3] * inv) };
                *(u32x2*)(op + d) = w;
            }
    }
}
#if SELFTEST
constexpr size_t WS_FLAGS = WS_CNT + 1024;
__device__ __forceinline__ bool st_close(float got, float ref, float rtol = 0.03f, float atol = 0.03f) { return fabsf(got - ref) <= rtol * fabsf(ref) + atol && got == got; }
__device__ __forceinline__ void st_fail(const Args& a, unsigned bit) { atomicOr((unsigned*)(a.ws + WS_FLAGS), bit); }
__device__ __forceinline__ float st_h(const Args& a, int row, int k) { const bf16_t* H = (const bf16_t*)(a.ws + WS_H); return __uint_as_float((unsigned)H[(size_t)row * D + k] << 16); }
__device__ __forceinline__ float st_mix(const Args& a, int row, int k, const float* mu) {
    const int within = row % RPB;
    const float h = st_h(a, row, k);
    const float hp = (within == 0 || within == CTX) ? 0.f : st_h(a, row - 1, k);
    const float hn = (within == CTX - 1 || within == RPB - 1) ? 0.f : st_h(a, row + 1, k);
    return h + (0.5f * (hp + hn) - h) * mu[k];
}
__constant__ int st_rows[8] = { 0, 255, 256, 257, 16639, 16640, 20000, 33279 };
__constant__ int st_toks[6] = { 0, 300, 9000, 16640, 20000, 33279 };
__device__ __forceinline__ void selftest_rwkv_proj(const Args& a, int j) {
    const int tid = otid(), bid = blockIdx.x;
    if (bid >= 8) return;
    const int row = st_rows[bid];
    const float* mu = a.in[I_RMU] + (size_t)j * 6 * D;
    for (int it = tid; it < 3 * 64; it += NT) {
        const int g = it / 64, col = (it % 64) * 16 + 3 + g;
        const int mi = g == 0 ? 0 : (g == 1 ? 2 : 3);
        const float* W = a.in[I_RWRKV] + (size_t)(j * 3 + g) * D * D;
        float s = 0.f;
        for (int k = 0; k < D; ++k) s += st_mix(a, row, k, mu + mi * D) * W[(size_t)k * D + col];
        const float* out = (const float*)(a.ws + (g == 0 ? RW_R : (g == 1 ? RW_K : (j == 0 ? WS_VFIRST : RW_V))));
        float got = out[(size_t)row * D + col];
        if (g == 2 && j == 1) continue;
        if (!st_close(got, s)) st_fail(a, 1u);
    }
    if (j == 1 && tid >= 32 && tid < 40) {
        const int col = (tid - 32) * 128 + 9;
        const float* W = a.in[I_RWRKV] + (size_t)(j * 3 + 2) * D * D;
        float v = 0.f;
        for (int k = 0; k < D; ++k) v += st_mix(a, row, k, mu + 3 * D) * W[(size_t)k * D + col];
        float acc = 0.f;
        for (int q = 0; q < 32; ++q) { float hsum = 0.f; for (int k = 0; k < D; ++k) hsum += st_mix(a, row, k, mu + 3 * D) * a.in[I_RV1][(size_t)k * 32 + q]; acc += hsum * a.in[I_RV2][(size_t)q * D + col]; }
        const float gate = 1.f / (1.f + expf(-(a.in[I_RV0][col] + acc)));
        const float vf = ((const float*)(a.ws + WS_VFIRST))[(size_t)row * D + col];
        const float ref = v + (vf - v) * gate;
        const float got = ((const float*)(a.ws + RW_V))[(size_t)row * D + col];
        if (!st_close(got, ref)) st_fail(a, 1u);
    }
    if (tid < 24) {
        const int kind = tid / 8, col = (tid % 8) * 128 + 5 + kind;
        float got, ref;
        if (kind == 0) {
            const float* w1 = a.in[I_RW1] + (size_t)(j * 2 + 1) * D * 64; const float* w2 = a.in[I_RW2] + (size_t)(j * 2 + 1) * 64 * D;
            float acc = 0.f;
            for (int q = 0; q < 64; ++q) { float hsum = 0.f; for (int k = 0; k < D; ++k) hsum += st_mix(a, row, k, mu + 1 * D) * w1[(size_t)k * 64 + q]; acc += tanhf(hsum) * w2[(size_t)q * D + col]; }
            const float z = -(a.in[I_RW0][(j * 2 + 1) * D + col] + acc);
            const float sp = z > 20.f ? z : log1pf(expf(z));
            ref = expf(-expf(-sp - 0.5f));
            got = ((const float*)(a.ws + RW_WD1))[(size_t)row * D + col];
            if (!st_close(got, ref, 0.005f, 0.002f)) st_fail(a, 1u);
        } else if (kind == 1) {
            const float* a1 = a.in[I_RA1] + (size_t)(j * 2 + 0) * D * 64; const float* a2 = a.in[I_RA2] + (size_t)(j * 2 + 0) * 64 * D;
            float acc = 0.f;
            for (int q = 0; q < 64; ++q) { float hsum = 0.f; for (int k = 0; k < D; ++k) hsum += st_mix(a, row, k, mu + 4 * D) * a1[(size_t)k * 64 + q]; acc += hsum * a2[(size_t)q * D + col]; }
            ref = 1.f / (1.f + expf(-(a.in[I_RA0][(j * 2 + 0) * D + col] + acc)));
            got = ((const float*)(a.ws + RW_AD0))[(size_t)row * D + col];
            if (!st_close(got, ref, 0.02f, 0.01f)) st_fail(a, 1u);
        } else {
            const float* g1 = a.in[I_RG1] + (size_t)j * D * 160; const float* g2 = a.in[I_RG2] + (size_t)j * 160 * D;
            float acc = 0.f;
            for (int q = 0; q < 160; ++q) { float hsum = 0.f; for (int k = 0; k < D; ++k) hsum += st_mix(a, row, k, mu + 5 * D) * g1[(size_t)k * 160 + q]; acc += (1.f / (1.f + expf(-hsum))) * g2[(size_t)q * D + col]; }
            ref = acc; got = ((const float*)(a.ws + RW_G))[(size_t)row * D + col];
            if (!st_close(got, ref)) st_fail(a, 1u);
        }
    }
}
__device__ __forceinline__ void selftest_wkv(const Args& a, unsigned char* lds, int j) {
    const int tid = otid(), bid = blockIdx.x;
    if (bid >= 2 || tid >= 64) return;
    const int b = bid, h = bid ? 5 : 0, d = bid, vrow = tid;
    const float* R = (const float*)(a.ws + RW_R); const float* K = (const float*)(a.ws + RW_K);
    const float* V = (const float*)(a.ws + (j == 0 ? WS_VFIRST : RW_V));
    const float* WD = (const float*)(a.ws + (d == 0 ? RW_WD0 : RW_WD1)); const float* AD = (const float*)(a.ws + (d == 0 ? RW_AD0 : RW_AD1));
    const float* Y = (const float*)(a.ws + (d == 0 ? RW_Y0 : RW_Y1));
    float* S = (float*)(lds + LDS_USER) + tid;
    for (int k = 0; k < 64; ++k) S[k * 64] = 0.f;
    bool bad = false;
    for (int t = 0; t < 330; ++t) {
        const int p = (d == 0) ? t : ((t < CTX) ? (CTX - 1 - t) : (RPB + CTX - 1 - t));
        const size_t o = ((size_t)b * RPB + p) * D + h * 64;
        float n2 = 0.f;
        for (int k = 0; k < 64; ++k) { const float x = K[o + k] * a.in[I_RKK][j * D + h * 64 + k]; n2 += x * x; }
        const float inv = 1.f / fmaxf(sqrtf(n2), 1e-12f);
        float sa = 0.f;
        for (int k = 0; k < 64; ++k) sa += S[k * 64] * (-(K[o + k] * a.in[I_RKK][j * D + h * 64 + k] * inv));
        const float vv = V[o + vrow];
        float y = 0.f;
        for (int k = 0; k < 64; ++k) {
            const float kr = K[o + k], av = AD[o + k], kk = kr * a.in[I_RKK][j * D + h * 64 + k] * inv;
            const float sn = S[k * 64] * WD[o + k] + sa * (kk * av) + vv * (kr * (1.f + (av - 1.f) * a.in[I_RKA][j * D + h * 64 + k]));
            S[k * 64] = sn;
            y += sn * R[o + k];
        }
        if (!st_close(Y[o + vrow], y, 0.01f, 0.01f)) bad = true;
    }
    if (bad) st_fail(a, 2u);
}
__device__ __forceinline__ void selftest_moe(const Args& a, unsigned char* lds, int layer) {
    const int tid = otid(), bid = blockIdx.x;
    if (bid >= 6) return;
    const int row = st_toks[bid], midx = mod_index(row);
    float* h2 = (float*)(lds + LDS_USER);
    float* act = h2 + 1024;
    float* red = act + 1024;
    float* outv = red + 512;
    float* lg = outv + 1024;
    const float* X = (const float*)(a.ws + WS_X) + (size_t)row * D;
    const float* mod = (const float*)(a.ws + WS_MOD) + ((size_t)layer * 3 + midx) * 6144;
    float ss = 0.f;
    for (int k = tid; k < D; k += NT) ss += X[k] * X[k];
    red[tid] = ss; __syncthreads();
    if (tid == 0) { float s = 0.f; for (int i = 0; i < NT; ++i) s += red[i]; red[0] = rsqrtf(s / 1024.f + 1e-6f); }
    __syncthreads();
    const float rstd = red[0];
    __syncthreads();
    for (int k = tid; k < D; k += NT) h2[k] = X[k] * rstd * a.in[I_NFFN][layer * D + k] * (1.f + mod[4 * 1024 + k]) + mod[3 * 1024 + k];
    for (int k = tid; k < D; k += NT) outv[k] = 0.f;
    __syncthreads();
    if (tid < 32) { float s = a.in[I_ERB][layer * 32 + tid]; for (int k = 0; k < D; ++k) s += h2[k] * a.in[I_ERW][(size_t)layer * 32768 + k * 32 + tid]; lg[tid] = s; }
    __syncthreads();
    int te[4]; float tvv[4];
    if (tid == 0) {
        for (int r = 0; r < 4; ++r) { int bi = 0; float bv = -INFINITY; for (int e = 0; e < 32; ++e) if (lg[e] > bv) { bv = lg[e]; bi = e; } lg[32 + r] = bv; ((int*)lg)[36 + r] = bi; lg[bi] = -INFINITY; }
    }
    __syncthreads();
#pragma unroll
    for (int r = 0; r < 4; ++r) { tvv[r] = lg[32 + r]; te[r] = ((int*)lg)[36 + r]; }
    float gs = 0.f; float gt[4];
#pragma unroll
    for (int r = 0; r < 4; ++r) { gt[r] = expf(tvv[r] - tvv[0]); gs += gt[r]; }
#pragma unroll
    for (int r = 0; r < 4; ++r) gt[r] /= gs;
    if (tid == 0) {
        const int* ae = (const int*)(a.ws + WS_ASGE) + (size_t)row * 4; const float* ag = (const float*)(a.ws + WS_ASGG) + (size_t)row * 4;
#pragma unroll
        for (int r = 0; r < 4; ++r) { if ((ae[r] >> 24) != te[r]) st_fail(a, 4u); if (!st_close(ag[r], gt[r], 0.02f, 0.005f)) st_fail(a, 4u); }
    }
#pragma unroll 1
    for (int rr = 0; rr < 4; ++rr) {
        const int e = rr == 0 ? te[0] : (rr == 1 ? te[1] : (rr == 2 ? te[2] : te[3])); const float gtr = rr == 0 ? gt[0] : (rr == 1 ? gt[1] : (rr == 2 ? gt[2] : gt[3]));
        const float* win = a.in[I_EWIN] + ((size_t)layer * 32 + e) * 1024 * 2048; const float* bin = a.in[I_EBIN] + ((size_t)layer * 32 + e) * 2048;
        const float* wout = a.in[I_EWOUT] + ((size_t)layer * 32 + e) * 1024 * 1024; const float* bout = a.in[I_EBOUT] + ((size_t)layer * 32 + e) * 1024;
        for (int c = tid; c < 1024; c += NT) {
            float g = bin[c], l = bin[1024 + c];
            for (int k = 0; k < D; ++k) { g += h2[k] * win[(size_t)k * 2048 + c]; l += h2[k] * win[(size_t)k * 2048 + 1024 + c]; }
            g = fminf(g, 7.f); l = fminf(fmaxf(l, -7.f), 7.f);
            act[c] = g * (1.f / (1.f + expf(-1.702f * g))) * (l + 1.f);
        }
        __syncthreads();
        for (int c = tid; c < 1024; c += NT) { float s = bout[c]; for (int k = 0; k < 1024; ++k) s += act[k] * wout[(size_t)k * 1024 + c]; outv[c] += gtr * s; }
        __syncthreads();
    }
    {
        const int* cnt = (const int*)(a.ws + WS_CNT) + layer * 32;
        const int* ae = (const int*)(a.ws + WS_ASGE) + (size_t)row * 4; const float* ag = (const float*)(a.ws + WS_ASGG) + (size_t)row * 4;
        for (int c = tid; c < 1024; c += NT) {
            float s = 0.f;
            for (int r = 0; r < 4; ++r) {
                const int e = ae[r] >> 24, slot = ae[r] & 0xffffff; int ps = 0; for (int q = 0; q < e; ++q) ps += ((cnt[q] + 255) >> 8) << 8;
                s += ag[r] * __uint_as_float((unsigned)((const bf16_t*)(a.ws + WS_YB))[((size_t)ps + slot) * D + c] << 16);
            }
            if (!st_close(s, outv[c], 0.03f, 0.03f)) st_fail(a, 4u);
        }
    }
    __syncthreads();
}

#if HAVE_HYENA
__device__ __forceinline__ void selftest_hy_filters(const Args& a, unsigned char* lds) {
    const int tid = otid();
    if (blockIdx.x != 0 || tid >= 32) return;
    const int isctx = tid >> 4, q = tid & 15, ni = q >> 2, ci = q & 3;
    const int Lh = isctx ? CTX : SEQ;
    const int n = ni == 0 ? 0 : (ni == 1 ? 1 : (ni == 2 ? (isctx ? 100 : 7777) : Lh - 1));
    const int c = ci == 0 ? 0 : (ci == 1 ? 513 : (ci == 2 ? 1023 : 1024 + 300));
    float* h1 = (float*)(lds + LDS_USER) + tid * 200; float* h2 = h1 + 64; float* zz = h2 + 64;
    zz[0] = (float)n / (float)(Lh - 1);
    for (int i = 0; i < 16; ++i) { const float f = 1e-4f + (float)i * ((15.0f - 1e-4f) / 15.0f); const float ang = 2.0f * 3.14159265358979323846f * f * (float)n / (float)Lh; zz[1 + i] = cos_acc(ang); zz[17 + i] = -sin_acc(ang); }
    for (int h = 0; h < 64; ++h) { float s = a.in[I_HFB1][h]; for (int k = 0; k < 33; ++k) s += zz[k] * a.in[I_HFW1][k * 64 + h]; h1[h] = sin_acc(a.in[I_HFREQ][h] * s); }
    for (int h = 0; h < 64; ++h) { float s = a.in[I_HFB2][h]; for (int k = 0; k < 64; ++k) s += h1[k] * a.in[I_HFW2][k * 64 + h]; h2[h] = sin_acc(a.in[I_HFREQ][64 + h] * s); }
    for (int h = 0; h < 64; ++h) { float s = a.in[I_HFB3][h]; for (int k = 0; k < 64; ++k) s += h2[k] * a.in[I_HFW3][k * 64 + h]; h1[h] = sin_acc(a.in[I_HFREQ][128 + h] * s); }
    float s = 0.f; for (int k = 0; k < 64; ++k) s += h1[k] * a.in[I_HFWOUT][(size_t)k * 2048 + c];
    const int ch = c & 1023;
    const float dl = fabsf(-15.350567286626973f + (float)ch * ((-3.0701134573253946f + 15.350567286626973f) / 1023.0f));
    const float ref = s * expf(-zz[0] * dl);
    float got;
    if (isctx) got = ((const float*)(a.ws + (c < 1024 ? HY_HFC : HY_HBC)))[(size_t)n * D + ch];
    else got = ((const float*)(a.ws + (c < 1024 ? HY_HF : HY_HB)))[(size_t)ch * SEQ + n];
    if (!st_close(got, ref, 0.01f, 2e-4f)) st_fail(a, 16u);
}
__device__ __forceinline__ float st_uu(const Args& a, int b, bool isctx, int t, int col) {
    const int Lh = isctx ? CTX : SEQ;
    if (t < 0 || t >= Lh) return 0.f;
    const size_t row = (size_t)b * RPB + (isctx ? 0 : CTX) + t;
    return __uint_as_float((unsigned)((const bf16_t*)(a.ws + HY_UU))[row * 3072 + col] << 16);
}
__device__ __forceinline__ float st_dw(const Args& a, int b, bool isctx, int t, int col) {
    const float* sw = a.in[I_HSW];
    return st_uu(a, b, isctx, t - 1, col) * sw[col] + st_uu(a, b, isctx, t, col) * sw[3072 + col] + st_uu(a, b, isctx, t + 1, col) * sw[2 * 3072 + col] + a.in[I_HSB][col];
}
__device__ __forceinline__ void selftest_hy_p(const Args& a) {
    const int tid = otid(), lane = tid & 63, wid = tid >> 6;
    if (blockIdx.x >= 2) return;
    const int sidx = blockIdx.x * 8 + wid;
    const bool isctx = sidx >= 10;
    const int b = sidx & 1, Lh = isctx ? CTX : SEQ;
    const int tsel = (sidx >> 1) % 5;
    const int t = tsel == 0 ? 0 : (tsel == 1 ? 3 : (tsel == 2 ? Lh / 2 + 1 : (tsel == 3 ? Lh - 2 : Lh - 1)));
    const int c = (sidx * 197 + 11) & 1023;
    float acc = 0.f;
    for (int s = lane; s < Lh; s += 64) {
        const float z = st_dw(a, b, isctx, s, 2048 + c) * st_dw(a, b, isctx, s, 1024 + c);
        float tap;
        if (isctx) tap = (s <= t) ? ((const float*)(a.ws + HY_HFC))[(size_t)(t - s) * D + c] : ((const float*)(a.ws + HY_HBC))[(size_t)(s - t) * D + c];
        else tap = (s <= t) ? ((const float*)(a.ws + HY_HF))[(size_t)c * SEQ + (t - s)] : ((const float*)(a.ws + HY_HB))[(size_t)c * SEQ + (s - t)];
        acc += tap * z;
    }
    acc = wave_sum(acc);
    const float zt = st_dw(a, b, isctx, t, 2048 + c) * st_dw(a, b, isctx, t, 1024 + c), x0 = st_dw(a, b, isctx, t, c);
    const float ref = x0 * (acc + zt * a.in[I_HBIAS][c]);
    const size_t row = (size_t)b * RPB + (isctx ? 0 : CTX) + t;
    const float got = __uint_as_float((unsigned)((const bf16_t*)(a.ws + HY_P))[row * D + c] << 16);
    if (lane == 0 && !st_close(got, ref, 0.03f, 0.02f)) st_fail(a, 16u);
}
#endif

#if HAVE_MLA
__device__ __forceinline__ void st_mla_vec(const Args& a, int row, int h, bool isq, float* o  ) {
    const int b = row / RPB, within = row - b * RPB; const bool lat = within >= CTX; const int tpos = within - CTX;
    float ss = 0.f;
    for (int i = 0; i < 192; ++i) {
        float v;
        if (isq) v = ((const float*)(a.ws + ML_QF))[(size_t)row * 1536 + h * 192 + i];
        else v = i < 128 ? ((const float*)(a.ws + ML_KVF))[(size_t)row * 2048 + h * 256 + i] : ((const float*)(a.ws + ML_QKVA))[(size_t)row * 768 + 640 + (i - 128)];
        o[i] = v; ss += v * v;
    }
    const float rs = rsqrtf(ss / 192.f + 1e-6f);
    const float* gn = a.in[isq ? I_MQN : I_MKN];
    for (int i = 0; i < 192; ++i) o[i] = o[i] * rs * gn[i];
    if (lat) {
        for (int part = 0; part < 2; ++part) {
            const int pos = part == 0 ? (tpos >> 6) : (tpos & 63);
            for (int i = 0; i < 16; ++i) {
                const float inv = exp2f(-(float)i * (13.287712379549449f / 16.f)), ang = (float)pos * inv, c = cos_acc(ang), s = sin_acc(ang);
                const float x1 = o[128 + part * 32 + i], x2 = o[128 + part * 32 + 16 + i];
                o[128 + part * 32 + i] = x1 * c - x2 * s; o[128 + part * 32 + 16 + i] = x1 * s + x2 * c;
            }
        }
    }
}
__device__ __forceinline__ float st_mla_kraw(const Args& a, int row, int h, int i) {
    return i < 128 ? ((const float*)(a.ws + ML_KVF))[(size_t)row * 2048 + h * 256 + i] : ((const float*)(a.ws + ML_QKVA))[(size_t)row * 768 + 640 + (i - 128)];
}
__device__ __forceinline__ float st_mla_qk(const Args& a, const float* qv, int row, int h) {
    const int b = row / RPB, within = row - b * RPB; const bool lat = within >= CTX; const int tpos = within - CTX;
    float ss = 0.f;
#pragma unroll 1
    for (int i = 0; i < 192; ++i) { const float v = st_mla_kraw(a, row, h, i); ss += v * v; }
    const float rs = rsqrtf(ss / 192.f + 1e-6f);
    const float* gn = a.in[I_MKN];
    float dot = 0.f;
#pragma unroll 1
    for (int i = 0; i < 128; ++i) dot += qv[i] * st_mla_kraw(a, row, h, i) * rs * gn[i];
#pragma unroll 1
    for (int part = 0; part < 2; ++part) {
        const int pos = part == 0 ? (tpos >> 6) : (tpos & 63);
#pragma unroll 1
        for (int i = 0; i < 16; ++i) {
            const int i1 = 128 + part * 32 + i, i2 = i1 + 16;
            const float x1 = st_mla_kraw(a, row, h, i1) * rs * gn[i1], x2 = st_mla_kraw(a, row, h, i2) * rs * gn[i2];
            float c = 1.f, s = 0.f;
            if (lat) { const float inv = exp2f(-(float)i * (13.287712379549449f / 16.f)), ang = (float)pos * inv; c = cos_acc(ang); s = sin_acc(ang); }
            dot += qv[i1] * (x1 * c - x2 * s) + qv[i2] * (x1 * s + x2 * c);
        }
    }
    return dot;
}
__device__ __forceinline__ void selftest_mla(const Args& a, unsigned char* lds) {
    const int tid = otid(), lane = tid & 63, wid = tid >> 6;
    if (blockIdx.x != 0) return;
    float* qv = (float*)(lds + LDS_USER) + wid * 192;
    const int b = wid & 1;
    const int within = wid < 2 ? CTX : (wid < 4 ? RPB - 1 : (wid < 6 ? CTX + 5000 + wid : 100 + wid));
    const int h = (wid * 3) & 7, row = b * RPB + within;
    const bool qctx = within < CTX;
    if (lane == 0) st_mla_vec(a, row, h, true, qv);
    __syncthreads();
    const int nkeys = qctx ? CTX : RPB;
    float m = -INFINITY, l = 0.f, acc[8];
#pragma unroll
    for (int i = 0; i < 8; ++i) acc[i] = 0.f;
#pragma unroll 1
    for (int t = lane; t < nkeys; t += 64) {
        const int krow = b * RPB + t;
        const float s = st_mla_qk(a, qv, krow, h) * 0.07216878364870322f;
        const float mn = fmaxf(m, s), al = expf(m - mn), p = expf(s - mn);
        l = l * al + p;
#pragma unroll
        for (int i = 0; i < 8; ++i) acc[i] = acc[i] * al + p * ((const float*)(a.ws + ML_KVF))[(size_t)krow * 2048 + h * 256 + 128 + i * 16 + 3];
        m = mn;
    }
    float mg = m;
#pragma unroll
    for (int o = 32; o >= 1; o >>= 1) mg = fmaxf(mg, __shfl_xor(mg, o));
    const float sc = expf(m - mg);
    const float lt = wave_sum(l * sc);
    bool bad = false;
#pragma unroll
    for (int i = 0; i < 8; ++i) {
        const float ref = wave_sum(acc[i] * sc) / lt;
        const float got = __uint_as_float((unsigned)((const bf16_t*)(a.ws + ML_O))[(size_t)row * 1024 + h * 128 + i * 16 + 3] << 16);
        if (!st_close(got, ref, 0.03f, 0.01f)) bad = true;
    }
    if (bad && lane == 0) st_fail(a, 32u);
}
#endif
__device__ __forceinline__ void selftest_finish(const Args& a) {
    if (blockIdx.x == 0 && otid() == 0) {
        unsigned m = __hip_atomic_load((unsigned*)(a.ws + WS_FLAGS), __ATOMIC_RELAXED, __HIP_MEMORY_SCOPE_AGENT);
        if (__hip_atomic_load((unsigned*)(a.ws + WS_BAR) + XB_TMO, __ATOMIC_RELAXED, __HIP_MEMORY_SCOPE_AGENT)) m |= 8u;
        if (m) a.out[0] = 1e4f * exp2f((float)m);
    }
}
#endif
#if HAVE_HYENA
__device__ __forceinline__ void hyena_layer(const Args& a, unsigned char* lds, int layer, const XcdBarrier& bar) {
    phase_hy_filters(a, lds); xcd_barrier(bar);
#if SELFTEST
    selftest_hy_filters(a, lds); __syncthreads();
#endif
    phase_hy_filter_fft(a, lds); phase_hy_in(a, lds); xcd_barrier(bar);
    phase_hy_short(a, lds); xcd_barrier(bar);
    phase_hy_fftconv(a, lds); xcd_barrier(bar);
    phase_hy_combine(a, lds); xcd_barrier(bar);
#if SELFTEST
    selftest_hy_p(a);
#endif
    phase_outproj(a, lds, layer, (const bf16_t*)(a.ws + HY_P), (const bf16_t*)(a.ws + WS_HYOUTT), a.in[I_HBOUT]); xcd_barrier(bar);
}
#endif
#if HAVE_MLA
__device__ __forceinline__ void mla_layer(const Args& a, unsigned char* lds, int layer, const XcdBarrier& bar) {
    phase_mla_a(a, lds); xcd_barrier(bar);
    phase_mla_norm(a); xcd_barrier(bar);
    phase_mla_b(a, lds); xcd_barrier(bar);
    phase_mla_rope(a, lds); xcd_barrier(bar);
    phase_mla_attn(a, lds); xcd_barrier(bar);
#if SELFTEST
    selftest_mla(a, lds); __syncthreads();
#endif
    phase_outproj(a, lds, layer, (const bf16_t*)(a.ws + ML_O), (const bf16_t*)(a.ws + WS_MWOT), nullptr); xcd_barrier(bar);
}
#endif
constexpr size_t WS_END0 = RW_END > HY_END ? RW_END : HY_END;
constexpr size_t WS_END = WS_END0 > ML_END ? WS_END0 : ML_END;
#ifndef NLAYERS
#define NLAYERS 4
#endif
template <int J> __device__ __forceinline__ void rwkv_layer(const Args& a, unsigned char* lds, int l, const XcdBarrier& bar) {
    phase_rwkv_proj1(a, lds, J); xcd_barrier(bar);
    phase_rwkv_proj2(a, lds, J); xcd_barrier(bar);
#if SELFTEST
    selftest_rwkv_proj(a, J);
#endif
    phase_wkv(a, lds, J);        xcd_barrier(bar);
#if SELFTEST
    selftest_wkv(a, lds, J); __syncthreads();
#endif
    phase_rwkv_readout(a, J);    xcd_barrier(bar);
    phase_outproj(a, lds, l, (const bf16_t*)(a.ws + RW_Z), (const bf16_t*)(a.ws + WS_RWOT) + (size_t)J * D * D, nullptr);
    xcd_barrier(bar);
}
template <int L> __device__ __forceinline__ void ffn_layer(const Args& a, unsigned char* lds, const XcdBarrier& bar) {
    phase_norm<false, false, true, false>(a, lds, L); xcd_barrier(bar);
    phase_moe1(a, lds, L); xcd_barrier(bar);
    phase_moe2(a, lds, L); xcd_barrier(bar);
#if SELFTEST
    selftest_moe(a, lds, L); xcd_barrier(bar);
#endif
}
__global__ void __launch_bounds__(NT, 2) mega(Args a) {
    extern __shared__ __attribute__((aligned(16))) unsigned char lds[];
    if (threadIdx.x < 16) ((volatile LAS unsigned*)lds)[threadIdx.x] = 0u;
    __syncthreads();
    XcdBarrier bar = xcd_barrier_post((unsigned*)(a.ws + WS_BAR), (volatile LAS unsigned*)lds);
    phase_prologue(a, lds);
    xcd_barrier(bar);
    phase_norm<true, false, false, false>(a, lds, 0); xcd_barrier(bar);
    rwkv_layer<0>(a, lds, 0, bar);
    ffn_layer<0>(a, lds, bar);
#if NLAYERS > 1
    phase_norm<false, true, false, false>(a, lds, 1); xcd_barrier(bar);
    hyena_layer(a, lds, 1, bar);
    ffn_layer<1>(a, lds, bar);
#endif
#if NLAYERS > 2
    phase_norm<false, true, false, false>(a, lds, 2); xcd_barrier(bar);
    mla_layer(a, lds, 2, bar);
    ffn_layer<2>(a, lds, bar);
#endif
#if NLAYERS > 3
    phase_norm<false, true, false, false>(a, lds, 3); xcd_barrier(bar);
    rwkv_layer<1>(a, lds, 3, bar);
    ffn_layer<3>(a, lds, bar);
#endif
    phase_norm<false, true, false, true>(a, lds, NLAYERS);
#if SELFTEST
    xcd_barrier(bar); selftest_finish(a);
#endif
}

extern "C" void kernel_launch(void* const* d_in, const int* in_sizes, int n_in, void* d_out, int out_size, void* d_ws, size_t ws_size, hipStream_t stream) {
    static int grid = 0;
    if (grid == 0) {
        int dev = 0, cus = 0, per_cu = 0;
        if (hipGetDevice(&dev) != hipSuccess || hipDeviceGetAttribute(&cus, hipDeviceAttributeMultiprocessorCount, dev) != hipSuccess) { grid = -1; return; }
        if (hipFuncSetAttribute((const void*)mega, hipFuncAttributeMaxDynamicSharedMemorySize, LDS_BYTES) != hipSuccess) { grid = -1; return; }
        if (hipOccupancyMaxActiveBlocksPerMultiprocessor(&per_cu, (const void*)mega, NT, LDS_BYTES) != hipSuccess || per_cu < 1) fprintf(stderr, "occupancy query: %d\n", per_cu);
        (void)hipGetLastError();
        if (n_in != N_IN || ws_size < WS_END) { fprintf(stderr, "kernel_launch: n_in %d ws %zu (need %zu)\n", n_in, ws_size, (size_t)WS_END); grid = -1; return; }
        grid = cus;
    }
    if (grid < 0) return;
    (void)hipMemsetAsync(d_ws, 0, WS_ZERO_BYTES, stream);
    Args a{};
    for (int i = 0; i < N_IN; ++i) a.in[i] = (const float*)d_in[i];
    a.out = (float*)d_out; a.ws = (unsigned char*)d_ws;
    hipLaunchKernelGGL(mega, dim3(grid), dim3(NT), LDS_BYTES, stream, a);
}
```

```cpp
#ifndef HAVE_HYENA
#define HAVE_HYENA 1
#endif
#ifndef HAVE_MLA
#define HAVE_MLA 1
#endif
#ifndef REP_MOE
#define REP_MOE 1
#endif
#ifndef REP_WKV
#define REP_WKV 1
#endif
#ifndef REP_PROJ
#define REP_PROJ 1
#endif
#ifndef REP_PRO
#define REP_PRO 1
#endif
#ifndef REP_ATT
#define REP_ATT 1
#endif
#ifndef REP_FFT
#define REP_FFT 1
#endif
#ifndef REP_EW
#define REP_EW 1
#endif
#ifndef WKV_PHASE
#define WKV_PHASE phase_wkv2
#endif
#ifndef REP_WKVP
#define REP_WKVP 1
#endif
#ifndef REP_WKVS
#define REP_WKVS 1
#endif
#ifndef REP_N0
#define REP_N0 1
#endif
#ifndef REP_MIX
#define REP_MIX 1
#endif
#ifndef REP_P2
#define REP_P2 1
#endif
#ifndef REP_BAR
#define REP_BAR 0
#endif
#ifndef REP_RT
#define REP_RT 1
#endif
#ifndef SHADOW_NOATOM
#define SHADOW_NOATOM 0
#endif
#ifndef REP_NC
#define REP_NC 1
#endif
#ifndef REP_ID
#define REP_ID 0
#endif
#define REPI(id) ((id) == REP_ID ? 2 : 1)
#ifndef WKV_SERIAL
#define WKV_SERIAL 0
#endif
#ifndef MOE1_MAP
#define MOE1_MAP 3
#endif
#ifndef WKNSEG
#define WKNSEG 8
#endif
#include <hip/hip_runtime.h>
#include <cstdio>
#include <cstdint>

#define XB_TMO      128
#define XB_XCNT(j)  (256  + 64 * (j))
#define XB_XSUB(j)  (1280 + 64 * (j))
#define XB_XGEN(j)  (2304 + 64 * (j))
#define XB_TOP      3328
#define XB_TOPGEN   3392
#define XCD_BAR_WORDS 3456
#define XB_SPIN_CAP (1u << 22)
#define LAS __attribute__((address_space(3)))

__device__ __forceinline__ unsigned xb_ld(unsigned* p)              { return __hip_atomic_load(p, __ATOMIC_RELAXED, __HIP_MEMORY_SCOPE_AGENT); }
__device__ __forceinline__ unsigned xb_add(unsigned* p, unsigned v) { return __hip_atomic_fetch_add(p, v, __ATOMIC_RELAXED, __HIP_MEMORY_SCOPE_AGENT); }
__device__ __forceinline__ unsigned xb_xcc_id() { return (unsigned)__builtin_amdgcn_s_getreg((3 << 11) | 20) & 0xFu; }
#define XB_SPIN(cond, bar) do { unsigned _sp = 0; while (cond) { __builtin_amdgcn_s_sleep(1); \
    if ((++_sp & 255u) == 0u) { if (xb_ld(&(bar)[XB_TMO])) break; if (_sp > XB_SPIN_CAP) { atomicAdd(&(bar)[XB_TMO], 1u); break; } } } } while (0)

struct XcdBarrier { unsigned* bar; unsigned x; volatile LAS unsigned* st; };

__device__ __forceinline__ XcdBarrier xcd_barrier_post(unsigned* bar, volatile LAS unsigned* st) {
    XcdBarrier b; b.bar = bar; b.x = xb_xcc_id(); b.st = st;
    if (threadIdx.x == 0) (void)xb_add(&bar[XB_XCNT(b.x)], 1u);
    return b;
}
__device__ __forceinline__ void xcd_barrier_complete(unsigned* bar, unsigned x, unsigned& nloc, unsigned& nx) {
    const unsigned G = gridDim.x * gridDim.y * gridDim.z;
    unsigned sum, cnt, mine, sp = 0u;
    for (;;) {
        sum = 0u; cnt = 0u; mine = 0u;
#pragma unroll
        for (unsigned j = 0; j < 16; ++j) { const unsigned c = xb_ld(&bar[XB_XCNT(j)]); sum += c; cnt += (c > 0u) ? 1u : 0u; mine = (j == x) ? c : mine; }
        if (sum == G) break;
        __builtin_amdgcn_s_sleep(1);
        if ((++sp & 255u) == 0u) { if (xb_ld(&bar[XB_TMO])) break; if (sp > XB_SPIN_CAP) { atomicAdd(&bar[XB_TMO], 1u); break; } }
    }
    nloc = mine > 0u ? mine : 1u; nx = cnt > 0u ? cnt : 1u;
}
__device__ __forceinline__ void xcd_barrier(const XcdBarrier& b) {
    asm volatile("s_waitcnt vmcnt(0)" ::: "memory");
    __syncthreads();
    if (threadIdx.x == 0) {
        unsigned* bar = b.bar;
        __builtin_amdgcn_s_waitcnt(0);
        unsigned nloc = b.st[0], nx = b.st[1];
        if (nloc == 0u) { xcd_barrier_complete(bar, b.x, nloc, nx); b.st[0] = nloc; b.st[1] = nx; }
        const unsigned old = xb_add(&bar[XB_XSUB(b.x)], 1u);
        const unsigned gen = old / nloc;
        if (old + 1u == (gen + 1u) * nloc) {
            __builtin_amdgcn_fence(__ATOMIC_RELEASE, "agent");
            asm volatile("s_waitcnt vmcnt(0)" ::: "memory");
            const unsigned og = xb_add(&bar[XB_TOP], 1u);
            const unsigned tg = og / nx;
            if (og + 1u == (tg + 1u) * nx) xb_add(&bar[XB_TOPGEN], 1u);
            else XB_SPIN(xb_ld(&bar[XB_TOPGEN]) == tg, bar);
            __builtin_amdgcn_fence(__ATOMIC_ACQUIRE, "agent");
            xb_add(&bar[XB_XGEN(b.x)], 1u);
            asm volatile("s_waitcnt vmcnt(0)" ::: "memory");
        } else {
            XB_SPIN(xb_ld(&bar[XB_XGEN(b.x)]) == gen, bar);
            __builtin_amdgcn_fence(__ATOMIC_ACQUIRE, "agent");
            asm volatile("s_waitcnt vmcnt(0)" ::: "memory");
        }
#if TIMING
        if (blockIdx.x == 0) { const unsigned k = b.st[2] + 1u; b.st[2] = k; ((unsigned long long*)(b.bar + 4608))[k] = wall_clock64(); }
#endif
    }
    __syncthreads();
}

typedef unsigned short bf16_t;
typedef short bf16x8 __attribute__((ext_vector_type(8)));
typedef float f32x4 __attribute__((ext_vector_type(4)));
typedef float f32x16 __attribute__((ext_vector_type(16)));
typedef unsigned u32x4 __attribute__((ext_vector_type(4)));
typedef unsigned u32x2 __attribute__((ext_vector_type(2)));

constexpr int NT = 512;
constexpr int LDS_BYTES = 147456;
constexpr int LDS_CTL = 0;
constexpr int LDS_USER = 256;
constexpr int D = 1024, BATCH = 2, SEQ = 16384, CTX = 256, DEPTH = 4;
constexpr int RPB = CTX + SEQ;
constexpr int T = BATCH * RPB;
constexpr int NEXP = 32, TOPK = 4, DEXP = 1024;
constexpr int MAXROWS = T * TOPK + NEXP * 256;

enum { I_X = 0, I_C, I_CTX, I_CCTX, I_ADAW, I_ADAB, I_NMIX, I_NFFN,
       I_RMU, I_RWRKV, I_RW0, I_RW1, I_RW2, I_RA0, I_RA1, I_RA2, I_RG1, I_RG2, I_RKK, I_RKA, I_RRK, I_RLNG, I_RLNB, I_RWO, I_RV0, I_RV1, I_RV2,
       I_HWIN, I_HBIN, I_HSW, I_HSB, I_HFW1, I_HFB1, I_HFW2, I_HFB2, I_HFW3, I_HFB3, I_HFREQ, I_HFWOUT, I_HBIAS, I_HWOUT, I_HBOUT,
       I_MWA, I_MQNG, I_MKVNG, I_MWQB, I_MWKVB, I_MQN, I_MKN, I_MWO,
       I_ERW, I_ERB, I_EWIN, I_EBIN, I_EWOUT, I_EBOUT, N_IN };

struct Args { const float* in[56]; float* out; unsigned char* ws; };

constexpr size_t al256(size_t x) { return (x + 255) & ~(size_t)255; }
constexpr size_t WS_BAR    = 0;
constexpr size_t WS_CNT    = 16384;
constexpr size_t WS_ZERO_BYTES = 1u << 20;
constexpr size_t WS_CNT2   = 65536;
constexpr int    CSTR      = 1088;
constexpr size_t WS_SHADOW_ABS = 4170000000ull;
constexpr size_t WS_MOD    = 1u << 20;
constexpr size_t WS_TW1    = al256(WS_MOD + (size_t)4 * 3 * 6144 * 4);
constexpr size_t WS_TW2    = WS_TW1 + 16384 * 8;
constexpr size_t WS_RWT    = WS_TW2 + 16384 * 8;
constexpr size_t WS_HWOT   = WS_RWT + (size_t)4 * 32 * 1024 * 4;
constexpr size_t WS_X      = WS_HWOT + (size_t)2 * 2048 * 64 * 2;
constexpr size_t WS_H      = WS_X + (size_t)T * D * 4;
constexpr size_t WS_ASGE   = WS_H + (size_t)T * D * 2;
constexpr size_t WS_ASGG   = WS_ASGE + (size_t)T * 4 * 4;
constexpr size_t WS_TOKL   = WS_ASGG + (size_t)T * 4 * 4;
constexpr size_t WS_ACT    = WS_TOKL + (size_t)NEXP * T * 4;
constexpr size_t WS_YB     = WS_ACT + (size_t)MAXROWS * D * 2;
constexpr size_t WS_RKVT   = WS_YB + (size_t)MAXROWS * D * 2;
constexpr size_t WS_RWOT   = WS_RKVT + (size_t)6 * D * D * 2;
constexpr size_t WS_L1T    = WS_RWOT + (size_t)2 * D * D * 2;
constexpr size_t WS_W2T    = WS_L1T + (size_t)2 * 640 * D * 2;
constexpr size_t WS_A2T    = WS_W2T + (size_t)4 * D * 64 * 2;
constexpr size_t WS_G2T    = WS_A2T + (size_t)4 * D * 64 * 2;
constexpr size_t WS_V2T    = WS_G2T + (size_t)2 * D * 192 * 2;
constexpr size_t WS_HYINT  = WS_V2T + (size_t)D * 64 * 2;
constexpr size_t WS_HYOUTT = WS_HYINT + (size_t)3072 * D * 2;
constexpr size_t WS_MWAT   = WS_HYOUTT + (size_t)D * D * 2;
constexpr size_t WS_MWQBT  = WS_MWAT + (size_t)768 * D * 2;
constexpr size_t WS_MWKVBT = WS_MWQBT + (size_t)1536 * 384 * 2;
constexpr size_t WS_MWOT   = WS_MWKVBT + (size_t)2048 * 256 * 2;
constexpr size_t WS_EWINT  = WS_MWOT + (size_t)D * D * 2;
constexpr size_t WS_EWOUTT = WS_EWINT + (size_t)4 * 32 * 2048 * D * 2;
constexpr size_t WS_VFIRST = WS_EWOUTT + (size_t)4 * 32 * D * D * 2;
constexpr size_t WS_MIX    = WS_VFIRST + (size_t)T * D * 4;
constexpr size_t TD4 = (size_t)T * D * 4;
constexpr size_t RW_R   = WS_MIX;
constexpr size_t RW_K   = RW_R + TD4;
constexpr size_t RW_V   = RW_K + TD4;
constexpr size_t RW_G   = RW_V + TD4;
constexpr size_t RW_WD0 = RW_G + TD4;
constexpr size_t RW_WD1 = RW_WD0 + TD4;
constexpr size_t RW_AD0 = RW_WD1 + TD4;
constexpr size_t RW_AD1 = RW_AD0 + TD4;
constexpr size_t RW_Y0  = RW_AD1 + TD4;
constexpr size_t RW_Y1  = RW_Y0 + TD4;
constexpr size_t RW_HL  = RW_Y1 + TD4;
constexpr size_t RW_Z   = RW_HL + (size_t)T * 640 * 2;
constexpr size_t RW_XR  = RW_Z + (size_t)T * D * 2;
constexpr size_t RW_XK  = RW_XR + (size_t)T * D * 2;
constexpr size_t RW_XV  = RW_XK + (size_t)T * D * 2;
constexpr size_t WKSET_B = 13824;
constexpr size_t RW_SETS = RW_XR;
constexpr size_t RW_END = RW_SETS + (size_t)64 * (RPB / 16) * WKSET_B;

template <class TP> __device__ __forceinline__ TP* uniform_ptr(TP* p) {
    const unsigned long long v = (unsigned long long)p;
    const unsigned lo = __builtin_amdgcn_readfirstlane((unsigned)v), hi = __builtin_amdgcn_readfirstlane((unsigned)(v >> 32));
    return (TP*)(__attribute__((address_space(1))) TP*)(((unsigned long long)hi << 32) | lo);
}
__device__ __forceinline__ int otid() { int t = threadIdx.x; asm volatile("" : "+v"(t)); return t; }
typedef float f32x2v __attribute__((ext_vector_type(2)));
typedef __bf16 bf16x2v __attribute__((ext_vector_type(2)));
__device__ __forceinline__ unsigned cvt_pk_bf16(float lo, float hi) { const f32x2v v = {lo, hi}; return __builtin_bit_cast(unsigned, __builtin_convertvector(v, bf16x2v)); }
__device__ __forceinline__ float bf_lo(unsigned u) { return __uint_as_float(u << 16); }
__device__ __forceinline__ float bf_hi(unsigned u) { return __uint_as_float(u & 0xffff0000u); }
template <int CTRL> __device__ __forceinline__ float dpp_f(float v) { return __int_as_float(__builtin_amdgcn_update_dpp(0, __float_as_int(v), CTRL, 0xf, 0xf, false)); }
__device__ __forceinline__ float row16_sum(float v) {
    v += dpp_f<0x128>(v); v += dpp_f<0x124>(v); v += dpp_f<0x122>(v); v += dpp_f<0x121>(v); return v;
}
__device__ __forceinline__ float lane_bcast(float v, int l) { return __int_as_float(__builtin_amdgcn_readlane(__float_as_int(v), l)); }
__device__ __forceinline__ float wave_sum(float v) {
    v = row16_sum(v);
    return (lane_bcast(v, 0) + lane_bcast(v, 16)) + (lane_bcast(v, 32) + lane_bcast(v, 48));
}
__device__ __forceinline__ float sin_acc(float x) {
    const float k = rintf(x * 0.15915494309189535f);
    float r = fmaf(-k, 6.28125f, x); r = fmaf(-k, 1.9353071795864769e-3f, r);
    const float pi = 3.14159265358979f;
    r = r > 0.5f * pi ? pi - r : (r < -0.5f * pi ? -pi - r : r);
    const float r2 = r * r;
    float p = -2.5052108e-8f; p = fmaf(p, r2, 2.7557319e-6f); p = fmaf(p, r2, -1.9841270e-4f); p = fmaf(p, r2, 8.3333333e-3f); p = fmaf(p, r2, -1.6666667e-1f);
    return fmaf(r * r2, p, r);
}
__device__ __forceinline__ float cos_acc(float x) { return sin_acc(x + 1.57079632679489662f); }
__device__ __forceinline__ float sigmoidf_(float x) { return __builtin_amdgcn_rcpf(1.f + __expf(-x)); }
__device__ __forceinline__ int mod_index(int row) { const int b = row / RPB; return (row - b * RPB) < CTX ? 2 : b; }

constexpr int G_A_BYTES = 256 * 64 * 2, G_B_BYTES = 128 * 64 * 2, G_BUF = G_A_BYTES + G_B_BYTES, G_LDS = 2 * G_BUF;
__device__ __forceinline__ int gswz(int row, int ch) { return row * 128 + ((ch ^ ((row >> 1) & 7)) << 4); }

struct ALoadPlain {
    const bf16_t* A; int lda;
    __device__ __forceinline__ u32x4 load(int row, int k) const { return *(const u32x4*)(A + (size_t)row * lda + k); }
};

template <class AL, class EP>
__device__ __forceinline__ void gemm_tile(const AL& al, const bf16_t* __restrict__ Bt, int ldb, int nk, unsigned char* lds, const EP& ep, int m0, int n0) {
    const int tid = otid(), lane = tid & 63, wid = tid >> 6, wm = wid >> 1, wn = wid & 1, fr = lane & 15, fq = lane >> 4;
    f32x4 acc[4][4];
#pragma unroll
    for (int i = 0; i < 4; ++i)
#pragma unroll
        for (int j = 0; j < 4; ++j) acc[i][j] = (f32x4){0.f, 0.f, 0.f, 0.f};
    u32x4 ra[4], rb[2];
    const int srow = tid >> 3, sch = tid & 7;
    {
#pragma unroll
        for (int i = 0; i < 4; ++i) ra[i] = al.load(m0 + srow + i * 64, sch * 8);
#pragma unroll
        for (int i = 0; i < 2; ++i) rb[i] = *(const u32x4*)(Bt + (size_t)(n0 + srow + i * 64) * ldb + sch * 8);
#pragma unroll
        for (int i = 0; i < 4; ++i) *(u32x4*)(lds + gswz(srow + i * 64, sch)) = ra[i];
#pragma unroll
        for (int i = 0; i < 2; ++i) *(u32x4*)(lds + G_A_BYTES + gswz(srow + i * 64, sch)) = rb[i];
    }
    __syncthreads();
    for (int kt = 0; kt < nk; ++kt) {
        const bool more = (kt + 1 < nk);
        if (more) {
#pragma unroll
            for (int i = 0; i < 4; ++i) ra[i] = al.load(m0 + srow + i * 64, (kt + 1) * 64 + sch * 8);
#pragma unroll
            for (int i = 0; i < 2; ++i) rb[i] = *(const u32x4*)(Bt + (size_t)(n0 + srow + i * 64) * ldb + (kt + 1) * 64 + sch * 8);
        }
        const unsigned char* base = lds + (kt & 1) * G_BUF;
#pragma unroll
        for (int ks = 0; ks < 2; ++ks) {
            bf16x8 af[4], bfr[4];
#pragma unroll
            for (int mi = 0; mi < 4; ++mi) af[mi] = *(const bf16x8*)(base + gswz(wm * 64 + mi * 16 + fr, ks * 4 + fq));
#pragma unroll
            for (int ni = 0; ni < 4; ++ni) bfr[ni] = *(const bf16x8*)(base + G_A_BYTES + gswz(wn * 64 + ni * 16 + fr, ks * 4 + fq));
#pragma unroll
            for (int mi = 0; mi < 4; ++mi)
#pragma unroll
                for (int ni = 0; ni < 4; ++ni) acc[mi][ni] = __builtin_amdgcn_mfma_f32_16x16x32_bf16(bfr[ni], af[mi], acc[mi][ni], 0, 0, 0);
        }
        if (more) {
            unsigned char* nb = lds + ((kt + 1) & 1) * G_BUF;
#pragma unroll
            for (int i = 0; i < 4; ++i) *(u32x4*)(nb + gswz(srow + i * 64, sch)) = ra[i];
#pragma unroll
            for (int i = 0; i < 2; ++i) *(u32x4*)(nb + G_A_BYTES + gswz(srow + i * 64, sch)) = rb[i];
        }
        __syncthreads();
    }
    ep(acc, m0 + wm * 64, n0 + wn * 64, fr, fq);
}
template <class F> struct EpiElem {
    F f;
    __device__ __forceinline__ void operator()(const f32x4 (&acc)[4][4], int rbase, int cbase, int fr, int fq) const {
#pragma unroll
        for (int mi = 0; mi < 4; ++mi)
#pragma unroll
            for (int ni = 0; ni < 4; ++ni) f(rbase + mi * 16 + fr, cbase + ni * 16 + fq * 4, acc[mi][ni]);
    }
};
template <class F> __device__ __forceinline__ EpiElem<F> make_epi(F f) { return EpiElem<F>{f}; }

struct Nil {};
template <class FC, class FR, class FS> struct Epi3 {
    FC fc; FR frow; FS fs;
    __device__ __forceinline__ void operator()(const f32x4 (&acc)[4][4], int rbase, int cbase, int fr, int fq) const {
        decltype(fc(0)) ci[4];
#pragma unroll
        for (int ni = 0; ni < 4; ++ni) ci[ni] = fc(cbase + ni * 16 + fq * 4);
        decltype(frow(0, 0)) ri[4][4];
#pragma unroll
        for (int mi = 0; mi < 4; ++mi)
#pragma unroll
            for (int ni = 0; ni < 4; ++ni) ri[mi][ni] = frow(rbase + mi * 16 + fr, cbase + ni * 16 + fq * 4);
#pragma unroll
        for (int mi = 0; mi < 4; ++mi)
#pragma unroll
            for (int ni = 0; ni < 4; ++ni) fs(rbase + mi * 16 + fr, cbase + ni * 16 + fq * 4, acc[mi][ni], ci[ni], ri[mi][ni]);
    }
    __device__ __forceinline__ void operator()(const f32x4 (&acc)[2][2][4][2], int row0, int col0) const {
        decltype(fc(0)) ci[2][2];
#pragma unroll
        for (int bj = 0; bj < 2; ++bj)
#pragma unroll
            for (int n = 0; n < 2; ++n) ci[bj][n] = fc(col0 + bj * 128 + n * 16);
#pragma unroll
        for (int ai = 0; ai < 2; ++ai) {
            decltype(frow(0, 0)) ri[4][2][2];
#pragma unroll
            for (int m = 0; m < 4; ++m)
#pragma unroll
                for (int bj = 0; bj < 2; ++bj)
#pragma unroll
                    for (int n = 0; n < 2; ++n) ri[m][bj][n] = frow(row0 + ai * 128 + m * 16, col0 + bj * 128 + n * 16);
#pragma unroll
            for (int m = 0; m < 4; ++m)
#pragma unroll
                for (int bj = 0; bj < 2; ++bj)
#pragma unroll
                    for (int n = 0; n < 2; ++n) fs(row0 + ai * 128 + m * 16, col0 + bj * 128 + n * 16, acc[ai][bj][m][n], ci[bj][n], ri[m][bj][n]);
        }
    }
};
template <class FC, class FR, class FS> __device__ __forceinline__ Epi3<FC, FR, FS> make_epi3(FC fc, FR fr, FS fs) { return Epi3<FC, FR, FS>{fc, fr, fs}; }
__device__ __forceinline__ Nil nil_col(int) { return Nil{}; }
__device__ __forceinline__ Nil nil_row(int, int) { return Nil{}; }
namespace g8 {
constexpr int BK = 64, HALF = 128, HT = HALF * BK, SHM_B = 8 * HT * 2;
__device__ __forceinline__ int lds_byte(int r, int c) { const int st = (r >> 4) * 2 + (c >> 5), rr = r & 15, cc = c & 31, ob = rr * 64 + cc * 2; return st * 1024 + (ob ^ (((ob >> 9) & 1) << 5)); }
__device__ __forceinline__ void stage_rc(int b, int& R, int& C) { const int st = b / 1024, sb = b % 1024, swz = sb ^ (((sb >> 9) & 1) << 5); R = (st >> 1) * 16 + swz / 64; C = (st & 1) * 32 + (swz % 64) / 2; }

struct AOffPlain { unsigned row0; unsigned lda; __device__ __forceinline__ unsigned operator()(int r) const { return (row0 + (unsigned)r) * lda; } };
template <bool GATHER, class AOff, class Epi>
__device__ __forceinline__ void gemm256(const bf16_t* __restrict__ Abase, const AOff& aoff, const bf16_t* __restrict__ Bt  , int K,
                                        unsigned char* shmb, const Epi& epi, int brow, int bcol) {
    LAS bf16_t* shm = (LAS bf16_t*)shmb;
#define G8_SA(b, h) (shm + ((b) * 2 + (h)) * HT)
#define G8_SB(b, h) (shm + (4 + (b) * 2 + (h)) * HT)
#define G8_STAGE_A(P, h, dk) do { _Pragma("unroll") for (int _i = 0; _i < 2; ++_i) \
        __builtin_amdgcn_raw_ptr_buffer_load_lds(rsA, (LAS void*)((LAS char*)(P) + wid * 1024 + _i * 8192), 16, GATHER ? oa[h][_i] : oa[0][0], \
            sK + (unsigned)((dk) * (BK * 2)) + (GATHER ? 0u : (unsigned)((h) * HALF + _i * 64) * arow_bytes), 0, 0); } while (0)
#define G8_STAGE_B(P, h, dk) do { _Pragma("unroll") for (int _i = 0; _i < 2; ++_i) \
        __builtin_amdgcn_raw_ptr_buffer_load_lds(rsB, (LAS void*)((LAS char*)(P) + wid * 1024 + _i * 8192), 16, ob, \
            sK + (unsigned)((dk) * (BK * 2)) + (unsigned)((h) * HALF + _i * 64) * brow_bytes, 0, 0); } while (0)
#define G8_LDA(dst, b, h) _Pragma("unroll") for (int m = 0; m < 4; ++m) _Pragma("unroll") for (int k = 0; k < 2; ++k) \
        dst[m][k] = *(const LAS bf16x8*)((LAS char*)G8_SA(b, h) + lds_byte(wr * 64 + m * 16 + fr, k * 32 + fq * 8))
#define G8_LDB(dst, b, h) _Pragma("unroll") for (int n = 0; n < 2; ++n) _Pragma("unroll") for (int k = 0; k < 2; ++k) \
        dst[n][k] = *(const LAS bf16x8*)((LAS char*)G8_SB(b, h) + lds_byte(wc * 32 + n * 16 + fr, k * 32 + fq * 8))
#define G8_MMA(ai, bj, At, Bx) do { __builtin_amdgcn_s_setprio(1); \
        _Pragma("unroll") for (int m = 0; m < 4; ++m) _Pragma("unroll") for (int n = 0; n < 2; ++n) _Pragma("unroll") for (int k = 0; k < 2; ++k) \
            acc[ai][bj][m][n] = __builtin_amdgcn_mfma_f32_16x16x32_bf16(Bx[n][k], At[m][k], acc[ai][bj][m][n], 0, 0, 0); \
        __builtin_amdgcn_s_setprio(0); } while (0)
#define G8_WAIT_V(n) asm volatile("s_waitcnt vmcnt(" #n ")" ::: "memory")
#define G8_WAIT_L(n) asm volatile("s_waitcnt lgkmcnt(" #n ")" ::: "memory")
#define G8_BAR __builtin_amdgcn_s_barrier()
#define G8_SCHED __builtin_amdgcn_sched_barrier(0)
    int tz = threadIdx.x; asm volatile("" : "+v"(tz));
    int wid = tz >> 6, lane = tz & 63, wr = wid >> 2, wc = wid & 3, fr = lane & 15, fq = lane >> 4;
    unsigned oa[2][2], ob;
    {
        int R0, C0; stage_rc(tz * 16, R0, C0);
        ob = ((unsigned)R0 * (unsigned)K + (unsigned)C0) * 2u;
        if (GATHER) {
#pragma unroll
            for (int h = 0; h < 2; ++h)
#pragma unroll
                for (int i = 0; i < 2; ++i) oa[h][i] = (aoff(h * HALF + R0 + i * 64) + (unsigned)C0) * 2u;
        } else { oa[0][0] = ((aoff(R0) - aoff(0)) + (unsigned)C0) * 2u; oa[0][1] = oa[1][0] = oa[1][1] = 0u; }
    }
    f32x4 acc[2][2][4][2];
#pragma unroll
    for (int x = 0; x < 2; ++x)
#pragma unroll
        for (int y = 0; y < 2; ++y)
#pragma unroll
            for (int m = 0; m < 4; ++m)
#pragma unroll
                for (int n = 0; n < 2; ++n) acc[x][y][m][n] = (f32x4){0.f, 0.f, 0.f, 0.f};
    bf16x8 At[4][2], B0[2][2], B1[2][2];
    const int nt = K / BK;
    const __amdgpu_buffer_rsrc_t rsA = __builtin_amdgcn_make_buffer_rsrc((void*)(Abase + (GATHER ? 0u : aoff(0))), (short)0, 0x7ffffff0, 0x00020000);
    const __amdgpu_buffer_rsrc_t rsB = __builtin_amdgcn_make_buffer_rsrc((void*)Bt, (short)0, 0x7ffffff0, 0x00020000);
    const unsigned arow_bytes = GATHER ? 0u : (aoff(1) - aoff(0)) * 2u, brow_bytes = (unsigned)K * 2u;
    unsigned sK = 0;
    asm volatile("s_waitcnt vmcnt(0)" ::: "memory");
    G8_STAGE_B(G8_SB(0, 0), 0, 0); G8_STAGE_A(G8_SA(0, 0), 0, 0);
    G8_STAGE_B(G8_SB(0, 1), 1, 0); G8_STAGE_A(G8_SA(0, 1), 1, 0);
    if (wr == 1) G8_BAR;
    G8_WAIT_V(4); G8_BAR;
    G8_STAGE_B(G8_SB(1, 0), 0, 1); G8_STAGE_A(G8_SA(1, 0), 0, 1); G8_STAGE_B(G8_SB(1, 1), 1, 1);
    G8_WAIT_V(6); G8_BAR;
    for (int t = 0; t < nt - 2; t += 2) {
        G8_LDB(B0, 0, 0); G8_SCHED; G8_LDA(At, 0, 0); G8_STAGE_A(G8_SA(1, 1), 1, 1);
        G8_WAIT_L(8); G8_BAR; G8_WAIT_L(0); G8_MMA(0, 0, At, B0); G8_BAR; G8_SCHED;
        G8_LDB(B1, 0, 1); G8_STAGE_B(G8_SB(0, 0), 0, 2);
        G8_BAR; G8_WAIT_L(0); G8_MMA(0, 1, At, B1); G8_BAR;
        G8_LDA(At, 0, 1); G8_STAGE_A(G8_SA(0, 0), 0, 2);
        G8_BAR; G8_WAIT_L(0); G8_MMA(1, 0, At, B0); G8_BAR; G8_SCHED;
        G8_STAGE_B(G8_SB(0, 1), 1, 2);
        G8_WAIT_V(6); G8_BAR; G8_MMA(1, 1, At, B1); G8_BAR;
        G8_LDB(B0, 1, 0); G8_SCHED; G8_LDA(At, 1, 0); G8_STAGE_A(G8_SA(0, 1), 1, 2);
        G8_WAIT_L(8); G8_BAR; G8_WAIT_L(0); G8_MMA(0, 0, At, B0); G8_BAR; G8_SCHED;
        G8_LDB(B1, 1, 1); G8_STAGE_B(G8_SB(1, 0), 0, 3);
        G8_BAR; G8_WAIT_L(0); G8_MMA(0, 1, At, B1); G8_BAR;
        G8_LDA(At, 1, 1); G8_STAGE_A(G8_SA(1, 0), 0, 3);
        G8_BAR; G8_WAIT_L(0); G8_MMA(1, 0, At, B0); G8_BAR; G8_SCHED;
        G8_STAGE_B(G8_SB(1, 1), 1, 3);
        G8_WAIT_V(6); G8_BAR; G8_MMA(1, 1, At, B1); G8_BAR;
        sK += 2 * BK * 2;
    }
    { G8_LDB(B0, 0, 0); G8_WAIT_V(0); G8_LDA(At, 0, 0); G8_STAGE_A(G8_SA(1, 1), 1, 1);
      G8_BAR; G8_WAIT_L(0); G8_MMA(0, 0, At, B0); G8_BAR;
      G8_LDB(B1, 0, 1); G8_BAR; G8_WAIT_L(0); G8_MMA(0, 1, At, B1); G8_BAR;
      G8_LDA(At, 0, 1); G8_WAIT_V(4); G8_BAR; G8_WAIT_L(0); G8_MMA(1, 0, At, B0); G8_MMA(1, 1, At, B1); G8_BAR; }
    { G8_LDB(B0, 1, 0); G8_LDA(At, 1, 0); G8_WAIT_V(2); G8_BAR; G8_WAIT_L(0); G8_MMA(0, 0, At, B0); G8_BAR;
      G8_LDB(B1, 1, 1); G8_WAIT_V(0); G8_BAR; G8_WAIT_L(0); G8_MMA(0, 1, At, B1); G8_BAR;
      G8_LDA(At, 1, 1); G8_BAR; G8_WAIT_L(0); G8_MMA(1, 0, At, B0); G8_MMA(1, 1, At, B1); G8_BAR; }
    if (wr == 0) G8_BAR;
    tz = threadIdx.x; asm volatile("" : "+v"(tz)); wid = tz >> 6; lane = tz & 63; wr = wid >> 2; wc = wid & 3; fr = lane & 15; fq = lane >> 4;
    epi(acc, brow + wr * 64 + fr, bcol + wc * 32 + fq * 4);
#undef G8_SA
#undef G8_SB
#undef G8_STAGE_A
#undef G8_STAGE_B
#undef G8_LDA
#undef G8_LDB
#undef G8_MMA
#undef G8_WAIT_V
#undef G8_WAIT_L
#undef G8_BAR
#undef G8_SCHED
}
template <bool GATHER, class U, class Ctx, class NextFn>
__device__ __forceinline__ void gemm256_stream(int K, unsigned lda, unsigned char* shmb, const Ctx& ctx, NextFn next) {
    LAS bf16_t* shm = (LAS bf16_t*)shmb;
#define G8_SA(b, h) (shm + ((b) * 2 + (h)) * HT)
#define G8_SB(b, h) (shm + (4 + (b) * 2 + (h)) * HT)
#define G8_STAGE_A(P, h, dk, NXT) do { const bool _n = (NXT) && last; const __amdgpu_buffer_rsrc_t _rs = __builtin_amdgcn_make_buffer_rsrc((void*)(_n ? pA_n : pA_c), (short)0, 0x7ffffff0, 0x00020000); \
        _Pragma("unroll") for (int _i = 0; _i < 2; ++_i) \
        __builtin_amdgcn_raw_ptr_buffer_load_lds(_rs, (LAS void*)((LAS char*)(P) + wid * 1024 + _i * 8192), 16, GATHER ? (_n ? oa_n[h][_i] : oa_c[h][_i]) : oa_c[0][0], \
            (_n ? (unsigned)(((dk) - 2) * (BK * 2)) : sK + (unsigned)((dk) * (BK * 2))) + (GATHER ? 0u : (unsigned)((h) * HALF + _i * 64) * arow_bytes), 0, 0); } while (0)
#define G8_STAGE_B(P, h, dk, NXT) do { const bool _n = (NXT) && last; const __amdgpu_buffer_rsrc_t _rs = __builtin_amdgcn_make_buffer_rsrc((void*)(_n ? pB_n : pB_c), (short)0, 0x7ffffff0, 0x00020000); \
        _Pragma("unroll") for (int _i = 0; _i < 2; ++_i) \
        __builtin_amdgcn_raw_ptr_buffer_load_lds(_rs, (LAS void*)((LAS char*)(P) + wid * 1024 + _i * 8192), 16, ob, \
            (_n ? (unsigned)(((dk) - 2) * (BK * 2)) : sK + (unsigned)((dk) * (BK * 2))) + (unsigned)((h) * HALF + _i * 64) * brow_bytes, 0, 0); } while (0)
#define G8_LDA(dst, b, h) _Pragma("unroll") for (int m = 0; m < 4; ++m) _Pragma("unroll") for (int k = 0; k < 2; ++k) \
        dst[m][k] = *(const LAS bf16x8*)((LAS char*)G8_SA(b, h) + lds_byte(wr * 64 + m * 16 + fr, k * 32 + fq * 8))
#define G8_LDB(dst, b, h) _Pragma("unroll") for (int n = 0; n < 2; ++n) _Pragma("unroll") for (int k = 0; k < 2; ++k) \
        dst[n][k] = *(const LAS bf16x8*)((LAS char*)G8_SB(b, h) + lds_byte(wc * 32 + n * 16 + fr, k * 32 + fq * 8))
#define G8_MMA(ai, bj, At, Bx) do { __builtin_amdgcn_s_setprio(1); \
        _Pragma("unroll") for (int m = 0; m < 4; ++m) _Pragma("unroll") for (int n = 0; n < 2; ++n) _Pragma("unroll") for (int k = 0; k < 2; ++k) \
            acc[ai][bj][m][n] = __builtin_amdgcn_mfma_f32_16x16x32_bf16(Bx[n][k], At[m][k], acc[ai][bj][m][n], 0, 0, 0); \
        __builtin_amdgcn_s_setprio(0); } while (0)
#define G8_WAIT_V(n) asm volatile("s_waitcnt vmcnt(" #n ")" ::: "memory")
#define G8_WAIT_L(n) asm volatile("s_waitcnt lgkmcnt(" #n ")" ::: "memory")
#define G8_BAR __builtin_amdgcn_s_barrier()
#define G8_SCHED __builtin_amdgcn_sched_barrier(0)
    int tz = threadIdx.x; asm volatile("" : "+v"(tz));
    int wid = tz >> 6, lane = tz & 63, wr = wid >> 2, wc = wid & 3, fr = lane & 15, fq = lane >> 4;
    unsigned ob;
    { int R0, C0; stage_rc(tz * 16, R0, C0); ob = ((unsigned)R0 * (unsigned)K + (unsigned)C0) * 2u; }
    const unsigned arow_bytes = GATHER ? 0u : lda * 2u, brow_bytes = (unsigned)K * 2u;
    U cur, nxt;
    if (!next(cur)) return;
    const bf16_t* pA_c; const bf16_t* pB_c; const bf16_t* pA_n; const bf16_t* pB_n; unsigned oa_c[2][2], oa_n[2][2];
    auto setup = [&](const U& u, const bf16_t*& pa, const bf16_t*& pb, unsigned (&oa)[2][2]) {
        int tq = threadIdx.x; asm volatile("" : "+v"(tq));
        int R0, C0; stage_rc(tq * 16, R0, C0);
        pa = uniform_ptr(ctx.A(u)); pb = uniform_ptr(ctx.B(u));
        if (GATHER) {
#pragma unroll
            for (int h = 0; h < 2; ++h)
#pragma unroll
                for (int i = 0; i < 2; ++i) oa[h][i] = (ctx.aoff(u, h * HALF + R0 + i * 64) + (unsigned)C0) * 2u;
        } else { oa[0][0] = ((unsigned)R0 * lda + (unsigned)C0) * 2u; oa[0][1] = oa[1][0] = oa[1][1] = 0u; }
    };
    setup(cur, pA_c, pB_c, oa_c);
    bool have_n = next(nxt);
    if (have_n) setup(nxt, pA_n, pB_n, oa_n);
    else { pA_n = pA_c; pB_n = pB_c;
#pragma unroll
        for (int h = 0; h < 2; ++h)
#pragma unroll
            for (int i = 0; i < 2; ++i) oa_n[h][i] = oa_c[h][i]; }
    f32x4 acc[2][2][4][2];
    bf16x8 At[4][2], B0[2][2], B1[2][2];
    const int nt = K / BK;
    unsigned sK = 0;
    {
        const bool last = false;
        asm volatile("s_waitcnt vmcnt(0)" ::: "memory");
        G8_STAGE_B(G8_SB(0, 0), 0, 0, 0); G8_STAGE_A(G8_SA(0, 0), 0, 0, 0);
        G8_STAGE_B(G8_SB(0, 1), 1, 0, 0); G8_STAGE_A(G8_SA(0, 1), 1, 0, 0);
        if (wr == 1) G8_BAR;
        G8_WAIT_V(4); G8_BAR;
        G8_STAGE_B(G8_SB(1, 0), 0, 1, 0); G8_STAGE_A(G8_SA(1, 0), 0, 1, 0); G8_STAGE_B(G8_SB(1, 1), 1, 1, 0);
        G8_WAIT_V(6); G8_BAR;
    }
    for (;;) {
        {
            int t2 = threadIdx.x; asm volatile("" : "+v"(t2));
            ctx.init(cur, acc, ctx.bcol(cur) + ((t2 >> 6) & 3) * 32 + ((t2 & 63) >> 4) * 4);
        }
        sK = 0;
        for (int t = 0; t < nt; t += 2) {
            const bool last = (t + 2 >= nt);
            G8_LDB(B0, 0, 0); G8_SCHED; G8_LDA(At, 0, 0); G8_STAGE_A(G8_SA(1, 1), 1, 1, 0);
            G8_WAIT_L(8); G8_BAR; G8_WAIT_L(0); G8_MMA(0, 0, At, B0); G8_BAR; G8_SCHED;
            G8_LDB(B1, 0, 1); G8_STAGE_B(G8_SB(0, 0), 0, 2, 1);
            G8_BAR; G8_WAIT_L(0); G8_MMA(0, 1, At, B1); G8_BAR;
            G8_LDA(At, 0, 1); G8_STAGE_A(G8_SA(0, 0), 0, 2, 1);
            G8_BAR; G8_WAIT_L(0); G8_MMA(1, 0, At, B0); G8_BAR; G8_SCHED;
            G8_STAGE_B(G8_SB(0, 1), 1, 2, 1);
            G8_WAIT_V(6); G8_BAR; G8_MMA(1, 1, At, B1); G8_BAR;
            G8_LDB(B0, 1, 0); G8_SCHED; G8_LDA(At, 1, 0); G8_STAGE_A(G8_SA(0, 1), 1, 2, 1);
            G8_WAIT_L(8); G8_BAR; G8_WAIT_L(0); G8_MMA(0, 0, At, B0); G8_BAR; G8_SCHED;
            G8_LDB(B1, 1, 1); G8_STAGE_B(G8_SB(1, 0), 0, 3, 1);
            G8_BAR; G8_WAIT_L(0); G8_MMA(0, 1, At, B1); G8_BAR;
            G8_LDA(At, 1, 1); G8_STAGE_A(G8_SA(1, 0), 0, 3, 1);
            G8_BAR; G8_WAIT_L(0); G8_MMA(1, 0, At, B0); G8_BAR; G8_SCHED;
            G8_STAGE_B(G8_SB(1, 1), 1, 3, 1);
            G8_WAIT_V(6); G8_BAR; G8_MMA(1, 1, At, B1); G8_BAR;
            sK += 2 * BK * 2;
        }
        {
            int t2 = threadIdx.x; asm volatile("" : "+v"(t2));
            const int w2 = t2 >> 6, l2 = t2 & 63;
            ctx.epi(cur, acc, ctx.brow(cur) + (w2 >> 2) * 64 + (l2 & 15), ctx.bcol(cur) + (w2 & 3) * 32 + (l2 >> 4) * 4);
        }
        if (!have_n) break;
        cur = nxt; pA_c = pA_n; pB_c = pB_n;
#pragma unroll
        for (int h = 0; h < 2; ++h)
#pragma unroll
            for (int i = 0; i < 2; ++i) oa_c[h][i] = oa_n[h][i];
        have_n = next(nxt);
        if (have_n) setup(nxt, pA_n, pB_n, oa_n);
    }
    G8_WAIT_V(0);
    if (wr == 0) G8_BAR;
    __syncthreads();
#undef G8_SA
#undef G8_SB
#undef G8_STAGE_A
#undef G8_STAGE_B
#undef G8_LDA
#undef G8_LDB
#undef G8_MMA
#undef G8_WAIT_V
#undef G8_WAIT_L
#undef G8_BAR
#undef G8_SCHED
}
template <class F> struct EpiElem256 {
    F f;
    __device__ __forceinline__ void operator()(const f32x4 (&acc)[2][2][4][2], int row0, int col0) const {
#pragma unroll
        for (int ai = 0; ai < 2; ++ai)
#pragma unroll
            for (int m = 0; m < 4; ++m)
#pragma unroll
                for (int bj = 0; bj < 2; ++bj)
#pragma unroll
                    for (int n = 0; n < 2; ++n) f(row0 + ai * HALF + m * 16, col0 + bj * HALF + n * 16, acc[ai][bj][m][n]);
    }
};
template <class F> __device__ __forceinline__ EpiElem256<F> make_epi256(F f) { return EpiElem256<F>{f}; }
struct UTile { int mt, nt, g; };
__device__ __forceinline__ void zero_acc(f32x4 (&acc)[2][2][4][2]) {
#pragma unroll
    for (int ai = 0; ai < 2; ++ai)
#pragma unroll
        for (int bj = 0; bj < 2; ++bj)
#pragma unroll
            for (int m = 0; m < 4; ++m)
#pragma unroll
                for (int n = 0; n < 2; ++n) acc[ai][bj][m][n] = (f32x4){ 0.f, 0.f, 0.f, 0.f };
}
__device__ __forceinline__ void bias_acc(f32x4 (&acc)[2][2][4][2], const float* bias, int col0) {
#pragma unroll
    for (int bj = 0; bj < 2; ++bj)
#pragma unroll
        for (int n = 0; n < 2; ++n) {
            float4 bv = make_float4(0.f, 0.f, 0.f, 0.f);
            if (bias) bv = *(const float4*)(bias + col0 + bj * 128 + n * 16);
#pragma unroll
            for (int ai = 0; ai < 2; ++ai)
#pragma unroll
                for (int m = 0; m < 4; ++m) acc[ai][bj][m][n] = (f32x4){ bv.x, bv.y, bv.z, bv.w };
        }
}
template <class F> __device__ __forceinline__ void each_acc(const f32x4 (&acc)[2][2][4][2], int row0, int col0, F f) {
#pragma unroll
    for (int ai = 0; ai < 2; ++ai)
#pragma unroll
        for (int m = 0; m < 4; ++m)
#pragma unroll
            for (int bj = 0; bj < 2; ++bj)
#pragma unroll
                for (int n = 0; n < 2; ++n) f(row0 + ai * HALF + m * 16, col0 + bj * HALF + n * 16, acc[ai][bj][m][n]);
}
template <class FA, class FB, class FI, class FE> struct CtxL {
    FA fa; FB fb; FI fi; FE fe;
    __device__ __forceinline__ const bf16_t* A(const UTile& u) const { return fa(u); }
    __device__ __forceinline__ const bf16_t* B(const UTile& u) const { return fb(u); }
    __device__ __forceinline__ int brow(const UTile& u) const { return u.mt * 256; }
    __device__ __forceinline__ int bcol(const UTile& u) const { return u.nt * 256; }
    __device__ __forceinline__ unsigned aoff(const UTile&, int) const { return 0u; }
    __device__ __forceinline__ void init(const UTile& u, f32x4 (&acc)[2][2][4][2], int col0) const { fi(u, acc, col0); }
    __device__ __forceinline__ void epi(const UTile& u, const f32x4 (&acc)[2][2][4][2], int row0, int col0) const { fe(u, acc, row0, col0); }
};
template <class FA, class FB, class FI, class FE> __device__ __forceinline__ CtxL<FA, FB, FI, FE> make_ctx(FA fa, FB fb, FI fi, FE fe) { return CtxL<FA, FB, FI, FE>{ fa, fb, fi, fe }; }
}
struct TJob { int in_idx, src_off, K, N, Kpad, Npad, batch, sbs, dbs, perm; size_t dst; };
constexpr int NJOBS = 27;
__constant__ TJob g_jobs[NJOBS] = {
    { I_RWRKV, 0,             1024, 1024, 1024, 1024, 6,   1024 * 1024, 1024 * 1024, 0, WS_RKVT },
    { I_RWO,   0,             1024, 1024, 1024, 1024, 2,   1024 * 1024, 1024 * 1024, 0, WS_RWOT },
    { I_RW1,   0,             1024, 64,   1024, 64,   2,   1024 * 64,   64 * 1024,   0, WS_L1T + (size_t)0 * 1024 * 2 },
    { I_RW1,   2 * 1024 * 64, 1024, 64,   1024, 64,   2,   1024 * 64,   64 * 1024,   0, WS_L1T + (size_t)640 * 1024 * 2 },
    { I_RA1,   0,             1024, 64,   1024, 64,   2,   1024 * 64,   64 * 1024,   0, WS_L1T + (size_t)128 * 1024 * 2 },
    { I_RA1,   2 * 1024 * 64, 1024, 64,   1024, 64,   2,   1024 * 64,   64 * 1024,   0, WS_L1T + (size_t)(640 + 128) * 1024 * 2 },
    { I_RG1,   0,             1024, 160,  1024, 256,  1,   0,           0,           0, WS_L1T + (size_t)256 * 1024 * 2 },
    { I_RG1,   1024 * 160,    1024, 160,  1024, 256,  1,   0,           0,           0, WS_L1T + (size_t)(640 + 256) * 1024 * 2 },
    { I_RV1,   0,             1024, 32,   1024, 128,  1,   0,           0,           0, WS_L1T + (size_t)(640 + 512) * 1024 * 2 },
    { I_RW2,   0,             64,   1024, 64,   1024, 4,   64 * 1024,   1024 * 64,   0, WS_W2T },
    { I_RA2,   0,             64,   1024, 64,   1024, 4,   64 * 1024,   1024 * 64,   0, WS_A2T },
    { I_RG2,   0,             160,  1024, 192,  1024, 2,   160 * 1024,  1024 * 192,  0, WS_G2T },
    { I_RV2,   0,             32,   1024, 64,   1024, 1,   0,           0,           0, WS_V2T },
    { I_HWIN,  0,             1024, 3072, 1024, 3072, 1,   0,           0,           0, WS_HYINT },
    { I_HWOUT, 0,             1024, 1024, 1024, 1024, 1,   0,           0,           0, WS_HYOUTT },
    { I_MWA,   0,             1024, 704,  1024, 768,  1,   0,           0,           0, WS_MWAT },
    { I_MWQB,  0,             384,  1536, 384,  1536, 1,   0,           0,           0, WS_MWQBT },
    { I_MWKVB, 0,             256,  2048, 256,  2048, 1,   0,           0,           0, WS_MWKVBT },
    { I_MWO,   0,             1024, 1024, 1024, 1024, 1,   0,           0,           0, WS_MWOT },
    { I_EWIN,  0 * 32 * 1024 * 2048, 1024, 2048, 1024, 2048, 32, 1024 * 2048, 2048 * 1024, 1, WS_EWINT  + (size_t)0 * 32 * 2048 * 1024 * 2 },
    { I_EWOUT, 0 * 32 * 1024 * 1024, 1024, 1024, 1024, 1024, 32, 1024 * 1024, 1024 * 1024, 0, WS_EWOUTT + (size_t)0 * 32 * 1024 * 1024 * 2 },
    { I_EWIN,  1 * 32 * 1024 * 2048, 1024, 2048, 1024, 2048, 32, 1024 * 2048, 2048 * 1024, 1, WS_EWINT  + (size_t)1 * 32 * 2048 * 1024 * 2 },
    { I_EWOUT, 1 * 32 * 1024 * 1024, 1024, 1024, 1024, 1024, 32, 1024 * 1024, 1024 * 1024, 0, WS_EWOUTT + (size_t)1 * 32 * 1024 * 1024 * 2 },
    { I_EWIN,  2 * 32 * 1024 * 2048, 1024, 2048, 1024, 2048, 32, 1024 * 2048, 2048 * 1024, 1, WS_EWINT  + (size_t)2 * 32 * 2048 * 1024 * 2 },
    { I_EWOUT, 2 * 32 * 1024 * 1024, 1024, 1024, 1024, 1024, 32, 1024 * 1024, 1024 * 1024, 0, WS_EWOUTT + (size_t)2 * 32 * 1024 * 1024 * 2 },
    { I_EWIN,  3 * 32 * 1024 * 2048, 1024, 2048, 1024, 2048, 32, 1024 * 2048, 2048 * 1024, 1, WS_EWINT  + (size_t)3 * 32 * 2048 * 1024 * 2 },
    { I_EWOUT, 3 * 32 * 1024 * 1024, 1024, 1024, 1024, 1024, 32, 1024 * 1024, 1024 * 1024, 0, WS_EWOUTT + (size_t)3 * 32 * 1024 * 1024 * 2 },
};
constexpr int NJ_PRO = NJOBS - 6;
__device__ __forceinline__ int swiglu_perm(int np) { const int nt = np >> 8, bj = (np >> 7) & 1, c = np & 127; return (bj ? 1024 : 0) + nt * 128 + c; }

__device__ __forceinline__ void transpose_unit(const Args& a, float* lt, const TJob& jb, int t, int tid) {
    const int tk = jb.Kpad >> 6, tn = jb.Npad >> 6, gk = (tk + 3) >> 2, per = gk * tn;
    const int bi = t / per, r = t - bi * per, ti_n = r / gk, kg = r - ti_n * gk;
    const float* src = a.in[jb.in_idx] + jb.src_off + (size_t)bi * jb.sbs;
    bf16_t* dst = (bf16_t*)(a.ws + jb.dst) + (size_t)bi * jb.dbs;
    const int kt0 = kg * 4, nkt = (tk - kt0) < 4 ? (tk - kt0) : 4, n0 = ti_n * 64;
    float4 v[4][2];
#pragma unroll
    for (int g = 0; g < 4; ++g)
#pragma unroll
        for (int i = 0; i < 2; ++i) {
            const int item = tid + i * 512, kl = item >> 4, n4 = (item & 15) * 4, k = (kt0 + g) * 64 + kl, np = n0 + n4;
            v[g][i] = make_float4(0.f, 0.f, 0.f, 0.f);
            if (g < nkt && k < jb.K && np < jb.N) { const int col = jb.perm ? swiglu_perm(np) : np; v[g][i] = *(const float4*)(src + (size_t)k * jb.N + col); }
        }
#pragma unroll
    for (int g = 0; g < 4; ++g)
#pragma unroll
        for (int i = 0; i < 2; ++i) {
            const int item = tid + i * 512, kl = item >> 4, n4 = (item & 15) * 4;
            float* p = lt + (g * 64 + kl) * 65 + n4; p[0] = v[g][i].x; p[1] = v[g][i].y; p[2] = v[g][i].z; p[3] = v[g][i].w;
        }
    __syncthreads();
    {
        const int nl = tid >> 3, kc = tid & 7;
#pragma unroll
        for (int g = 0; g < 4; ++g) {
            if (g < nkt) {
                float f[8];
#pragma unroll
                for (int q = 0; q < 8; ++q) f[q] = lt[(g * 64 + kc * 8 + q) * 65 + nl];
                u32x4 o = { cvt_pk_bf16(f[0], f[1]), cvt_pk_bf16(f[2], f[3]), cvt_pk_bf16(f[4], f[5]), cvt_pk_bf16(f[6], f[7]) };
                *(u32x4*)(dst + (size_t)(n0 + nl) * jb.Kpad + (kt0 + g) * 64 + kc * 8) = o;
            }
        }
    }
    __syncthreads();
}
__device__ __forceinline__ int transpose_units_of(const TJob& jb) { const int tk = jb.Kpad >> 6, tn = jb.Npad >> 6, gk = (tk + 3) >> 2; return jb.batch * gk * tn; }
__device__ __forceinline__ void deferred_transposes(const Args& a, unsigned char* lds, int j0, int j1, int part, int nparts, int blk_lo, int nblk) {
    const int tid = otid();
    float* lt = (float*)(lds + LDS_USER);
    const int bl = (int)blockIdx.x - blk_lo;
    if (bl < 0 || bl >= nblk) return;
    __syncthreads();
    for (int j = j0; j < j1; ++j) {
        const TJob jb = g_jobs[j];
        const int total = transpose_units_of(jb), per_part = (total + nparts - 1) / nparts, lo = part * per_part, hi = (lo + per_part) < total ? (lo + per_part) : total;
        for (int t = lo + bl; t < hi; t += nblk) transpose_unit(a, lt, jb, t, tid);
    }
}

__device__ __forceinline__ void phase_prologue(const Args& a, unsigned char* lds) {
    const int tid = otid(), nb = gridDim.x, bid = blockIdx.x;
    float* lt = (float*)(lds + LDS_USER);
    int base = 0;
    for (int j = 0; j < NJ_PRO; ++j) {
        const TJob jb = g_jobs[j];
        const int total = transpose_units_of(jb);
        int t = (bid - base % nb + nb) % nb;
        for (; t < total; t += nb) transpose_unit(a, lt, jb, t, tid);
        base += total;
    }
    for (int u = bid; u < 4 * 96; u += nb) {
        const int l = u / 96, cg = u - l * 96, kg = tid >> 6, cl = tid & 63, col = cg * 64 + cl;
        const float* w = a.in[I_ADAW] + (size_t)l * 1024 * 6144 + col;
        float s0 = 0.f, s1 = 0.f, s2 = 0.f;
        for (int k = kg * 128; k < kg * 128 + 128; ++k) {
            const float wv = w[(size_t)k * 6144];
            float c0 = a.in[I_C][k], c1 = a.in[I_C][1024 + k], c2 = a.in[I_CCTX][k];
            c0 = c0 / (1.f + __expf(-c0)); c1 = c1 / (1.f + __expf(-c1)); c2 = c2 / (1.f + __expf(-c2));
            s0 += c0 * wv; s1 += c1 * wv; s2 += c2 * wv;
        }
        lt[(kg * 3 + 0) * 64 + cl] = s0; lt[(kg * 3 + 1) * 64 + cl] = s1; lt[(kg * 3 + 2) * 64 + cl] = s2;
        __syncthreads();
        if (tid < 192) {
            const int m = tid >> 6;
            float s = a.in[I_ADAB][l * 6144 + col];
#pragma unroll
            for (int g = 0; g < 8; ++g) s += lt[(g * 3 + m) * 64 + cl];
            ((float*)(a.ws + WS_MOD))[((size_t)l * 3 + m) * 6144 + col] = s;
        }
        __syncthreads();
    }
    for (int i = bid * NT + tid; i < 16384; i += nb * NT) {
        float s, c;
        sincospif((float)i / 8192.0f, &s, &c);  ((float2*)(a.ws + WS_TW1))[i] = make_float2(c, -s);
        sincospif((float)i / 16384.0f, &s, &c); ((float2*)(a.ws + WS_TW2))[i] = make_float2(c, -s);
    }
    for (int i = bid * NT + tid; i < 4 * 32 * 1024; i += nb * NT) {
        const int l = i >> 15, e = (i >> 10) & 31, col = i & 1023;
        ((float*)(a.ws + WS_RWT))[i] = a.in[I_ERW][(size_t)l * 32768 + col * 32 + e];
    }
    for (int i = bid * NT + tid; i < 2048 * 64; i += nb * NT) {
        const int col = i >> 6, k = i & 63;
        const float w = a.in[I_HFWOUT][(size_t)k * 2048 + col];
        const unsigned hi = cvt_pk_bf16(w, 0.f) & 0xffffu, lo = cvt_pk_bf16(w - bf_lo(hi), 0.f) & 0xffffu;
        ((bf16_t*)(a.ws + WS_HWOT))[i] = (bf16_t)hi; ((bf16_t*)(a.ws + WS_HWOT))[2048 * 64 + i] = (bf16_t)lo;
    }
}


template <bool SRC_IN, bool COMBINE, bool ROUTER, bool FINAL>
__device__ __forceinline__ void phase_norm(const Args& a, unsigned char* lds, int layer, int shadow = 0) {
    const size_t shoff = shadow ? (size_t)(WS_SHADOW_ABS - WS_ASGE) : 0;
    const int tid = otid(), lane = tid & 63, wid = tid >> 6;
    float* X = (float*)(a.ws + WS_X);
    int* padstart = (int*)(lds + LDS_USER);
    float* rwt = (float*)(lds + LDS_USER + 256);
    if (COMBINE) {
        if (tid == 0) {
            const int* cnt = (const int*)(a.ws + WS_CNT2) + (layer - 1) * 32 * CSTR;
            int acc = 0;
            for (int e = 0; e < 32; ++e) { padstart[e] = acc; acc += ((cnt[e * CSTR] + 255) >> 8) << 8; }
        }
    }
    if (ROUTER) {
        const float4* src = (const float4*)(a.ws + WS_RWT) + (size_t)layer * 8192;
        for (int i = tid; i < 8192; i += NT) ((float4*)rwt)[i] = src[i];
    }
    if (COMBINE || ROUTER) __syncthreads();
    const float* modbase = (const float*)(a.ws + WS_MOD);
    const int rstride = gridDim.x * 8;
    auto ldx = [&](int r, float4 (&x)[4]) {
        if (SRC_IN) {
            const int bb = r / RPB, ww = r - bb * RPB;
            const float* src = ww < CTX ? a.in[I_CTX] + ((size_t)bb * CTX + ww) * D : a.in[I_X] + ((size_t)bb * SEQ + (ww - CTX)) * D;
#pragma unroll
            for (int q = 0; q < 4; ++q) x[q] = *(const float4*)(src + q * 256 + lane * 4);
        } else {
#pragma unroll
            for (int q = 0; q < 4; ++q) x[q] = *(const float4*)(X + (size_t)r * D + q * 256 + lane * 4);
        }
    };
    auto ldasg = [&](int r, int4& e4, float4& g4) { e4 = *(const int4*)((const int*)(a.ws + WS_ASGE) + (size_t)r * 4); g4 = *(const float4*)((const float*)(a.ws + WS_ASGG) + (size_t)r * 4); };
    auto ldyb = [&](const int4& e4, u32x2 (&y)[4][4]) {
        const int es[4] = { e4.x, e4.y, e4.z, e4.w };
#pragma unroll
        for (int k = 0; k < 4; ++k) {
            const size_t yrow = (size_t)padstart[es[k] >> 24] + (es[k] & 0xffffff);
            const bf16_t* yb = (const bf16_t*)(a.ws + WS_YB) + yrow * D;
#pragma unroll
            for (int q = 0; q < 4; ++q) y[k][q] = *(const u32x2*)(yb + q * 256 + lane * 4);
        }
    };
    float4 xn[4]; int4 ae0 = {0, 0, 0, 0}, ae1 = {0, 0, 0, 0}; float4 ag0 = {0.f, 0.f, 0.f, 0.f}, ag1 = ag0; u32x2 ybn[4][4];
    int row = blockIdx.x * 8 + wid;
    if (row < T) {
        ldx(row, xn);
        if (COMBINE) { ldasg(row, ae0, ag0); if (row + rstride < T) ldasg(row + rstride, ae1, ag1); ldyb(ae0, ybn); }
    }
    for (; row < T; row += rstride) {
        const int b = row / RPB, within = row - b * RPB, midx = within < CTX ? 2 : b;
        float4 xv[4]; float4 agc = ag0; u32x2 ybc[4][4];
#pragma unroll
        for (int q = 0; q < 4; ++q) xv[q] = xn[q];
        if (COMBINE) {
#pragma unroll
            for (int k = 0; k < 4; ++k)
#pragma unroll
                for (int q = 0; q < 4; ++q) ybc[k][q] = ybn[k][q];
        }
        {
            const int nrow = row + rstride;
            if (nrow < T) {
                ldx(nrow, xn);
                if (COMBINE) { ae0 = ae1; ag0 = ag1; ldyb(ae0, ybn); if (nrow + rstride < T) ldasg(nrow + rstride, ae1, ag1); }
            }
        }
        if (SRC_IN) {
#pragma unroll
            for (int q = 0; q < 4; ++q) *(float4*)(X + (size_t)row * D + q * 256 + lane * 4) = xv[q];
        }
        if (COMBINE) {
            const float gk[4] = { agc.x, agc.y, agc.z, agc.w };
            float4 f[4];
#pragma unroll
            for (int q = 0; q < 4; ++q) f[q] = make_float4(0.f, 0.f, 0.f, 0.f);
#pragma unroll
            for (int k = 0; k < 4; ++k) {
                const float gate = gk[k];
#pragma unroll
                for (int q = 0; q < 4; ++q) {
                    const u32x2 u = ybc[k][q];
                    f[q].x += gate * bf_lo(u[0]); f[q].y += gate * bf_hi(u[0]); f[q].z += gate * bf_lo(u[1]); f[q].w += gate * bf_hi(u[1]);
                }
            }
            const float* g2 = modbase + ((size_t)(layer - 1) * 3 + midx) * 6144 + 5 * 1024;
#pragma unroll
            for (int q = 0; q < 4; ++q) {
                const float4 g = *(const float4*)(g2 + q * 256 + lane * 4);
                xv[q].x += g.x * f[q].x; xv[q].y += g.y * f[q].y; xv[q].z += g.z * f[q].z; xv[q].w += g.w * f[q].w;
                if (!FINAL) *(float4*)((shadow ? (float*)(a.ws + WS_MIX) : X) + (size_t)row * D + q * 256 + lane * 4) = xv[q];
            }
        }
        if (FINAL) {
            if (within >= CTX) {
                float* o = a.out + ((size_t)b * SEQ + (within - CTX)) * D;
#pragma unroll
                for (int q = 0; q < 4; ++q) *(float4*)(o + q * 256 + lane * 4) = xv[q];
            }
            continue;
        }
        float ss = 0.f;
#pragma unroll
        for (int q = 0; q < 4; ++q) ss += xv[q].x * xv[q].x + xv[q].y * xv[q].y + xv[q].z * xv[q].z + xv[q].w * xv[q].w;
        ss = wave_sum(ss);
        const float rstd = rsqrtf(ss * (1.f / 1024.f) + 1e-6f);
        const float* gn = a.in[ROUTER ? I_NFFN : I_NMIX] + layer * 1024;
        const float* mod = modbase + ((size_t)layer * 3 + midx) * 6144 + (ROUTER ? 3 * 1024 : 0);
        float4 hv[4];
#pragma unroll
        for (int q = 0; q < 4; ++q) {
            const int c = q * 256 + lane * 4;
            const float4 g = *(const float4*)(gn + c), sh = *(const float4*)(mod + c), sc = *(const float4*)(mod + 1024 + c);
            hv[q].x = xv[q].x * rstd * g.x * (1.f + sc.x) + sh.x; hv[q].y = xv[q].y * rstd * g.y * (1.f + sc.y) + sh.y;
            hv[q].z = xv[q].z * rstd * g.z * (1.f + sc.z) + sh.z; hv[q].w = xv[q].w * rstd * g.w * (1.f + sc.w) + sh.w;
            u32x2 o = { cvt_pk_bf16(hv[q].x, hv[q].y), cvt_pk_bf16(hv[q].z, hv[q].w) };
            *(u32x2*)((bf16_t*)(a.ws + WS_H) + (size_t)row * D + c) = o;
        }
        if (ROUTER) {
            float p[32];
#pragma unroll
            for (int e = 0; e < 32; ++e) {
                float s = 0.f;
#pragma unroll
                for (int q = 0; q < 4; ++q) { const float4 w = *(const float4*)(rwt + e * 1024 + q * 256 + lane * 4); s += hv[q].x * w.x + hv[q].y * w.y + hv[q].z * w.z + hv[q].w * w.w; }
                p[e] = s;
                if ((e & 3) == 3) __builtin_amdgcn_sched_barrier(0);
            }
#pragma unroll
            for (int i = 0; i < 16; ++i) { const bool hi = lane & 32; const float snd = hi ? p[i] : p[i + 16], kp = hi ? p[i + 16] : p[i]; p[i] = kp + __shfl_xor(snd, 32); }
#pragma unroll
            for (int i = 0; i < 8; ++i)  { const bool hi = lane & 16; const float snd = hi ? p[i] : p[i + 8],  kp = hi ? p[i + 8]  : p[i]; p[i] = kp + __shfl_xor(snd, 16); }
#pragma unroll
            for (int i = 0; i < 4; ++i)  { const bool hi = lane & 8;  const float snd = hi ? p[i] : p[i + 4],  kp = hi ? p[i + 4]  : p[i]; p[i] = kp + __shfl_xor(snd, 8); }
#pragma unroll
            for (int i = 0; i < 2; ++i)  { const bool hi = lane & 4;  const float snd = hi ? p[i] : p[i + 2],  kp = hi ? p[i + 2]  : p[i]; p[i] = kp + __shfl_xor(snd, 4); }
            { const bool hi = lane & 2; const float snd = hi ? p[0] : p[1], kp = hi ? p[1] : p[0]; p[0] = kp + __shfl_xor(snd, 2); }
            p[0] += __shfl_xor(p[0], 1);
            const int myE = ((lane >> 5) & 1) * 16 + ((lane >> 4) & 1) * 8 + ((lane >> 3) & 1) * 4 + ((lane >> 2) & 1) * 2 + ((lane >> 1) & 1);
            float v = p[0] + a.in[I_ERB][layer * 32 + myE];
            float tv[4]; int ti[4];
#pragma unroll
            for (int r = 0; r < 4; ++r) {
                float bv = v; int bi = myE;
#pragma unroll
                for (int o = 32; o >= 1; o >>= 1) { const float ov = __shfl_xor(bv, o); const int oi = __shfl_xor(bi, o); if (ov > bv || (ov == bv && oi < bi)) { bv = ov; bi = oi; } }
                tv[r] = bv; ti[r] = bi;
                if (myE == bi) v = -INFINITY;
            }
            {
                const float e1 = __expf(tv[1] - tv[0]), e2 = __expf(tv[2] - tv[0]), e3 = __expf(tv[3] - tv[0]);
                const float inv = 1.f / (1.f + e1 + e2 + e3);
                const int   me = lane == 0 ? ti[0] : (lane == 1 ? ti[1] : (lane == 2 ? ti[2] : ti[3]));
                const float mg = lane == 0 ? inv : (lane == 1 ? e1 * inv : (lane == 2 ? e2 * inv : e3 * inv));
                if (lane < 4) {
                    int* cnt = (int*)(a.ws + WS_CNT2) + layer * 32 * CSTR + (shadow ? CSTR / 2 : 0);
                    const int slot = (SHADOW_NOATOM && shadow) ? (row & 4095) : atomicAdd(&cnt[me * CSTR], 1);
                    ((int*)(a.ws + shoff + WS_TOKL))[(size_t)me * T + slot] = row;
                    ((int*)(a.ws + shoff + WS_ASGE))[(size_t)row * 4 + lane] = (me << 24) | slot;
                    ((float*)(a.ws + shoff + WS_ASGG))[(size_t)row * 4 + lane] = mg;
                }
            }
        }
    }
}

namespace rt {
constexpr int RCAP = 320;
constexpr int TROW = 2064;
constexpr int PS = 36;
constexpr int OFF_CNT = LDS_USER;
constexpr int OFF_ABE = OFF_CNT + 256;
constexpr int OFF_ABG = OFF_ABE + RCAP * 16;
constexpr int OFF_TILE = OFF_ABG + RCAP * 16;
constexpr int OFF_PART = OFF_TILE + 2 * 16 * TROW;
constexpr int OFF_END = OFF_PART + 8 * 16 * PS * 4;
static_assert(OFF_END <= LDS_BYTES && OFF_TILE % 16 == 0 && OFF_PART % 16 == 0, "router LDS layout");
}
__device__ __forceinline__ void phase_norm_router(const Args& a, unsigned char* lds, int layer, int shadow = 0) {
    const size_t shoff = shadow ? (size_t)(WS_SHADOW_ABS - WS_ASGE) : 0;
    const int tid = otid(), lane = tid & 63, wid = tid >> 6, fr = lane & 15, fq = lane >> 4;
    const float* X = (const float*)(a.ws + WS_X);
    int* lcnt = (int*)(lds + rt::OFF_CNT); int* gbase = lcnt + 32;
    int* abe = (int*)(lds + rt::OFF_ABE); float* abg = (float*)(lds + rt::OFF_ABG);
    unsigned char* tile = lds + rt::OFF_TILE; float* part = (float*)(lds + rt::OFF_PART);
    if (tid < 32) lcnt[tid] = 0;
    bf16x8 Wh[4][2], Wl[4][2];
    {
        const float* rw = (const float*)(a.ws + WS_RWT) + (size_t)layer * 32768;
#pragma unroll
        for (int ks = 0; ks < 4; ++ks)
#pragma unroll
            for (int b = 0; b < 2; ++b) {
                const float* p = rw + (size_t)(b * 16 + fr) * 1024 + wid * 128 + ks * 32 + fq * 8;
                const float4 w0 = *(const float4*)p, w1 = *(const float4*)(p + 4);
                u32x4 h, l;
                h[0] = cvt_pk_bf16(w0.x, w0.y); h[1] = cvt_pk_bf16(w0.z, w0.w); h[2] = cvt_pk_bf16(w1.x, w1.y); h[3] = cvt_pk_bf16(w1.z, w1.w);
                l[0] = cvt_pk_bf16(w0.x - bf_lo(h[0]), w0.y - bf_hi(h[0])); l[1] = cvt_pk_bf16(w0.z - bf_lo(h[1]), w0.w - bf_hi(h[1]));
                l[2] = cvt_pk_bf16(w1.x - bf_lo(h[2]), w1.y - bf_hi(h[2])); l[3] = cvt_pk_bf16(w1.z - bf_lo(h[3]), w1.w - bf_hi(h[3]));
                Wh[ks][b] = __builtin_bit_cast(bf16x8, h); Wl[ks][b] = __builtin_bit_cast(bf16x8, l);
            }
    }
    const float* modbase = (const float*)(a.ws + WS_MOD);
    const int rstride = gridDim.x * 8, row0 = blockIdx.x * 8 + wid;
    const int niter = (T - (int)blockIdx.x * 8 + rstride - 1) / rstride;
    auto ldx = [&](int r, float4 (&x)[4]) {
#pragma unroll
        for (int q = 0; q < 4; ++q) x[q] = *(const float4*)(X + (size_t)r * D + q * 256 + lane * 4);
    };
    float4 xn[4];
    if (row0 < T) ldx(row0, xn);
    const float biasv = a.in[I_ERB][layer * 32 + (lane & 31)];
    __syncthreads();
    for (int i0 = 0; i0 < niter; i0 += 2) {
#pragma unroll
        for (int ii = 0; ii < 2; ++ii) {
            const int row = row0 + (i0 + ii) * rstride;
            if (row < T) {
                const int b = row / RPB, within = row - b * RPB, midx = within < CTX ? 2 : b;
                float4 xv[4];
#pragma unroll
                for (int q = 0; q < 4; ++q) xv[q] = xn[q];
                if (row + rstride < T) ldx(row + rstride, xn);
                float ss = 0.f;
#pragma unroll
                for (int q = 0; q < 4; ++q) ss += xv[q].x * xv[q].x + xv[q].y * xv[q].y + xv[q].z * xv[q].z + xv[q].w * xv[q].w;
                ss = wave_sum(ss);
                const float rstd = rsqrtf(ss * (1.f / 1024.f) + 1e-6f);
                const float* gn = a.in[I_NFFN] + layer * 1024;
                const float* mod = modbase + ((size_t)layer * 3 + midx) * 6144 + 3 * 1024;
                unsigned char* trow = tile + (ii * 8 + wid) * rt::TROW;
#pragma unroll
                for (int q = 0; q < 4; ++q) {
                    const int c = q * 256 + lane * 4;
                    const float4 g = *(const float4*)(gn + c), sh = *(const float4*)(mod + c), sc = *(const float4*)(mod + 1024 + c);
                    float4 hv;
                    hv.x = xv[q].x * rstd * g.x * (1.f + sc.x) + sh.x; hv.y = xv[q].y * rstd * g.y * (1.f + sc.y) + sh.y;
                    hv.z = xv[q].z * rstd * g.z * (1.f + sc.z) + sh.z; hv.w = xv[q].w * rstd * g.w * (1.f + sc.w) + sh.w;
                    const u32x2 hi = { cvt_pk_bf16(hv.x, hv.y), cvt_pk_bf16(hv.z, hv.w) };
                    const u32x2 lo = { cvt_pk_bf16(hv.x - bf_lo(hi[0]), hv.y - bf_hi(hi[0])), cvt_pk_bf16(hv.z - bf_lo(hi[1]), hv.w - bf_hi(hi[1])) };
                    *(u32x2*)((bf16_t*)(a.ws + WS_H) + (size_t)row * D + c) = hi;
                    *(u32x2*)(trow + c * 2) = hi;
                    *(u32x2*)(trow + 16 * rt::TROW + c * 2) = lo;
                }
            }
        }
        __syncthreads();
        {
            f32x4 acc[2] = { (f32x4){0.f, 0.f, 0.f, 0.f}, (f32x4){0.f, 0.f, 0.f, 0.f} };
#pragma unroll
            for (int ks = 0; ks < 4; ++ks) {
                const unsigned char* p = tile + fr * rt::TROW + (wid * 128 + ks * 32 + fq * 8) * 2;
                const bf16x8 Bh = *(const bf16x8*)p, Bl = *(const bf16x8*)(p + 16 * rt::TROW);
#pragma unroll
                for (int b = 0; b < 2; ++b) {
                    acc[b] = __builtin_amdgcn_mfma_f32_16x16x32_bf16(Wh[ks][b], Bh, acc[b], 0, 0, 0);
                    acc[b] = __builtin_amdgcn_mfma_f32_16x16x32_bf16(Wl[ks][b], Bh, acc[b], 0, 0, 0);
                    acc[b] = __builtin_amdgcn_mfma_f32_16x16x32_bf16(Wh[ks][b], Bl, acc[b], 0, 0, 0);
                }
            }
#pragma unroll
            for (int b = 0; b < 2; ++b) *(f32x4*)(part + (wid * 16 + fr) * rt::PS + b * 16 + fq * 4) = acc[b];
        }
        __syncthreads();
        {
            const int hf = lane >> 5, tr = 2 * wid + hf, e = lane & 31;
            float v = biasv;
#pragma unroll
            for (int w = 0; w < 8; ++w) v += part[(w * 16 + tr) * rt::PS + e];
            const int ww = tr & 7, it = i0 + (tr >> 3);
            const int row = blockIdx.x * 8 + ww + it * rstride;
            float tv[4]; int ti[4];
#pragma unroll
            for (int r = 0; r < 4; ++r) {
                float m = v;
                m = fmaxf(m, dpp_f<0x128>(m)); m = fmaxf(m, dpp_f<0x124>(m)); m = fmaxf(m, dpp_f<0x122>(m)); m = fmaxf(m, dpp_f<0x121>(m));
                const float m0 = __int_as_float(__builtin_amdgcn_readlane(__float_as_int(m), 0)),  m1 = __int_as_float(__builtin_amdgcn_readlane(__float_as_int(m), 16));
                const float m2 = __int_as_float(__builtin_amdgcn_readlane(__float_as_int(m), 32)), m3 = __int_as_float(__builtin_amdgcn_readlane(__float_as_int(m), 48));
                const float mx = hf ? fmaxf(m2, m3) : fmaxf(m0, m1);
                const unsigned long long bal = __ballot(v == mx);
                const unsigned hm = hf ? (unsigned)(bal >> 32) : (unsigned)bal;
                const int first = __ffs(hm) - 1;
                tv[r] = mx; ti[r] = first;
                if (e == first) v = -INFINITY;
            }
            const float e1 = __expf(tv[1] - tv[0]), e2 = __expf(tv[2] - tv[0]), e3 = __expf(tv[3] - tv[0]);
            const float inv = 1.f / (1.f + e1 + e2 + e3);
            const int   me = e == 0 ? ti[0] : (e == 1 ? ti[1] : (e == 2 ? ti[2] : ti[3]));
            const float mg = e == 0 ? inv : (e == 1 ? e1 * inv : (e == 2 ? e2 * inv : e3 * inv));
            if (e < 4 && row < T && it < niter) {
                const int ls = atomicAdd(&lcnt[me], 1);
                const int li = it * 8 + ww;
                abe[li * 4 + e] = (me << 24) | ls;
                abg[li * 4 + e] = mg;
            }
        }
    }
    __syncthreads();
    if (tid < 32) {
        int* cnt = (int*)(a.ws + WS_CNT2) + layer * 32 * CSTR + (shadow ? CSTR / 2 : 0);
        gbase[tid] = atomicAdd(&cnt[tid * CSTR], lcnt[tid]);
    }
    __syncthreads();
    for (int idx = tid; idx < niter * 32; idx += NT) {
        const int li = idx >> 2, k = idx & 3, row = blockIdx.x * 8 + (li & 7) + (li >> 3) * rstride;
        if (row < T) {
            const int ev = abe[idx], e = ev >> 24, slot = gbase[e] + (ev & 0xffffff);
            ((int*)(a.ws + shoff + WS_TOKL))[(size_t)e * T + slot] = row;
            ((int*)(a.ws + shoff + WS_ASGE))[(size_t)row * 4 + k] = (e << 24) | slot;
            ((float*)(a.ws + shoff + WS_ASGG))[(size_t)row * 4 + k] = abg[idx];
        }
    }
}
struct ALoadMix {
    const bf16_t* H; const float* mu;
    __device__ __forceinline__ u32x4 load(int row, int k) const {
        const int within = row % RPB;
        const bool first = (within == 0) || (within == CTX), last = (within == CTX - 1) || (within == RPB - 1);
        const bf16_t* p = H + (size_t)row * D + k;
        const u32x4 c = *(const u32x4*)p;
        u32x4 pv = {0u, 0u, 0u, 0u}, nv = {0u, 0u, 0u, 0u};
        if (!first) pv = *(const u32x4*)(p - D);
        if (!last)  nv = *(const u32x4*)(p + D);
        const float4 m0 = *(const float4*)(mu + k), m1 = *(const float4*)(mu + k + 4);
        const float mm[8] = { m0.x, m0.y, m0.z, m0.w, m1.x, m1.y, m1.z, m1.w };
        u32x4 o;
#pragma unroll
        for (int i = 0; i < 4; ++i) {
            const float h0 = bf_lo(c[i]), h1 = bf_hi(c[i]);
            const float x0 = h0 + (0.5f * (bf_lo(pv[i]) + bf_lo(nv[i])) - h0) * mm[2 * i];
            const float x1 = h1 + (0.5f * (bf_hi(pv[i]) + bf_hi(nv[i])) - h1) * mm[2 * i + 1];
            o[i] = cvt_pk_bf16(x0, x1);
        }
        return o;
    }
};

__device__ __forceinline__ void phase_rwkv_mix(const Args& a, int j) {
    const int tid = otid();
    const bf16_t* H = (const bf16_t*)(a.ws + WS_H);
    const float* mu = a.in[I_RMU] + (size_t)j * 6 * D;
#pragma unroll 2
    for (int it = blockIdx.x * NT + tid; it < T * 128; it += gridDim.x * NT) {
        const int row = it >> 7, k = (it & 127) * 8;
        const int within = row % RPB;
        const bool first = (within == 0) || (within == CTX), last = (within == CTX - 1) || (within == RPB - 1);
        const bf16_t* p = H + (size_t)row * D + k;
        const u32x4 c = *(const u32x4*)p;
        u32x4 pv = {0u, 0u, 0u, 0u}, nv = {0u, 0u, 0u, 0u};
        if (!first) pv = *(const u32x4*)(p - D);
        if (!last)  nv = *(const u32x4*)(p + D);
        float hc[8], xx[8];
#pragma unroll
        for (int i = 0; i < 4; ++i) {
            hc[2 * i] = bf_lo(c[i]); hc[2 * i + 1] = bf_hi(c[i]);
            xx[2 * i] = 0.5f * (bf_lo(pv[i]) + bf_lo(nv[i])) - hc[2 * i]; xx[2 * i + 1] = 0.5f * (bf_hi(pv[i]) + bf_hi(nv[i])) - hc[2 * i + 1];
        }
#pragma unroll
        for (int g = 0; g < 3; ++g) {
            const int mi = (g == 0) ? 0 : (g == 1 ? 2 : 3);
            const float4 m0 = *(const float4*)(mu + mi * D + k), m1 = *(const float4*)(mu + mi * D + k + 4);
            const float mm[8] = { m0.x, m0.y, m0.z, m0.w, m1.x, m1.y, m1.z, m1.w };
            u32x4 o;
#pragma unroll
            for (int i = 0; i < 4; ++i) o[i] = cvt_pk_bf16(hc[2 * i] + xx[2 * i] * mm[2 * i], hc[2 * i + 1] + xx[2 * i + 1] * mm[2 * i + 1]);
            *(u32x4*)((bf16_t*)(a.ws + (g == 0 ? RW_XR : (g == 1 ? RW_XK : RW_XV))) + (size_t)row * D + k) = o;
        }
    }
}
__device__ __forceinline__ void phase_rwkv_proj1(const Args& a, unsigned char* lds, int j) {
    unsigned char* gl = lds + LDS_USER;
    const bf16_t* H = (const bf16_t*)(a.ws + WS_H);
    const int nl = (j == 0) ? 4 : 5, NL = 130 * nl;
    const float* mu = a.in[I_RMU] + (size_t)j * 6 * D;
    int u = blockIdx.x;
    for (; u < NL; u += gridDim.x) {
        const int mt = u / nl, nt = u - mt * nl, m0 = mt * 256;
        const int mi = (nt == 0) ? 1 : (nt == 1 ? 4 : (nt < 4 ? 5 : 3));
        const bf16_t* Bt = (const bf16_t*)(a.ws + WS_L1T) + (size_t)j * 640 * D;
        bf16_t* HL = (bf16_t*)(a.ws + RW_HL);
        ALoadMix al{ H, mu + mi * D };
        gemm_tile(al, Bt, D, 16, gl, make_epi([=](int row, int col, const f32x4& v) {
            float o[4];
#pragma unroll
            for (int i = 0; i < 4; ++i) { float x = v[i]; if (nt == 0) x = 1.f - 2.f * __builtin_amdgcn_rcpf(1.f + __expf(2.f * x));   else if (nt == 2 || nt == 3) x = sigmoidf_(x); o[i] = x; }
            u32x2 w = { cvt_pk_bf16(o[0], o[1]), cvt_pk_bf16(o[2], o[3]) };
            *(u32x2*)(HL + (size_t)row * 640 + col) = w;
        }), m0, nt * 128);
    }
    __syncthreads();
    const unsigned char* ws = a.ws;
    const int xq = blockIdx.x & 7, nxw = (gridDim.x + 7 - xq) >> 3;
    int si = blockIdx.x >> 3;
    auto next = [&](g8::UTile& t) -> bool {
        const int m4 = si / 6, s = (xq & 1) * 6 + (si - m4 * 6), mt = 4 * m4 + (xq >> 1);
        if (mt >= 130) return false;
        si += nxw;
        t.mt = mt; t.g = s >> 2; t.nt = s & 3;
        return true;
    };
    const auto ctx = g8::make_ctx(
        [=](const g8::UTile& t) { return (const bf16_t*)(ws + (t.g == 0 ? RW_XR : (t.g == 1 ? RW_XK : RW_XV))) + (size_t)t.mt * 256 * D; },
        [=](const g8::UTile& t) { return (const bf16_t*)(ws + WS_RKVT) + (size_t)(j * 3 + t.g) * D * D + (size_t)t.nt * 256 * D; },
        [=](const g8::UTile&, f32x4 (&acc)[2][2][4][2], int) { g8::zero_acc(acc); },
        [=](const g8::UTile& t, const f32x4 (&acc)[2][2][4][2], int row0, int col0) {
            bf16_t* out = uniform_ptr((bf16_t*)(ws + (t.g == 0 ? RW_R : (t.g == 1 ? RW_K : (j == 0 ? WS_VFIRST : RW_V)))));
            g8::each_acc(acc, row0, col0, [=](int row, int col, const f32x4& vv) { *(u32x2*)(out + (size_t)row * D + col) = (u32x2){ cvt_pk_bf16(vv[0], vv[1]), cvt_pk_bf16(vv[2], vv[3]) }; });
        });
    g8::gemm256_stream<false, g8::UTile>(D, (unsigned)D, gl, ctx, next);
}
template <int KS, bool DBUF, class FB, class FR, class FE>
__device__ __forceinline__ void p2_wave_run(const bf16_t* A, const bf16_t* Bt, bf16_t* out, int row0, int q_lo, int q_hi, int lane, FB fbias, FR frow, FE fe) {
    const int fr = lane & 15, fq = lane >> 4;
    bf16x8 Af[4][KS];
#pragma unroll
    for (int mb = 0; mb < 4; ++mb)
#pragma unroll
        for (int ks = 0; ks < KS; ++ks) Af[mb][ks] = *(const bf16x8*)(A + (size_t)(row0 + mb * 16 + fr) * 640 + ks * 32 + fq * 8);
    const int bcol = (fr >> 2) * 8 + (fr & 3);
    bf16x8 Bf[2][KS], Bn[2][KS];
    decltype(fbias(0)) bi[2], bn[2];
    auto ldB = [&](int q, bf16x8 (&bf)[2][KS], decltype(fbias(0)) (&bb)[2]) {
#pragma unroll
        for (int nb = 0; nb < 2; ++nb) {
#pragma unroll
            for (int ks = 0; ks < KS; ++ks) bf[nb][ks] = *(const bf16x8*)(Bt + (size_t)(q * 32 + bcol + nb * 4) * (KS * 32) + ks * 32 + fq * 8);
            bb[nb] = fbias(q * 32 + fq * 8 + nb * 4);
        }
    };
    ldB(q_lo, Bf, bi);
#pragma unroll 1
    for (int q = q_lo; q < q_hi; ++q) {
        if (DBUF) { if (q + 1 < q_hi) ldB(q + 1, Bn, bn); }
        const int c0 = q * 32 + fq * 8;
        decltype(frow(0, 0)) ex[4][2];
#pragma unroll
        for (int nb = 0; nb < 2; ++nb)
#pragma unroll
            for (int mb = 0; mb < 4; ++mb) ex[mb][nb] = frow(row0 + mb * 16 + fr, c0 + nb * 4);
        f32x4 acc[4][2];
#pragma unroll
        for (int mb = 0; mb < 4; ++mb)
#pragma unroll
            for (int nb = 0; nb < 2; ++nb) {
                acc[mb][nb] = (f32x4){0.f, 0.f, 0.f, 0.f};
#pragma unroll
                for (int ks = 0; ks < KS; ++ks) acc[mb][nb] = __builtin_amdgcn_mfma_f32_16x16x32_bf16(Bf[nb][ks], Af[mb][ks], acc[mb][nb], 0, 0, 0);
            }
#pragma unroll
        for (int mb = 0; mb < 4; ++mb) {
            const f32x4 o0 = fe(acc[mb][0], bi[0], ex[mb][0]), o1 = fe(acc[mb][1], bi[1], ex[mb][1]);
            *(u32x4*)(out + (size_t)(row0 + mb * 16 + fr) * D + c0) = (u32x4){ cvt_pk_bf16(o0[0], o0[1]), cvt_pk_bf16(o0[2], o0[3]), cvt_pk_bf16(o1[0], o1[1]), cvt_pk_bf16(o1[2], o1[3]) };
        }
        if (DBUF) {
#pragma unroll
            for (int nb = 0; nb < 2; ++nb) { bi[nb] = bn[nb];
#pragma unroll
                for (int ks = 0; ks < KS; ++ks) Bf[nb][ks] = Bn[nb][ks]; }
        } else if (q + 1 < q_hi) ldB(q + 1, Bf, bi);
    }
}
__device__ __forceinline__ void phase_rwkv_proj2(const Args& a, unsigned char* lds, int j) {
    const int tid = otid(), lane = tid & 63, wid = tid >> 6;
    const bf16_t* HL = (const bf16_t*)(a.ws + RW_HL);
    const int NG = (j == 0) ? 5 : 6;
    const int U = 520 * NG * 8, nw = gridDim.x * 8, gw = blockIdx.x * 8 + wid;
    int u = (int)(((long long)U * gw) / nw);
    const int u_hi = (int)(((long long)U * (gw + 1)) / nw);
    while (u < u_hi) {
        const int grp = u >> 3, rb = grp / NG, g = grp - rb * NG, row0 = rb * 64;
        const int run_end = ((grp + 1) << 3) < u_hi ? ((grp + 1) << 3) : u_hi;
        const int q_lo = (u & 7) * 4, q_hi = q_lo + (run_end - u) * 4;
        if (g < 2) {
            const int d = g;
            const float* w0 = a.in[I_RW0] + (size_t)(j * 2 + d) * D;
            p2_wave_run<2, true>(HL + d * 64, (const bf16_t*)(a.ws + WS_W2T) + (size_t)(j * 2 + d) * D * 64, (bf16_t*)(a.ws + (d == 0 ? RW_WD0 : RW_WD1)), row0, q_lo, q_hi, lane,
                [=](int col) { return *(const float4*)(w0 + col); }, nil_row, [=](const f32x4& v, const float4& b, Nil) {
                return (f32x4){ 0.6065306597126334f * sigmoidf_(b.x + v[0]), 0.6065306597126334f * sigmoidf_(b.y + v[1]), 0.6065306597126334f * sigmoidf_(b.z + v[2]), 0.6065306597126334f * sigmoidf_(b.w + v[3]) };
            });
        } else if (g < 4) {
            const int d = g - 2;
            const float* a0 = a.in[I_RA0] + (size_t)(j * 2 + d) * D;
            p2_wave_run<2, true>(HL + 128 + d * 64, (const bf16_t*)(a.ws + WS_A2T) + (size_t)(j * 2 + d) * D * 64, (bf16_t*)(a.ws + (d == 0 ? RW_AD0 : RW_AD1)), row0, q_lo, q_hi, lane,
                [=](int col) { return *(const float4*)(a0 + col); }, nil_row, [=](const f32x4& v, const float4& b, Nil) {
                return (f32x4){ sigmoidf_(b.x + v[0]), sigmoidf_(b.y + v[1]), sigmoidf_(b.z + v[2]), sigmoidf_(b.w + v[3]) };
            });
        } else if (g == 4) {
            p2_wave_run<6, false>(HL + 256, (const bf16_t*)(a.ws + WS_G2T) + (size_t)j * D * 192, (bf16_t*)(a.ws + RW_G), row0, q_lo, q_hi, lane,
                nil_col, nil_row, [=](const f32x4& v, Nil, Nil) { return v; });
        } else {
            bf16_t* V = (bf16_t*)(a.ws + RW_V);
            const bf16_t* VF = (const bf16_t*)(a.ws + WS_VFIRST);
            const float* v0 = a.in[I_RV0];
            struct VR { u32x2 cur, vf; };
            p2_wave_run<2, true>(HL + 512, (const bf16_t*)(a.ws + WS_V2T), V, row0, q_lo, q_hi, lane,
                [=](int col) { return *(const float4*)(v0 + col); },
                [=](int row, int col) { return VR{ *(const u32x2*)(V + (size_t)row * D + col), *(const u32x2*)(VF + (size_t)row * D + col) }; },
                [=](const f32x4& v, const float4& b, const VR& rr) {
                const float cur[4] = { bf_lo(rr.cur[0]), bf_hi(rr.cur[0]), bf_lo(rr.cur[1]), bf_hi(rr.cur[1]) }, vf[4] = { bf_lo(rr.vf[0]), bf_hi(rr.vf[0]), bf_lo(rr.vf[1]), bf_hi(rr.vf[1]) };
                return (f32x4){ cur[0] + (vf[0] - cur[0]) * sigmoidf_(b.x + v[0]), cur[1] + (vf[1] - cur[1]) * sigmoidf_(b.y + v[1]),
                                cur[2] + (vf[2] - cur[2]) * sigmoidf_(b.z + v[2]), cur[3] + (vf[3] - cur[3]) * sigmoidf_(b.w + v[3]) };
            });
        }
        u = run_end;
    }
}
constexpr int WK_CH = 32;
constexpr int WK_VEC = 5 * WK_CH * 64 * 4, WK_VQ = WK_CH * 16 * 4, WK_BUF = WK_VEC + WK_VQ;
constexpr int WK_YP = WK_CH * 16 * 4 * 4;
typedef float f32x2 __attribute__((ext_vector_type(2)));
__device__ __forceinline__ void phase_wkv(const Args& a, unsigned char* lds, int j) {
    const int tid = otid(), lane = tid & 63, wid = tid >> 6;
    unsigned char* base = lds + LDS_USER;
    float* ypart = (float*)(base + 2 * WK_BUF);
    const float* R = (const float*)(a.ws + RW_R); const float* K = (const float*)(a.ws + RW_K);
    const float* V = (const float*)(a.ws + (j == 0 ? WS_VFIRST : RW_V));
    for (int unit = blockIdx.x; unit < 256; unit += gridDim.x) {
        const int chain = unit >> 2, qv = unit & 3, b = chain >> 5, h = (chain >> 1) & 15, d = chain & 1;
        const float* WD = (const float*)(a.ws + (d == 0 ? RW_WD0 : RW_WD1));
        const float* AD = (const float*)(a.ws + (d == 0 ? RW_AD0 : RW_AD1));
        float* Y = (float*)(a.ws + (d == 0 ? RW_Y0 : RW_Y1));
        const int ch0 = h * 64;
        auto rowof = [&](int t) -> size_t { const int p = (d == 0) ? t : ((t < CTX) ? (CTX - 1 - t) : (RPB + CTX - 1 - t)); return (size_t)b * RPB + p; };
        constexpr int NCH = RPB / WK_CH;
        if (wid >= 4) {
            const int sw = wid - 4;
            const float kkw = a.in[I_RKK][j * D + ch0 + lane], kaw = a.in[I_RKA][j * D + ch0 + lane];
            float fr[8], fk[8], fw[8], fa[8], fv[8];
            auto issue = [&](int c) {
#pragma unroll
                for (int i = 0; i < 8; ++i) {
                    const size_t row = rowof(c * WK_CH + sw * 8 + i); const size_t o = row * D + ch0 + lane;
                    fr[i] = R[o]; fk[i] = K[o]; fw[i] = WD[o]; fa[i] = AD[o];
                    fv[i] = V[row * D + ch0 + qv * 16 + (lane & 15)];
                }
            };
            auto process = [&](int buf) {
                float* vec = (float*)(base + buf * WK_BUF); float* vq = (float*)(base + buf * WK_BUF + WK_VEC);
                float kkv[8], n2[8];
#pragma unroll
                for (int i = 0; i < 8; ++i) { kkv[i] = fk[i] * kkw; n2[i] = row16_sum(kkv[i] * kkv[i]); }
#pragma unroll
                for (int i = 0; i < 8; ++i) n2[i] += __shfl_xor(n2[i], 16);
#pragma unroll
                for (int i = 0; i < 8; ++i) n2[i] += __shfl_xor(n2[i], 32);
#pragma unroll
                for (int i = 0; i < 8; ++i) {
                    const int s = sw * 8 + i;
                    const float kk = kkv[i] / fmaxf(sqrtf(n2[i]), 1e-12f);
                    vec[(0 * WK_CH + s) * 64 + lane] = fr[i]; vec[(1 * WK_CH + s) * 64 + lane] = fw[i]; vec[(2 * WK_CH + s) * 64 + lane] = kk;
                    vec[(3 * WK_CH + s) * 64 + lane] = kk * fa[i]; vec[(4 * WK_CH + s) * 64 + lane] = fk[i] * (1.f + (fa[i] - 1.f) * kaw);
                    if (lane < 16) vq[s * 16 + lane] = fv[i];
                }
            };
            auto yout = [&](int c, int buf) {
                const int st = tid - 256;
#pragma unroll
                for (int i = 0; i < 2; ++i) {
                    const int idx = st + i * 256, s = idx >> 4, i16 = idx & 15;
                    const float4 p = *(const float4*)(ypart + buf * (WK_CH * 64) + idx * 4);
                    Y[rowof(c * WK_CH + s) * D + ch0 + qv * 16 + i16] = (p.x + p.y) + (p.z + p.w);
                }
            };
            issue(0); process(0); issue(1);
            __syncthreads();
            for (int c = 0; c < NCH; ++c) {
                if (c > 0) yout(c - 1, (c - 1) & 1);
                if (c + 1 < NCH) { process((c + 1) & 1); if (c + 2 < NCH) issue(c + 2); }
                __syncthreads();
            }
            yout(NCH - 1, (NCH - 1) & 1);
        } else {
            f32x2 S01 = {0.f, 0.f}, S23 = {0.f, 0.f};
            const int vl = wid * 4 + (lane >> 4), k0 = (lane & 15) * 4;
            __syncthreads();
            for (int c = 0; c < NCH; ++c) {
                const float* vec = (const float*)(base + (c & 1) * WK_BUF); const float* vq = (const float*)(base + (c & 1) * WK_BUF + WK_VEC);
                float* yp = ypart + (c & 1) * (WK_CH * 64) + vl * 4 + (lane & 3);
#pragma unroll 2
                for (int g = 0; g < WK_CH / 4; ++g) {
                    float yv[4];
#pragma unroll
                    for (int uu = 0; uu < 4; ++uu) {
                        const int s = g * 4 + uu;
                        const float4 r4 = *(const float4*)(vec + (0 * WK_CH + s) * 64 + k0), w4 = *(const float4*)(vec + (1 * WK_CH + s) * 64 + k0);
                        const float4 kk4 = *(const float4*)(vec + (2 * WK_CH + s) * 64 + k0), ka4 = *(const float4*)(vec + (3 * WK_CH + s) * 64 + k0);
                        const float4 kd4 = *(const float4*)(vec + (4 * WK_CH + s) * 64 + k0);
                        const float vv = vq[s * 16 + vl];
                        const f32x2 p = S01 * (f32x2){kk4.x, kk4.y} + S23 * (f32x2){kk4.z, kk4.w};
                        const float sa = -row16_sum(p.x + p.y);
                        S01 = S01 * (f32x2){w4.x, w4.y} + (f32x2){ka4.x, ka4.y} * sa + (f32x2){kd4.x, kd4.y} * vv;
                        S23 = S23 * (f32x2){w4.z, w4.w} + (f32x2){ka4.z, ka4.w} * sa + (f32x2){kd4.z, kd4.w} * vv;
                        const f32x2 q = S01 * (f32x2){r4.x, r4.y} + S23 * (f32x2){r4.z, r4.w};
                        float y = q.x + q.y;
                        y += dpp_f<0x128>(y); y += dpp_f<0x124>(y);
                        yv[uu] = y;
                    }
                    if ((lane & 15) < 4) {
#pragma unroll
                        for (int uu = 0; uu < 4; ++uu) yp[(g * 4 + uu) * 64] = yv[uu];
                    }
                }
                __syncthreads();
            }
        }
        __syncthreads();
    }
}
__device__ __forceinline__ void phase_rwkv_readout(const Args& a, int j) {
    const int tid = otid(), lane = tid & 63, wid = tid >> 6;
    const bf16_t* R = (const bf16_t*)(a.ws + RW_R); const bf16_t* K = (const bf16_t*)(a.ws + RW_K);
    const bf16_t* V = (const bf16_t*)(a.ws + (j == 0 ? WS_VFIRST : RW_V)); const bf16_t* G = (const bf16_t*)(a.ws + RW_G);
    const bf16_t* A0 = (const bf16_t*)(a.ws + RW_AD0); const bf16_t* A1 = (const bf16_t*)(a.ws + RW_AD1);
    const float* Y0 = (const float*)(a.ws + RW_Y0); const float* Y1 = (const float*)(a.ws + RW_Y1);
    bf16_t* Z = (bf16_t*)(a.ws + RW_Z);
    const float* lng = a.in[I_RLNG] + j * D; const float* lnb = a.in[I_RLNB] + j * D; const float* rk = a.in[I_RRK] + j * D; const float* ka = a.in[I_RKA] + j * D;
    for (int row = blockIdx.x * 8 + wid; row < T; row += gridDim.x * 8) {
        float4 y0v[4], y1v[4]; u32x2 r4v[4], k4v[4], v4v[4], g4v[4], a0v[4], a1v[4];
#pragma unroll
        for (int q = 0; q < 4; ++q) {
            const size_t o = (size_t)row * D + q * 256 + lane * 4;
            y0v[q] = *(const float4*)(Y0 + o); y1v[q] = *(const float4*)(Y1 + o); r4v[q] = *(const u32x2*)(R + o); k4v[q] = *(const u32x2*)(K + o);
            v4v[q] = *(const u32x2*)(V + o); g4v[q] = *(const u32x2*)(G + o); a0v[q] = *(const u32x2*)(A0 + o); a1v[q] = *(const u32x2*)(A1 + o);
        }
#pragma unroll
        for (int q = 0; q < 4; ++q) {
            const int c = q * 256 + lane * 4; const size_t o = (size_t)row * D + c;
            const float4 y0 = y0v[q], y1 = y1v[q];
            const float y[4] = { y0.x + y1.x, y0.y + y1.y, y0.z + y1.z, y0.w + y1.w };
            const float mean = row16_sum(y[0] + y[1] + y[2] + y[3]) * (1.f / 64.f);
            float dv = 0.f;
#pragma unroll
            for (int i = 0; i < 4; ++i) dv += (y[i] - mean) * (y[i] - mean);
            const float rs = rsqrtf(row16_sum(dv) * (1.f / 64.f) + 64e-5f);
            const u32x2 r4 = r4v[q], k4 = k4v[q], v4 = v4v[q], g4 = g4v[q], a04 = a0v[q], a14 = a1v[q];
            const float4 lg = *(const float4*)(lng + c), lb = *(const float4*)(lnb + c), rk4 = *(const float4*)(rk + c), ka4 = *(const float4*)(ka + c);
            const float rr[4] = { bf_lo(r4[0]), bf_hi(r4[0]), bf_lo(r4[1]), bf_hi(r4[1]) }, kk[4] = { bf_lo(k4[0]), bf_hi(k4[0]), bf_lo(k4[1]), bf_hi(k4[1]) };
            const float vv[4] = { bf_lo(v4[0]), bf_hi(v4[0]), bf_lo(v4[1]), bf_hi(v4[1]) }, gg[4] = { bf_lo(g4[0]), bf_hi(g4[0]), bf_lo(g4[1]), bf_hi(g4[1]) };
            const float aa[4] = { bf_lo(a04[0]) + bf_lo(a14[0]), bf_hi(a04[0]) + bf_hi(a14[0]), bf_lo(a04[1]) + bf_lo(a14[1]), bf_hi(a04[1]) + bf_hi(a14[1]) };
            const float lgv[4] = { lg.x, lg.y, lg.z, lg.w }, lbv[4] = { lb.x, lb.y, lb.z, lb.w }, rkv[4] = { rk4.x, rk4.y, rk4.z, rk4.w }, kav[4] = { ka4.x, ka4.y, ka4.z, ka4.w };
            float bp = 0.f;
#pragma unroll
            for (int i = 0; i < 4; ++i) bp += rr[i] * kk[i] * rkv[i] * (2.f + (aa[i] - 2.f) * kav[i]);
            const float bonus = row16_sum(bp);
            float o4[4];
#pragma unroll
            for (int i = 0; i < 4; ++i) o4[i] = ((y[i] - mean) * rs * lgv[i] + lbv[i] + bonus * vv[i]) * gg[i];
            u32x2 w = { cvt_pk_bf16(o4[0], o4[1]), cvt_pk_bf16(o4[2], o4[3]) };
            *(u32x2*)(Z + o) = w;
        }
    }
}
struct GB { float4 g, b; };
__device__ __forceinline__ void phase_outproj(const Args& a, unsigned char* lds, int layer, const bf16_t* A, const bf16_t* Bt, const float* bias) {
    unsigned char* gl = lds + LDS_USER;
    float* X = (float*)(a.ws + WS_X);
    const float* modbase = (const float*)(a.ws + WS_MOD) + (size_t)layer * 3 * 6144 + 2 * 1024;
    constexpr int OP_FULL = ((130 * 4) / 256) * 256 / 4;
    constexpr int TAIL_R0 = OP_FULL * 256, TAIL_RB = (T - TAIL_R0) / 16;
    {
        const int tid = otid(), lane = tid & 63, wid = tid >> 6, fr = lane & 15, fq = lane >> 4;
        for (int w = blockIdx.x * 8 + wid; w < TAIL_RB * 64; w += gridDim.x * 8) {
            const int rblk = w >> 6, cblk = w & 63, row = TAIL_R0 + rblk * 16 + fr, colb = cblk * 16;
            const bf16_t* ap = A + (size_t)row * D + fq * 8;
            const bf16_t* bp = Bt + (size_t)(colb + fr) * D + fq * 8;
            f32x4 acc = {0.f, 0.f, 0.f, 0.f};
#pragma unroll
            for (int kc = 0; kc < 4; ++kc) {
                bf16x8 af[8], bf[8];
#pragma unroll
                for (int ks = 0; ks < 8; ++ks) { af[ks] = *(const bf16x8*)(ap + (kc * 8 + ks) * 32); bf[ks] = *(const bf16x8*)(bp + (kc * 8 + ks) * 32); }
#pragma unroll
                for (int ks = 0; ks < 8; ++ks) acc = __builtin_amdgcn_mfma_f32_16x16x32_bf16(bf[ks], af[ks], acc, 0, 0, 0);
            }
            const int col = colb + fq * 4;
            const float4 g = *(const float4*)(modbase + (size_t)mod_index(row) * 6144 + col);
            float4 bv = make_float4(0.f, 0.f, 0.f, 0.f);
            if (bias) bv = *(const float4*)(bias + col);
            f32x4 x = *(const f32x4*)(X + (size_t)row * D + col);
            x[0] += g.x * (acc[0] + bv.x); x[1] += g.y * (acc[1] + bv.y); x[2] += g.z * (acc[2] + bv.z); x[3] += g.w * (acc[3] + bv.w);
            *(f32x4*)(X + (size_t)row * D + col) = x;
        }
    }
    const int xq = blockIdx.x & 7, nxw = (gridDim.x + 7 - xq) >> 3;
    int si = blockIdx.x >> 3;
    auto next = [&](g8::UTile& t) -> bool {
        const int mt = 8 * (si >> 2) + xq;
        if (mt >= OP_FULL) return false;
        t.mt = mt; t.nt = si & 3; t.g = 0; si += nxw;
        return true;
    };
    const auto ctx = g8::make_ctx(
        [=](const g8::UTile& t) { return A + (size_t)t.mt * 256 * D; },
        [=](const g8::UTile& t) { return Bt + (size_t)t.nt * 256 * D; },
        [=](const g8::UTile&, f32x4 (&acc)[2][2][4][2], int col0) { g8::bias_acc(acc, bias, col0); },
        [=](const g8::UTile& t, const f32x4 (&acc)[2][2][4][2], int row0, int col0) {
            const float* gp = uniform_ptr(modbase + (size_t)mod_index(t.mt * 256) * 6144);
            float4 gv[2][2];
#pragma unroll
            for (int bj = 0; bj < 2; ++bj)
#pragma unroll
                for (int n = 0; n < 2; ++n) gv[bj][n] = *(const float4*)(gp + col0 + bj * 128 + n * 16);
#pragma unroll
            for (int ai = 0; ai < 2; ++ai) {
                f32x4 x[4][2][2];
#pragma unroll
                for (int m = 0; m < 4; ++m)
#pragma unroll
                    for (int bj = 0; bj < 2; ++bj)
#pragma unroll
                        for (int n = 0; n < 2; ++n) x[m][bj][n] = *(const f32x4*)(X + (size_t)(row0 + ai * 128 + m * 16) * D + col0 + bj * 128 + n * 16);
#pragma unroll
                for (int m = 0; m < 4; ++m)
#pragma unroll
                    for (int bj = 0; bj < 2; ++bj)
#pragma unroll
                        for (int n = 0; n < 2; ++n) {
                            f32x4 o = x[m][bj][n]; const f32x4 v = acc[ai][bj][m][n]; const float4 g = gv[bj][n];
                            o[0] += g.x * v[0]; o[1] += g.y * v[1]; o[2] += g.z * v[2]; o[3] += g.w * v[3];
                            *(f32x4*)(X + (size_t)(row0 + ai * 128 + m * 16) * D + col0 + bj * 128 + n * 16) = o;
                        }
            }
        });
    g8::gemm256_stream<false, g8::UTile>(D, (unsigned)D, gl, ctx, next);
}

struct ALoadGather {
    const bf16_t* H; const int* tl; int rowbase, cnt;
    __device__ __forceinline__ u32x4 load(int row, int k) const {
        int idx = row - rowbase; idx = idx < cnt ? idx : cnt - 1;
        return *(const u32x4*)(H + (size_t)tl[idx] * D + k);
    }
};
__device__ __forceinline__ void moe_tiles(const Args& a, int layer, int* tp) {
    if (threadIdx.x == 0) {
        const int* cnt = (const int*)(a.ws + WS_CNT2) + layer * 32 * CSTR;
        int acc = 0;
        for (int e = 0; e < 32; ++e) { tp[e] = acc; acc += (cnt[e * CSTR] + 255) >> 8; }
        tp[32] = acc;
    }
    __syncthreads();
}
struct UMoe1 { int rt, nt, e, tile, ce; };
struct CMoe1 {
    const unsigned char* ws; const float* binbase; int layer;
    __device__ __forceinline__ const bf16_t* A(const UMoe1&) const { return (const bf16_t*)(ws + WS_H); }
    __device__ __forceinline__ const bf16_t* B(const UMoe1& u) const { return (const bf16_t*)(ws + WS_EWINT) + ((size_t)layer * 32 + u.e) * 2048 * D + (size_t)u.nt * 256 * D; }
    __device__ __forceinline__ int brow(const UMoe1& u) const { return u.rt * 256; }
    __device__ __forceinline__ int bcol(const UMoe1& u) const { return u.nt * 256; }
    __device__ __forceinline__ unsigned aoff(const UMoe1& u, int r) const {
        const int* tl = uniform_ptr((const int*)(ws + WS_TOKL) + (size_t)u.e * T); int idx = u.tile * 256 + r; idx = idx < u.ce ? idx : u.ce - 1; return (unsigned)tl[(unsigned)idx] * (unsigned)D; }
    __device__ __forceinline__ void init(const UMoe1& u, f32x4 (&acc)[2][2][4][2], int col0) const {
        const float* bin = uniform_ptr(binbase + ((size_t)layer * 32 + u.e) * 2048);
#pragma unroll
        for (int n = 0; n < 2; ++n) {
            const float4 bg = *(const float4*)(bin + col0 - u.nt * 128 + n * 16), bl = *(const float4*)(bin + 1024 + col0 - u.nt * 128 + n * 16);
#pragma unroll
            for (int ai = 0; ai < 2; ++ai)
#pragma unroll
                for (int m = 0; m < 4; ++m) { acc[ai][0][m][n] = (f32x4){ bg.x, bg.y, bg.z, bg.w }; acc[ai][1][m][n] = (f32x4){ bl.x, bl.y, bl.z, bl.w }; }
        }
    }
    __device__ __forceinline__ void epi(const UMoe1& u, const f32x4 (&acc)[2][2][4][2], int row0, int col0) const {
        bf16_t* ACT = uniform_ptr((bf16_t*)(ws + WS_ACT));
#pragma unroll
        for (int ai = 0; ai < 2; ++ai)
#pragma unroll
            for (int m = 0; m < 4; ++m)
#pragma unroll
                for (int n = 0; n < 2; ++n) {
                    const int row = row0 + ai * 128 + m * 16, colg = col0 - u.nt * 128 + n * 16;
                    float o[4];
#pragma unroll
                    for (int i = 0; i < 4; ++i) {
                        const float glu = fminf(acc[ai][0][m][n][i], 7.f);
                        const float lin = fminf(fmaxf(acc[ai][1][m][n][i], -7.f), 7.f);
                        o[i] = glu * sigmoidf_(1.702f * glu) * (lin + 1.f);
                    }
                    u32x2 w = { cvt_pk_bf16(o[0], o[1]), cvt_pk_bf16(o[2], o[3]) };
                    *(u32x2*)(ACT + (size_t)row * D + colg) = w;
                }
    }
};
__device__ __forceinline__ void phase_moe1(const Args& a, unsigned char* lds, int layer) {
    int* tp = (int*)(lds + LDS_USER); unsigned char* gl = lds + LDS_USER + 256;
    moe_tiles(a, layer, tp);
    const int total = tp[32];
    const int* cnt = (const int*)(a.ws + WS_CNT2) + layer * 32 * CSTR;
    const int xq = blockIdx.x & 7, xr = xq >> 1, xc = xq & 1, nxw = (gridDim.x + 7 - xq) >> 3;
    int si = blockIdx.x >> 3, ecur = 0;
    auto next = [&](UMoe1& u) -> bool {
        const int rt = MOE1_MAP == 2 ? 8 * (si >> 3) + xq : (MOE1_MAP == 4 ? 2 * (si >> 1) + (xq >> 2) : 4 * (si >> 2) + xr), nt = MOE1_MAP == 2 ? (si & 7) : (MOE1_MAP == 4 ? (xq & 3) * 2 + (si & 1) : xc * 4 + (si & 3));
        if (rt >= total) return false;
        si += nxw;
        int e = ecur;
        while (tp[e + 1] <= rt) ++e;
        e = __builtin_amdgcn_readfirstlane(e); ecur = e;
        u.rt = rt; u.nt = nt; u.e = e; u.tile = rt - __builtin_amdgcn_readfirstlane(tp[e]); u.ce = __builtin_amdgcn_readfirstlane(cnt[e * CSTR]);
        return true;
    };
    const CMoe1 ctx{ a.ws, a.in[I_EBIN], layer };
    g8::gemm256_stream<true, UMoe1>(D, (unsigned)D, gl, ctx, next);
}
struct UMoe2 { int rt, nt, e; };
struct CMoe2 {
    const unsigned char* ws; const float* boutbase; int layer;
    __device__ __forceinline__ const bf16_t* A(const UMoe2& u) const { return (const bf16_t*)(ws + WS_ACT) + (size_t)u.rt * 256 * D; }
    __device__ __forceinline__ const bf16_t* B(const UMoe2& u) const { return (const bf16_t*)(ws + WS_EWOUTT) + ((size_t)layer * 32 + u.e) * D * D + (size_t)u.nt * 256 * D; }
    __device__ __forceinline__ int brow(const UMoe2& u) const { return u.rt * 256; }
    __device__ __forceinline__ int bcol(const UMoe2& u) const { return u.nt * 256; }
    __device__ __forceinline__ unsigned aoff(const UMoe2&, int) const { return 0u; }
    __device__ __forceinline__ void init(const UMoe2& u, f32x4 (&acc)[2][2][4][2], int col0) const {
        const float* bout = uniform_ptr(boutbase + ((size_t)layer * 32 + u.e) * D);
#pragma unroll
        for (int bj = 0; bj < 2; ++bj)
#pragma unroll
            for (int n = 0; n < 2; ++n) {
                const float4 bv = *(const float4*)(bout + col0 + bj * 128 + n * 16);
#pragma unroll
                for (int ai = 0; ai < 2; ++ai)
#pragma unroll
                    for (int m = 0; m < 4; ++m) acc[ai][bj][m][n] = (f32x4){ bv.x, bv.y, bv.z, bv.w };
            }
    }
    __device__ __forceinline__ void epi(const UMoe2&, const f32x4 (&acc)[2][2][4][2], int row0, int col0) const {
        bf16_t* YB = uniform_ptr((bf16_t*)(ws + WS_YB));
#pragma unroll
        for (int ai = 0; ai < 2; ++ai)
#pragma unroll
            for (int m = 0; m < 4; ++m)
#pragma unroll
                for (int bj = 0; bj < 2; ++bj)
#pragma unroll
                    for (int n = 0; n < 2; ++n) {
                        const f32x4 v = acc[ai][bj][m][n];
                        u32x2 w = { cvt_pk_bf16(v[0], v[1]), cvt_pk_bf16(v[2], v[3]) };
                        *(u32x2*)(YB + (size_t)(row0 + ai * 128 + m * 16) * D + col0 + bj * 128 + n * 16) = w;
                    }
    }
};
__device__ __forceinline__ void phase_moe2(const Args& a, unsigned char* lds, int layer) {
    int* tp = (int*)(lds + LDS_USER); unsigned char* gl = lds + LDS_USER + 256;
    moe_tiles(a, layer, tp);
    const int total = tp[32];
    const int xq = blockIdx.x & 7, nxw = (gridDim.x + 7 - xq) >> 3;
    int si = blockIdx.x >> 3, ecur = 0;
    auto next = [&](UMoe2& u) -> bool {
        const int rt = 8 * (si >> 2) + xq, nt = si & 3;
        if (rt >= total) return false;
        si += nxw;
        int e = ecur;
        while (tp[e + 1] <= rt) ++e;
        e = __builtin_amdgcn_readfirstlane(e); ecur = e;
        u.rt = rt; u.nt = nt; u.e = e;
        return true;
    };
    const CMoe2 ctx{ a.ws, a.in[I_EBOUT], layer };
    g8::gemm256_stream<false, UMoe2>(D, (unsigned)D, gl, ctx, next);
}
namespace wk2 {
constexpr int AST = 144;
constexpr int SST = 80;
constexpr int OFF_AAT = 0, OFF_RT = 16 * AST, OFF_MT = 2 * 16 * AST, OFF_TT = OFF_MT + 16 * SST, OFF_PQ = OFF_TT + 16 * SST, OFF_BK = OFF_PQ + 16 * SST,
              OFF_WC = OFF_BK + 64 * SST, SETB = OFF_WC + 256, NSET = 8, NCHK = RPB / 16;
static_assert(SETB == (int)WKSET_B && SETB % 16 == 0, "image size");
constexpr int PW_AAT = 0, PW_RT = 16 * AST, PW_BT = 2 * 16 * AST, PW_KT = 3 * 16 * AST, PW_TT = 4 * 16 * AST, PW_N = PW_TT + 16 * SST, PWB = PW_N + 1024;
static_assert(LDS_USER + 8 * PWB <= LDS_BYTES && LDS_USER + 256 + NSET * SETB <= LDS_BYTES, "LDS budget");
constexpr int SLOTB = SETB;
constexpr int G_AAT = 0, G_RT = 2048, G_PQ = 4096, G_BK = 5120, G_MT = 9216, G_TT = 9728, G_WC = 10240, GSETB = 10496;
static_assert(GSETB <= SETB && GSETB % 128 == 0, "compact image");
typedef volatile LAS int* vflag;
}
__device__ __forceinline__ void phase_wkv_prep(const Args& a, unsigned char* lds, int j, int c_lo, int c_hi, int blk_lo, int nblk) {
    using namespace wk2;
    const int tid = otid(), lane = tid & 63, wid = tid >> 6;
    LAS unsigned char* scr = (LAS unsigned char*)(lds + LDS_USER) + wid * PWB;
    const bf16_t* R = (const bf16_t*)(a.ws + RW_R); const bf16_t* K = (const bf16_t*)(a.ws + RW_K);
    const int kc = lane >> 4, kg = (lane >> 2) & 3, kr = lane & 3, kq = kc >> 1, kj = (kc & 1) * 4 + kr;
    const int ti = lane & 15, g = lane >> 4;
    const int nch = c_hi - c_lo, nunits = 64 * nch, wstride = nblk * 8;
    unsigned qr[16], qk[16], qw[16], qa[16];
    auto issue = [&](int u) {
        const int chain = u / nch, c = c_lo + (u - chain * nch), b = chain >> 5, h = (chain >> 1) & 15, d = chain & 1;
        const bf16_t* WD = (const bf16_t*)(a.ws + (d == 0 ? RW_WD0 : RW_WD1)); const bf16_t* AD = (const bf16_t*)(a.ws + (d == 0 ? RW_AD0 : RW_AD1));
        const int t0 = c * 16, p0 = (d == 0) ? t0 : ((t0 < CTX) ? (CTX - 1 - t0) : (RPB + CTX - 1 - t0));
        const long rstep = (d == 0) ? (long)D : -(long)D;
        const size_t o0 = ((size_t)b * RPB + p0) * D + h * 64 + lane;
#pragma unroll
        for (int t = 0; t < 16; ++t) { const size_t o = o0 + t * rstep; qr[t] = R[o]; qk[t] = K[o]; qw[t] = WD[o]; qa[t] = AD[o]; }
    };
    int u = ((int)blockIdx.x - blk_lo) * 8 + wid;
    if (u < 0) u = nunits;
    if (u < nunits) issue(u);
    for (; u < nunits; u += wstride) {
        const int chain = u / nch, c = c_lo + (u - chain * nch), h = (chain >> 1) & 15;
        unsigned char* gset = a.ws + RW_SETS + ((size_t)chain * NCHK + c) * GSETB;
        const float kkw = a.in[I_RKK][j * D + h * 64 + lane], kaw = a.in[I_RKA][j * D + h * 64 + lane];
        float fr[16], fk[16], fw[16], fa[16];
#pragma unroll
        for (int t = 0; t < 16; ++t) { fr[t] = __uint_as_float(qr[t] << 16); fk[t] = __uint_as_float(qk[t] << 16); fw[t] = __expf(-__uint_as_float(qw[t] << 16)); fa[t] = __uint_as_float(qa[t] << 16); }
        float kkv[16], n2[16];
#pragma unroll
        for (int t = 0; t < 16; ++t) { kkv[t] = fk[t] * kkw; n2[t] = row16_sum(kkv[t] * kkv[t]); }
#pragma unroll
        for (int t = 0; t < 16; ++t) n2[t] += __shfl_xor(n2[t], 16);
#pragma unroll
        for (int t = 0; t < 16; ++t) n2[t] += __shfl_xor(n2[t], 32);
        float Wc = 1.f;
        unsigned bkp[16];
#pragma unroll
        for (int t = 0; t < 16; ++t) {
            const float kk = kkv[t] * rsqrtf(fmaxf(n2[t], 1e-24f));
            const float Wp = Wc; Wc *= fw[t];
            const float iw = __builtin_amdgcn_rcpf(Wc);
            const unsigned ab = cvt_pk_bf16(-kk * Wp, fr[t] * Wc);
            const unsigned bk = cvt_pk_bf16(kk * fa[t] * iw, fk[t] * (1.f + (fa[t] - 1.f) * kaw) * iw);
            bkp[t] = bk;
            const int o1 = t * AST + (((kq * 4 + kg) * 8 + kj) * 2);
            *(LAS bf16_t*)(scr + PW_AAT + o1) = (bf16_t)(ab & 0xffffu); *(LAS bf16_t*)(scr + PW_RT + o1) = (bf16_t)(ab >> 16);
            *(LAS bf16_t*)(scr + PW_BT + o1) = (bf16_t)(bk & 0xffffu);  *(LAS bf16_t*)(scr + PW_KT + o1) = (bf16_t)(bk >> 16);
        }
#pragma unroll
        for (int gg = 0; gg < 4; ++gg) {
            const unsigned b0 = bkp[4 * gg], b1 = bkp[4 * gg + 1], b2 = bkp[4 * gg + 2], b3 = bkp[4 * gg + 3];
            *(u32x4*)(gset + G_BK + lane * 64 + gg * 16) = (u32x4){ (b0 & 0xffffu) | (b1 << 16), (b2 & 0xffffu) | (b3 << 16), (b0 >> 16) | (b1 & 0xffff0000u), (b2 >> 16) | (b3 & 0xffff0000u) };
        }
        *(float*)(gset + G_WC + ((kg * 4 + kc) * 4 + kr) * 4) = Wc;
        if (u + wstride < nunits) issue(u + wstride);
        asm volatile("s_waitcnt lgkmcnt(0)" ::: "memory");
        f32x4 cN = {0.f, 0.f, 0.f, 0.f}, cM = cN, cP = cN, cQ = cN;
#pragma unroll
        for (int q = 0; q < 2; ++q) {
            const int oo = ti * AST + (q * 4 + g) * 16;
            const bf16x8 fa8 = *(const LAS bf16x8*)(scr + PW_AAT + oo), fr8 = *(const LAS bf16x8*)(scr + PW_RT + oo);
            const bf16x8 fb8 = *(const LAS bf16x8*)(scr + PW_BT + oo), fk8 = *(const LAS bf16x8*)(scr + PW_KT + oo);
            cN = __builtin_amdgcn_mfma_f32_16x16x32_bf16(fb8, fa8, cN, 0, 0, 0); cM = __builtin_amdgcn_mfma_f32_16x16x32_bf16(fk8, fa8, cM, 0, 0, 0);
            cP = __builtin_amdgcn_mfma_f32_16x16x32_bf16(fb8, fr8, cP, 0, 0, 0); cQ = __builtin_amdgcn_mfma_f32_16x16x32_bf16(fk8, fr8, cQ, 0, 0, 0);
        }
#pragma unroll
        for (int rr = 0; rr < 4; ++rr) { const int s = 4 * g + rr; if (!(s < ti)) { cN[rr] = 0.f; cM[rr] = 0.f; } if (!(s <= ti)) { cP[rr] = 0.f; cQ[rr] = 0.f; } }
#pragma unroll
        for (int rr = 0; rr < 4; ++rr) *(LAS float*)(scr + PW_N + ((4 * g + rr) * 16 + ti) * 4) = cN[rr];
        *(u32x2*)(gset + G_MT + ti * 32 + g * 8) = (u32x2){ cvt_pk_bf16(cM[0], cM[1]), cvt_pk_bf16(cM[2], cM[3]) };
        *(u32x4*)(gset + G_PQ + ti * 64 + g * 16) = (u32x4){ cvt_pk_bf16(cP[0], cP[1]), cvt_pk_bf16(cP[2], cP[3]), cvt_pk_bf16(cQ[0], cQ[1]), cvt_pk_bf16(cQ[2], cQ[3]) };
#pragma unroll
        for (int i = 0; i < 4; ++i) { const int idx = lane + i * 64, r = (idx & 127) >> 3, jj = idx & 7; *(u32x4*)(gset + G_AAT + idx * 16) = *(const LAS u32x4*)(scr + (i < 2 ? PW_AAT : PW_RT) + r * AST + jj * 16); }
        asm volatile("s_waitcnt lgkmcnt(0)" ::: "memory");
        if (lane < 16) {
            float Tr[16];
#pragma unroll
            for (int t = 0; t < 16; ++t) Tr[t] = (lane == t) ? 1.f : 0.f;
#pragma unroll
            for (int s = 0; s < 15; ++s) {
                const LAS float* nr = (const LAS float*)(scr + PW_N + s * 64);
                const float ts = Tr[s];
#pragma unroll
                for (int t = s + 1; t < 16; ++t) Tr[t] += ts * nr[t];
            }
            const int ig = lane >> 2, ij = lane & 3;
#pragma unroll
            for (int s = 0; s < 16; ++s) {
                const bf16_t tv = (bf16_t)(cvt_pk_bf16(Tr[s], 0.f) & 0xffffu);
                *(LAS bf16_t*)(scr + PW_TT + s * SST + ((ig * 8 + ij) * 2)) = tv; *(LAS bf16_t*)(scr + PW_TT + s * SST + ((ig * 8 + 4 + ij) * 2)) = tv;
            }
        }
        asm volatile("s_waitcnt lgkmcnt(0)" ::: "memory");
        if (lane < 32) {
            const int s = lane >> 1, hh = lane & 1;
            const u32x2 t0 = *(const LAS u32x2*)(scr + PW_TT + s * SST + (2 * hh) * 16), t1 = *(const LAS u32x2*)(scr + PW_TT + s * SST + (2 * hh + 1) * 16);
            *(u32x4*)(gset + G_TT + lane * 16) = (u32x4){ t0[0], t0[1], t1[0], t1[1] };
        }
        asm volatile("s_waitcnt lgkmcnt(0)" ::: "memory");
    }
}
constexpr int WK_NSEG = WKNSEG, WK_SEGC = wk2::NCHK / WK_NSEG;
static_assert(WK_SEGC * WK_NSEG == wk2::NCHK, "segments");
__device__ __forceinline__ void phase_wkv_pipe(const Args& a, unsigned char* lds, int j, const XcdBarrier& bar) {
    using namespace wk2;
    const int tid = otid(), lane = tid & 63, wid = tid >> 6;
    LAS unsigned char* base = (LAS unsigned char*)(lds + LDS_USER);
    vflag ready = (vflag)base, done = (vflag)(base + 64);
    const bf16_t* V = (const bf16_t*)(a.ws + (j == 0 ? WS_VFIRST : RW_V));
    const int nprep = (int)gridDim.x - 64;
#if WKV_SERIAL
    for (int r = 0; r < REP_WKVP; ++r) phase_wkv_prep(a, lds, j, 0, NCHK, 0, gridDim.x);
#else
    phase_wkv_prep(a, lds, j, 0, WK_SEGC, 0, gridDim.x);
#endif
    xcd_barrier(bar);
    const int chain = blockIdx.x; const bool scanner = chain < 64;
    if (!scanner) {
#pragma unroll 1
        for (int seg = 0; seg < WK_NSEG; ++seg) {
#if !WKV_SERIAL
            for (int r = 0; r < REP_WKVP; ++r) if (seg + 1 < WK_NSEG) phase_wkv_prep(a, lds, j, (seg + 1) * WK_SEGC, (seg + 2) * WK_SEGC, 64, nprep);
#endif
            deferred_transposes(a, lds, j == 0 ? NJ_PRO : NJ_PRO + 4, j == 0 ? NJ_PRO + 4 : NJOBS, seg, WK_NSEG, 64, nprep);
            xcd_barrier(bar);
        }
        return;
    }
    const int b = (chain >> 5) & 1, h = (chain >> 1) & 15, d = chain & 1, ch0 = h * 64;
    float* Y = (float*)(a.ws + (d == 0 ? RW_Y0 : RW_Y1));
    const int v = lane & 15, g = lane >> 4;
    auto chunk_p0 = [&](int c) -> int { const int t0 = c * 16; return (d == 0) ? t0 : ((t0 < CTX) ? (CTX - 1 - t0) : (RPB + CTX - 1 - t0)); };
    const int dir = (d == 0) ? 1 : -1;
    const unsigned char* Vb = (const unsigned char*)uniform_ptr(V + (size_t)b * RPB * D); unsigned char* Yb = (unsigned char*)uniform_ptr(Y + (size_t)b * RPB * D);
    int loff[4];
#pragma unroll
    for (int i = 0; i < 4; ++i) loff[i] = (4 * g + i) * dir * D + ch0 + (wid & 3) * 16 + v;
    if (tid < 16) ready[tid] = -1;
    if (tid >= 16 && tid < 20) done[tid - 16] = -1;
    __syncthreads();
    if (wid >= 4) {
#pragma unroll 1
        for (int seg = 0; seg < WK_NSEG; ++seg) {
            const int c_lo = seg * WK_SEGC, c_hi = c_lo + WK_SEGC;
            {
                const int sw = wid - 4;
                const unsigned char* gs = a.ws + RW_SETS + (size_t)chain * NCHK * GSETB;
                u32x4 preA[11], preB[11], preC[11];
                auto issueA = [&](int c) { const unsigned char* p = gs + (size_t)c * GSETB;
#pragma unroll
                    for (int i = 0; i < 11; ++i) { const int idx = lane + i * 64; if (idx < GSETB / 16) preA[i] = *(const u32x4*)(p + idx * 16); } };
                auto issueB = [&](int c) { const unsigned char* p = gs + (size_t)c * GSETB;
#pragma unroll
                    for (int i = 0; i < 11; ++i) { const int idx = lane + i * 64; if (idx < GSETB / 16) preB[i] = *(const u32x4*)(p + idx * 16); } };
                auto issueC = [&](int c) { const unsigned char* p = gs + (size_t)c * GSETB;
#pragma unroll
                    for (int i = 0; i < 11; ++i) { const int idx = lane + i * 64; if (idx < GSETB / 16) preC[i] = *(const u32x4*)(p + idx * 16); } };
                auto scatter = [&](LAS unsigned char* set, const u32x4 (&pre)[11]) {
#pragma unroll
                    for (int i = 0; i < 4; ++i) { const int r = ((lane + i * 64) & 127) >> 3, jj = lane & 7; *(LAS u32x4*)(set + (i < 2 ? OFF_AAT : OFF_RT) + r * AST + jj * 16) = pre[i]; }
                    *(LAS u32x4*)(set + OFF_PQ + (lane >> 2) * SST + (lane & 3) * 16) = pre[4];
#pragma unroll
                    for (int i = 5; i < 9; ++i) { const int k = lane + (i - 5) * 64; *(LAS u32x4*)(set + OFF_BK + (k >> 2) * SST + (k & 3) * 16) = pre[i]; }
                    {
                        const int kk = lane & 31, r = kk >> 1, hh = kk & 1;
                        LAS unsigned char* d = set + (lane < 32 ? OFF_MT : OFF_TT) + r * SST + (2 * hh) * 16;
                        *(LAS u32x4*)d = (u32x4){ pre[9][0], pre[9][1], 0u, 0u }; *(LAS u32x4*)(d + 16) = (u32x4){ pre[9][2], pre[9][3], 0u, 0u };
                    }
                    if (lane < 16) *(LAS u32x4*)(set + OFF_WC + lane * 16) = pre[10];
                };
                auto waitslot = [&](int c) { while (min(min(done[0], done[1]), min(done[2], done[3])) < c - NSET) __builtin_amdgcn_s_sleep(24); };
                if (c_lo + sw < c_hi) issueA(c_lo + sw);
                if (c_lo + sw + 4 < c_hi) issueB(c_lo + sw + 4);
                if (c_lo + sw + 8 < c_hi) issueC(c_lo + sw + 8);
                for (int c = c_lo + sw; c < c_hi; c += 12) {
                    {
                        LAS unsigned char* set = base + 256 + (c % NSET) * SLOTB;
                        waitslot(c);
                        scatter(set, preA);
                        if (c + 12 < c_hi) issueA(c + 12);
                        asm volatile("s_waitcnt lgkmcnt(0)" ::: "memory");
                        if (lane == 0) ready[c % NSET] = c;
                    }
                    if (c + 4 < c_hi) {
                        const int c2 = c + 4;
                        LAS unsigned char* set = base + 256 + (c2 % NSET) * SLOTB;
                        waitslot(c2);
                        scatter(set, preB);
                        if (c2 + 12 < c_hi) issueB(c2 + 12);
                        asm volatile("s_waitcnt lgkmcnt(0)" ::: "memory");
                        if (lane == 0) ready[c2 % NSET] = c2;
                    }
                    if (c + 8 < c_hi) {
                        const int c3 = c + 8;
                        LAS unsigned char* set = base + 256 + (c3 % NSET) * SLOTB;
                        waitslot(c3);
                        scatter(set, preC);
                        if (c3 + 12 < c_hi) issueC(c3 + 12);
                        asm volatile("s_waitcnt lgkmcnt(0)" ::: "memory");
                        if (lane == 0) ready[c3 % NSET] = c3;
                    }
                }
            }
            xcd_barrier(bar);
        }
    } else {
    f32x4 St[4];
#pragma unroll
    for (int c4 = 0; c4 < 4; ++c4) St[c4] = (f32x4){0.f, 0.f, 0.f, 0.f};
    bf16x8 Bhi[2];
#pragma unroll
    for (int q = 0; q < 2; ++q) Bhi[q] = (bf16x8){0, 0, 0, 0, 0, 0, 0, 0};
#pragma unroll 1
        for (int seg = 0; seg < WK_NSEG; ++seg) {
            const int c_lo = seg * WK_SEGC, c_hi = c_lo + WK_SEGC;
            {
                constexpr int VPD = 4;
                unsigned vq[VPD][4];
#pragma unroll
                for (int k = 0; k < VPD; ++k) if (c_lo + k < c_hi) { const int p0 = __builtin_amdgcn_readfirstlane(chunk_p0(c_lo + k));
#pragma unroll
                  for (int i = 0; i < 4; ++i) vq[k][i] = *(const bf16_t*)(Vb + (unsigned)((p0 * D + loff[i]) * 2)); }
                bf16x8 oA[2][2], oR[2][2], oM[2], oT[2], oPQ[2], oBK[2][4]; f32x4 oW[2][4];
                auto load_ops = [&](int c, bf16x8 (&xA)[2], bf16x8 (&xR)[2], bf16x8& xM, bf16x8& xT, bf16x8& xPQ, bf16x8 (&xBK)[4], f32x4 (&xW)[4]) {
                    const LAS unsigned char* set = base + 256 + (c % NSET) * SLOTB;
#pragma unroll
                    for (int q = 0; q < 2; ++q) { xA[q] = *(const LAS bf16x8*)(set + OFF_AAT + v * AST + (q * 4 + g) * 16); xR[q] = *(const LAS bf16x8*)(set + OFF_RT + v * AST + (q * 4 + g) * 16); }
                    xM = *(const LAS bf16x8*)(set + OFF_MT + v * SST + g * 16); xT = *(const LAS bf16x8*)(set + OFF_TT + v * SST + g * 16); xPQ = *(const LAS bf16x8*)(set + OFF_PQ + v * SST + g * 16);
#pragma unroll
                    for (int c4 = 0; c4 < 4; ++c4) { xBK[c4] = *(const LAS bf16x8*)(set + OFF_BK + (c4 * 16 + v) * SST + g * 16); xW[c4] = *(const LAS f32x4*)(set + OFF_WC + ((g * 4 + c4) * 4) * 4); }
                };
                while (ready[c_lo % NSET] != c_lo) __builtin_amdgcn_s_sleep(1);
                asm volatile("" ::: "memory");
                load_ops(c_lo, oA[0], oR[0], oM[0], oT[0], oPQ[0], oBK[0], oW[0]);
                for (int cb = c_lo; cb < c_hi; cb += VPD) {
#pragma unroll
                  for (int kk = 0; kk < VPD; ++kk) {
                    const int c = cb + kk;
                    constexpr int dummy = 0; (void)dummy;
                    const int P = kk & 1, Q = P ^ 1;
                    if (c >= c_hi) break;
                    const u32x2 vmw = { vq[kk][0] | (vq[kk][1] << 16), vq[kk][2] | (vq[kk][3] << 16) };
                    if (c + VPD < c_hi) { const int p1 = __builtin_amdgcn_readfirstlane(chunk_p0(c + VPD));
#pragma unroll
                        for (int i = 0; i < 4; ++i) vq[kk][i] = *(const bf16_t*)(Vb + (unsigned)((p1 * D + loff[i]) * 2)); }
                    asm volatile("s_waitcnt lgkmcnt(0)" ::: "memory");
                    if (lane == 0) done[wid] = c;
                    if (c + 1 < c_hi) {
                        while (ready[(c + 1) % NSET] != c + 1) __builtin_amdgcn_s_sleep(1);
                        asm volatile("" ::: "memory");
                        load_ops(c + 1, oA[Q], oR[Q], oM[Q], oT[Q], oPQ[Q], oBK[Q], oW[Q]);
                    }
                    const f32x4 z4 = {0.f, 0.f, 0.f, 0.f};
                    const bf16x8 bv = __builtin_bit_cast(bf16x8, ((u32x4){ vmw[0], vmw[1], 0u, 0u }));
                    f32x4 a1 = __builtin_amdgcn_mfma_f32_16x16x32_bf16(oA[P][0], Bhi[0], z4, 0, 0, 0);
                    f32x4 a1m = __builtin_amdgcn_mfma_f32_16x16x32_bf16(oM[P], bv, z4, 0, 0, 0);
                    a1 = __builtin_amdgcn_mfma_f32_16x16x32_bf16(oA[P][1], Bhi[1], a1, 0, 0, 0);
                    f32x4 a2 = __builtin_amdgcn_mfma_f32_16x16x32_bf16(oR[P][0], Bhi[0], z4, 0, 0, 0);
                    a2 = __builtin_amdgcn_mfma_f32_16x16x32_bf16(oR[P][1], Bhi[1], a2, 0, 0, 0);
                    a1 = a1 + a1m;
                    const bf16x8 b3 = __builtin_bit_cast(bf16x8, ((u32x4){ cvt_pk_bf16(a1[0], a1[1]), cvt_pk_bf16(a1[2], a1[3]), 0u, 0u }));
                    const f32x4 a3 = __builtin_amdgcn_mfma_f32_16x16x32_bf16(oT[P], b3, z4, 0, 0, 0);
                    const bf16x8 b45 = __builtin_bit_cast(bf16x8, ((u32x4){ cvt_pk_bf16(a3[0], a3[1]), cvt_pk_bf16(a3[2], a3[3]), vmw[0], vmw[1] }));
#pragma unroll
                    for (int c4 = 0; c4 < 4; ++c4) St[c4] = __builtin_amdgcn_mfma_f32_16x16x32_bf16(oBK[P][c4], b45, St[c4], 0, 0, 0);
                    a2 = __builtin_amdgcn_mfma_f32_16x16x32_bf16(oPQ[P], b45, a2, 0, 0, 0);
#pragma unroll
                    for (int c4 = 0; c4 < 4; ++c4) St[c4] = St[c4] * oW[P][c4];
#pragma unroll
                    for (int q = 0; q < 2; ++q)
                        Bhi[q] = __builtin_bit_cast(bf16x8, ((u32x4){ cvt_pk_bf16(St[2 * q][0], St[2 * q][1]), cvt_pk_bf16(St[2 * q][2], St[2 * q][3]), cvt_pk_bf16(St[2 * q + 1][0], St[2 * q + 1][1]), cvt_pk_bf16(St[2 * q + 1][2], St[2 * q + 1][3]) }));
                    {
                        const int p0 = __builtin_amdgcn_readfirstlane(chunk_p0(c));
#pragma unroll
                        for (int rr = 0; rr < 4; ++rr) *(float*)(Yb + (unsigned)((p0 * D + loff[rr]) * 4)) = a2[rr];
                    }
                  }
                }
            }
            xcd_barrier(bar);
        }
    }
}
__device__ __forceinline__ void phase_wkv2(const Args& a, unsigned char* lds, int j) { }
constexpr size_t HY_UU   = WS_MIX;
constexpr size_t HY_X0   = HY_UU + (size_t)T * 3072 * 2;
constexpr size_t HY_X0ZB = HY_X0 + (size_t)T * D * 2;
constexpr size_t HY_P    = HY_X0ZB + (size_t)T * D * 2;
constexpr size_t HY_ZT   = HY_P + (size_t)T * D * 2;
constexpr size_t HY_ZC   = HY_ZT + (size_t)D * 2 * SEQ * 4;
constexpr size_t HY_HF   = HY_ZC + (size_t)2 * CTX * D * 4;
constexpr size_t HY_HB   = HY_HF + (size_t)D * SEQ * 4;
constexpr size_t HY_HFC  = HY_HB + (size_t)D * SEQ * 4;
constexpr size_t HY_HBC  = HY_HFC + (size_t)CTX * D * 4;
constexpr size_t HY_FS   = HY_HBC + (size_t)CTX * D * 4;
constexpr size_t HY_U    = HY_FS + (size_t)2 * D * SEQ * 8;
constexpr size_t HY_END  = HY_U + (size_t)2 * D * 2 * SEQ * 4;
constexpr int FFT_N = 16384;

__device__ __forceinline__ float2 cmul(float2 a, float2 b) { return make_float2(a.x * b.x - a.y * b.y, a.x * b.y + a.y * b.x); }
__device__ __forceinline__ float2 cmulc(float2 a, float2 b) { return make_float2(a.x * b.x + a.y * b.y, a.y * b.x - a.x * b.y); }

__device__ __forceinline__ float2 tw_get(const float2* twl, int e) { return cmul(twl[e & 127], twl[128 + (e >> 7)]); }
__device__ __forceinline__ void fft_fwd(float2* x, const float2* tw) {
    const int tid = otid();
#pragma unroll 1
    for (int lq = 12; lq >= 0; lq -= 2) {
        const int q = 1 << lq, tws = FFT_N >> (lq + 2);
#pragma unroll 4
        for (int i = 0; i < 8; ++i) {
            const int u = tid + i * 512, j = u & (q - 1), B = (u >> lq) << (lq + 2);
            float2* p = x + B + j;
            const float2 a0 = p[0], a1 = p[q], a2 = p[2 * q], a3 = p[3 * q];
            const float2 t0 = make_float2(a0.x + a2.x, a0.y + a2.y), t1 = make_float2(a0.x - a2.x, a0.y - a2.y);
            const float2 t2 = make_float2(a1.x + a3.x, a1.y + a3.y);
            const float2 d = make_float2(a1.x - a3.x, a1.y - a3.y), t3 = make_float2(d.y, -d.x);
            const float2 y0 = make_float2(t0.x + t2.x, t0.y + t2.y), y1 = make_float2(t1.x + t3.x, t1.y + t3.y);
            const float2 y2 = make_float2(t0.x - t2.x, t0.y - t2.y), y3 = make_float2(t1.x - t3.x, t1.y - t3.y);
            if (q > 1) {
                const float2 w1 = tw_get(tw, j * tws), w2 = cmul(w1, w1), w3 = cmul(w2, w1);
                p[0] = y0; p[q] = cmul(y1, w1); p[2 * q] = cmul(y2, w2); p[3 * q] = cmul(y3, w3);
            } else { p[0] = y0; p[1] = y1; p[2] = y2; p[3] = y3; }
        }
        __syncthreads();
    }
}
__device__ __forceinline__ void fft_inv(float2* x, const float2* tw) {
    const int tid = otid();
#pragma unroll 1
    for (int lq = 0; lq <= 12; lq += 2) {
        const int q = 1 << lq, tws = FFT_N >> (lq + 2);
#pragma unroll 4
        for (int i = 0; i < 8; ++i) {
            const int u = tid + i * 512, j = u & (q - 1), B = (u >> lq) << (lq + 2);
            float2* p = x + B + j;
            float2 b0 = p[0], b1 = p[q], b2 = p[2 * q], b3 = p[3 * q];
            if (q > 1) { const float2 w1 = tw_get(tw, j * tws), w2 = cmul(w1, w1), w3 = cmul(w2, w1); b1 = cmulc(b1, w1); b2 = cmulc(b2, w2); b3 = cmulc(b3, w3); }
            const float2 t0 = make_float2(b0.x + b2.x, b0.y + b2.y), t1 = make_float2(b0.x - b2.x, b0.y - b2.y);
            const float2 t2 = make_float2(b1.x + b3.x, b1.y + b3.y);
            const float2 d = make_float2(b1.x - b3.x, b1.y - b3.y), t3 = make_float2(-d.y, d.x);
            p[0] = make_float2(t0.x + t2.x, t0.y + t2.y); p[q] = make_float2(t1.x + t3.x, t1.y + t3.y);
            p[2 * q] = make_float2(t0.x - t2.x, t0.y - t2.y); p[3 * q] = make_float2(t1.x - t3.x, t1.y - t3.y);
        }
        __syncthreads();
    }
}

__device__ __forceinline__ void phase_hy_filters(const Args& a, unsigned char* lds) {
    const int tid = otid();
    float* zemb = (float*)(lds + LDS_USER);
    float* hA = zemb + 64 * 36;
    float* hB = hA + 64 * 68;
    const float* w1 = a.in[I_HFW1]; const float* b1 = a.in[I_HFB1]; const float* w2 = a.in[I_HFW2]; const float* b2 = a.in[I_HFB2];
    const float* w3 = a.in[I_HFW3]; const float* b3 = a.in[I_HFB3]; const float* fr = a.in[I_HFREQ]; const float* wo = a.in[I_HFWOUT];
    for (int u = blockIdx.x; u < 260; u += gridDim.x) {
        const bool isctx = u >= 256;
        const int Lh = isctx ? CTX : SEQ, n0 = (isctx ? (u - 256) : u) * 64;
        for (int it = tid; it < 64 * 33; it += NT) {
            const int p = it / 33, e = it - p * 33, n = n0 + p;
            float v;
            if (e == 0) v = (float)n / (float)(Lh - 1);
            else {
                const int bi = (e - 1) & 15;
                const float f = 1e-4f + (float)bi * ((15.0f - 1e-4f) / 15.0f);
                const float ang = 2.0f * 3.14159265358979323846f * f * (float)n / (float)Lh;
                v = (e <= 16) ? cos_acc(ang) : -sin_acc(ang);
            }
            zemb[p * 36 + e] = v;
        }
        __syncthreads();
        {
            const int p = tid & 63, h0 = (tid >> 6) * 8;
            float acc[8];
#pragma unroll
            for (int i = 0; i < 8; ++i) acc[i] = b1[h0 + i];
#pragma unroll 1
            for (int k = 0; k < 33; ++k) { const float zv = zemb[p * 36 + k];
#pragma unroll
                for (int i = 0; i < 8; ++i) acc[i] += zv * w1[k * 64 + h0 + i]; }
#pragma unroll
            for (int i = 0; i < 8; ++i) hA[p * 68 + h0 + i] = sin_acc(fr[h0 + i] * acc[i]);
            __syncthreads();
#pragma unroll
            for (int i = 0; i < 8; ++i) acc[i] = b2[h0 + i];
#pragma unroll 2
            for (int k = 0; k < 64; ++k) { const float hv = hA[p * 68 + k];
#pragma unroll
                for (int i = 0; i < 8; ++i) acc[i] += hv * w2[k * 64 + h0 + i]; }
#pragma unroll
            for (int i = 0; i < 8; ++i) hB[p * 68 + h0 + i] = sin_acc(fr[64 + h0 + i] * acc[i]);
            __syncthreads();
#pragma unroll
            for (int i = 0; i < 8; ++i) acc[i] = b3[h0 + i];
#pragma unroll 2
            for (int k = 0; k < 64; ++k) { const float hv = hB[p * 68 + k];
#pragma unroll
                for (int i = 0; i < 8; ++i) acc[i] += hv * w3[k * 64 + h0 + i]; }
            __syncthreads();
#pragma unroll
            for (int i = 0; i < 8; ++i) hA[p * 68 + h0 + i] = sin_acc(fr[128 + h0 + i] * acc[i]);
            __syncthreads();
        }
        {
            const int lane = tid & 63, wid = tid >> 6, fr = lane & 15, fq = lane >> 4;
            bf16x8 Ah[4][2], Al[4][2];
#pragma unroll
            for (int mb = 0; mb < 4; ++mb)
#pragma unroll
                for (int ks = 0; ks < 2; ++ks) {
                    const float* hp = hA + (mb * 16 + fr) * 68 + ks * 32 + fq * 8;
                    const float4 x0 = *(const float4*)hp, x1 = *(const float4*)(hp + 4);
                    u32x4 h, l;
                    h[0] = cvt_pk_bf16(x0.x, x0.y); h[1] = cvt_pk_bf16(x0.z, x0.w); h[2] = cvt_pk_bf16(x1.x, x1.y); h[3] = cvt_pk_bf16(x1.z, x1.w);
                    l[0] = cvt_pk_bf16(x0.x - bf_lo(h[0]), x0.y - bf_hi(h[0])); l[1] = cvt_pk_bf16(x0.z - bf_lo(h[1]), x0.w - bf_hi(h[1]));
                    l[2] = cvt_pk_bf16(x1.x - bf_lo(h[2]), x1.y - bf_hi(h[2])); l[3] = cvt_pk_bf16(x1.z - bf_lo(h[3]), x1.w - bf_hi(h[3]));
                    Ah[mb][ks] = __builtin_bit_cast(bf16x8, h); Al[mb][ks] = __builtin_bit_cast(bf16x8, l);
                }
            const bf16_t* WH = (const bf16_t*)(a.ws + WS_HWOT); const bf16_t* WL = WH + 2048 * 64;
            bf16x8 Bh[2], Bl[2], Nh[2], Nl[2];
            auto ldB = [&](int nb, bf16x8 (&bh)[2], bf16x8 (&bl)[2]) {
                const size_t o = (size_t)(wid * 256 + nb * 16 + fr) * 64 + fq * 8;
#pragma unroll
                for (int ks = 0; ks < 2; ++ks) { bh[ks] = *(const bf16x8*)(WH + o + ks * 32); bl[ks] = *(const bf16x8*)(WL + o + ks * 32); }
            };
            ldB(0, Bh, Bl);
#pragma unroll 1
            for (int nb = 0; nb < 16; ++nb) {
                if (nb + 1 < 16) ldB(nb + 1, Nh, Nl);
                f32x4 acc[4];
#pragma unroll
                for (int mb = 0; mb < 4; ++mb) {
                    acc[mb] = (f32x4){0.f, 0.f, 0.f, 0.f};
#pragma unroll
                    for (int ks = 0; ks < 2; ++ks) {
                        acc[mb] = __builtin_amdgcn_mfma_f32_16x16x32_bf16(Ah[mb][ks], Bh[ks], acc[mb], 0, 0, 0);
                        acc[mb] = __builtin_amdgcn_mfma_f32_16x16x32_bf16(Al[mb][ks], Bh[ks], acc[mb], 0, 0, 0);
                        acc[mb] = __builtin_amdgcn_mfma_f32_16x16x32_bf16(Ah[mb][ks], Bl[ks], acc[mb], 0, 0, 0);
                    }
                }
                const int col = wid * 256 + nb * 16 + fr, ch = col & 1023;
                const float dl = fabsf(-15.350567286626973f + (float)ch * ((-3.0701134573253946f + 15.350567286626973f) / 1023.0f));
                if (!isctx) {
                    float* dst = (float*)(a.ws + (col < 1024 ? HY_HF : HY_HB)) + (size_t)ch * SEQ + n0;
#pragma unroll
                    for (int mb = 0; mb < 4; ++mb) {
                        float o[4];
#pragma unroll
                        for (int r = 0; r < 4; ++r) { const int n = n0 + mb * 16 + fq * 4 + r; o[r] = acc[mb][r] * __expf(-((float)n / (float)(SEQ - 1)) * dl); }
                        *(float4*)(dst + mb * 16 + fq * 4) = make_float4(o[0], o[1], o[2], o[3]);
                    }
                } else {
                    float* dst = (float*)(a.ws + (col < 1024 ? HY_HFC : HY_HBC));
#pragma unroll
                    for (int mb = 0; mb < 4; ++mb)
#pragma unroll
                        for (int r = 0; r < 4; ++r) { const int n = n0 + mb * 16 + fq * 4 + r; dst[(size_t)n * D + ch] = acc[mb][r] * __expf(-((float)n / (float)(CTX - 1)) * dl); }
                }
#pragma unroll
                for (int ks = 0; ks < 2; ++ks) { Bh[ks] = Nh[ks]; Bl[ks] = Nl[ks]; }
            }
        }
        __syncthreads();
    }
}
__device__ __forceinline__ void phase_hy_filter_fft(const Args& a, unsigned char* lds) {
    const int tid = otid();
    float2* x = (float2*)(lds + LDS_USER);
    const float2* tw1g = (const float2*)(a.ws + WS_TW1); const float2* tw2 = (const float2*)(a.ws + WS_TW2);
    float2* tw1 = x + FFT_N;
    if (tid < 128) tw1[tid] = tw1g[tid]; else if (tid < 160) tw1[tid] = tw1g[(tid - 128) * 128];
    __syncthreads();
    for (int u = blockIdx.x; u < 2048; u += gridDim.x) {
        const int c = u >> 1, par = u & 1;
        const float* hf = (const float*)(a.ws + HY_HF) + (size_t)c * SEQ; const float* hb = (const float*)(a.ws + HY_HB) + (size_t)c * SEQ;
#pragma unroll
        for (int it = 0; it < 8; ++it) {
            const int n = (tid + it * NT) * 4;
            const float4 f0 = *(const float4*)(hf + n);
            float f1[4];
            if (n == 0) { f1[0] = 0.f; f1[1] = hb[SEQ - 1]; f1[2] = hb[SEQ - 2]; f1[3] = hb[SEQ - 3]; }
            else { const float4 t = *(const float4*)(hb + SEQ - n - 4); const float s0 = hb[SEQ - n]; f1[0] = s0; f1[1] = t.w; f1[2] = t.z; f1[3] = t.y; }
            const float f0v[4] = { f0.x, f0.y, f0.z, f0.w };
            float2 o[4];
            if (par == 0) {
#pragma unroll
                for (int q = 0; q < 4; ++q) o[q] = make_float2(f0v[q] + f1[q], 0.f);
            } else {
                const float4 wa = *(const float4*)(tw2 + n), wb = *(const float4*)(tw2 + n + 2);
                const float wr[4] = { wa.x, wa.z, wb.x, wb.z }, wi[4] = { wa.y, wa.w, wb.y, wb.w };
#pragma unroll
                for (int q = 0; q < 4; ++q) { const float dd = f0v[q] - f1[q]; o[q] = make_float2(dd * wr[q], dd * wi[q]); }
            }
            *(float4*)(x + n) = make_float4(o[0].x, o[0].y, o[1].x, o[1].y); *(float4*)(x + n + 2) = make_float4(o[2].x, o[2].y, o[3].x, o[3].y);
        }
        __syncthreads();
        fft_fwd(x, tw1);
        float2* dst = (float2*)(a.ws + HY_FS) + ((size_t)par * D + c) * SEQ;
#pragma unroll
        for (int it = 0; it < 16; ++it) { const int n = (tid + it * NT) * 2; *(float4*)(dst + n) = *(const float4*)(x + n); }
        __syncthreads();
    }
}
__device__ __forceinline__ void phase_hy_in(const Args& a, unsigned char* lds) {
    unsigned char* gl = lds + LDS_USER;
    bf16_t* UU = (bf16_t*)(a.ws + HY_UU);
    const float* bin = a.in[I_HBIN];
    int u = blockIdx.x;
    const unsigned char* ws = a.ws;
    const int xq = blockIdx.x & 7, nxw = (gridDim.x + 7 - xq) >> 3;
    int si = blockIdx.x >> 3;
    auto next = [&](g8::UTile& t) -> bool {
        const int m4 = si / 6, mt = 4 * m4 + (xq >> 1);
        if (mt >= 130) return false;
        t.mt = mt; t.nt = (xq & 1) * 6 + (si - m4 * 6); t.g = 0; si += nxw;
        return true;
    };
    const auto ctx = g8::make_ctx(
        [=](const g8::UTile& t) { return (const bf16_t*)(ws + WS_H) + (size_t)t.mt * 256 * D; },
        [=](const g8::UTile& t) { return (const bf16_t*)(ws + WS_HYINT) + (size_t)t.nt * 256 * D; },
        [=](const g8::UTile&, f32x4 (&acc)[2][2][4][2], int col0) { g8::bias_acc(acc, bin, col0); },
        [=](const g8::UTile&, const f32x4 (&acc)[2][2][4][2], int row0, int col0) {
            g8::each_acc(acc, row0, col0, [=](int row, int col, const f32x4& v) {
                u32x2 w = { cvt_pk_bf16(v[0], v[1]), cvt_pk_bf16(v[2], v[3]) };
                *(u32x2*)(UU + (size_t)row * 3072 + col) = w;
            });
        });
    g8::gemm256_stream<false, g8::UTile>(D, (unsigned)D, gl, ctx, next);
}
__device__ __forceinline__ void phase_hy_short(const Args& a, unsigned char* lds) {
    const int tid = otid();
    float* zt = (float*)(lds + LDS_USER);
    const bf16_t* UU = (const bf16_t*)(a.ws + HY_UU);
    const float* sw = a.in[I_HSW]; const float* sb = a.in[I_HSB]; const float* bias = a.in[I_HBIAS];
    for (int u = blockIdx.x; u < 520 * 4; u += gridDim.x) {
        const int rb = u >> 2, cc = u & 3, row0 = rb * 64, b = row0 / RPB, within0 = row0 - b * RPB;
        const bool isctx = within0 < CTX;
        const int c4 = tid & 63, rg = tid >> 6, cl = c4 * 4, c = cc * 256 + cl;
        float wt[3][3][4], bs[3][4];
#pragma unroll
        for (int g = 0; g < 3; ++g) {
#pragma unroll
            for (int tp = 0; tp < 3; ++tp) { const float4 w = *(const float4*)(sw + (size_t)tp * 3072 + g * 1024 + c); wt[g][tp][0] = w.x; wt[g][tp][1] = w.y; wt[g][tp][2] = w.z; wt[g][tp][3] = w.w; }
            const float4 bb = *(const float4*)(sb + g * 1024 + c); bs[g][0] = bb.x; bs[g][1] = bb.y; bs[g][2] = bb.z; bs[g][3] = bb.w;
        }
        const float4 bi4 = *(const float4*)(bias + c); const float bi[4] = { bi4.x, bi4.y, bi4.z, bi4.w };
        auto ld = [&](int row, int g, float (&o)[4]) {
            const int w = row - b * RPB;
            const bool valid = isctx ? (w >= 0 && w < CTX) : (w >= CTX && w < RPB);
            if (valid) { const u32x2 v = *(const u32x2*)(UU + (size_t)row * 3072 + g * 1024 + c); o[0] = bf_lo(v[0]); o[1] = bf_hi(v[0]); o[2] = bf_lo(v[1]); o[3] = bf_hi(v[1]); }
            else { o[0] = o[1] = o[2] = o[3] = 0.f; }
        };
        float pv[3][4], cv[3][4], nv[3][4];
        const int r0 = row0 + rg * 8;
#pragma unroll
        for (int g = 0; g < 3; ++g) { ld(r0 - 1, g, pv[g]); ld(r0, g, cv[g]); }
#pragma unroll 1
        for (int i = 0; i < 8; ++i) {
            const int row = r0 + i;
#pragma unroll
            for (int g = 0; g < 3; ++g) ld(row + 1, g, nv[g]);
            float uo[3][4];
#pragma unroll
            for (int g = 0; g < 3; ++g)
#pragma unroll
                for (int q = 0; q < 4; ++q) uo[g][q] = pv[g][q] * wt[g][0][q] + cv[g][q] * wt[g][1][q] + nv[g][q] * wt[g][2][q] + bs[g][q];
            float z[4], xz[4];
#pragma unroll
            for (int q = 0; q < 4; ++q) { z[q] = uo[2][q] * uo[1][q]; xz[q] = uo[0][q] * z[q] * bi[q]; }
            u32x2 o0 = { cvt_pk_bf16(uo[0][0], uo[0][1]), cvt_pk_bf16(uo[0][2], uo[0][3]) }, o1 = { cvt_pk_bf16(xz[0], xz[1]), cvt_pk_bf16(xz[2], xz[3]) };
            *(u32x2*)((bf16_t*)(a.ws + HY_X0) + (size_t)row * D + c) = o0;
            *(u32x2*)((bf16_t*)(a.ws + HY_X0ZB) + (size_t)row * D + c) = o1;
            if (isctx) *(float4*)((float*)(a.ws + HY_ZC) + ((size_t)b * CTX + (within0 + rg * 8 + i)) * D + c) = make_float4(z[0], z[1], z[2], z[3]);
            else {
#pragma unroll
                for (int q = 0; q < 4; ++q) zt[(cl + q) * 65 + rg * 8 + i] = z[q];
            }
#pragma unroll
            for (int g = 0; g < 3; ++g)
#pragma unroll
                for (int q = 0; q < 4; ++q) { pv[g][q] = cv[g][q]; cv[g][q] = nv[g][q]; }
        }
        __syncthreads();
        if (!isctx) {
            const int t0 = within0 - CTX;
#pragma unroll
            for (int i = 0; i < 8; ++i) {
                const int idx = tid + i * 512, ch = idx >> 4, t4 = (idx & 15) * 4;
                const float* s = zt + ch * 65 + t4;
                *(float4*)((float*)(a.ws + HY_ZT) + ((size_t)(cc * 256 + ch) * 2 + b) * SEQ + t0 + t4) = make_float4(s[0], s[1], s[2], s[3]);
            }
        }
        __syncthreads();
    }
}
__device__ __forceinline__ void phase_hy_fftconv(const Args& a, unsigned char* lds) {
    const int tid = otid();
    float2* x = (float2*)(lds + LDS_USER);
    const float2* tw1g = (const float2*)(a.ws + WS_TW1); const float2* tw2 = (const float2*)(a.ws + WS_TW2);
    float2* tw1 = x + FFT_N;
    if (tid < 128) tw1[tid] = tw1g[tid]; else if (tid < 160) tw1[tid] = tw1g[(tid - 128) * 128];
    __syncthreads();
    float4 zin[8][2];
    auto ld_in = [&](int uu) {
        const int cc = uu >> 1;
        const float* q0 = (const float*)(a.ws + HY_ZT) + (size_t)cc * 2 * SEQ; const float* q1 = q0 + SEQ;
#pragma unroll
        for (int it = 0; it < 8; ++it) { const int n = (tid + it * NT) * 4; zin[it][0] = *(const float4*)(q0 + n); zin[it][1] = *(const float4*)(q1 + n); }
    };
    if (blockIdx.x < 2048) ld_in(blockIdx.x);
    for (int u = blockIdx.x; u < 2048; u += gridDim.x) {
        const int c = u >> 1, par = u & 1;
#pragma unroll
        for (int it = 0; it < 8; ++it) {
            const int n = (tid + it * NT) * 4;
            const float4 a0 = zin[it][0], a1 = zin[it][1];
            float2 v[4] = { make_float2(a0.x, a1.x), make_float2(a0.y, a1.y), make_float2(a0.z, a1.z), make_float2(a0.w, a1.w) };
            if (par) {
                const float4 wa = *(const float4*)(tw2 + n), wb = *(const float4*)(tw2 + n + 2);
                v[0] = cmul(v[0], make_float2(wa.x, wa.y)); v[1] = cmul(v[1], make_float2(wa.z, wa.w)); v[2] = cmul(v[2], make_float2(wb.x, wb.y)); v[3] = cmul(v[3], make_float2(wb.z, wb.w));
            }
            *(float4*)(x + n) = make_float4(v[0].x, v[0].y, v[1].x, v[1].y); *(float4*)(x + n + 2) = make_float4(v[2].x, v[2].y, v[3].x, v[3].y);
        }
        const float2* fs = (const float2*)(a.ws + HY_FS) + ((size_t)par * D + c) * SEQ;
        float4 fsp[16];
#pragma unroll
        for (int it = 0; it < 16; ++it) fsp[it] = *(const float4*)(fs + (tid + it * NT) * 2);
        __syncthreads();
        fft_fwd(x, tw1);
#pragma unroll
        for (int it = 0; it < 16; ++it) {
            const int n = (tid + it * NT) * 2;
            const float4 f = fsp[it], xv = *(const float4*)(x + n);
            const float2 r0 = cmul(make_float2(xv.x, xv.y), make_float2(f.x, f.y)), r1 = cmul(make_float2(xv.z, xv.w), make_float2(f.z, f.w));
            *(float4*)(x + n) = make_float4(r0.x, r0.y, r1.x, r1.y);
        }
        if (u + (int)gridDim.x < 2048) ld_in(u + gridDim.x);
        __syncthreads();
        fft_inv(x, tw1);
        float* u0 = (float*)(a.ws + HY_U) + ((size_t)par * D + c) * 2 * SEQ; float* u1 = u0 + SEQ;
#pragma unroll
        for (int it = 0; it < 8; ++it) {
            const int n = (tid + it * NT) * 4;
            const float4 va = *(const float4*)(x + n), vb = *(const float4*)(x + n + 2);
            *(float4*)(u0 + n) = make_float4(va.x, va.z, vb.x, vb.z); *(float4*)(u1 + n) = make_float4(va.y, va.w, vb.y, vb.w);
        }
        __syncthreads();
    }
}
__device__ __forceinline__ void phase_hy_combine(const Args& a, unsigned char* lds) {
    const int tid = otid();
    float* tile = (float*)(lds + LDS_USER);
    const float2* tw2 = (const float2*)(a.ws + WS_TW2);
    bf16_t* P = (bf16_t*)(a.ws + HY_P);
    const bf16_t* X0 = (const bf16_t*)(a.ws + HY_X0); const bf16_t* X0ZB = (const bf16_t*)(a.ws + HY_X0ZB);
    for (int u = blockIdx.x; u < 128; u += gridDim.x) {
        const int b = u >> 6, tg = (u >> 1) & 31, c = (u & 1) * 512 + tid, t0 = tg * 8;
        const float* z = (const float*)(a.ws + HY_ZC) + (size_t)b * CTX * D + c;
        const float* hf = (const float*)(a.ws + HY_HFC) + c; const float* hb = (const float*)(a.ws + HY_HBC) + c;
        float w[8], acc[8];
#pragma unroll
        for (int i = 0; i < 8; ++i) { acc[i] = 0.f; w[i] = hf[(size_t)(t0 + i) * D]; }
#pragma unroll 1
        for (int s = 0; s < CTX; ++s) {
            const float zv = z[(size_t)s * D];
#pragma unroll
            for (int i = 0; i < 8; ++i) acc[i] += w[i] * zv;
#pragma unroll
            for (int i = 7; i >= 1; --i) w[i] = w[i - 1];
            const int s1 = s + 1;
            w[0] = (s1 <= t0) ? hf[(size_t)(t0 - s1) * D] : ((s1 - t0) < CTX ? hb[(size_t)(s1 - t0) * D] : 0.f);
        }
#pragma unroll
        for (int i = 0; i < 8; ++i) {
            const size_t row = (size_t)b * RPB + t0 + i;
            const float x0 = __uint_as_float((unsigned)X0[row * D + c] << 16), xz = __uint_as_float((unsigned)X0ZB[row * D + c] << 16);
            P[row * D + c] = (bf16_t)(cvt_pk_bf16(x0 * acc[i] + xz, 0.f) & 0xffffu);
        }
    }
    for (int u = blockIdx.x; u < 256 * 8; u += gridDim.x) {
        const int tb = u >> 3, cc = u & 7, t0 = tb * 64, c0 = cc * 128;
#pragma unroll
        for (int i = 0; i < 4; ++i) {
            const int idx = tid + i * 512, ch = idx >> 4, t4 = (idx & 15) * 4;
            const float* ue = (const float*)(a.ws + HY_U) + ((size_t)0 * D + c0 + ch) * 2 * SEQ + t0 + t4;
            const float* uo = (const float*)(a.ws + HY_U) + ((size_t)1 * D + c0 + ch) * 2 * SEQ + t0 + t4;
            const float4 er = *(const float4*)ue, ei = *(const float4*)(ue + SEQ), orr = *(const float4*)uo, oi = *(const float4*)(uo + SEQ);
            const float4 wa = *(const float4*)(tw2 + t0 + t4), wb = *(const float4*)(tw2 + t0 + t4 + 2);
            const float e_r[4] = { er.x, er.y, er.z, er.w }, e_i[4] = { ei.x, ei.y, ei.z, ei.w }, o_r[4] = { orr.x, orr.y, orr.z, orr.w }, o_i[4] = { oi.x, oi.y, oi.z, oi.w };
            const float wr[4] = { wa.x, wa.z, wb.x, wb.z }, wi[4] = { wa.y, wa.w, wb.y, wb.w };
#pragma unroll
            for (int q = 0; q < 4; ++q) {
                const float cr = wr[q], ci = -wi[q];
                const float yr = (e_r[q] + (o_r[q] * cr - o_i[q] * ci)) * (1.f / 32768.f), yi = (e_i[q] + (o_r[q] * ci + o_i[q] * cr)) * (1.f / 32768.f);
                tile[(0 * 64 + t4 + q) * 129 + ch] = yr; tile[(1 * 64 + t4 + q) * 129 + ch] = yi;
            }
        }
        __syncthreads();
#pragma unroll
        for (int i = 0; i < 4; ++i) {
            const int idx = tid + i * 512, b = idx >> 10, t = (idx >> 4) & 63, c8 = (idx & 15) * 8;
            const size_t row = (size_t)b * RPB + CTX + t0 + t;
            const u32x4 x0 = *(const u32x4*)(X0 + row * D + c0 + c8), xz = *(const u32x4*)(X0ZB + row * D + c0 + c8);
            const float* y = tile + (b * 64 + t) * 129 + c8;
            u32x4 o;
#pragma unroll
            for (int q = 0; q < 4; ++q) o[q] = cvt_pk_bf16(bf_lo(x0[q]) * y[2 * q] + bf_lo(xz[q]), bf_hi(x0[q]) * y[2 * q + 1] + bf_hi(xz[q]));
            *(u32x4*)(P + row * D + c0 + c8) = o;
        }
        __syncthreads();
    }
}
constexpr size_t ML_QKVA = WS_MIX;
constexpr size_t ML_QC   = ML_QKVA + (size_t)T * 768 * 4;
constexpr size_t ML_KVC  = ML_QC + (size_t)T * 384 * 2;
constexpr size_t ML_QF   = ML_KVC + (size_t)T * 256 * 2;
constexpr size_t ML_KVF  = ML_QF + (size_t)T * 1536 * 4;
constexpr size_t ML_Q    = ML_KVF + (size_t)T * 2048 * 4;
constexpr size_t ML_K    = ML_Q + (size_t)T * 1536 * 2;
constexpr size_t ML_VT   = ML_K + (size_t)T * 1536 * 2;
constexpr size_t ML_O    = ML_VT + (size_t)T * 1024 * 2;
constexpr size_t ML_QM   = ML_O + (size_t)T * 1024 * 2;
constexpr size_t ML_END  = ML_QM + (size_t)T * 8 * 4;

__device__ __forceinline__ void phase_mla_a(const Args& a, unsigned char* lds) {
    unsigned char* gl = lds + LDS_USER;
    float* out = (float*)(a.ws + ML_QKVA);
    const int xq = blockIdx.x & 7, nxw = (gridDim.x + 7 - xq) >> 3;
    for (int si = blockIdx.x >> 3; ; si += nxw) {
        const int m8 = si / 3, mt = 8 * m8 + xq, nt = si - m8 * 3;
        if (mt >= 130) break;
        g8::gemm256<false>((const bf16_t*)(a.ws + WS_H), g8::AOffPlain{ (unsigned)(mt * 256), (unsigned)D }, (const bf16_t*)(a.ws + WS_MWAT) + (size_t)nt * 256 * D, D, gl,
            make_epi3(nil_col, nil_row, [=](int row, int col, const f32x4& v, Nil, Nil) { *(f32x4*)(out + (size_t)row * 768 + col) = v; }), mt * 256, nt * 256);
        __syncthreads();
    }
}
__device__ __forceinline__ void phase_mla_norm(const Args& a) {
    const int tid = otid(), lane = tid & 63, wid = tid >> 6;
    const float* qg = a.in[I_MQNG]; const float* kg = a.in[I_MKVNG];
    for (int row = blockIdx.x * 8 + wid; row < T; row += gridDim.x * 8) {
        const float* src = (const float*)(a.ws + ML_QKVA) + (size_t)row * 768;
        const float4 q0 = *(const float4*)(src + lane * 4);
        float4 q1 = make_float4(0.f, 0.f, 0.f, 0.f);
        if (lane < 32) q1 = *(const float4*)(src + 256 + lane * 4);
        float ss = q0.x * q0.x + q0.y * q0.y + q0.z * q0.z + q0.w * q0.w + q1.x * q1.x + q1.y * q1.y + q1.z * q1.z + q1.w * q1.w;
        ss = wave_sum(ss);
        const float rq = rsqrtf(ss * (1.f / 384.f) + 1e-6f);
        bf16_t* qc = (bf16_t*)(a.ws + ML_QC) + (size_t)row * 384;
        { const float4 g = *(const float4*)(qg + lane * 4); u32x2 o = { cvt_pk_bf16(q0.x * rq * g.x, q0.y * rq * g.y), cvt_pk_bf16(q0.z * rq * g.z, q0.w * rq * g.w) }; *(u32x2*)(qc + lane * 4) = o; }
        if (lane < 32) { const float4 g = *(const float4*)(qg + 256 + lane * 4); u32x2 o = { cvt_pk_bf16(q1.x * rq * g.x, q1.y * rq * g.y), cvt_pk_bf16(q1.z * rq * g.z, q1.w * rq * g.w) }; *(u32x2*)(qc + 256 + lane * 4) = o; }
        const float4 k0 = *(const float4*)(src + 384 + lane * 4);
        float s2 = k0.x * k0.x + k0.y * k0.y + k0.z * k0.z + k0.w * k0.w;
        s2 = wave_sum(s2);
        const float rk = rsqrtf(s2 * (1.f / 256.f) + 1e-6f);
        { const float4 g = *(const float4*)(kg + lane * 4); u32x2 o = { cvt_pk_bf16(k0.x * rk * g.x, k0.y * rk * g.y), cvt_pk_bf16(k0.z * rk * g.z, k0.w * rk * g.w) }; *(u32x2*)((bf16_t*)(a.ws + ML_KVC) + (size_t)row * 256 + lane * 4) = o; }
    }
}
__device__ __forceinline__ void phase_mla_b(const Args& a, unsigned char* lds) {
    unsigned char* gl = lds + LDS_USER;
    const unsigned char* ws = a.ws;
    {
        const int xq = blockIdx.x & 7, nxw = (gridDim.x + 7 - xq) >> 3;
        int si = blockIdx.x >> 3;
        auto next = [&](g8::UTile& t) -> bool { const int m8 = si / 6, mt = 8 * m8 + xq; if (mt >= 130) return false; t.mt = mt; t.nt = si - m8 * 6; t.g = 0; si += nxw; return true; };
        const auto ctx = g8::make_ctx(
            [=](const g8::UTile& t) { return (const bf16_t*)(ws + ML_QC) + (size_t)t.mt * 256 * 384; },
            [=](const g8::UTile& t) { return (const bf16_t*)(ws + WS_MWQBT) + (size_t)t.nt * 256 * 384; },
            [=](const g8::UTile&, f32x4 (&acc)[2][2][4][2], int) { g8::zero_acc(acc); },
            [=](const g8::UTile&, const f32x4 (&acc)[2][2][4][2], int row0, int col0) {
                float* out = uniform_ptr((float*)(ws + ML_QF));
                g8::each_acc(acc, row0, col0, [=](int row, int col, const f32x4& v) { *(f32x4*)(out + (size_t)row * 1536 + col) = v; });
            });
        g8::gemm256_stream<false, g8::UTile>(384, 384u, gl, ctx, next);
    }
    {
        const int xq = blockIdx.x & 7, nxw = (gridDim.x + 7 - xq) >> 3;
        int si = nxw - 1 - (int)(blockIdx.x >> 3);
        auto next = [&](g8::UTile& t) -> bool { const int mt = 8 * (si >> 3) + xq; if (mt >= 130) return false; t.mt = mt; t.nt = si & 7; t.g = 0; si += nxw; return true; };
        const auto ctx = g8::make_ctx(
            [=](const g8::UTile& t) { return (const bf16_t*)(ws + ML_KVC) + (size_t)t.mt * 256 * 256; },
            [=](const g8::UTile& t) { return (const bf16_t*)(ws + WS_MWKVBT) + (size_t)t.nt * 256 * 256; },
            [=](const g8::UTile&, f32x4 (&acc)[2][2][4][2], int) { g8::zero_acc(acc); },
            [=](const g8::UTile&, const f32x4 (&acc)[2][2][4][2], int row0, int col0) {
                float* out = uniform_ptr((float*)(ws + ML_KVF));
                g8::each_acc(acc, row0, col0, [=](int row, int col, const f32x4& v) { *(f32x4*)(out + (size_t)row * 2048 + col) = v; });
            });
        g8::gemm256_stream<false, g8::UTile>(256, 256u, gl, ctx, next);
    }
}
__device__ __forceinline__ void phase_mla_rope(const Args& a, unsigned char* lds) {
    const int tid = otid();
    bf16_t* vt = (bf16_t*)(lds + LDS_USER);
    const float* qn = a.in[I_MQN]; const float* kn = a.in[I_MKN];
    const float QSCALE = 0.07216878364870322f * 1.4426950408889634f;
    for (int u = blockIdx.x; u < 520 * 8; u += gridDim.x) {
        const int rb = u >> 3, h = u & 7, row0 = rb * 64, b = row0 / RPB, within0 = row0 - b * RPB;
        const bool lat = within0 >= CTX;
#pragma unroll 1
        for (int pass = 0; pass < 2; ++pass) {
            const int rl = pass * 32 + (tid >> 4), g = tid & 15, row = row0 + rl;
            const int tpos = within0 + rl - CTX;
            float cs[4], sn[4];
            {
                const float inv = exp2f(-(float)g * (13.287712379549449f / 16.f));
                const float ar = (float)(tpos >> 6) * inv, ac = (float)(tpos & 63) * inv;
                cs[0] = lat ? cos_acc(ar) : 1.f; sn[0] = lat ? sin_acc(ar) : 0.f; cs[1] = lat ? cos_acc(ac) : 1.f; sn[1] = lat ? sin_acc(ac) : 0.f;
            }
            {
                const float* src = (const float*)(a.ws + ML_QF) + (size_t)row * 1536 + h * 192;
                const float4 n0 = *(const float4*)(src + g * 8), n1 = *(const float4*)(src + g * 8 + 4);
                float r0 = src[128 + g], r1 = src[144 + g], c0 = src[160 + g], c1 = src[176 + g];
                float ss = n0.x * n0.x + n0.y * n0.y + n0.z * n0.z + n0.w * n0.w + n1.x * n1.x + n1.y * n1.y + n1.z * n1.z + n1.w * n1.w + r0 * r0 + r1 * r1 + c0 * c0 + c1 * c1;
                ss = row16_sum(ss);
                const float rs = rsqrtf(ss * (1.f / 192.f) + 1e-6f) * QSCALE;
                const float4 g0 = *(const float4*)(qn + g * 8), g1 = *(const float4*)(qn + g * 8 + 4);
                bf16_t* dst = (bf16_t*)(a.ws + ML_Q) + (size_t)row * 1536 + h * 192;
                u32x4 o = { cvt_pk_bf16(n0.x * rs * g0.x, n0.y * rs * g0.y), cvt_pk_bf16(n0.z * rs * g0.z, n0.w * rs * g0.w), cvt_pk_bf16(n1.x * rs * g1.x, n1.y * rs * g1.y), cvt_pk_bf16(n1.z * rs * g1.z, n1.w * rs * g1.w) };
                *(u32x4*)(dst + g * 8) = o;
                r0 *= rs * qn[128 + g]; r1 *= rs * qn[144 + g]; c0 *= rs * qn[160 + g]; c1 *= rs * qn[176 + g];
                const unsigned pr = cvt_pk_bf16(r0 * cs[0] - r1 * sn[0], r0 * sn[0] + r1 * cs[0]), pc = cvt_pk_bf16(c0 * cs[1] - c1 * sn[1], c0 * sn[1] + c1 * cs[1]);
                dst[128 + g] = (bf16_t)(pr & 0xffffu); dst[144 + g] = (bf16_t)(pr >> 16); dst[160 + g] = (bf16_t)(pc & 0xffffu); dst[176 + g] = (bf16_t)(pc >> 16);
                float q2 = 0.f;
                { const float e[8] = { n0.x * rs * g0.x, n0.y * rs * g0.y, n0.z * rs * g0.z, n0.w * rs * g0.w, n1.x * rs * g1.x, n1.y * rs * g1.y, n1.z * rs * g1.z, n1.w * rs * g1.w };
#pragma unroll
                  for (int i = 0; i < 8; ++i) q2 += e[i] * e[i]; }
                q2 += r0 * r0 + r1 * r1 + c0 * c0 + c1 * c1;
                q2 = row16_sum(q2);
                const float4 k0g = *(const float4*)(kn + g * 8), k1g = *(const float4*)(kn + g * 8 + 4);
                float km = fmaxf(fmaxf(fmaxf(fabsf(k0g.x), fabsf(k0g.y)), fmaxf(fabsf(k0g.z), fabsf(k0g.w))), fmaxf(fmaxf(fabsf(k1g.x), fabsf(k1g.y)), fmaxf(fabsf(k1g.z), fabsf(k1g.w))));
                km = fmaxf(km, fmaxf(fmaxf(fabsf(kn[128 + g]), fabsf(kn[144 + g])), fmaxf(fabsf(kn[160 + g]), fabsf(kn[176 + g]))));
                km = fmaxf(km, dpp_f<0x128>(km)); km = fmaxf(km, dpp_f<0x124>(km)); km = fmaxf(km, dpp_f<0x122>(km)); km = fmaxf(km, dpp_f<0x121>(km));
                if (g == 0) ((float*)(a.ws + ML_QM))[(size_t)row * 8 + h] = 1.02f * sqrtf(q2) * km * 13.856406460551018f;
            }
            {
                const float* src = (const float*)(a.ws + ML_KVF) + (size_t)row * 2048 + h * 256;
                const float* pe = (const float*)(a.ws + ML_QKVA) + (size_t)row * 768 + 640;
                const float4 n0 = *(const float4*)(src + g * 8), n1 = *(const float4*)(src + g * 8 + 4);
                float r0 = pe[g], r1 = pe[16 + g], c0 = pe[32 + g], c1 = pe[48 + g];
                float ss = n0.x * n0.x + n0.y * n0.y + n0.z * n0.z + n0.w * n0.w + n1.x * n1.x + n1.y * n1.y + n1.z * n1.z + n1.w * n1.w + r0 * r0 + r1 * r1 + c0 * c0 + c1 * c1;
                ss = row16_sum(ss);
                const float rs = rsqrtf(ss * (1.f / 192.f) + 1e-6f);
                const float4 g0 = *(const float4*)(kn + g * 8), g1 = *(const float4*)(kn + g * 8 + 4);
                bf16_t* dst = (bf16_t*)(a.ws + ML_K) + (size_t)row * 1536 + h * 192;
                u32x4 o = { cvt_pk_bf16(n0.x * rs * g0.x, n0.y * rs * g0.y), cvt_pk_bf16(n0.z * rs * g0.z, n0.w * rs * g0.w), cvt_pk_bf16(n1.x * rs * g1.x, n1.y * rs * g1.y), cvt_pk_bf16(n1.z * rs * g1.z, n1.w * rs * g1.w) };
                *(u32x4*)(dst + g * 8) = o;
                r0 *= rs * kn[128 + g]; r1 *= rs * kn[144 + g]; c0 *= rs * kn[160 + g]; c1 *= rs * kn[176 + g];
                const unsigned pr = cvt_pk_bf16(r0 * cs[0] - r1 * sn[0], r0 * sn[0] + r1 * cs[0]), pc = cvt_pk_bf16(c0 * cs[1] - c1 * sn[1], c0 * sn[1] + c1 * cs[1]);
                dst[128 + g] = (bf16_t)(pr & 0xffffu); dst[144 + g] = (bf16_t)(pr >> 16); dst[160 + g] = (bf16_t)(pc & 0xffffu); dst[176 + g] = (bf16_t)(pc >> 16);
                const float4 v0 = *(const float4*)(src + 128 + g * 8), v1 = *(const float4*)(src + 128 + g * 8 + 4);
                const unsigned p0 = cvt_pk_bf16(v0.x, v0.y), p1 = cvt_pk_bf16(v0.z, v0.w), p2 = cvt_pk_bf16(v1.x, v1.y), p3 = cvt_pk_bf16(v1.z, v1.w);
                bf16_t* vd = vt + (g * 8) * 72 + rl;
                vd[0 * 72] = (bf16_t)(p0 & 0xffffu); vd[1 * 72] = (bf16_t)(p0 >> 16); vd[2 * 72] = (bf16_t)(p1 & 0xffffu); vd[3 * 72] = (bf16_t)(p1 >> 16);
                vd[4 * 72] = (bf16_t)(p2 & 0xffffu); vd[5 * 72] = (bf16_t)(p2 >> 16); vd[6 * 72] = (bf16_t)(p3 & 0xffffu); vd[7 * 72] = (bf16_t)(p3 >> 16);
            }
        }
        __syncthreads();
        {
            bf16_t* VT = (bf16_t*)(a.ws + ML_VT) + ((size_t)(b * 8 + h) * 128) * RPB + within0;
#pragma unroll
            for (int i = 0; i < 2; ++i) {
                const int idx = tid + i * 512, d = idx >> 3, c = idx & 7;
                *(u32x4*)(VT + (size_t)d * RPB + c * 8) = *(const u32x4*)(vt + d * 72 + c * 8);
            }
        }
        __syncthreads();
    }
}
constexpr int AT_KROW = 400, AT_VROW = 136, AT_KB = 64 * AT_KROW, AT_VB = 128 * AT_VROW, AT_BUF = AT_KB + AT_VB;
__device__ __forceinline__ void phase_mla_attn(const Args& a, unsigned char* lds) {
    const int tid = otid(), lane = tid & 63, wid = tid >> 6, ln = lane & 31, hk = lane >> 5;
    unsigned char* base = lds + LDS_USER;
    const bf16_t* Qg = (const bf16_t*)(a.ws + ML_Q); const bf16_t* Kg = (const bf16_t*)(a.ws + ML_K); const bf16_t* VTg = (const bf16_t*)(a.ws + ML_VT);
    bf16_t* Og = (bf16_t*)(a.ws + ML_O);
    if (wid >= 4) __builtin_amdgcn_s_setprio(1);
    const int xq = blockIdx.x & 7, nxw = (gridDim.x + 7 - xq) >> 3;
    for (int si = blockIdx.x >> 3; ; si += nxw) {
        int u;
        { const int pp = 8 * (si >> 6) + xq; u = pp < 16 ? pp * 64 + (si & 63) : 1024 + (si - 128) * 8 + xq; if (pp >= 16 && (si - 128) >= 2) break; }
        int b, h, qrow0, nkeys;
        if (u < 1024) { b = u >> 9; h = (u >> 6) & 7; qrow0 = b * RPB + CTX + (u & 63) * 256; nkeys = RPB; }
        else { const int v = u - 1024; b = v >> 3; h = v & 7; qrow0 = b * RPB; nkeys = CTX; }
        const int ntiles = nkeys >> 6;
        const bf16_t* Kb = Kg + (size_t)b * RPB * 1536 + h * 192;
        const bf16_t* Vb = VTg + (size_t)(b * 8 + h) * 128 * RPB;
        bf16x8 qf[12];
        {
            const bf16_t* qp = Qg + (size_t)(qrow0 + wid * 32 + ln) * 1536 + h * 192 + hk * 8;
#pragma unroll
            for (int ks = 0; ks < 12; ++ks) qf[ks] = *(const bf16x8*)(qp + ks * 16);
        }
        f32x16 o[4];
#pragma unroll
        for (int i = 0; i < 4; ++i)
#pragma unroll
            for (int r = 0; r < 16; ++r) o[i][r] = 0.f;
        float lrun = 0.f;
        const float nqm = -((const float*)(a.ws + ML_QM))[(size_t)(qrow0 + wid * 32 + ln) * 8 + h];
        u32x4 rk[3];
        auto gloadK = [&](int t) {
            const int k0 = t * 64;
#pragma unroll
            for (int i = 0; i < 3; ++i) { const int id = tid + i * 512, key = id / 24, c = id - key * 24; rk[i] = *(const u32x4*)(Kb + (size_t)(k0 + key) * 1536 + c * 8); }
        };
        auto gloadV = [&](int t) {
            const int k0 = t * 64;
#pragma unroll
            for (int i = 0; i < 2; ++i) { const int id = tid + i * 512, d = id >> 3, c = id & 7; rk[i] = *(const u32x4*)(Vb + (size_t)d * RPB + k0 + c * 8); }
        };
        auto lstoreK = [&](int buf) {
            unsigned char* kb = base + buf * AT_BUF;
#pragma unroll
            for (int i = 0; i < 3; ++i) { const int id = tid + i * 512, key = id / 24, c = id - key * 24; *(u32x4*)(kb + key * AT_KROW + c * 16) = rk[i]; }
        };
        auto lstoreV = [&](int buf) {
            unsigned char* vb = base + buf * AT_BUF + AT_KB;
#pragma unroll
            for (int i = 0; i < 2; ++i) { const int id = tid + i * 512, d = id >> 3, c = id & 7; *(u32x2*)(vb + d * AT_VROW + c * 16) = (u32x2){ rk[i][0], rk[i][1] }; *(u32x2*)(vb + d * AT_VROW + c * 16 + 8) = (u32x2){ rk[i][2], rk[i][3] }; }
        };
        gloadK(0); lstoreK(0); gloadV(0); lstoreV(0);
        __syncthreads();
        for (int t = 0; t < ntiles; ++t) {
            const bool more = t + 1 < ntiles;
            if (more) gloadK(t + 1);
            const unsigned char* kb = base + (t & 1) * AT_BUF; const unsigned char* vb = kb + AT_KB;
            f32x16 s0, s1;
#pragma unroll
            for (int r = 0; r < 16; ++r) { s0[r] = nqm; s1[r] = nqm; }
#pragma unroll
            for (int ks = 0; ks < 12; ++ks) {
                const bf16x8 k0f = *(const bf16x8*)(kb + ln * AT_KROW + ks * 32 + hk * 16);
                const bf16x8 k1f = *(const bf16x8*)(kb + (32 + ln) * AT_KROW + ks * 32 + hk * 16);
                s0 = __builtin_amdgcn_mfma_f32_32x32x16_bf16(k0f, qf[ks], s0, 0, 0, 0);
                s1 = __builtin_amdgcn_mfma_f32_32x32x16_bf16(k1f, qf[ks], s1, 0, 0, 0);
            }
            if (more) { lstoreK((t + 1) & 1); gloadV(t + 1); }
            float ps = 0.f;
#pragma unroll
            for (int r = 0; r < 16; ++r) { s0[r] = __builtin_amdgcn_exp2f(s0[r]); ps += s0[r]; }
#pragma unroll
            for (int r = 0; r < 16; ++r) { s1[r] = __builtin_amdgcn_exp2f(s1[r]); ps += s1[r]; }
            lrun += ps;
#pragma unroll
            for (int kb2 = 0; kb2 < 2; ++kb2) {
#pragma unroll
                for (int s = 0; s < 2; ++s) {
                    u32x4 pw;
                    if (kb2 == 0) pw = (u32x4){ cvt_pk_bf16(s0[8 * s + 0], s0[8 * s + 1]), cvt_pk_bf16(s0[8 * s + 2], s0[8 * s + 3]), cvt_pk_bf16(s0[8 * s + 4], s0[8 * s + 5]), cvt_pk_bf16(s0[8 * s + 6], s0[8 * s + 7]) };
                    else          pw = (u32x4){ cvt_pk_bf16(s1[8 * s + 0], s1[8 * s + 1]), cvt_pk_bf16(s1[8 * s + 2], s1[8 * s + 3]), cvt_pk_bf16(s1[8 * s + 4], s1[8 * s + 5]), cvt_pk_bf16(s1[8 * s + 6], s1[8 * s + 7]) };
                    const bf16x8 pf = __builtin_bit_cast(bf16x8, pw);
                    const int koff = (kb2 * 32 + s * 16 + hk * 4) * 2;
#pragma unroll
                    for (int db = 0; db < 4; ++db) {
                        const unsigned char* vp = vb + (db * 32 + ln) * AT_VROW + koff;
                        const u32x2 va = *(const u32x2*)vp, vc = *(const u32x2*)(vp + 16);
                        const bf16x8 vf = __builtin_bit_cast(bf16x8, ((u32x4){ va[0], va[1], vc[0], vc[1] }));
                        o[db] = __builtin_amdgcn_mfma_f32_32x32x16_bf16(vf, pf, o[db], 0, 0, 0);
                    }
                }
            }
            if (more) lstoreV((t + 1) & 1);
            __syncthreads();
        }
        const float ltot = lrun + __shfl_xor(lrun, 32);
        const float inv = 1.f / ltot;
        bf16_t* op = Og + (size_t)(qrow0 + wid * 32 + ln) * 1024 + h * 128;
#pragma unroll
        for (int db = 0; db < 4; ++db)
#pragma unroll
            for (int r4 = 0; r4 < 4; ++r4) {
                const int d = db * 32 + 8 * r4 + 4 * hk;
                u32x2 w = { cvt_pk_bf16(o[db][4 * r4 + 0] * inv, o[db][4 * r4 + 1] * inv), cvt_pk_bf16(o[db][4 * r4 + 2] * inv, o[db][4 * r4 + 3] * inv) };
                *(u32x2*)(op + d) = w;
            }
    }
    __builtin_amdgcn_s_setprio(0);
}
#if SELFTEST
constexpr size_t WS_FLAGS = WS_CNT + 1024;
__device__ __forceinline__ bool st_close(float got, float ref, float rtol = 0.03f, float atol = 0.03f) { return fabsf(got - ref) <= rtol * fabsf(ref) + atol && got == got; }
__device__ __forceinline__ void st_fail(const Args& a, unsigned bit) { atomicOr((unsigned*)(a.ws + WS_FLAGS), bit); }
__device__ __forceinline__ float st_h(const Args& a, int row, int k) { const bf16_t* H = (const bf16_t*)(a.ws + WS_H); return __uint_as_float((unsigned)H[(size_t)row * D + k] << 16); }
__device__ __forceinline__ float st_mix(const Args& a, int row, int k, const float* mu) {
    const int within = row % RPB;
    const float h = st_h(a, row, k);
    const float hp = (within == 0 || within == CTX) ? 0.f : st_h(a, row - 1, k);
    const float hn = (within == CTX - 1 || within == RPB - 1) ? 0.f : st_h(a, row + 1, k);
    return h + (0.5f * (hp + hn) - h) * mu[k];
}
__constant__ int st_rows[8] = { 0, 255, 256, 257, 16639, 16640, 20000, 33279 };
__constant__ int st_toks[6] = { 0, 300, 9000, 16640, 20000, 33279 };
__device__ __forceinline__ void selftest_rwkv_proj(const Args& a, int j) {
    const int tid = otid(), bid = blockIdx.x;
    if (bid >= 8) return;
    const int row = st_rows[bid];
    const float* mu = a.in[I_RMU] + (size_t)j * 6 * D;
    for (int it = tid; it < 3 * 64; it += NT) {
        const int g = it / 64, col = (it % 64) * 16 + 3 + g;
        const int mi = g == 0 ? 0 : (g == 1 ? 2 : 3);
        const float* W = a.in[I_RWRKV] + (size_t)(j * 3 + g) * D * D;
        float s = 0.f;
        for (int k = 0; k < D; ++k) s += st_mix(a, row, k, mu + mi * D) * W[(size_t)k * D + col];
        const float* out = (const float*)(a.ws + (g == 0 ? RW_R : (g == 1 ? RW_K : (j == 0 ? WS_VFIRST : RW_V))));
        float got = out[(size_t)row * D + col];
        if (g == 2 && j == 1) continue;
        if (!st_close(got, s)) st_fail(a, 1u);
    }
    if (j == 1 && tid >= 32 && tid < 40) {
        const int col = (tid - 32) * 128 + 9;
        const float* W = a.in[I_RWRKV] + (size_t)(j * 3 + 2) * D * D;
        float v = 0.f;
        for (int k = 0; k < D; ++k) v += st_mix(a, row, k, mu + 3 * D) * W[(size_t)k * D + col];
        float acc = 0.f;
        for (int q = 0; q < 32; ++q) { float hsum = 0.f; for (int k = 0; k < D; ++k) hsum += st_mix(a, row, k, mu + 3 * D) * a.in[I_RV1][(size_t)k * 32 + q]; acc += hsum * a.in[I_RV2][(size_t)q * D + col]; }
        const float gate = 1.f / (1.f + expf(-(a.in[I_RV0][col] + acc)));
        const float vf = ((const float*)(a.ws + WS_VFIRST))[(size_t)row * D + col];
        const float ref = v + (vf - v) * gate;
        const float got = ((const float*)(a.ws + RW_V))[(size_t)row * D + col];
        if (!st_close(got, ref)) st_fail(a, 1u);
    }
    if (tid < 24) {
        const int kind = tid / 8, col = (tid % 8) * 128 + 5 + kind;
        float got, ref;
        if (kind == 0) {
            const float* w1 = a.in[I_RW1] + (size_t)(j * 2 + 1) * D * 64; const float* w2 = a.in[I_RW2] + (size_t)(j * 2 + 1) * 64 * D;
            float acc = 0.f;
            for (int q = 0; q < 64; ++q) { float hsum = 0.f; for (int k = 0; k < D; ++k) hsum += st_mix(a, row, k, mu + 1 * D) * w1[(size_t)k * 64 + q]; acc += tanhf(hsum) * w2[(size_t)q * D + col]; }
            const float z = -(a.in[I_RW0][(j * 2 + 1) * D + col] + acc);
            const float sp = z > 20.f ? z : log1pf(expf(z));
            ref = expf(-expf(-sp - 0.5f));
            got = ((const float*)(a.ws + RW_WD1))[(size_t)row * D + col];
            if (!st_close(got, ref, 0.005f, 0.002f)) st_fail(a, 1u);
        } else if (kind == 1) {
            const float* a1 = a.in[I_RA1] + (size_t)(j * 2 + 0) * D * 64; const float* a2 = a.in[I_RA2] + (size_t)(j * 2 + 0) * 64 * D;
            float acc = 0.f;
            for (int q = 0; q < 64; ++q) { float hsum = 0.f; for (int k = 0; k < D; ++k) hsum += st_mix(a, row, k, mu + 4 * D) * a1[(size_t)k * 64 + q]; acc += hsum * a2[(size_t)q * D + col]; }
            ref = 1.f / (1.f + expf(-(a.in[I_RA0][(j * 2 + 0) * D + col] + acc)));
            got = ((const float*)(a.ws + RW_AD0))[(size_t)row * D + col];
            if (!st_close(got, ref, 0.02f, 0.01f)) st_fail(a, 1u);
        } else {
            const float* g1 = a.in[I_RG1] + (size_t)j * D * 160; const float* g2 = a.in[I_RG2] + (size_t)j * 160 * D;
            float acc = 0.f;
            for (int q = 0; q < 160; ++q) { float hsum = 0.f; for (int k = 0; k < D; ++k) hsum += st_mix(a, row, k, mu + 5 * D) * g1[(size_t)k * 160 + q]; acc += (1.f / (1.f + expf(-hsum))) * g2[(size_t)q * D + col]; }
            ref = acc; got = ((const float*)(a.ws + RW_G))[(size_t)row * D + col];
            if (!st_close(got, ref)) st_fail(a, 1u);
        }
    }
}
__device__ __forceinline__ void selftest_wkv(const Args& a, unsigned char* lds, int j) {
    const int tid = otid(), bid = blockIdx.x;
    if (bid >= 2 || tid >= 64) return;
    const int b = bid, h = bid ? 5 : 0, d = bid, vrow = tid;
    const float* R = (const float*)(a.ws + RW_R); const float* K = (const float*)(a.ws + RW_K);
    const float* V = (const float*)(a.ws + (j == 0 ? WS_VFIRST : RW_V));
    const float* WD = (const float*)(a.ws + (d == 0 ? RW_WD0 : RW_WD1)); const float* AD = (const float*)(a.ws + (d == 0 ? RW_AD0 : RW_AD1));
    const float* Y = (const float*)(a.ws + (d == 0 ? RW_Y0 : RW_Y1));
    float* S = (float*)(lds + LDS_USER) + tid;
    for (int k = 0; k < 64; ++k) S[k * 64] = 0.f;
    bool bad = false;
    for (int t = 0; t < 330; ++t) {
        const int p = (d == 0) ? t : ((t < CTX) ? (CTX - 1 - t) : (RPB + CTX - 1 - t));
        const size_t o = ((size_t)b * RPB + p) * D + h * 64;
        float n2 = 0.f;
        for (int k = 0; k < 64; ++k) { const float x = K[o + k] * a.in[I_RKK][j * D + h * 64 + k]; n2 += x * x; }
        const float inv = 1.f / fmaxf(sqrtf(n2), 1e-12f);
        float sa = 0.f;
        for (int k = 0; k < 64; ++k) sa += S[k * 64] * (-(K[o + k] * a.in[I_RKK][j * D + h * 64 + k] * inv));
        const float vv = V[o + vrow];
        float y = 0.f;
        for (int k = 0; k < 64; ++k) {
            const float kr = K[o + k], av = AD[o + k], kk = kr * a.in[I_RKK][j * D + h * 64 + k] * inv;
            const float sn = S[k * 64] * WD[o + k] + sa * (kk * av) + vv * (kr * (1.f + (av - 1.f) * a.in[I_RKA][j * D + h * 64 + k]));
            S[k * 64] = sn;
            y += sn * R[o + k];
        }
        if (!st_close(Y[o + vrow], y, 0.01f, 0.01f)) bad = true;
    }
    if (bad) st_fail(a, 2u);
}
__device__ __forceinline__ void selftest_moe(const Args& a, unsigned char* lds, int layer) {
    const int tid = otid(), bid = blockIdx.x;
    if (bid >= 6) return;
    const int row = st_toks[bid], midx = mod_index(row);
    float* h2 = (float*)(lds + LDS_USER);
    float* act = h2 + 1024;
    float* red = act + 1024;
    float* outv = red + 512;
    float* lg = outv + 1024;
    const float* X = (const float*)(a.ws + WS_X) + (size_t)row * D;
    const float* mod = (const float*)(a.ws + WS_MOD) + ((size_t)layer * 3 + midx) * 6144;
    float ss = 0.f;
    for (int k = tid; k < D; k += NT) ss += X[k] * X[k];
    red[tid] = ss; __syncthreads();
    if (tid == 0) { float s = 0.f; for (int i = 0; i < NT; ++i) s += red[i]; red[0] = rsqrtf(s / 1024.f + 1e-6f); }
    __syncthreads();
    const float rstd = red[0];
    __syncthreads();
    for (int k = tid; k < D; k += NT) h2[k] = X[k] * rstd * a.in[I_NFFN][layer * D + k] * (1.f + mod[4 * 1024 + k]) + mod[3 * 1024 + k];
    for (int k = tid; k < D; k += NT) outv[k] = 0.f;
    __syncthreads();
    if (tid < 32) { float s = a.in[I_ERB][layer * 32 + tid]; for (int k = 0; k < D; ++k) s += h2[k] * a.in[I_ERW][(size_t)layer * 32768 + k * 32 + tid]; lg[tid] = s; }
    __syncthreads();
    int te[4]; float tvv[4];
    if (tid == 0) {
        for (int r = 0; r < 4; ++r) { int bi = 0; float bv = -INFINITY; for (int e = 0; e < 32; ++e) if (lg[e] > bv) { bv = lg[e]; bi = e; } lg[32 + r] = bv; ((int*)lg)[36 + r] = bi; lg[bi] = -INFINITY; }
    }
    __syncthreads();
#pragma unroll
    for (int r = 0; r < 4; ++r) { tvv[r] = lg[32 + r]; te[r] = ((int*)lg)[36 + r]; }
    float gs = 0.f; float gt[4];
#pragma unroll
    for (int r = 0; r < 4; ++r) { gt[r] = expf(tvv[r] - tvv[0]); gs += gt[r]; }
#pragma unroll
    for (int r = 0; r < 4; ++r) gt[r] /= gs;
    if (tid == 0) {
        const int* ae = (const int*)(a.ws + WS_ASGE) + (size_t)row * 4; const float* ag = (const float*)(a.ws + WS_ASGG) + (size_t)row * 4;
#pragma unroll
        for (int r = 0; r < 4; ++r) { if ((ae[r] >> 24) != te[r]) st_fail(a, 4u); if (!st_close(ag[r], gt[r], 0.02f, 0.005f)) st_fail(a, 4u); }
    }
#pragma unroll 1
    for (int rr = 0; rr < 4; ++rr) {
        const int e = rr == 0 ? te[0] : (rr == 1 ? te[1] : (rr == 2 ? te[2] : te[3])); const float gtr = rr == 0 ? gt[0] : (rr == 1 ? gt[1] : (rr == 2 ? gt[2] : gt[3]));
        const float* win = a.in[I_EWIN] + ((size_t)layer * 32 + e) * 1024 * 2048; const float* bin = a.in[I_EBIN] + ((size_t)layer * 32 + e) * 2048;
        const float* wout = a.in[I_EWOUT] + ((size_t)layer * 32 + e) * 1024 * 1024; const float* bout = a.in[I_EBOUT] + ((size_t)layer * 32 + e) * 1024;
        for (int c = tid; c < 1024; c += NT) {
            float g = bin[c], l = bin[1024 + c];
            for (int k = 0; k < D; ++k) { g += h2[k] * win[(size_t)k * 2048 + c]; l += h2[k] * win[(size_t)k * 2048 + 1024 + c]; }
            g = fminf(g, 7.f); l = fminf(fmaxf(l, -7.f), 7.f);
            act[c] = g * (1.f / (1.f + expf(-1.702f * g))) * (l + 1.f);
        }
        __syncthreads();
        for (int c = tid; c < 1024; c += NT) { float s = bout[c]; for (int k = 0; k < 1024; ++k) s += act[k] * wout[(size_t)k * 1024 + c]; outv[c] += gtr * s; }
        __syncthreads();
    }
    {
        const int* cnt = (const int*)(a.ws + WS_CNT2) + layer * 32 * CSTR;
        const int* ae = (const int*)(a.ws + WS_ASGE) + (size_t)row * 4; const float* ag = (const float*)(a.ws + WS_ASGG) + (size_t)row * 4;
        for (int c = tid; c < 1024; c += NT) {
            float s = 0.f;
            for (int r = 0; r < 4; ++r) {
                const int e = ae[r] >> 24, slot = ae[r] & 0xffffff; int ps = 0; for (int q = 0; q < e; ++q) ps += ((cnt[q * CSTR] + 255) >> 8) << 8;
                s += ag[r] * __uint_as_float((unsigned)((const bf16_t*)(a.ws + WS_YB))[((size_t)ps + slot) * D + c] << 16);
            }
            if (!st_close(s, outv[c], 0.03f, 0.03f)) st_fail(a, 4u);
        }
    }
    __syncthreads();
}

#if HAVE_HYENA
__device__ __forceinline__ void selftest_hy_filters(const Args& a, unsigned char* lds) {
    const int tid = otid();
    if (blockIdx.x != 0 || tid >= 32) return;
    const int isctx = tid >> 4, q = tid & 15, ni = q >> 2, ci = q & 3;
    const int Lh = isctx ? CTX : SEQ;
    const int n = ni == 0 ? 0 : (ni == 1 ? 1 : (ni == 2 ? (isctx ? 100 : 7777) : Lh - 1));
    const int c = ci == 0 ? 0 : (ci == 1 ? 513 : (ci == 2 ? 1023 : 1024 + 300));
    float* h1 = (float*)(lds + LDS_USER) + tid * 200; float* h2 = h1 + 64; float* zz = h2 + 64;
    zz[0] = (float)n / (float)(Lh - 1);
    for (int i = 0; i < 16; ++i) { const float f = 1e-4f + (float)i * ((15.0f - 1e-4f) / 15.0f); const float ang = 2.0f * 3.14159265358979323846f * f * (float)n / (float)Lh; zz[1 + i] = cos_acc(ang); zz[17 + i] = -sin_acc(ang); }
    for (int h = 0; h < 64; ++h) { float s = a.in[I_HFB1][h]; for (int k = 0; k < 33; ++k) s += zz[k] * a.in[I_HFW1][k * 64 + h]; h1[h] = sin_acc(a.in[I_HFREQ][h] * s); }
    for (int h = 0; h < 64; ++h) { float s = a.in[I_HFB2][h]; for (int k = 0; k < 64; ++k) s += h1[k] * a.in[I_HFW2][k * 64 + h]; h2[h] = sin_acc(a.in[I_HFREQ][64 + h] * s); }
    for (int h = 0; h < 64; ++h) { float s = a.in[I_HFB3][h]; for (int k = 0; k < 64; ++k) s += h2[k] * a.in[I_HFW3][k * 64 + h]; h1[h] = sin_acc(a.in[I_HFREQ][128 + h] * s); }
    float s = 0.f; for (int k = 0; k < 64; ++k) s += h1[k] * a.in[I_HFWOUT][(size_t)k * 2048 + c];
    const int ch = c & 1023;
    const float dl = fabsf(-15.350567286626973f + (float)ch * ((-3.0701134573253946f + 15.350567286626973f) / 1023.0f));
    const float ref = s * expf(-zz[0] * dl);
    float got;
    if (isctx) got = ((const float*)(a.ws + (c < 1024 ? HY_HFC : HY_HBC)))[(size_t)n * D + ch];
    else got = ((const float*)(a.ws + (c < 1024 ? HY_HF : HY_HB)))[(size_t)ch * SEQ + n];
    if (!st_close(got, ref, 0.01f, 2e-4f)) st_fail(a, 16u);
}
__device__ __forceinline__ float st_uu(const Args& a, int b, bool isctx, int t, int col) {
    const int Lh = isctx ? CTX : SEQ;
    if (t < 0 || t >= Lh) return 0.f;
    const size_t row = (size_t)b * RPB + (isctx ? 0 : CTX) + t;
    return __uint_as_float((unsigned)((const bf16_t*)(a.ws + HY_UU))[row * 3072 + col] << 16);
}
__device__ __forceinline__ float st_dw(const Args& a, int b, bool isctx, int t, int col) {
    const float* sw = a.in[I_HSW];
    return st_uu(a, b, isctx, t - 1, col) * sw[col] + st_uu(a, b, isctx, t, col) * sw[3072 + col] + st_uu(a, b, isctx, t + 1, col) * sw[2 * 3072 + col] + a.in[I_HSB][col];
}
__device__ __forceinline__ void selftest_hy_p(const Args& a) {
    const int tid = otid(), lane = tid & 63, wid = tid >> 6;
    if (blockIdx.x >= 2) return;
    const int sidx = blockIdx.x * 8 + wid;
    const bool isctx = sidx >= 10;
    const int b = sidx & 1, Lh = isctx ? CTX : SEQ;
    const int tsel = (sidx >> 1) % 5;
    const int t = tsel == 0 ? 0 : (tsel == 1 ? 3 : (tsel == 2 ? Lh / 2 + 1 : (tsel == 3 ? Lh - 2 : Lh - 1)));
    const int c = (sidx * 197 + 11) & 1023;
    float acc = 0.f;
    for (int s = lane; s < Lh; s += 64) {
        const float z = st_dw(a, b, isctx, s, 2048 + c) * st_dw(a, b, isctx, s, 1024 + c);
        float tap;
        if (isctx) tap = (s <= t) ? ((const float*)(a.ws + HY_HFC))[(size_t)(t - s) * D + c] : ((const float*)(a.ws + HY_HBC))[(size_t)(s - t) * D + c];
        else tap = (s <= t) ? ((const float*)(a.ws + HY_HF))[(size_t)c * SEQ + (t - s)] : ((const float*)(a.ws + HY_HB))[(size_t)c * SEQ + (s - t)];
        acc += tap * z;
    }
    acc = wave_sum(acc);
    const float zt = st_dw(a, b, isctx, t, 2048 + c) * st_dw(a, b, isctx, t, 1024 + c), x0 = st_dw(a, b, isctx, t, c);
    const float ref = x0 * (acc + zt * a.in[I_HBIAS][c]);
    const size_t row = (size_t)b * RPB + (isctx ? 0 : CTX) + t;
    const float got = __uint_as_float((unsigned)((const bf16_t*)(a.ws + HY_P))[row * D + c] << 16);
    if (lane == 0 && !st_close(got, ref, 0.03f, 0.02f)) st_fail(a, 16u);
}
#endif

#if HAVE_MLA
__device__ __forceinline__ void st_mla_vec(const Args& a, int row, int h, bool isq, float* o  ) {
    const int b = row / RPB, within = row - b * RPB; const bool lat = within >= CTX; const int tpos = within - CTX;
    float ss = 0.f;
    for (int i = 0; i < 192; ++i) {
        float v;
        if (isq) v = ((const float*)(a.ws + ML_QF))[(size_t)row * 1536 + h * 192 + i];
        else v = i < 128 ? ((const float*)(a.ws + ML_KVF))[(size_t)row * 2048 + h * 256 + i] : ((const float*)(a.ws + ML_QKVA))[(size_t)row * 768 + 640 + (i - 128)];
        o[i] = v; ss += v * v;
    }
    const float rs = rsqrtf(ss / 192.f + 1e-6f);
    const float* gn = a.in[isq ? I_MQN : I_MKN];
    for (int i = 0; i < 192; ++i) o[i] = o[i] * rs * gn[i];
    if (lat) {
        for (int part = 0; part < 2; ++part) {
            const int pos = part == 0 ? (tpos >> 6) : (tpos & 63);
            for (int i = 0; i < 16; ++i) {
                const float inv = exp2f(-(float)i * (13.287712379549449f / 16.f)), ang = (float)pos * inv, c = cos_acc(ang), s = sin_acc(ang);
                const float x1 = o[128 + part * 32 + i], x2 = o[128 + part * 32 + 16 + i];
                o[128 + part * 32 + i] = x1 * c - x2 * s; o[128 + part * 32 + 16 + i] = x1 * s + x2 * c;
            }
        }
    }
}
__device__ __forceinline__ float st_mla_kraw(const Args& a, int row, int h, int i) {
    return i < 128 ? ((const float*)(a.ws + ML_KVF))[(size_t)row * 2048 + h * 256 + i] : ((const float*)(a.ws + ML_QKVA))[(size_t)row * 768 + 640 + (i - 128)];
}
__device__ __forceinline__ float st_mla_qk(const Args& a, const float* qv, int row, int h) {
    const int b = row / RPB, within = row - b * RPB; const bool lat = within >= CTX; const int tpos = within - CTX;
    float ss = 0.f;
#pragma unroll 1
    for (int i = 0; i < 192; ++i) { const float v = st_mla_kraw(a, row, h, i); ss += v * v; }
    const float rs = rsqrtf(ss / 192.f + 1e-6f);
    const float* gn = a.in[I_MKN];
    float dot = 0.f;
#pragma unroll 1
    for (int i = 0; i < 128; ++i) dot += qv[i] * st_mla_kraw(a, row, h, i) * rs * gn[i];
#pragma unroll 1
    for (int part = 0; part < 2; ++part) {
        const int pos = part == 0 ? (tpos >> 6) : (tpos & 63);
#pragma unroll 1
        for (int i = 0; i < 16; ++i) {
            const int i1 = 128 + part * 32 + i, i2 = i1 + 16;
            const float x1 = st_mla_kraw(a, row, h, i1) * rs * gn[i1], x2 = st_mla_kraw(a, row, h, i2) * rs * gn[i2];
            float c = 1.f, s = 0.f;
            if (lat) { const float inv = exp2f(-(float)i * (13.287712379549449f / 16.f)), ang = (float)pos * inv; c = cos_acc(ang); s = sin_acc(ang); }
            dot += qv[i1] * (x1 * c - x2 * s) + qv[i2] * (x1 * s + x2 * c);
        }
    }
    return dot;
}
__device__ __forceinline__ void selftest_mla(const Args& a, unsigned char* lds) {
    const int tid = otid(), lane = tid & 63, wid = tid >> 6;
    if (blockIdx.x != 0) return;
    float* qv = (float*)(lds + LDS_USER) + wid * 192;
    const int b = wid & 1;
    const int within = wid < 2 ? CTX : (wid < 4 ? RPB - 1 : (wid < 6 ? CTX + 5000 + wid : 100 + wid));
    const int h = (wid * 3) & 7, row = b * RPB + within;
    const bool qctx = within < CTX;
    if (lane == 0) st_mla_vec(a, row, h, true, qv);
    __syncthreads();
    const int nkeys = qctx ? CTX : RPB;
    float m = -INFINITY, l = 0.f, acc[8];
#pragma unroll
    for (int i = 0; i < 8; ++i) acc[i] = 0.f;
#pragma unroll 1
    for (int t = lane; t < nkeys; t += 64) {
        const int krow = b * RPB + t;
        const float s = st_mla_qk(a, qv, krow, h) * 0.07216878364870322f;
        const float mn = fmaxf(m, s), al = expf(m - mn), p = expf(s - mn);
        l = l * al + p;
#pragma unroll
        for (int i = 0; i < 8; ++i) acc[i] = acc[i] * al + p * ((const float*)(a.ws + ML_KVF))[(size_t)krow * 2048 + h * 256 + 128 + i * 16 + 3];
        m = mn;
    }
    float mg = m;
#pragma unroll
    for (int o = 32; o >= 1; o >>= 1) mg = fmaxf(mg, __shfl_xor(mg, o));
    const float sc = expf(m - mg);
    const float lt = wave_sum(l * sc);
    bool bad = false;
#pragma unroll
    for (int i = 0; i < 8; ++i) {
        const float ref = wave_sum(acc[i] * sc) / lt;
        const float got = __uint_as_float((unsigned)((const bf16_t*)(a.ws + ML_O))[(size_t)row * 1024 + h * 128 + i * 16 + 3] << 16);
        if (!st_close(got, ref, 0.03f, 0.01f)) bad = true;
    }
    if (bad && lane == 0) st_fail(a, 32u);
}
#endif
__device__ __forceinline__ void selftest_finish(const Args& a) {
    if (blockIdx.x == 0 && otid() == 0) {
        unsigned m = __hip_atomic_load((unsigned*)(a.ws + WS_FLAGS), __ATOMIC_RELAXED, __HIP_MEMORY_SCOPE_AGENT);
        if (__hip_atomic_load((unsigned*)(a.ws + WS_BAR) + XB_TMO, __ATOMIC_RELAXED, __HIP_MEMORY_SCOPE_AGENT)) m |= 8u;
        if (m) a.out[0] = 1e4f * exp2f((float)m);
    }
}
#endif
#if HAVE_HYENA
__device__ __forceinline__ void hyena_layer(const Args& a, unsigned char* lds, int layer, const XcdBarrier& bar) {
    for (int r = 0; r < REP_EW * REPI(1); ++r) { phase_hy_filters(a, lds); xcd_barrier(bar); }
#if SELFTEST
    selftest_hy_filters(a, lds); __syncthreads();
#endif
    for (int r = 0; r < REP_FFT * REPI(7); ++r) { phase_hy_filter_fft(a, lds); xcd_barrier(bar); }
    for (int r = 0; r < REP_PROJ * REPI(11); ++r) { phase_hy_in(a, lds); xcd_barrier(bar); }
    for (int r = 0; r < REP_EW * REPI(2); ++r) { phase_hy_short(a, lds); xcd_barrier(bar); }
    for (int r = 0; r < REP_FFT * REPI(8); ++r) { phase_hy_fftconv(a, lds); xcd_barrier(bar); }
    for (int r = 0; r < REP_EW * REPI(3); ++r) { phase_hy_combine(a, lds); xcd_barrier(bar); }
#if SELFTEST
    selftest_hy_p(a);
#endif
    phase_outproj(a, lds, layer, (const bf16_t*)(a.ws + HY_P), (const bf16_t*)(a.ws + WS_HYOUTT), a.in[I_HBOUT]); xcd_barrier(bar);
}
#endif
#if HAVE_MLA
__device__ __forceinline__ void mla_layer(const Args& a, unsigned char* lds, int layer, const XcdBarrier& bar) {
    for (int r = 0; r < REP_PROJ * REPI(9); ++r) { phase_mla_a(a, lds); xcd_barrier(bar); }
    for (int r = 0; r < REP_EW * REPI(4); ++r) { phase_mla_norm(a); xcd_barrier(bar); }
    for (int r = 0; r < REP_PROJ * REPI(10); ++r) { phase_mla_b(a, lds); xcd_barrier(bar); }
    for (int r = 0; r < REP_EW * REPI(5); ++r) { phase_mla_rope(a, lds); xcd_barrier(bar); }
    for (int r = 0; r < REP_ATT; ++r) { phase_mla_attn(a, lds); xcd_barrier(bar); }
#if SELFTEST
    selftest_mla(a, lds); __syncthreads();
#endif
    phase_outproj(a, lds, layer, (const bf16_t*)(a.ws + ML_O), (const bf16_t*)(a.ws + WS_MWOT), nullptr); xcd_barrier(bar);
}
#endif
constexpr size_t WS_END0 = RW_END > HY_END ? RW_END : HY_END;
constexpr size_t WS_END = WS_END0 > ML_END ? WS_END0 : ML_END;
static_assert(WS_END <= WS_SHADOW_ABS, "shadow tables overlap the workspace");
#ifndef NLAYERS
#define NLAYERS 4
#endif
template <int J> __device__ __forceinline__ void rwkv_layer(const Args& a, unsigned char* lds, int l, const XcdBarrier& bar) {
    for (int r = 0; r < REP_MIX; ++r) { phase_rwkv_mix(a, J); xcd_barrier(bar); }
    for (int r = 0; r < REP_PROJ * REPI(12); ++r) { phase_rwkv_proj1(a, lds, J); xcd_barrier(bar); }
    for (int r = 0; r < (J == 0 ? REP_P2 : 1); ++r) { phase_rwkv_proj2(a, lds, J); xcd_barrier(bar); }
#if SELFTEST
    selftest_rwkv_proj(a, J);
#endif
    for (int r = 0; r < REP_WKV; ++r) phase_wkv_pipe(a, lds, J, bar);
#if SELFTEST
    selftest_wkv(a, lds, J); __syncthreads();
#endif
    for (int r = 0; r < REP_EW * REPI(6); ++r) { phase_rwkv_readout(a, J);    xcd_barrier(bar); }
    phase_outproj(a, lds, l, (const bf16_t*)(a.ws + RW_Z), (const bf16_t*)(a.ws + WS_RWOT) + (size_t)J * D * D, nullptr);
    xcd_barrier(bar);
}
template <int L> __device__ __forceinline__ void ffn_layer(const Args& a, unsigned char* lds, const XcdBarrier& bar) {
    for (int r = 1; r < REP_RT; ++r) { phase_norm_router(a, lds, L, 1); xcd_barrier(bar); }
    phase_norm_router(a, lds, L); xcd_barrier(bar);
    for (int r = 0; r < REP_MOE * REPI(21); ++r) { phase_moe1(a, lds, L); xcd_barrier(bar); }
    for (int r = 0; r < REP_MOE * REPI(22); ++r) { phase_moe2(a, lds, L); xcd_barrier(bar); }
#if SELFTEST
    selftest_moe(a, lds, L); xcd_barrier(bar);
#endif
}
__global__ void __launch_bounds__(NT, 2) mega(Args a) {
    extern __shared__ __attribute__((aligned(16))) unsigned char lds[];
    if (threadIdx.x < 16) ((volatile LAS unsigned*)lds)[threadIdx.x] = 0u;
    __syncthreads();
    XcdBarrier bar = xcd_barrier_post((unsigned*)(a.ws + WS_BAR), (volatile LAS unsigned*)lds);
#if TIMING
    if (blockIdx.x == 0 && threadIdx.x == 0) ((unsigned long long*)(a.ws + WS_CNT + 2048))[0] = wall_clock64();
#endif
    for (int r = 0; r < REP_PRO; ++r) { phase_prologue(a, lds);
    xcd_barrier(bar); }
    for (int r = 0; r < REP_N0; ++r) { phase_norm<true, false, false, false>(a, lds, 0); xcd_barrier(bar); }
    rwkv_layer<0>(a, lds, 0, bar);
    ffn_layer<0>(a, lds, bar);
#if NLAYERS > 1
    for (int r = 1; r < REP_NC; ++r) { phase_norm<false, true, false, false>(a, lds, 1, 1); xcd_barrier(bar); }
    phase_norm<false, true, false, false>(a, lds, 1); xcd_barrier(bar);
    hyena_layer(a, lds, 1, bar);
    ffn_layer<1>(a, lds, bar);
#endif
#if NLAYERS > 2
    for (int r = 1; r < REP_NC; ++r) { phase_norm<false, true, false, false>(a, lds, 2, 1); xcd_barrier(bar); }
    phase_norm<false, true, false, false>(a, lds, 2); xcd_barrier(bar);
    mla_layer(a, lds, 2, bar);
    ffn_layer<2>(a, lds, bar);
#endif
#if NLAYERS > 3
    for (int r = 1; r < REP_NC; ++r) { phase_norm<false, true, false, false>(a, lds, 3, 1); xcd_barrier(bar); }
    phase_norm<false, true, false, false>(a, lds, 3); xcd_barrier(bar);
    rwkv_layer<1>(a, lds, 3, bar);
    ffn_layer<3>(a, lds, bar);
#endif
    for (int r = 0; r < REP_BAR; ++r) xcd_barrier(bar);
    phase_norm<false, true, false, true>(a, lds, NLAYERS);
#if SELFTEST
    xcd_barrier(bar); selftest_finish(a);
#endif
#if TIMING
    xcd_barrier(bar);
    {
        const unsigned long long* ts = (const unsigned long long*)(a.ws + WS_CNT + 2048);
        const float t1 = (float)(ts[TS_A] - ts[0]) * 0.01f, t2 = (float)(ts[TS_B] - ts[0]) * 0.01f;
        if (blockIdx.x == 0 && threadIdx.x == 0) a.out[0] = 1e4f * t1;
        for (int i = blockIdx.x * NT + threadIdx.x; i < (1 << 20); i += gridDim.x * NT) a.out[1024 + i] = 1e2f * t2;
    }
#endif
}

extern "C" void kernel_launch(void* const* d_in, const int* in_sizes, int n_in, void* d_out, int out_size, void* d_ws, size_t ws_size, hipStream_t stream) {
    static int grid = 0;
    if (grid == 0) {
        int dev = 0, cus = 0, per_cu = 0;
        if (hipGetDevice(&dev) != hipSuccess || hipDeviceGetAttribute(&cus, hipDeviceAttributeMultiprocessorCount, dev) != hipSuccess) { grid = -1; return; }
        if (hipFuncSetAttribute((const void*)mega, hipFuncAttributeMaxDynamicSharedMemorySize, LDS_BYTES) != hipSuccess) { grid = -1; return; }
        if (hipOccupancyMaxActiveBlocksPerMultiprocessor(&per_cu, (const void*)mega, NT, LDS_BYTES) != hipSuccess || per_cu < 1) fprintf(stderr, "occupancy query: %d\n", per_cu);
        (void)hipGetLastError();
        if (n_in != N_IN || ws_size < WS_END) { fprintf(stderr, "kernel_launch: n_in %d ws %zu (need %zu)\n", n_in, ws_size, (size_t)WS_END); grid = -1; return; }
        grid = cus;
        if ((T + grid * 8 - 1) / (grid * 8) > rt::RCAP / 8) { fprintf(stderr, "kernel_launch: %d workgroups are too few\n", grid); grid = -1; return; }
    }
    if (grid < 0) return;
    (void)hipMemsetAsync(d_ws, 0, WS_ZERO_BYTES, stream);
    Args a{};
    for (int i = 0; i < N_IN; ++i) a.in[i] = (const float*)d_in[i];
    a.out = (float*)d_out; a.ws = (unsigned char*)d_ws;
    hipLaunchKernelGGL(mega, dim3(grid), dim3(NT), LDS_BYTES, stream, a);
}
```

```cpp
#ifndef HAVE_HYENA
#define HAVE_HYENA 1
#endif
#ifndef HAVE_MLA
#define HAVE_MLA 1
#endif
#ifndef REP_MOE
#define REP_MOE 1
#endif
#ifndef REP_WKV
#define REP_WKV 1
#endif
#ifndef REP_PROJ
#define REP_PROJ 1
#endif
#ifndef REP_PRO
#define REP_PRO 1
#endif
#ifndef REP_ATT
#define REP_ATT 1
#endif
#ifndef REP_FFT
#define REP_FFT 1
#endif
#ifndef REP_EW
#define REP_EW 1
#endif
#ifndef WKV_PHASE
#define WKV_PHASE phase_wkv2
#endif
#ifndef REP_WKVP
#define REP_WKVP 1
#endif
#ifndef REP_WKVS
#define REP_WKVS 1
#endif
#ifndef REP_N0
#define REP_N0 1
#endif
#ifndef REP_MIX
#define REP_MIX 1
#endif
#ifndef REP_P2
#define REP_P2 1
#endif
#ifndef REP_BAR
#define REP_BAR 0
#endif
#ifndef REP_RT
#define REP_RT 1
#endif
#ifndef SHADOW_NOATOM
#define SHADOW_NOATOM 0
#endif
#ifndef REP_NC
#define REP_NC 1
#endif
#ifndef REP_ID
#define REP_ID 0
#endif
#define REPI(id) ((id) == REP_ID ? 2 : 1)
#ifndef WKV_SERIAL
#define WKV_SERIAL 0
#endif
#ifndef MOE1_MAP
#define MOE1_MAP 3
#endif
#ifndef WKNSEG
#define WKNSEG 8
#endif
#include <hip/hip_runtime.h>
#include <cstdio>
#include <cstdint>

#define XB_TMO      128
#define XB_XCNT(j)  (256  + 64 * (j))
#define XB_XSUB(j)  (1280 + 64 * (j))
#define XB_XGEN(j)  (2304 + 64 * (j))
#define XB_TOP      3328
#define XB_TOPGEN   3392
#define XCD_BAR_WORDS 3456
#define XB_SPIN_CAP (1u << 22)
#define LAS __attribute__((address_space(3)))

__device__ __forceinline__ unsigned xb_ld(unsigned* p)              { return __hip_atomic_load(p, __ATOMIC_RELAXED, __HIP_MEMORY_SCOPE_AGENT); }
__device__ __forceinline__ unsigned xb_add(unsigned* p, unsigned v) { return __hip_atomic_fetch_add(p, v, __ATOMIC_RELAXED, __HIP_MEMORY_SCOPE_AGENT); }
__device__ __forceinline__ unsigned xb_xcc_id() { return (unsigned)__builtin_amdgcn_s_getreg((3 << 11) | 20) & 0xFu; }
#define XB_SPIN(cond, bar) do { unsigned _sp = 0; while (cond) { __builtin_amdgcn_s_sleep(1); \
    if ((++_sp & 255u) == 0u) { if (xb_ld(&(bar)[XB_TMO])) break; if (_sp > XB_SPIN_CAP) { atomicAdd(&(bar)[XB_TMO], 1u); break; } } } } while (0)

struct XcdBarrier { unsigned* bar; unsigned x; volatile LAS unsigned* st; };

__device__ __forceinline__ XcdBarrier xcd_barrier_post(unsigned* bar, volatile LAS unsigned* st) {
    XcdBarrier b; b.bar = bar; b.x = xb_xcc_id(); b.st = st;
    if (threadIdx.x == 0) (void)xb_add(&bar[XB_XCNT(b.x)], 1u);
    return b;
}
__device__ __forceinline__ void xcd_barrier_complete(unsigned* bar, unsigned x, unsigned& nloc, unsigned& nx) {
    const unsigned G = gridDim.x * gridDim.y * gridDim.z;
    unsigned sum, cnt, mine, sp = 0u;
    for (;;) {
        sum = 0u; cnt = 0u; mine = 0u;
#pragma unroll
        for (unsigned j = 0; j < 16; ++j) { const unsigned c = xb_ld(&bar[XB_XCNT(j)]); sum += c; cnt += (c > 0u) ? 1u : 0u; mine = (j == x) ? c : mine; }
        if (sum == G) break;
        __builtin_amdgcn_s_sleep(1);
        if ((++sp & 255u) == 0u) { if (xb_ld(&bar[XB_TMO])) break; if (sp > XB_SPIN_CAP) { atomicAdd(&bar[XB_TMO], 1u); break; } }
    }
    nloc = mine > 0u ? mine : 1u; nx = cnt > 0u ? cnt : 1u;
}
__device__ __forceinline__ void xcd_barrier(const XcdBarrier& b) {
    asm volatile("s_waitcnt vmcnt(0)" ::: "memory");
    __syncthreads();
    if (threadIdx.x == 0) {
        unsigned* bar = b.bar;
        __builtin_amdgcn_s_waitcnt(0);
        unsigned nloc = b.st[0], nx = b.st[1];
        if (nloc == 0u) { xcd_barrier_complete(bar, b.x, nloc, nx); b.st[0] = nloc; b.st[1] = nx; }
        const unsigned old = xb_add(&bar[XB_XSUB(b.x)], 1u);
        const unsigned gen = old / nloc;
        if (old + 1u == (gen + 1u) * nloc) {
            __builtin_amdgcn_fence(__ATOMIC_RELEASE, "agent");
            asm volatile("s_waitcnt vmcnt(0)" ::: "memory");
            const unsigned og = xb_add(&bar[XB_TOP], 1u);
            const unsigned tg = og / nx;
            if (og + 1u == (tg + 1u) * nx) xb_add(&bar[XB_TOPGEN], 1u);
            else XB_SPIN(xb_ld(&bar[XB_TOPGEN]) == tg, bar);
            __builtin_amdgcn_fence(__ATOMIC_ACQUIRE, "agent");
            xb_add(&bar[XB_XGEN(b.x)], 1u);
            asm volatile("s_waitcnt vmcnt(0)" ::: "memory");
        } else {
            XB_SPIN(xb_ld(&bar[XB_XGEN(b.x)]) == gen, bar);
            __builtin_amdgcn_fence(__ATOMIC_ACQUIRE, "agent");
            asm volatile("s_waitcnt vmcnt(0)" ::: "memory");
        }
#if TIMING
        if (blockIdx.x == 0) { const unsigned k = b.st[2] + 1u; b.st[2] = k; ((unsigned long long*)(b.bar + 4608))[k] = wall_clock64(); }
#endif
    }
    __syncthreads();
}

typedef unsigned short bf16_t;
typedef short bf16x8 __attribute__((ext_vector_type(8)));
typedef float f32x4 __attribute__((ext_vector_type(4)));
typedef float f32x16 __attribute__((ext_vector_type(16)));
typedef unsigned u32x4 __attribute__((ext_vector_type(4)));
typedef unsigned u32x2 __attribute__((ext_vector_type(2)));

constexpr int NT = 512;
constexpr int LDS_BYTES = 147456;
constexpr int LDS_CTL = 0;
constexpr int LDS_USER = 256;
constexpr int D = 1024, BATCH = 2, SEQ = 16384, CTX = 256, DEPTH = 4;
constexpr int RPB = CTX + SEQ;
constexpr int T = BATCH * RPB;
constexpr int NEXP = 32, TOPK = 4, DEXP = 1024;
constexpr int MAXROWS = T * TOPK + NEXP * 256;

enum { I_X = 0, I_C, I_CTX, I_CCTX, I_ADAW, I_ADAB, I_NMIX, I_NFFN,
       I_RMU, I_RWRKV, I_RW0, I_RW1, I_RW2, I_RA0, I_RA1, I_RA2, I_RG1, I_RG2, I_RKK, I_RKA, I_RRK, I_RLNG, I_RLNB, I_RWO, I_RV0, I_RV1, I_RV2,
       I_HWIN, I_HBIN, I_HSW, I_HSB, I_HFW1, I_HFB1, I_HFW2, I_HFB2, I_HFW3, I_HFB3, I_HFREQ, I_HFWOUT, I_HBIAS, I_HWOUT, I_HBOUT,
       I_MWA, I_MQNG, I_MKVNG, I_MWQB, I_MWKVB, I_MQN, I_MKN, I_MWO,
       I_ERW, I_ERB, I_EWIN, I_EBIN, I_EWOUT, I_EBOUT, N_IN };

struct Args { const float* in[56]; float* out; unsigned char* ws; };

constexpr size_t al256(size_t x) { return (x + 255) & ~(size_t)255; }
constexpr size_t WS_BAR    = 0;
constexpr size_t WS_CNT    = 16384;
constexpr size_t WS_ZERO_BYTES = 1u << 20;
constexpr size_t WS_CNT2   = 65536;
constexpr int    CSTR      = 1088;
constexpr size_t WS_SHADOW_ABS = 4170000000ull;
constexpr size_t WS_MOD    = 1u << 20;
constexpr size_t WS_TW1    = al256(WS_MOD + (size_t)4 * 3 * 6144 * 4);
constexpr size_t WS_TW2    = WS_TW1 + 16384 * 8;
constexpr size_t WS_RWT    = WS_TW2 + 16384 * 8;
constexpr size_t WS_HWOT   = WS_RWT + (size_t)4 * 32 * 1024 * 4;
constexpr size_t WS_X      = WS_HWOT + (size_t)2 * 2048 * 64 * 2;
constexpr size_t WS_H      = WS_X + (size_t)T * D * 4;
constexpr size_t WS_ASGE   = WS_H + (size_t)T * D * 2;
constexpr size_t WS_ASGG   = WS_ASGE + (size_t)T * 4 * 4;
constexpr size_t WS_TOKL   = WS_ASGG + (size_t)T * 4 * 4;
constexpr size_t WS_ACT    = WS_TOKL + (size_t)NEXP * T * 4;
constexpr size_t WS_YB     = WS_ACT + (size_t)MAXROWS * D * 2;
constexpr size_t WS_RKVT   = WS_YB + (size_t)MAXROWS * D * 2;
constexpr size_t WS_RWOT   = WS_RKVT + (size_t)6 * D * D * 2;
constexpr size_t WS_L1T    = WS_RWOT + (size_t)2 * D * D * 2;
constexpr size_t WS_W2T    = WS_L1T + (size_t)2 * 640 * D * 2;
constexpr size_t WS_A2T    = WS_W2T + (size_t)4 * D * 64 * 2;
constexpr size_t WS_G2T    = WS_A2T + (size_t)4 * D * 64 * 2;
constexpr size_t WS_V2T    = WS_G2T + (size_t)2 * D * 192 * 2;
constexpr size_t WS_HYINT  = WS_V2T + (size_t)D * 64 * 2;
constexpr size_t WS_HYOUTT = WS_HYINT + (size_t)3072 * D * 2;
constexpr size_t WS_MWAT   = WS_HYOUTT + (size_t)D * D * 2;
constexpr size_t WS_MWQBT  = WS_MWAT + (size_t)768 * D * 2;
constexpr size_t WS_MWKVBT = WS_MWQBT + (size_t)1536 * 384 * 2;
constexpr size_t WS_MWOT   = WS_MWKVBT + (size_t)2048 * 256 * 2;
constexpr size_t WS_EWINT  = WS_MWOT + (size_t)D * D * 2;
constexpr size_t WS_EWOUTT = WS_EWINT + (size_t)4 * 32 * 2048 * D * 2;
constexpr size_t WS_VFIRST = WS_EWOUTT + (size_t)4 * 32 * D * D * 2;
constexpr size_t WS_MIX    = WS_VFIRST + (size_t)T * D * 4;
constexpr size_t TD4 = (size_t)T * D * 4;
constexpr size_t RW_R   = WS_MIX;
constexpr size_t RW_K   = RW_R + TD4;
constexpr size_t RW_V   = RW_K + TD4;
constexpr size_t RW_G   = RW_V + TD4;
constexpr size_t RW_WD0 = RW_G + TD4;
constexpr size_t RW_WD1 = RW_WD0 + TD4;
constexpr size_t RW_AD0 = RW_WD1 + TD4;
constexpr size_t RW_AD1 = RW_AD0 + TD4;
constexpr size_t RW_Y0  = RW_AD1 + TD4;
constexpr size_t RW_Y1  = RW_Y0 + TD4;
constexpr size_t RW_HL  = RW_Y1 + TD4;
constexpr size_t RW_Z   = RW_HL + (size_t)T * 640 * 2;
constexpr size_t RW_XR  = RW_Z + (size_t)T * D * 2;
constexpr size_t RW_XK  = RW_XR + (size_t)T * D * 2;
constexpr size_t RW_XV  = RW_XK + (size_t)T * D * 2;
constexpr size_t WKSET_B = 13824;
constexpr size_t RW_SETS = RW_XR;
constexpr size_t RW_END = RW_SETS + (size_t)64 * (RPB / 16) * WKSET_B;

template <class TP> __device__ __forceinline__ TP* uniform_ptr(TP* p) {
    const unsigned long long v = (unsigned long long)p;
    const unsigned lo = __builtin_amdgcn_readfirstlane((unsigned)v), hi = __builtin_amdgcn_readfirstlane((unsigned)(v >> 32));
    return (TP*)(__attribute__((address_space(1))) TP*)(((unsigned long long)hi << 32) | lo);
}
__device__ __forceinline__ int otid() { int t = threadIdx.x; asm volatile("" : "+v"(t)); return t; }
typedef float f32x2v __attribute__((ext_vector_type(2)));
typedef __bf16 bf16x2v __attribute__((ext_vector_type(2)));
__device__ __forceinline__ unsigned cvt_pk_bf16(float lo, float hi) { const f32x2v v = {lo, hi}; return __builtin_bit_cast(unsigned, __builtin_convertvector(v, bf16x2v)); }
__device__ __forceinline__ float bf_lo(unsigned u) { return __uint_as_float(u << 16); }
__device__ __forceinline__ float bf_hi(unsigned u) { return __uint_as_float(u & 0xffff0000u); }
template <int CTRL> __device__ __forceinline__ float dpp_f(float v) { return __int_as_float(__builtin_amdgcn_update_dpp(0, __float_as_int(v), CTRL, 0xf, 0xf, false)); }
__device__ __forceinline__ float row16_sum(float v) {
    v += dpp_f<0x128>(v); v += dpp_f<0x124>(v); v += dpp_f<0x122>(v); v += dpp_f<0x121>(v); return v;
}
__device__ __forceinline__ float lane_bcast(float v, int l) { return __int_as_float(__builtin_amdgcn_readlane(__float_as_int(v), l)); }
__device__ __forceinline__ float wave_sum(float v) {
    v = row16_sum(v);
    return (lane_bcast(v, 0) + lane_bcast(v, 16)) + (lane_bcast(v, 32) + lane_bcast(v, 48));
}
__device__ __forceinline__ float sin_acc(float x) {
    const float k = rintf(x * 0.15915494309189535f);
    float r = fmaf(-k, 6.28125f, x); r = fmaf(-k, 1.9353071795864769e-3f, r);
    const float pi = 3.14159265358979f;
    r = r > 0.5f * pi ? pi - r : (r < -0.5f * pi ? -pi - r : r);
    const float r2 = r * r;
    float p = -2.5052108e-8f; p = fmaf(p, r2, 2.7557319e-6f); p = fmaf(p, r2, -1.9841270e-4f); p = fmaf(p, r2, 8.3333333e-3f); p = fmaf(p, r2, -1.6666667e-1f);
    return fmaf(r * r2, p, r);
}
__device__ __forceinline__ float cos_acc(float x) { return sin_acc(x + 1.57079632679489662f); }
__device__ __forceinline__ float sigmoidf_(float x) { return __builtin_amdgcn_rcpf(1.f + __expf(-x)); }
__device__ __forceinline__ int mod_index(int row) { const int b = row / RPB; return (row - b * RPB) < CTX ? 2 : b; }

constexpr int G_A_BYTES = 256 * 64 * 2, G_B_BYTES = 128 * 64 * 2, G_BUF = G_A_BYTES + G_B_BYTES, G_LDS = 2 * G_BUF;
__device__ __forceinline__ int gswz(int row, int ch) { return row * 128 + ((ch ^ ((row >> 1) & 7)) << 4); }

struct ALoadPlain {
    const bf16_t* A; int lda;
    __device__ __forceinline__ u32x4 load(int row, int k) const { return *(const u32x4*)(A + (size_t)row * lda + k); }
};

template <class AL, class EP>
__device__ __forceinline__ void gemm_tile(const AL& al, const bf16_t* __restrict__ Bt, int ldb, int nk, unsigned char* lds, const EP& ep, int m0, int n0) {
    const int tid = otid(), lane = tid & 63, wid = tid >> 6, wm = wid >> 1, wn = wid & 1, fr = lane & 15, fq = lane >> 4;
    f32x4 acc[4][4];
#pragma unroll
    for (int i = 0; i < 4; ++i)
#pragma unroll
        for (int j = 0; j < 4; ++j) acc[i][j] = (f32x4){0.f, 0.f, 0.f, 0.f};
    u32x4 ra[4], rb[2];
    const int srow = tid >> 3, sch = tid & 7;
    {
#pragma unroll
        for (int i = 0; i < 4; ++i) ra[i] = al.load(m0 + srow + i * 64, sch * 8);
#pragma unroll
        for (int i = 0; i < 2; ++i) rb[i] = *(const u32x4*)(Bt + (size_t)(n0 + srow + i * 64) * ldb + sch * 8);
#pragma unroll
        for (int i = 0; i < 4; ++i) *(u32x4*)(lds + gswz(srow + i * 64, sch)) = ra[i];
#pragma unroll
        for (int i = 0; i < 2; ++i) *(u32x4*)(lds + G_A_BYTES + gswz(srow + i * 64, sch)) = rb[i];
    }
    __syncthreads();
    for (int kt = 0; kt < nk; ++kt) {
        const bool more = (kt + 1 < nk);
        if (more) {
#pragma unroll
            for (int i = 0; i < 4; ++i) ra[i] = al.load(m0 + srow + i * 64, (kt + 1) * 64 + sch * 8);
#pragma unroll
            for (int i = 0; i < 2; ++i) rb[i] = *(const u32x4*)(Bt + (size_t)(n0 + srow + i * 64) * ldb + (kt + 1) * 64 + sch * 8);
        }
        const unsigned char* base = lds + (kt & 1) * G_BUF;
#pragma unroll
        for (int ks = 0; ks < 2; ++ks) {
            bf16x8 af[4], bfr[4];
#pragma unroll
            for (int mi = 0; mi < 4; ++mi) af[mi] = *(const bf16x8*)(base + gswz(wm * 64 + mi * 16 + fr, ks * 4 + fq));
#pragma unroll
            for (int ni = 0; ni < 4; ++ni) bfr[ni] = *(const bf16x8*)(base + G_A_BYTES + gswz(wn * 64 + ni * 16 + fr, ks * 4 + fq));
#pragma unroll
            for (int mi = 0; mi < 4; ++mi)
#pragma unroll
                for (int ni = 0; ni < 4; ++ni) acc[mi][ni] = __builtin_amdgcn_mfma_f32_16x16x32_bf16(bfr[ni], af[mi], acc[mi][ni], 0, 0, 0);
        }
        if (more) {
            unsigned char* nb = lds + ((kt + 1) & 1) * G_BUF;
#pragma unroll
            for (int i = 0; i < 4; ++i) *(u32x4*)(nb + gswz(srow + i * 64, sch)) = ra[i];
#pragma unroll
            for (int i = 0; i < 2; ++i) *(u32x4*)(nb + G_A_BYTES + gswz(srow + i * 64, sch)) = rb[i];
        }
        __syncthreads();
    }
    ep(acc, m0 + wm * 64, n0 + wn * 64, fr, fq);
}
template <class F> struct EpiElem {
    F f;
    __device__ __forceinline__ void operator()(const f32x4 (&acc)[4][4], int rbase, int cbase, int fr, int fq) const {
#pragma unroll
        for (int mi = 0; mi < 4; ++mi)
#pragma unroll
            for (int ni = 0; ni < 4; ++ni) f(rbase + mi * 16 + fr, cbase + ni * 16 + fq * 4, acc[mi][ni]);
    }
};
template <class F> __device__ __forceinline__ EpiElem<F> make_epi(F f) { return EpiElem<F>{f}; }

struct Nil {};
template <class FC, class FR, class FS> struct Epi3 {
    FC fc; FR frow; FS fs;
    __device__ __forceinline__ void operator()(const f32x4 (&acc)[4][4], int rbase, int cbase, int fr, int fq) const {
        decltype(fc(0)) ci[4];
#pragma unroll
        for (int ni = 0; ni < 4; ++ni) ci[ni] = fc(cbase + ni * 16 + fq * 4);
        decltype(frow(0, 0)) ri[4][4];
#pragma unroll
        for (int mi = 0; mi < 4; ++mi)
#pragma unroll
            for (int ni = 0; ni < 4; ++ni) ri[mi][ni] = frow(rbase + mi * 16 + fr, cbase + ni * 16 + fq * 4);
#pragma unroll
        for (int mi = 0; mi < 4; ++mi)
#pragma unroll
            for (int ni = 0; ni < 4; ++ni) fs(rbase + mi * 16 + fr, cbase + ni * 16 + fq * 4, acc[mi][ni], ci[ni], ri[mi][ni]);
    }
    __device__ __forceinline__ void operator()(const f32x4 (&acc)[2][2][4][2], int row0, int col0) const {
        decltype(fc(0)) ci[2][2];
#pragma unroll
        for (int bj = 0; bj < 2; ++bj)
#pragma unroll
            for (int n = 0; n < 2; ++n) ci[bj][n] = fc(col0 + bj * 128 + n * 16);
#pragma unroll
        for (int ai = 0; ai < 2; ++ai) {
            decltype(frow(0, 0)) ri[4][2][2];
#pragma unroll
            for (int m = 0; m < 4; ++m)
#pragma unroll
                for (int bj = 0; bj < 2; ++bj)
#pragma unroll
                    for (int n = 0; n < 2; ++n) ri[m][bj][n] = frow(row0 + ai * 128 + m * 16, col0 + bj * 128 + n * 16);
#pragma unroll
            for (int m = 0; m < 4; ++m)
#pragma unroll
                for (int bj = 0; bj < 2; ++bj)
#pragma unroll
                    for (int n = 0; n < 2; ++n) fs(row0 + ai * 128 + m * 16, col0 + bj * 128 + n * 16, acc[ai][bj][m][n], ci[bj][n], ri[m][bj][n]);
        }
    }
};
template <class FC, class FR, class FS> __device__ __forceinline__ Epi3<FC, FR, FS> make_epi3(FC fc, FR fr, FS fs) { return Epi3<FC, FR, FS>{fc, fr, fs}; }
__device__ __forceinline__ Nil nil_col(int) { return Nil{}; }
__device__ __forceinline__ Nil nil_row(int, int) { return Nil{}; }
namespace g8 {
constexpr int BK = 64, HALF = 128, HT = HALF * BK, SHM_B = 8 * HT * 2;
__device__ __forceinline__ int lds_byte(int r, int c) { const int st = (r >> 4) * 2 + (c >> 5), rr = r & 15, cc = c & 31, ob = rr * 64 + cc * 2; return st * 1024 + (ob ^ (((ob >> 9) & 1) << 5)); }
__device__ __forceinline__ void stage_rc(int b, int& R, int& C) { const int st = b / 1024, sb = b % 1024, swz = sb ^ (((sb >> 9) & 1) << 5); R = (st >> 1) * 16 + swz / 64; C = (st & 1) * 32 + (swz % 64) / 2; }

struct AOffPlain { unsigned row0; unsigned lda; __device__ __forceinline__ unsigned operator()(int r) const { return (row0 + (unsigned)r) * lda; } };
template <bool GATHER, class AOff, class Epi>
__device__ __forceinline__ void gemm256(const bf16_t* __restrict__ Abase, const AOff& aoff, const bf16_t* __restrict__ Bt  , int K,
                                        unsigned char* shmb, const Epi& epi, int brow, int bcol) {
    LAS bf16_t* shm = (LAS bf16_t*)shmb;
#define G8_SA(b, h) (shm + ((b) * 2 + (h)) * HT)
#define G8_SB(b, h) (shm + (4 + (b) * 2 + (h)) * HT)
#define G8_STAGE_A(P, h, dk) do { _Pragma("unroll") for (int _i = 0; _i < 2; ++_i) \
        __builtin_amdgcn_raw_ptr_buffer_load_lds(rsA, (LAS void*)((LAS char*)(P) + wid * 1024 + _i * 8192), 16, GATHER ? oa[h][_i] : oa[0][0], \
            sK + (unsigned)((dk) * (BK * 2)) + (GATHER ? 0u : (unsigned)((h) * HALF + _i * 64) * arow_bytes), 0, 0); } while (0)
#define G8_STAGE_B(P, h, dk) do { _Pragma("unroll") for (int _i = 0; _i < 2; ++_i) \
        __builtin_amdgcn_raw_ptr_buffer_load_lds(rsB, (LAS void*)((LAS char*)(P) + wid * 1024 + _i * 8192), 16, ob, \
            sK + (unsigned)((dk) * (BK * 2)) + (unsigned)((h) * HALF + _i * 64) * brow_bytes, 0, 0); } while (0)
#define G8_LDA(dst, b, h) _Pragma("unroll") for (int m = 0; m < 4; ++m) _Pragma("unroll") for (int k = 0; k < 2; ++k) \
        dst[m][k] = *(const LAS bf16x8*)((LAS char*)G8_SA(b, h) + lds_byte(wr * 64 + m * 16 + fr, k * 32 + fq * 8))
#define G8_LDB(dst, b, h) _Pragma("unroll") for (int n = 0; n < 2; ++n) _Pragma("unroll") for (int k = 0; k < 2; ++k) \
        dst[n][k] = *(const LAS bf16x8*)((LAS char*)G8_SB(b, h) + lds_byte(wc * 32 + n * 16 + fr, k * 32 + fq * 8))
#define G8_MMA(ai, bj, At, Bx) do { __builtin_amdgcn_s_setprio(1); \
        _Pragma("unroll") for (int m = 0; m < 4; ++m) _Pragma("unroll") for (int n = 0; n < 2; ++n) _Pragma("unroll") for (int k = 0; k < 2; ++k) \
            acc[ai][bj][m][n] = __builtin_amdgcn_mfma_f32_16x16x32_bf16(Bx[n][k], At[m][k], acc[ai][bj][m][n], 0, 0, 0); \
        __builtin_amdgcn_s_setprio(0); } while (0)
#define G8_WAIT_V(n) asm volatile("s_waitcnt vmcnt(" #n ")" ::: "memory")
#define G8_WAIT_L(n) asm volatile("s_waitcnt lgkmcnt(" #n ")" ::: "memory")
#define G8_BAR __builtin_amdgcn_s_barrier()
#define G8_SCHED __builtin_amdgcn_sched_barrier(0)
    int tz = threadIdx.x; asm volatile("" : "+v"(tz));
    int wid = tz >> 6, lane = tz & 63, wr = wid >> 2, wc = wid & 3, fr = lane & 15, fq = lane >> 4;
    unsigned oa[2][2], ob;
    {
        int R0, C0; stage_rc(tz * 16, R0, C0);
        ob = ((unsigned)R0 * (unsigned)K + (unsigned)C0) * 2u;
        if (GATHER) {
#pragma unroll
            for (int h = 0; h < 2; ++h)
#pragma unroll
                for (int i = 0; i < 2; ++i) oa[h][i] = (aoff(h * HALF + R0 + i * 64) + (unsigned)C0) * 2u;
        } else { oa[0][0] = ((aoff(R0) - aoff(0)) + (unsigned)C0) * 2u; oa[0][1] = oa[1][0] = oa[1][1] = 0u; }
    }
    f32x4 acc[2][2][4][2];
#pragma unroll
    for (int x = 0; x < 2; ++x)
#pragma unroll
        for (int y = 0; y < 2; ++y)
#pragma unroll
            for (int m = 0; m < 4; ++m)
#pragma unroll
                for (int n = 0; n < 2; ++n) acc[x][y][m][n] = (f32x4){0.f, 0.f, 0.f, 0.f};
    bf16x8 At[4][2], B0[2][2], B1[2][2];
    const int nt = K / BK;
    const __amdgpu_buffer_rsrc_t rsA = __builtin_amdgcn_make_buffer_rsrc((void*)(Abase + (GATHER ? 0u : aoff(0))), (short)0, 0x7ffffff0, 0x00020000);
    const __amdgpu_buffer_rsrc_t rsB = __builtin_amdgcn_make_buffer_rsrc((void*)Bt, (short)0, 0x7ffffff0, 0x00020000);
    const unsigned arow_bytes = GATHER ? 0u : (aoff(1) - aoff(0)) * 2u, brow_bytes = (unsigned)K * 2u;
    unsigned sK = 0;
    asm volatile("s_waitcnt vmcnt(0)" ::: "memory");
    G8_STAGE_B(G8_SB(0, 0), 0, 0); G8_STAGE_A(G8_SA(0, 0), 0, 0);
    G8_STAGE_B(G8_SB(0, 1), 1, 0); G8_STAGE_A(G8_SA(0, 1), 1, 0);
    if (wr == 1) G8_BAR;
    G8_WAIT_V(4); G8_BAR;
    G8_STAGE_B(G8_SB(1, 0), 0, 1); G8_STAGE_A(G8_SA(1, 0), 0, 1); G8_STAGE_B(G8_SB(1, 1), 1, 1);
    G8_WAIT_V(6); G8_BAR;
    for (int t = 0; t < nt - 2; t += 2) {
        G8_LDB(B0, 0, 0); G8_SCHED; G8_LDA(At, 0, 0); G8_STAGE_A(G8_SA(1, 1), 1, 1);
        G8_WAIT_L(8); G8_BAR; G8_WAIT_L(0); G8_MMA(0, 0, At, B0); G8_BAR; G8_SCHED;
        G8_LDB(B1, 0, 1); G8_STAGE_B(G8_SB(0, 0), 0, 2);
        G8_BAR; G8_WAIT_L(0); G8_MMA(0, 1, At, B1); G8_BAR;
        G8_LDA(At, 0, 1); G8_STAGE_A(G8_SA(0, 0), 0, 2);
        G8_BAR; G8_WAIT_L(0); G8_MMA(1, 0, At, B0); G8_BAR; G8_SCHED;
        G8_STAGE_B(G8_SB(0, 1), 1, 2);
        G8_WAIT_V(6); G8_BAR; G8_MMA(1, 1, At, B1); G8_BAR;
        G8_LDB(B0, 1, 0); G8_SCHED; G8_LDA(At, 1, 0); G8_STAGE_A(G8_SA(0, 1), 1, 2);
        G8_WAIT_L(8); G8_BAR; G8_WAIT_L(0); G8_MMA(0, 0, At, B0); G8_BAR; G8_SCHED;
        G8_LDB(B1, 1, 1); G8_STAGE_B(G8_SB(1, 0), 0, 3);
        G8_BAR; G8_WAIT_L(0); G8_MMA(0, 1, At, B1); G8_BAR;
        G8_LDA(At, 1, 1); G8_STAGE_A(G8_SA(1, 0), 0, 3);
        G8_BAR; G8_WAIT_L(0); G8_MMA(1, 0, At, B0); G8_BAR; G8_SCHED;
        G8_STAGE_B(G8_SB(1, 1), 1, 3);
        G8_WAIT_V(6); G8_BAR; G8_MMA(1, 1, At, B1); G8_BAR;
        sK += 2 * BK * 2;
    }
    { G8_LDB(B0, 0, 0); G8_WAIT_V(0); G8_LDA(At, 0, 0); G8_STAGE_A(G8_SA(1, 1), 1, 1);
      G8_BAR; G8_WAIT_L(0); G8_MMA(0, 0, At, B0); G8_BAR;
      G8_LDB(B1, 0, 1); G8_BAR; G8_WAIT_L(0); G8_MMA(0, 1, At, B1); G8_BAR;
      G8_LDA(At, 0, 1); G8_WAIT_V(4); G8_BAR; G8_WAIT_L(0); G8_MMA(1, 0, At, B0); G8_MMA(1, 1, At, B1); G8_BAR; }
    { G8_LDB(B0, 1, 0); G8_LDA(At, 1, 0); G8_WAIT_V(2); G8_BAR; G8_WAIT_L(0); G8_MMA(0, 0, At, B0); G8_BAR;
      G8_LDB(B1, 1, 1); G8_WAIT_V(0); G8_BAR; G8_WAIT_L(0); G8_MMA(0, 1, At, B1); G8_BAR;
      G8_LDA(At, 1, 1); G8_BAR; G8_WAIT_L(0); G8_MMA(1, 0, At, B0); G8_MMA(1, 1, At, B1); G8_BAR; }
    if (wr == 0) G8_BAR;
    tz = threadIdx.x; asm volatile("" : "+v"(tz)); wid = tz >> 6; lane = tz & 63; wr = wid >> 2; wc = wid & 3; fr = lane & 15; fq = lane >> 4;
    epi(acc, brow + wr * 64 + fr, bcol + wc * 32 + fq * 4);
#undef G8_SA
#undef G8_SB
#undef G8_STAGE_A
#undef G8_STAGE_B
#undef G8_LDA
#undef G8_LDB
#undef G8_MMA
#undef G8_WAIT_V
#undef G8_WAIT_L
#undef G8_BAR
#undef G8_SCHED
}
template <bool GATHER, class U, class Ctx, class NextFn>
__device__ __forceinline__ void gemm256_stream(int K, unsigned lda, unsigned char* shmb, const Ctx& ctx, NextFn next) {
    LAS bf16_t* shm = (LAS bf16_t*)shmb;
#define G8_SA(b, h) (shm + ((b) * 2 + (h)) * HT)
#define G8_SB(b, h) (shm + (4 + (b) * 2 + (h)) * HT)
#define G8_STAGE_A(P, h, dk, NXT) do { const bool _n = (NXT) && last; const __amdgpu_buffer_rsrc_t _rs = __builtin_amdgcn_make_buffer_rsrc((void*)(_n ? pA_n : pA_c), (short)0, 0x7ffffff0, 0x00020000); \
        _Pragma("unroll") for (int _i = 0; _i < 2; ++_i) \
        __builtin_amdgcn_raw_ptr_buffer_load_lds(_rs, (LAS void*)((LAS char*)(P) + wid * 1024 + _i * 8192), 16, GATHER ? (_n ? oa_n[h][_i] : oa_c[h][_i]) : oa_c[0][0], \
            (_n ? (unsigned)(((dk) - 2) * (BK * 2)) : sK + (unsigned)((dk) * (BK * 2))) + (GATHER ? 0u : (unsigned)((h) * HALF + _i * 64) * arow_bytes), 0, 0); } while (0)
#define G8_STAGE_B(P, h, dk, NXT) do { const bool _n = (NXT) && last; const __amdgpu_buffer_rsrc_t _rs = __builtin_amdgcn_make_buffer_rsrc((void*)(_n ? pB_n : pB_c), (short)0, 0x7ffffff0, 0x00020000); \
        _Pragma("unroll") for (int _i = 0; _i < 2; ++_i) \
        __builtin_amdgcn_raw_ptr_buffer_load_lds(_rs, (LAS void*)((LAS char*)(P) + wid * 1024 + _i * 8192), 16, ob, \
            (_n ? (unsigned)(((dk) - 2) * (BK * 2)) : sK + (unsigned)((dk) * (BK * 2))) + (unsigned)((h) * HALF + _i * 64) * brow_bytes, 0, 0); } while (0)
#define G8_LDA(dst, b, h) _Pragma("unroll") for (int m = 0; m < 4; ++m) _Pragma("unroll") for (int k = 0; k < 2; ++k) \
        dst[m][k] = *(const LAS bf16x8*)((LAS char*)G8_SA(b, h) + lds_byte(wr * 64 + m * 16 + fr, k * 32 + fq * 8))
#define G8_LDB(dst, b, h) _Pragma("unroll") for (int n = 0; n < 2; ++n) _Pragma("unroll") for (int k = 0; k < 2; ++k) \
        dst[n][k] = *(const LAS bf16x8*)((LAS char*)G8_SB(b, h) + lds_byte(wc * 32 + n * 16 + fr, k * 32 + fq * 8))
#define G8_MMA(ai, bj, At, Bx) do { __builtin_amdgcn_s_setprio(1); \
        _Pragma("unroll") for (int m = 0; m < 4; ++m) _Pragma("unroll") for (int n = 0; n < 2; ++n) _Pragma("unroll") for (int k = 0; k < 2; ++k) \
            acc[ai][bj][m][n] = __builtin_amdgcn_mfma_f32_16x16x32_bf16(Bx[n][k], At[m][k], acc[ai][bj][m][n], 0, 0, 0); \
        __builtin_amdgcn_s_setprio(0); } while (0)
#define G8_WAIT_V(n) asm volatile("s_waitcnt vmcnt(" #n ")" ::: "memory")
#define G8_WAIT_L(n) asm volatile("s_waitcnt lgkmcnt(" #n ")" ::: "memory")
#define G8_BAR __builtin_amdgcn_s_barrier()
#define G8_SCHED __builtin_amdgcn_sched_barrier(0)
    int tz = threadIdx.x; asm volatile("" : "+v"(tz));
    int wid = tz >> 6, lane = tz & 63, wr = wid >> 2, wc = wid & 3, fr = lane & 15, fq = lane >> 4;
    unsigned ob;
    { int R0, C0; stage_rc(tz * 16, R0, C0); ob = ((unsigned)R0 * (unsigned)K + (unsigned)C0) * 2u; }
    const unsigned arow_bytes = GATHER ? 0u : lda * 2u, brow_bytes = (unsigned)K * 2u;
    U cur, nxt;
    if (!next(cur)) return;
    const bf16_t* pA_c; const bf16_t* pB_c; const bf16_t* pA_n; const bf16_t* pB_n; unsigned oa_c[2][2], oa_n[2][2];
    auto setup = [&](const U& u, const bf16_t*& pa, const bf16_t*& pb, unsigned (&oa)[2][2]) {
        int tq = threadIdx.x; asm volatile("" : "+v"(tq));
        int R0, C0; stage_rc(tq * 16, R0, C0);
        pa = uniform_ptr(ctx.A(u)); pb = uniform_ptr(ctx.B(u));
        if (GATHER) {
#pragma unroll
            for (int h = 0; h < 2; ++h)
#pragma unroll
                for (int i = 0; i < 2; ++i) oa[h][i] = (ctx.aoff(u, h * HALF + R0 + i * 64) + (unsigned)C0) * 2u;
        } else { oa[0][0] = ((unsigned)R0 * lda + (unsigned)C0) * 2u; oa[0][1] = oa[1][0] = oa[1][1] = 0u; }
    };
    setup(cur, pA_c, pB_c, oa_c);
    bool have_n = next(nxt);
    if (have_n) setup(nxt, pA_n, pB_n, oa_n);
    else { pA_n = pA_c; pB_n = pB_c;
#pragma unroll
        for (int h = 0; h < 2; ++h)
#pragma unroll
            for (int i = 0; i < 2; ++i) oa_n[h][i] = oa_c[h][i]; }
    f32x4 acc[2][2][4][2];
    bf16x8 At[4][2], B0[2][2], B1[2][2];
    const int nt = K / BK;
    unsigned sK = 0;
    {
        const bool last = false;
        asm volatile("s_waitcnt vmcnt(0)" ::: "memory");
        G8_STAGE_B(G8_SB(0, 0), 0, 0, 0); G8_STAGE_A(G8_SA(0, 0), 0, 0, 0);
        G8_STAGE_B(G8_SB(0, 1), 1, 0, 0); G8_STAGE_A(G8_SA(0, 1), 1, 0, 0);
        if (wr == 1) G8_BAR;
        G8_WAIT_V(4); G8_BAR;
        G8_STAGE_B(G8_SB(1, 0), 0, 1, 0); G8_STAGE_A(G8_SA(1, 0), 0, 1, 0); G8_STAGE_B(G8_SB(1, 1), 1, 1, 0);
        G8_WAIT_V(6); G8_BAR;
    }
    for (;;) {
        {
            int t2 = threadIdx.x; asm volatile("" : "+v"(t2));
            ctx.init(cur, acc, ctx.bcol(cur) + ((t2 >> 6) & 3) * 32 + ((t2 & 63) >> 4) * 4);
        }
        sK = 0;
        for (int t = 0; t < nt; t += 2) {
            const bool last = (t + 2 >= nt);
            G8_LDB(B0, 0, 0); G8_SCHED; G8_LDA(At, 0, 0); G8_STAGE_A(G8_SA(1, 1), 1, 1, 0);
            G8_WAIT_L(8); G8_BAR; G8_WAIT_L(0); G8_MMA(0, 0, At, B0); G8_BAR; G8_SCHED;
            G8_LDB(B1, 0, 1); G8_STAGE_B(G8_SB(0, 0), 0, 2, 1);
            G8_BAR; G8_WAIT_L(0); G8_MMA(0, 1, At, B1); G8_BAR;
            G8_LDA(At, 0, 1); G8_STAGE_A(G8_SA(0, 0), 0, 2, 1);
            G8_BAR; G8_WAIT_L(0); G8_MMA(1, 0, At, B0); G8_BAR; G8_SCHED;
            G8_STAGE_B(G8_SB(0, 1), 1, 2, 1);
            G8_WAIT_V(6); G8_BAR; G8_MMA(1, 1, At, B1); G8_BAR;
            G8_LDB(B0, 1, 0); G8_SCHED; G8_LDA(At, 1, 0); G8_STAGE_A(G8_SA(0, 1), 1, 2, 1);
            G8_WAIT_L(8); G8_BAR; G8_WAIT_L(0); G8_MMA(0, 0, At, B0); G8_BAR; G8_SCHED;
            G8_LDB(B1, 1, 1); G8_STAGE_B(G8_SB(1, 0), 0, 3, 1);
            G8_BAR; G8_WAIT_L(0); G8_MMA(0, 1, At, B1); G8_BAR;
            G8_LDA(At, 1, 1); G8_STAGE_A(G8_SA(1, 0), 0, 3, 1);
            G8_BAR; G8_WAIT_L(0); G8_MMA(1, 0, At, B0); G8_BAR; G8_SCHED;
            G8_STAGE_B(G8_SB(1, 1), 1, 3, 1);
            G8_WAIT_V(6); G8_BAR; G8_MMA(1, 1, At, B1); G8_BAR;
            sK += 2 * BK * 2;
        }
        {
            int t2 = threadIdx.x; asm volatile("" : "+v"(t2));
            const int w2 = t2 >> 6, l2 = t2 & 63;
            ctx.epi(cur, acc, ctx.brow(cur) + (w2 >> 2) * 64 + (l2 & 15), ctx.bcol(cur) + (w2 & 3) * 32 + (l2 >> 4) * 4);
        }
        if (!have_n) break;
        cur = nxt; pA_c = pA_n; pB_c = pB_n;
#pragma unroll
        for (int h = 0; h < 2; ++h)
#pragma unroll
            for (int i = 0; i < 2; ++i) oa_c[h][i] = oa_n[h][i];
        have_n = next(nxt);
        if (have_n) setup(nxt, pA_n, pB_n, oa_n);
    }
    G8_WAIT_V(0);
    if (wr == 0) G8_BAR;
    __syncthreads();
#undef G8_SA
#undef G8_SB
#undef G8_STAGE_A
#undef G8_STAGE_B
#undef G8_LDA
#undef G8_LDB
#undef G8_MMA
#undef G8_WAIT_V
#undef G8_WAIT_L
#undef G8_BAR
#undef G8_SCHED
}
template <class F> struct EpiElem256 {
    F f;
    __device__ __forceinline__ void operator()(const f32x4 (&acc)[2][2][4][2], int row0, int col0) const {
#pragma unroll
        for (int ai = 0; ai < 2; ++ai)
#pragma unroll
            for (int m = 0; m < 4; ++m)
#pragma unroll
                for (int bj = 0; bj < 2; ++bj)
#pragma unroll
                    for (int n = 0; n < 2; ++n) f(row0 + ai * HALF + m * 16, col0 + bj * HALF + n * 16, acc[ai][bj][m][n]);
    }
};
template <class F> __device__ __forceinline__ EpiElem256<F> make_epi256(F f) { return EpiElem256<F>{f}; }
struct UTile { int mt, nt, g; };
__device__ __forceinline__ void zero_acc(f32x4 (&acc)[2][2][4][2]) {
#pragma unroll
    for (int ai = 0; ai < 2; ++ai)
#pragma unroll
        for (int bj = 0; bj < 2; ++bj)
#pragma unroll
            for (int m = 0; m < 4; ++m)
#pragma unroll
                for (int n = 0; n < 2; ++n) acc[ai][bj][m][n] = (f32x4){ 0.f, 0.f, 0.f, 0.f };
}
__device__ __forceinline__ void bias_acc(f32x4 (&acc)[2][2][4][2], const float* bias, int col0) {
#pragma unroll
    for (int bj = 0; bj < 2; ++bj)
#pragma unroll
        for (int n = 0; n < 2; ++n) {
            float4 bv = make_float4(0.f, 0.f, 0.f, 0.f);
            if (bias) bv = *(const float4*)(bias + col0 + bj * 128 + n * 16);
#pragma unroll
            for (int ai = 0; ai < 2; ++ai)
#pragma unroll
                for (int m = 0; m < 4; ++m) acc[ai][bj][m][n] = (f32x4){ bv.x, bv.y, bv.z, bv.w };
        }
}
template <class F> __device__ __forceinline__ void each_acc(const f32x4 (&acc)[2][2][4][2], int row0, int col0, F f) {
#pragma unroll
    for (int ai = 0; ai < 2; ++ai)
#pragma unroll
        for (int m = 0; m < 4; ++m)
#pragma unroll
            for (int bj = 0; bj < 2; ++bj)
#pragma unroll
                for (int n = 0; n < 2; ++n) f(row0 + ai * HALF + m * 16, col0 + bj * HALF + n * 16, acc[ai][bj][m][n]);
}
template <class FA, class FB, class FI, class FE> struct CtxL {
    FA fa; FB fb; FI fi; FE fe;
    __device__ __forceinline__ const bf16_t* A(const UTile& u) const { return fa(u); }
    __device__ __forceinline__ const bf16_t* B(const UTile& u) const { return fb(u); }
    __device__ __forceinline__ int brow(const UTile& u) const { return u.mt * 256; }
    __device__ __forceinline__ int bcol(const UTile& u) const { return u.nt * 256; }
    __device__ __forceinline__ unsigned aoff(const UTile&, int) const { return 0u; }
    __device__ __forceinline__ void init(const UTile& u, f32x4 (&acc)[2][2][4][2], int col0) const { fi(u, acc, col0); }
    __device__ __forceinline__ void epi(const UTile& u, const f32x4 (&acc)[2][2][4][2], int row0, int col0) const { fe(u, acc, row0, col0); }
};
template <class FA, class FB, class FI, class FE> __device__ __forceinline__ CtxL<FA, FB, FI, FE> make_ctx(FA fa, FB fb, FI fi, FE fe) { return CtxL<FA, FB, FI, FE>{ fa, fb, fi, fe }; }
}
struct TJob { int in_idx, src_off, K, N, Kpad, Npad, batch, sbs, dbs, perm; size_t dst; };
constexpr int NJOBS = 27;
__constant__ TJob g_jobs[NJOBS] = {
    { I_RWRKV, 0,             1024, 1024, 1024, 1024, 6,   1024 * 1024, 1024 * 1024, 0, WS_RKVT },
    { I_RWO,   0,             1024, 1024, 1024, 1024, 2,   1024 * 1024, 1024 * 1024, 0, WS_RWOT },
    { I_RW1,   0,             1024, 64,   1024, 64,   2,   1024 * 64,   64 * 1024,   0, WS_L1T + (size_t)0 * 1024 * 2 },
    { I_RW1,   2 * 1024 * 64, 1024, 64,   1024, 64,   2,   1024 * 64,   64 * 1024,   0, WS_L1T + (size_t)640 * 1024 * 2 },
    { I_RA1,   0,             1024, 64,   1024, 64,   2,   1024 * 64,   64 * 1024,   0, WS_L1T + (size_t)128 * 1024 * 2 },
    { I_RA1,   2 * 1024 * 64, 1024, 64,   1024, 64,   2,   1024 * 64,   64 * 1024,   0, WS_L1T + (size_t)(640 + 128) * 1024 * 2 },
    { I_RG1,   0,             1024, 160,  1024, 256,  1,   0,           0,           0, WS_L1T + (size_t)256 * 1024 * 2 },
    { I_RG1,   1024 * 160,    1024, 160,  1024, 256,  1,   0,           0,           0, WS_L1T + (size_t)(640 + 256) * 1024 * 2 },
    { I_RV1,   0,             1024, 32,   1024, 128,  1,   0,           0,           0, WS_L1T + (size_t)(640 + 512) * 1024 * 2 },
    { I_RW2,   0,             64,   1024, 64,   1024, 4,   64 * 1024,   1024 * 64,   0, WS_W2T },
    { I_RA2,   0,             64,   1024, 64,   1024, 4,   64 * 1024,   1024 * 64,   0, WS_A2T },
    { I_RG2,   0,             160,  1024, 192,  1024, 2,   160 * 1024,  1024 * 192,  0, WS_G2T },
    { I_RV2,   0,             32,   1024, 64,   1024, 1,   0,           0,           0, WS_V2T },
    { I_HWIN,  0,             1024, 3072, 1024, 3072, 1,   0,           0,           0, WS_HYINT },
    { I_HWOUT, 0,             1024, 1024, 1024, 1024, 1,   0,           0,           0, WS_HYOUTT },
    { I_MWA,   0,             1024, 704,  1024, 768,  1,   0,           0,           0, WS_MWAT },
    { I_MWQB,  0,             384,  1536, 384,  1536, 1,   0,           0,           0, WS_MWQBT },
    { I_MWKVB, 0,             256,  2048, 256,  2048, 1,   0,           0,           0, WS_MWKVBT },
    { I_MWO,   0,             1024, 1024, 1024, 1024, 1,   0,           0,           0, WS_MWOT },
    { I_EWIN,  0 * 32 * 1024 * 2048, 1024, 2048, 1024, 2048, 32, 1024 * 2048, 2048 * 1024, 1, WS_EWINT  + (size_t)0 * 32 * 2048 * 1024 * 2 },
    { I_EWOUT, 0 * 32 * 1024 * 1024, 1024, 1024, 1024, 1024, 32, 1024 * 1024, 1024 * 1024, 0, WS_EWOUTT + (size_t)0 * 32 * 1024 * 1024 * 2 },
    { I_EWIN,  1 * 32 * 1024 * 2048, 1024, 2048, 1024, 2048, 32, 1024 * 2048, 2048 * 1024, 1, WS_EWINT  + (size_t)1 * 32 * 2048 * 1024 * 2 },
    { I_EWOUT, 1 * 32 * 1024 * 1024, 1024, 1024, 1024, 1024, 32, 1024 * 1024, 1024 * 1024, 0, WS_EWOUTT + (size_t)1 * 32 * 1024 * 1024 * 2 },
    { I_EWIN,  2 * 32 * 1024 * 2048, 1024, 2048, 1024, 2048, 32, 1024 * 2048, 2048 * 1024, 1, WS_EWINT  + (size_t)2 * 32 * 2048 * 1024 * 2 },
    { I_EWOUT, 2 * 32 * 1024 * 1024, 1024, 1024, 1024, 1024, 32, 1024 * 1024, 1024 * 1024, 0, WS_EWOUTT + (size_t)2 * 32 * 1024 * 1024 * 2 },
    { I_EWIN,  3 * 32 * 1024 * 2048, 1024, 2048, 1024, 2048, 32, 1024 * 2048, 2048 * 1024, 1, WS_EWINT  + (size_t)3 * 32 * 2048 * 1024 * 2 },
    { I_EWOUT, 3 * 32 * 1024 * 1024, 1024, 1024, 1024, 1024, 32, 1024 * 1024, 1024 * 1024, 0, WS_EWOUTT + (size_t)3 * 32 * 1024 * 1024 * 2 },
};
constexpr int NJ_PRO = NJOBS - 6;
__device__ __forceinline__ int swiglu_perm(int np) { const int nt = np >> 8, bj = (np >> 7) & 1, c = np & 127; return (bj ? 1024 : 0) + nt * 128 + c; }

__device__ __forceinline__ void transpose_unit(const Args& a, float* lt, const TJob& jb, int t, int tid) {
    const int tk = jb.Kpad >> 6, tn = jb.Npad >> 6, gk = (tk + 3) >> 2, per = gk * tn;
    const int bi = t / per, r = t - bi * per, ti_n = r / gk, kg = r - ti_n * gk;
    const float* src = a.in[jb.in_idx] + jb.src_off + (size_t)bi * jb.sbs;
    bf16_t* dst = (bf16_t*)(a.ws + jb.dst) + (size_t)bi * jb.dbs;
    const int kt0 = kg * 4, nkt = (tk - kt0) < 4 ? (tk - kt0) : 4, n0 = ti_n * 64;
    float4 v[4][2];
#pragma unroll
    for (int g = 0; g < 4; ++g)
#pragma unroll
        for (int i = 0; i < 2; ++i) {
            const int item = tid + i * 512, kl = item >> 4, n4 = (item & 15) * 4, k = (kt0 + g) * 64 + kl, np = n0 + n4;
            v[g][i] = make_float4(0.f, 0.f, 0.f, 0.f);
            if (g < nkt && k < jb.K && np < jb.N) { const int col = jb.perm ? swiglu_perm(np) : np; v[g][i] = *(const float4*)(src + (size_t)k * jb.N + col); }
        }
#pragma unroll
    for (int g = 0; g < 4; ++g)
#pragma unroll
        for (int i = 0; i < 2; ++i) {
            const int item = tid + i * 512, kl = item >> 4, n4 = (item & 15) * 4;
            float* p = lt + (g * 64 + kl) * 65 + n4; p[0] = v[g][i].x; p[1] = v[g][i].y; p[2] = v[g][i].z; p[3] = v[g][i].w;
        }
    __syncthreads();
    {
        const int nl = tid >> 3, kc = tid & 7;
#pragma unroll
        for (int g = 0; g < 4; ++g) {
            if (g < nkt) {
                float f[8];
#pragma unroll
                for (int q = 0; q < 8; ++q) f[q] = lt[(g * 64 + kc * 8 + q) * 65 + nl];
                u32x4 o = { cvt_pk_bf16(f[0], f[1]), cvt_pk_bf16(f[2], f[3]), cvt_pk_bf16(f[4], f[5]), cvt_pk_bf16(f[6], f[7]) };
                *(u32x4*)(dst + (size_t)(n0 + nl) * jb.Kpad + (kt0 + g) * 64 + kc * 8) = o;
            }
        }
    }
    __syncthreads();
}
__device__ __forceinline__ int transpose_units_of(const TJob& jb) { const int tk = jb.Kpad >> 6, tn = jb.Npad >> 6, gk = (tk + 3) >> 2; return jb.batch * gk * tn; }
__device__ __forceinline__ void deferred_transposes(const Args& a, unsigned char* lds, int j0, int j1, int part, int nparts, int blk_lo, int nblk) {
    const int tid = otid();
    float* lt = (float*)(lds + LDS_USER);
    const int bl = (int)blockIdx.x - blk_lo;
    if (bl < 0 || bl >= nblk) return;
    __syncthreads();
    for (int j = j0; j < j1; ++j) {
        const TJob jb = g_jobs[j];
        const int total = transpose_units_of(jb), per_part = (total + nparts - 1) / nparts, lo = part * per_part, hi = (lo + per_part) < total ? (lo + per_part) : total;
        for (int t = lo + bl; t < hi; t += nblk) transpose_unit(a, lt, jb, t, tid);
    }
}

__device__ __forceinline__ void phase_prologue(const Args& a, unsigned char* lds) {
    const int tid = otid(), nb = gridDim.x, bid = blockIdx.x;
    float* lt = (float*)(lds + LDS_USER);
    int base = 0;
    for (int j = 0; j < NJ_PRO; ++j) {
        const TJob jb = g_jobs[j];
        const int total = transpose_units_of(jb);
        int t = (bid - base % nb + nb) % nb;
        for (; t < total; t += nb) transpose_unit(a, lt, jb, t, tid);
        base += total;
    }
    for (int u = bid; u < 4 * 96; u += nb) {
        const int l = u / 96, cg = u - l * 96, kg = tid >> 6, cl = tid & 63, col = cg * 64 + cl;
        const float* w = a.in[I_ADAW] + (size_t)l * 1024 * 6144 + col;
        float s0 = 0.f, s1 = 0.f, s2 = 0.f;
        for (int k = kg * 128; k < kg * 128 + 128; ++k) {
            const float wv = w[(size_t)k * 6144];
            float c0 = a.in[I_C][k], c1 = a.in[I_C][1024 + k], c2 = a.in[I_CCTX][k];
            c0 = c0 / (1.f + __expf(-c0)); c1 = c1 / (1.f + __expf(-c1)); c2 = c2 / (1.f + __expf(-c2));
            s0 += c0 * wv; s1 += c1 * wv; s2 += c2 * wv;
        }
        lt[(kg * 3 + 0) * 64 + cl] = s0; lt[(kg * 3 + 1) * 64 + cl] = s1; lt[(kg * 3 + 2) * 64 + cl] = s2;
        __syncthreads();
        if (tid < 192) {
            const int m = tid >> 6;
            float s = a.in[I_ADAB][l * 6144 + col];
#pragma unroll
            for (int g = 0; g < 8; ++g) s += lt[(g * 3 + m) * 64 + cl];
            ((float*)(a.ws + WS_MOD))[((size_t)l * 3 + m) * 6144 + col] = s;
        }
        __syncthreads();
    }
    for (int i = bid * NT + tid; i < 16384; i += nb * NT) {
        float s, c;
        sincospif((float)i / 8192.0f, &s, &c);  ((float2*)(a.ws + WS_TW1))[i] = make_float2(c, -s);
        sincospif((float)i / 16384.0f, &s, &c); ((float2*)(a.ws + WS_TW2))[i] = make_float2(c, -s);
    }
    for (int i = bid * NT + tid; i < 4 * 32 * 1024; i += nb * NT) {
        const int l = i >> 15, e = (i >> 10) & 31, col = i & 1023;
        ((float*)(a.ws + WS_RWT))[i] = a.in[I_ERW][(size_t)l * 32768 + col * 32 + e];
    }
    for (int i = bid * NT + tid; i < 2048 * 64; i += nb * NT) {
        const int col = i >> 6, k = i & 63;
        const float w = a.in[I_HFWOUT][(size_t)k * 2048 + col];
        const unsigned hi = cvt_pk_bf16(w, 0.f) & 0xffffu, lo = cvt_pk_bf16(w - bf_lo(hi), 0.f) & 0xffffu;
        ((bf16_t*)(a.ws + WS_HWOT))[i] = (bf16_t)hi; ((bf16_t*)(a.ws + WS_HWOT))[2048 * 64 + i] = (bf16_t)lo;
    }
}


template <bool SRC_IN, bool COMBINE, bool ROUTER, bool FINAL>
__device__ __forceinline__ void phase_norm(const Args& a, unsigned char* lds, int layer, int shadow = 0) {
    const size_t shoff = shadow ? (size_t)(WS_SHADOW_ABS - WS_ASGE) : 0;
    const int tid = otid(), lane = tid & 63, wid = tid >> 6;
    float* X = (float*)(a.ws + WS_X);
    int* padstart = (int*)(lds + LDS_USER);
    float* rwt = (float*)(lds + LDS_USER + 256);
    if (COMBINE) {
        if (tid == 0) {
            const int* cnt = (const int*)(a.ws + WS_CNT2) + (layer - 1) * 32 * CSTR;
            int acc = 0;
            for (int e = 0; e < 32; ++e) { padstart[e] = acc; acc += ((cnt[e * CSTR] + 255) >> 8) << 8; }
        }
    }
    if (ROUTER) {
        const float4* src = (const float4*)(a.ws + WS_RWT) + (size_t)layer * 8192;
        for (int i = tid; i < 8192; i += NT) ((float4*)rwt)[i] = src[i];
    }
    if (COMBINE || ROUTER) __syncthreads();
    const float* modbase = (const float*)(a.ws + WS_MOD);
    const int rstride = gridDim.x * 8;
    auto ldx = [&](int r, float4 (&x)[4]) {
        if (SRC_IN) {
            const int bb = r / RPB, ww = r - bb * RPB;
            const float* src = ww < CTX ? a.in[I_CTX] + ((size_t)bb * CTX + ww) * D : a.in[I_X] + ((size_t)bb * SEQ + (ww - CTX)) * D;
#pragma unroll
            for (int q = 0; q < 4; ++q) x[q] = *(const float4*)(src + q * 256 + lane * 4);
        } else {
#pragma unroll
            for (int q = 0; q < 4; ++q) x[q] = *(const float4*)(X + (size_t)r * D + q * 256 + lane * 4);
        }
    };
    auto ldasg = [&](int r, int4& e4, float4& g4) { e4 = *(const int4*)((const int*)(a.ws + WS_ASGE) + (size_t)r * 4); g4 = *(const float4*)((const float*)(a.ws + WS_ASGG) + (size_t)r * 4); };
    auto ldyb = [&](const int4& e4, u32x2 (&y)[4][4]) {
        const int es[4] = { e4.x, e4.y, e4.z, e4.w };
#pragma unroll
        for (int k = 0; k < 4; ++k) {
            const size_t yrow = (size_t)padstart[es[k] >> 24] + (es[k] & 0xffffff);
            const bf16_t* yb = (const bf16_t*)(a.ws + WS_YB) + yrow * D;
#pragma unroll
            for (int q = 0; q < 4; ++q) y[k][q] = *(const u32x2*)(yb + q * 256 + lane * 4);
        }
    };
    float4 xn[4]; int4 ae0 = {0, 0, 0, 0}, ae1 = {0, 0, 0, 0}; float4 ag0 = {0.f, 0.f, 0.f, 0.f}, ag1 = ag0; u32x2 ybn[4][4];
    int row = blockIdx.x * 8 + wid;
    if (row < T) {
        ldx(row, xn);
        if (COMBINE) { ldasg(row, ae0, ag0); if (row + rstride < T) ldasg(row + rstride, ae1, ag1); ldyb(ae0, ybn); }
    }
    for (; row < T; row += rstride) {
        const int b = row / RPB, within = row - b * RPB, midx = within < CTX ? 2 : b;
        float4 xv[4]; float4 agc = ag0; u32x2 ybc[4][4];
#pragma unroll
        for (int q = 0; q < 4; ++q) xv[q] = xn[q];
        if (COMBINE) {
#pragma unroll
            for (int k = 0; k < 4; ++k)
#pragma unroll
                for (int q = 0; q < 4; ++q) ybc[k][q] = ybn[k][q];
        }
        {
            const int nrow = row + rstride;
            if (nrow < T) {
                ldx(nrow, xn);
                if (COMBINE) { ae0 = ae1; ag0 = ag1; ldyb(ae0, ybn); if (nrow + rstride < T) ldasg(nrow + rstride, ae1, ag1); }
            }
        }
        if (SRC_IN) {
#pragma unroll
            for (int q = 0; q < 4; ++q) *(float4*)(X + (size_t)row * D + q * 256 + lane * 4) = xv[q];
        }
        if (COMBINE) {
            const float gk[4] = { agc.x, agc.y, agc.z, agc.w };
            float4 f[4];
#pragma unroll
            for (int q = 0; q < 4; ++q) f[q] = make_float4(0.f, 0.f, 0.f, 0.f);
#pragma unroll
            for (int k = 0; k < 4; ++k) {
                const float gate = gk[k];
#pragma unroll
                for (int q = 0; q < 4; ++q) {
                    const u32x2 u = ybc[k][q];
                    f[q].x += gate * bf_lo(u[0]); f[q].y += gate * bf_hi(u[0]); f[q].z += gate * bf_lo(u[1]); f[q].w += gate * bf_hi(u[1]);
                }
            }
            const float* g2 = modbase + ((size_t)(layer - 1) * 3 + midx) * 6144 + 5 * 1024;
#pragma unroll
            for (int q = 0; q < 4; ++q) {
                const float4 g = *(const float4*)(g2 + q * 256 + lane * 4);
                xv[q].x += g.x * f[q].x; xv[q].y += g.y * f[q].y; xv[q].z += g.z * f[q].z; xv[q].w += g.w * f[q].w;
                if (!FINAL) *(float4*)((shadow ? (float*)(a.ws + WS_MIX) : X) + (size_t)row * D + q * 256 + lane * 4) = xv[q];
            }
        }
        if (FINAL) {
            if (within >= CTX) {
                float* o = a.out + ((size_t)b * SEQ + (within - CTX)) * D;
#pragma unroll
                for (int q = 0; q < 4; ++q) *(float4*)(o + q * 256 + lane * 4) = xv[q];
            }
            continue;
        }
        float ss = 0.f;
#pragma unroll
        for (int q = 0; q < 4; ++q) ss += xv[q].x * xv[q].x + xv[q].y * xv[q].y + xv[q].z * xv[q].z + xv[q].w * xv[q].w;
        ss = wave_sum(ss);
        const float rstd = rsqrtf(ss * (1.f / 1024.f) + 1e-6f);
        const float* gn = a.in[ROUTER ? I_NFFN : I_NMIX] + layer * 1024;
        const float* mod = modbase + ((size_t)layer * 3 + midx) * 6144 + (ROUTER ? 3 * 1024 : 0);
        float4 hv[4];
#pragma unroll
        for (int q = 0; q < 4; ++q) {
            const int c = q * 256 + lane * 4;
            const float4 g = *(const float4*)(gn + c), sh = *(const float4*)(mod + c), sc = *(const float4*)(mod + 1024 + c);
            hv[q].x = xv[q].x * rstd * g.x * (1.f + sc.x) + sh.x; hv[q].y = xv[q].y * rstd * g.y * (1.f + sc.y) + sh.y;
            hv[q].z = xv[q].z * rstd * g.z * (1.f + sc.z) + sh.z; hv[q].w = xv[q].w * rstd * g.w * (1.f + sc.w) + sh.w;
            u32x2 o = { cvt_pk_bf16(hv[q].x, hv[q].y), cvt_pk_bf16(hv[q].z, hv[q].w) };
            *(u32x2*)((bf16_t*)(a.ws + WS_H) + (size_t)row * D + c) = o;
        }
        if (ROUTER) {
            float p[32];
#pragma unroll
            for (int e = 0; e < 32; ++e) {
                float s = 0.f;
#pragma unroll
                for (int q = 0; q < 4; ++q) { const float4 w = *(const float4*)(rwt + e * 1024 + q * 256 + lane * 4); s += hv[q].x * w.x + hv[q].y * w.y + hv[q].z * w.z + hv[q].w * w.w; }
                p[e] = s;
                if ((e & 3) == 3) __builtin_amdgcn_sched_barrier(0);
            }
#pragma unroll
            for (int i = 0; i < 16; ++i) { const bool hi = lane & 32; const float snd = hi ? p[i] : p[i + 16], kp = hi ? p[i + 16] : p[i]; p[i] = kp + __shfl_xor(snd, 32); }
#pragma unroll
            for (int i = 0; i < 8; ++i)  { const bool hi = lane & 16; const float snd = hi ? p[i] : p[i + 8],  kp = hi ? p[i + 8]  : p[i]; p[i] = kp + __shfl_xor(snd, 16); }
#pragma unroll
            for (int i = 0; i < 4; ++i)  { const bool hi = lane & 8;  const float snd = hi ? p[i] : p[i + 4],  kp = hi ? p[i + 4]  : p[i]; p[i] = kp + __shfl_xor(snd, 8); }
#pragma unroll
            for (int i = 0; i < 2; ++i)  { const bool hi = lane & 4;  const float snd = hi ? p[i] : p[i + 2],  kp = hi ? p[i + 2]  : p[i]; p[i] = kp + __shfl_xor(snd, 4); }
            { const bool hi = lane & 2; const float snd = hi ? p[0] : p[1], kp = hi ? p[1] : p[0]; p[0] = kp + __shfl_xor(snd, 2); }
            p[0] += __shfl_xor(p[0], 1);
            const int myE = ((lane >> 5) & 1) * 16 + ((lane >> 4) & 1) * 8 + ((lane >> 3) & 1) * 4 + ((lane >> 2) & 1) * 2 + ((lane >> 1) & 1);
            float v = p[0] + a.in[I_ERB][layer * 32 + myE];
            float tv[4]; int ti[4];
#pragma unroll
            for (int r = 0; r < 4; ++r) {
                float bv = v; int bi = myE;
#pragma unroll
                for (int o = 32; o >= 1; o >>= 1) { const float ov = __shfl_xor(bv, o); const int oi = __shfl_xor(bi, o); if (ov > bv || (ov == bv && oi < bi)) { bv = ov; bi = oi; } }
                tv[r] = bv; ti[r] = bi;
                if (myE == bi) v = -INFINITY;
            }
            {
                const float e1 = __expf(tv[1] - tv[0]), e2 = __expf(tv[2] - tv[0]), e3 = __expf(tv[3] - tv[0]);
                const float inv = 1.f / (1.f + e1 + e2 + e3);
                const int   me = lane == 0 ? ti[0] : (lane == 1 ? ti[1] : (lane == 2 ? ti[2] : ti[3]));
                const float mg = lane == 0 ? inv : (lane == 1 ? e1 * inv : (lane == 2 ? e2 * inv : e3 * inv));
                if (lane < 4) {
                    int* cnt = (int*)(a.ws + WS_CNT2) + layer * 32 * CSTR + (shadow ? CSTR / 2 : 0);
                    const int slot = (SHADOW_NOATOM && shadow) ? (row & 4095) : atomicAdd(&cnt[me * CSTR], 1);
                    ((int*)(a.ws + shoff + WS_TOKL))[(size_t)me * T + slot] = row;
                    ((int*)(a.ws + shoff + WS_ASGE))[(size_t)row * 4 + lane] = (me << 24) | slot;
                    ((float*)(a.ws + shoff + WS_ASGG))[(size_t)row * 4 + lane] = mg;
                }
            }
        }
    }
}

namespace rt {
constexpr int RCAP = 320;
constexpr int TROW = 2064;
constexpr int PS = 36;
constexpr int OFF_CNT = LDS_USER;
constexpr int OFF_ABE = OFF_CNT + 256;
constexpr int OFF_ABG = OFF_ABE + RCAP * 16;
constexpr int OFF_TILE = OFF_ABG + RCAP * 16;
constexpr int OFF_PART = OFF_TILE + 2 * 16 * TROW;
constexpr int OFF_END = OFF_PART + 8 * 16 * PS * 4;
static_assert(OFF_END <= LDS_BYTES && OFF_TILE % 16 == 0 && OFF_PART % 16 == 0, "router LDS layout");
}
__device__ __forceinline__ void phase_norm_router(const Args& a, unsigned char* lds, int layer, int shadow = 0) {
    const size_t shoff = shadow ? (size_t)(WS_SHADOW_ABS - WS_ASGE) : 0;
    const int tid = otid(), lane = tid & 63, wid = tid >> 6, fr = lane & 15, fq = lane >> 4;
    const float* X = (const float*)(a.ws + WS_X);
    int* lcnt = (int*)(lds + rt::OFF_CNT); int* gbase = lcnt + 32;
    int* abe = (int*)(lds + rt::OFF_ABE); float* abg = (float*)(lds + rt::OFF_ABG);
    unsigned char* tile = lds + rt::OFF_TILE; float* part = (float*)(lds + rt::OFF_PART);
    if (tid < 32) lcnt[tid] = 0;
    bf16x8 Wh[4][2], Wl[4][2];
    {
        const float* rw = (const float*)(a.ws + WS_RWT) + (size_t)layer * 32768;
#pragma unroll
        for (int ks = 0; ks < 4; ++ks)
#pragma unroll
            for (int b = 0; b < 2; ++b) {
                const float* p = rw + (size_t)(b * 16 + fr) * 1024 + wid * 128 + ks * 32 + fq * 8;
                const float4 w0 = *(const float4*)p, w1 = *(const float4*)(p + 4);
                u32x4 h, l;
                h[0] = cvt_pk_bf16(w0.x, w0.y); h[1] = cvt_pk_bf16(w0.z, w0.w); h[2] = cvt_pk_bf16(w1.x, w1.y); h[3] = cvt_pk_bf16(w1.z, w1.w);
                l[0] = cvt_pk_bf16(w0.x - bf_lo(h[0]), w0.y - bf_hi(h[0])); l[1] = cvt_pk_bf16(w0.z - bf_lo(h[1]), w0.w - bf_hi(h[1]));
                l[2] = cvt_pk_bf16(w1.x - bf_lo(h[2]), w1.y - bf_hi(h[2])); l[3] = cvt_pk_bf16(w1.z - bf_lo(h[3]), w1.w - bf_hi(h[3]));
                Wh[ks][b] = __builtin_bit_cast(bf16x8, h); Wl[ks][b] = __builtin_bit_cast(bf16x8, l);
            }
    }
    const float* modbase = (const float*)(a.ws + WS_MOD);
    const int rstride = gridDim.x * 8, row0 = blockIdx.x * 8 + wid;
    const int niter = (T - (int)blockIdx.x * 8 + rstride - 1) / rstride;
    auto ldx = [&](int r, float4 (&x)[4]) {
#pragma unroll
        for (int q = 0; q < 4; ++q) x[q] = *(const float4*)(X + (size_t)r * D + q * 256 + lane * 4);
    };
    float4 xn[4];
    if (row0 < T) ldx(row0, xn);
    const float biasv = a.in[I_ERB][layer * 32 + (lane & 31)];
    __syncthreads();
    for (int i0 = 0; i0 < niter; i0 += 2) {
#pragma unroll
        for (int ii = 0; ii < 2; ++ii) {
            const int row = row0 + (i0 + ii) * rstride;
            if (row < T) {
                const int b = row / RPB, within = row - b * RPB, midx = within < CTX ? 2 : b;
                float4 xv[4];
#pragma unroll
                for (int q = 0; q < 4; ++q) xv[q] = xn[q];
                if (row + rstride < T) ldx(row + rstride, xn);
                float ss = 0.f;
#pragma unroll
                for (int q = 0; q < 4; ++q) ss += xv[q].x * xv[q].x + xv[q].y * xv[q].y + xv[q].z * xv[q].z + xv[q].w * xv[q].w;
                ss = wave_sum(ss);
                const float rstd = rsqrtf(ss * (1.f / 1024.f) + 1e-6f);
                const float* gn = a.in[I_NFFN] + layer * 1024;
                const float* mod = modbase + ((size_t)layer * 3 + midx) * 6144 + 3 * 1024;
                unsigned char* trow = tile + (ii * 8 + wid) * rt::TROW;
#pragma unroll
                for (int q = 0; q < 4; ++q) {
                    const int c = q * 256 + lane * 4;
                    const float4 g = *(const float4*)(gn + c), sh = *(const float4*)(mod + c), sc = *(const float4*)(mod + 1024 + c);
                    float4 hv;
                    hv.x = xv[q].x * rstd * g.x * (1.f + sc.x) + sh.x; hv.y = xv[q].y * rstd * g.y * (1.f + sc.y) + sh.y;
                    hv.z = xv[q].z * rstd * g.z * (1.f + sc.z) + sh.z; hv.w = xv[q].w * rstd * g.w * (1.f + sc.w) + sh.w;
                    const u32x2 hi = { cvt_pk_bf16(hv.x, hv.y), cvt_pk_bf16(hv.z, hv.w) };
                    const u32x2 lo = { cvt_pk_bf16(hv.x - bf_lo(hi[0]), hv.y - bf_hi(hi[0])), cvt_pk_bf16(hv.z - bf_lo(hi[1]), hv.w - bf_hi(hi[1])) };
                    *(u32x2*)((bf16_t*)(a.ws + WS_H) + (size_t)row * D + c) = hi;
                    *(u32x2*)(trow + c * 2) = hi;
                    *(u32x2*)(trow + 16 * rt::TROW + c * 2) = lo;
                }
            }
        }
        __syncthreads();
        {
            f32x4 acc[2] = { (f32x4){0.f, 0.f, 0.f, 0.f}, (f32x4){0.f, 0.f, 0.f, 0.f} };
#pragma unroll
            for (int ks = 0; ks < 4; ++ks) {
                const unsigned char* p = tile + fr * rt::TROW + (wid * 128 + ks * 32 + fq * 8) * 2;
                const bf16x8 Bh = *(const bf16x8*)p, Bl = *(const bf16x8*)(p + 16 * rt::TROW);
#pragma unroll
                for (int b = 0; b < 2; ++b) {
                    acc[b] = __builtin_amdgcn_mfma_f32_16x16x32_bf16(Wh[ks][b], Bh, acc[b], 0, 0, 0);
                    acc[b] = __builtin_amdgcn_mfma_f32_16x16x32_bf16(Wl[ks][b], Bh, acc[b], 0, 0, 0);
                    acc[b] = __builtin_amdgcn_mfma_f32_16x16x32_bf16(Wh[ks][b], Bl, acc[b], 0, 0, 0);
                }
            }
#pragma unroll
            for (int b = 0; b < 2; ++b) *(f32x4*)(part + (wid * 16 + fr) * rt::PS + b * 16 + fq * 4) = acc[b];
        }
        __syncthreads();
        {
            const int hf = lane >> 5, tr = 2 * wid + hf, e = lane & 31;
            float v = biasv;
#pragma unroll
            for (int w = 0; w < 8; ++w) v += part[(w * 16 + tr) * rt::PS + e];
            const int ww = tr & 7, it = i0 + (tr >> 3);
            const int row = blockIdx.x * 8 + ww + it * rstride;
            float tv[4]; int ti[4];
#pragma unroll
            for (int r = 0; r < 4; ++r) {
                float m = v;
                m = fmaxf(m, dpp_f<0x128>(m)); m = fmaxf(m, dpp_f<0x124>(m)); m = fmaxf(m, dpp_f<0x122>(m)); m = fmaxf(m, dpp_f<0x121>(m));
                const float m0 = __int_as_float(__builtin_amdgcn_readlane(__float_as_int(m), 0)),  m1 = __int_as_float(__builtin_amdgcn_readlane(__float_as_int(m), 16));
                const float m2 = __int_as_float(__builtin_amdgcn_readlane(__float_as_int(m), 32)), m3 = __int_as_float(__builtin_amdgcn_readlane(__float_as_int(m), 48));
                const float mx = hf ? fmaxf(m2, m3) : fmaxf(m0, m1);
                const unsigned long long bal = __ballot(v == mx);
                const unsigned hm = hf ? (unsigned)(bal >> 32) : (unsigned)bal;
                const int first = __ffs(hm) - 1;
                tv[r] = mx; ti[r] = first;
                if (e == first) v = -INFINITY;
            }
            const float e1 = __expf(tv[1] - tv[0]), e2 = __expf(tv[2] - tv[0]), e3 = __expf(tv[3] - tv[0]);
            const float inv = 1.f / (1.f + e1 + e2 + e3);
            const int   me = e == 0 ? ti[0] : (e == 1 ? ti[1] : (e == 2 ? ti[2] : ti[3]));
            const float mg = e == 0 ? inv : (e == 1 ? e1 * inv : (e == 2 ? e2 * inv : e3 * inv));
            if (e < 4 && row < T && it < niter) {
                const int ls = atomicAdd(&lcnt[me], 1);
                const int li = it * 8 + ww;
                abe[li * 4 + e] = (me << 24) | ls;
                abg[li * 4 + e] = mg;
            }
        }
    }
    __syncthreads();
    if (tid < 32) {
        int* cnt = (int*)(a.ws + WS_CNT2) + layer * 32 * CSTR + (shadow ? CSTR / 2 : 0);
        gbase[tid] = atomicAdd(&cnt[tid * CSTR], lcnt[tid]);
    }
    __syncthreads();
    for (int idx = tid; idx < niter * 32; idx += NT) {
        const int li = idx >> 2, k = idx & 3, row = blockIdx.x * 8 + (li & 7) + (li >> 3) * rstride;
        if (row < T) {
            const int ev = abe[idx], e = ev >> 24, slot = gbase[e] + (ev & 0xffffff);
            ((int*)(a.ws + shoff + WS_TOKL))[(size_t)e * T + slot] = row;
            ((int*)(a.ws + shoff + WS_ASGE))[(size_t)row * 4 + k] = (e << 24) | slot;
            ((float*)(a.ws + shoff + WS_ASGG))[(size_t)row * 4 + k] = abg[idx];
        }
    }
}
struct ALoadMix {
    const bf16_t* H; const float* mu;
    __device__ __forceinline__ u32x4 load(int row, int k) const {
        const int within = row % RPB;
        const bool first = (within == 0) || (within == CTX), last = (within == CTX - 1) || (within == RPB - 1);
        const bf16_t* p = H + (size_t)row * D + k;
        const u32x4 c = *(const u32x4*)p;
        u32x4 pv = {0u, 0u, 0u, 0u}, nv = {0u, 0u, 0u, 0u};
        if (!first) pv = *(const u32x4*)(p - D);
        if (!last)  nv = *(const u32x4*)(p + D);
        const float4 m0 = *(const float4*)(mu + k), m1 = *(const float4*)(mu + k + 4);
        const float mm[8] = { m0.x, m0.y, m0.z, m0.w, m1.x, m1.y, m1.z, m1.w };
        u32x4 o;
#pragma unroll
        for (int i = 0; i < 4; ++i) {
            const float h0 = bf_lo(c[i]), h1 = bf_hi(c[i]);
            const float x0 = h0 + (0.5f * (bf_lo(pv[i]) + bf_lo(nv[i])) - h0) * mm[2 * i];
            const float x1 = h1 + (0.5f * (bf_hi(pv[i]) + bf_hi(nv[i])) - h1) * mm[2 * i + 1];
            o[i] = cvt_pk_bf16(x0, x1);
        }
        return o;
    }
};

__device__ __forceinline__ void phase_rwkv_mix(const Args& a, int j) {
    const int tid = otid();
    const bf16_t* H = (const bf16_t*)(a.ws + WS_H);
    const float* mu = a.in[I_RMU] + (size_t)j * 6 * D;
#pragma unroll 2
    for (int it = blockIdx.x * NT + tid; it < T * 128; it += gridDim.x * NT) {
        const int row = it >> 7, k = (it & 127) * 8;
        const int within = row % RPB;
        const bool first = (within == 0) || (within == CTX), last = (within == CTX - 1) || (within == RPB - 1);
        const bf16_t* p = H + (size_t)row * D + k;
        const u32x4 c = *(const u32x4*)p;
        u32x4 pv = {0u, 0u, 0u, 0u}, nv = {0u, 0u, 0u, 0u};
        if (!first) pv = *(const u32x4*)(p - D);
        if (!last)  nv = *(const u32x4*)(p + D);
        float hc[8], xx[8];
#pragma unroll
        for (int i = 0; i < 4; ++i) {
            hc[2 * i] = bf_lo(c[i]); hc[2 * i + 1] = bf_hi(c[i]);
            xx[2 * i] = 0.5f * (bf_lo(pv[i]) + bf_lo(nv[i])) - hc[2 * i]; xx[2 * i + 1] = 0.5f * (bf_hi(pv[i]) + bf_hi(nv[i])) - hc[2 * i + 1];
        }
#pragma unroll
        for (int g = 0; g < 3; ++g) {
            const int mi = (g == 0) ? 0 : (g == 1 ? 2 : 3);
            const float4 m0 = *(const float4*)(mu + mi * D + k), m1 = *(const float4*)(mu + mi * D + k + 4);
            const float mm[8] = { m0.x, m0.y, m0.z, m0.w, m1.x, m1.y, m1.z, m1.w };
            u32x4 o;
#pragma unroll
            for (int i = 0; i < 4; ++i) o[i] = cvt_pk_bf16(hc[2 * i] + xx[2 * i] * mm[2 * i], hc[2 * i + 1] + xx[2 * i + 1] * mm[2 * i + 1]);
            *(u32x4*)((bf16_t*)(a.ws + (g == 0 ? RW_XR : (g == 1 ? RW_XK : RW_XV))) + (size_t)row * D + k) = o;
        }
    }
}
__device__ __forceinline__ void phase_rwkv_proj1(const Args& a, unsigned char* lds, int j) {
    unsigned char* gl = lds + LDS_USER;
    const bf16_t* H = (const bf16_t*)(a.ws + WS_H);
    const int nl = (j == 0) ? 4 : 5, NL = 130 * nl;
    const float* mu = a.in[I_RMU] + (size_t)j * 6 * D;
    int u = blockIdx.x;
    for (; u < NL; u += gridDim.x) {
        const int mt = u / nl, nt = u - mt * nl, m0 = mt * 256;
        const int mi = (nt == 0) ? 1 : (nt == 1 ? 4 : (nt < 4 ? 5 : 3));
        const bf16_t* Bt = (const bf16_t*)(a.ws + WS_L1T) + (size_t)j * 640 * D;
        bf16_t* HL = (bf16_t*)(a.ws + RW_HL);
        ALoadMix al{ H, mu + mi * D };
        gemm_tile(al, Bt, D, 16, gl, make_epi([=](int row, int col, const f32x4& v) {
            float o[4];
#pragma unroll
            for (int i = 0; i < 4; ++i) { float x = v[i]; if (nt == 0) x = 1.f - 2.f * __builtin_amdgcn_rcpf(1.f + __expf(2.f * x));   else if (nt == 2 || nt == 3) x = sigmoidf_(x); o[i] = x; }
            u32x2 w = { cvt_pk_bf16(o[0], o[1]), cvt_pk_bf16(o[2], o[3]) };
            *(u32x2*)(HL + (size_t)row * 640 + col) = w;
        }), m0, nt * 128);
    }
    __syncthreads();
    const unsigned char* ws = a.ws;
    const int xq = blockIdx.x & 7, nxw = (gridDim.x + 7 - xq) >> 3;
    int si = blockIdx.x >> 3;
    auto next = [&](g8::UTile& t) -> bool {
        const int m4 = si / 6, s = (xq & 1) * 6 + (si - m4 * 6), mt = 4 * m4 + (xq >> 1);
        if (mt >= 130) return false;
        si += nxw;
        t.mt = mt; t.g = s >> 2; t.nt = s & 3;
        return true;
    };
    const auto ctx = g8::make_ctx(
        [=](const g8::UTile& t) { return (const bf16_t*)(ws + (t.g == 0 ? RW_XR : (t.g == 1 ? RW_XK : RW_XV))) + (size_t)t.mt * 256 * D; },
        [=](const g8::UTile& t) { return (const bf16_t*)(ws + WS_RKVT) + (size_t)(j * 3 + t.g) * D * D + (size_t)t.nt * 256 * D; },
        [=](const g8::UTile&, f32x4 (&acc)[2][2][4][2], int) { g8::zero_acc(acc); },
        [=](const g8::UTile& t, const f32x4 (&acc)[2][2][4][2], int row0, int col0) {
            bf16_t* out = uniform_ptr((bf16_t*)(ws + (t.g == 0 ? RW_R : (t.g == 1 ? RW_K : (j == 0 ? WS_VFIRST : RW_V)))));
            g8::each_acc(acc, row0, col0, [=](int row, int col, const f32x4& vv) { *(u32x2*)(out + (size_t)row * D + col) = (u32x2){ cvt_pk_bf16(vv[0], vv[1]), cvt_pk_bf16(vv[2], vv[3]) }; });
        });
    g8::gemm256_stream<false, g8::UTile>(D, (unsigned)D, gl, ctx, next);
}
template <int KS, bool DBUF, class FB, class FR, class FE>
__device__ __forceinline__ void p2_wave_run(const bf16_t* A, const bf16_t* Bt, bf16_t* out, int row0, int q_lo, int q_hi, int lane, FB fbias, FR frow, FE fe) {
    const int fr = lane & 15, fq = lane >> 4;
    bf16x8 Af[4][KS];
#pragma unroll
    for (int mb = 0; mb < 4; ++mb)
#pragma unroll
        for (int ks = 0; ks < KS; ++ks) Af[mb][ks] = *(const bf16x8*)(A + (size_t)(row0 + mb * 16 + fr) * 640 + ks * 32 + fq * 8);
    const int bcol = (fr >> 2) * 8 + (fr & 3);
    bf16x8 Bf[2][KS], Bn[2][KS];
    decltype(fbias(0)) bi[2], bn[2];
    auto ldB = [&](int q, bf16x8 (&bf)[2][KS], decltype(fbias(0)) (&bb)[2]) {
#pragma unroll
        for (int nb = 0; nb < 2; ++nb) {
#pragma unroll
            for (int ks = 0; ks < KS; ++ks) bf[nb][ks] = *(const bf16x8*)(Bt + (size_t)(q * 32 + bcol + nb * 4) * (KS * 32) + ks * 32 + fq * 8);
            bb[nb] = fbias(q * 32 + fq * 8 + nb * 4);
        }
    };
    ldB(q_lo, Bf, bi);
#pragma unroll 1
    for (int q = q_lo; q < q_hi; ++q) {
        if (DBUF) { if (q + 1 < q_hi) ldB(q + 1, Bn, bn); }
        const int c0 = q * 32 + fq * 8;
        decltype(frow(0, 0)) ex[4][2];
#pragma unroll
        for (int nb = 0; nb < 2; ++nb)
#pragma unroll
            for (int mb = 0; mb < 4; ++mb) ex[mb][nb] = frow(row0 + mb * 16 + fr, c0 + nb * 4);
        f32x4 acc[4][2];
#pragma unroll
        for (int mb = 0; mb < 4; ++mb)
#pragma unroll
            for (int nb = 0; nb < 2; ++nb) {
                acc[mb][nb] = (f32x4){0.f, 0.f, 0.f, 0.f};
#pragma unroll
                for (int ks = 0; ks < KS; ++ks) acc[mb][nb] = __builtin_amdgcn_mfma_f32_16x16x32_bf16(Bf[nb][ks], Af[mb][ks], acc[mb][nb], 0, 0, 0);
            }
#pragma unroll
        for (int mb = 0; mb < 4; ++mb) {
            const f32x4 o0 = fe(acc[mb][0], bi[0], ex[mb][0]), o1 = fe(acc[mb][1], bi[1], ex[mb][1]);
            *(u32x4*)(out + (size_t)(row0 + mb * 16 + fr) * D + c0) = (u32x4){ cvt_pk_bf16(o0[0], o0[1]), cvt_pk_bf16(o0[2], o0[3]), cvt_pk_bf16(o1[0], o1[1]), cvt_pk_bf16(o1[2], o1[3]) };
        }
        if (DBUF) {
#pragma unroll
            for (int nb = 0; nb < 2; ++nb) { bi[nb] = bn[nb];
#pragma unroll
                for (int ks = 0; ks < KS; ++ks) Bf[nb][ks] = Bn[nb][ks]; }
        } else if (q + 1 < q_hi) ldB(q + 1, Bf, bi);
    }
}
__device__ __forceinline__ void phase_rwkv_proj2(const Args& a, unsigned char* lds, int j) {
    const int tid = otid(), lane = tid & 63, wid = tid >> 6;
    const bf16_t* HL = (const bf16_t*)(a.ws + RW_HL);
    const int NG = (j == 0) ? 5 : 6;
    const int U = 520 * NG * 8, nw = gridDim.x * 8, gw = blockIdx.x * 8 + wid;
    int u = (int)(((long long)U * gw) / nw);
    const int u_hi = (int)(((long long)U * (gw + 1)) / nw);
    while (u < u_hi) {
        const int grp = u >> 3, rb = grp / NG, g = grp - rb * NG, row0 = rb * 64;
        const int run_end = ((grp + 1) << 3) < u_hi ? ((grp + 1) << 3) : u_hi;
        const int q_lo = (u & 7) * 4, q_hi = q_lo + (run_end - u) * 4;
        if (g < 2) {
            const int d = g;
            const float* w0 = a.in[I_RW0] + (size_t)(j * 2 + d) * D;
            p2_wave_run<2, true>(HL + d * 64, (const bf16_t*)(a.ws + WS_W2T) + (size_t)(j * 2 + d) * D * 64, (bf16_t*)(a.ws + (d == 0 ? RW_WD0 : RW_WD1)), row0, q_lo, q_hi, lane,
                [=](int col) { return *(const float4*)(w0 + col); }, nil_row, [=](const f32x4& v, const float4& b, Nil) {
                return (f32x4){ 0.6065306597126334f * sigmoidf_(b.x + v[0]), 0.6065306597126334f * sigmoidf_(b.y + v[1]), 0.6065306597126334f * sigmoidf_(b.z + v[2]), 0.6065306597126334f * sigmoidf_(b.w + v[3]) };
            });
        } else if (g < 4) {
            const int d = g - 2;
            const float* a0 = a.in[I_RA0] + (size_t)(j * 2 + d) * D;
            p2_wave_run<2, true>(HL + 128 + d * 64, (const bf16_t*)(a.ws + WS_A2T) + (size_t)(j * 2 + d) * D * 64, (bf16_t*)(a.ws + (d == 0 ? RW_AD0 : RW_AD1)), row0, q_lo, q_hi, lane,
                [=](int col) { return *(const float4*)(a0 + col); }, nil_row, [=](const f32x4& v, const float4& b, Nil) {
                return (f32x4){ sigmoidf_(b.x + v[0]), sigmoidf_(b.y + v[1]), sigmoidf_(b.z + v[2]), sigmoidf_(b.w + v[3]) };
            });
        } else if (g == 4) {
            p2_wave_run<6, false>(HL + 256, (const bf16_t*)(a.ws + WS_G2T) + (size_t)j * D * 192, (bf16_t*)(a.ws + RW_G), row0, q_lo, q_hi, lane,
                nil_col, nil_row, [=](const f32x4& v, Nil, Nil) { return v; });
        } else {
            bf16_t* V = (bf16_t*)(a.ws + RW_V);
            const bf16_t* VF = (const bf16_t*)(a.ws + WS_VFIRST);
            const float* v0 = a.in[I_RV0];
            struct VR { u32x2 cur, vf; };
            p2_wave_run<2, true>(HL + 512, (const bf16_t*)(a.ws + WS_V2T), V, row0, q_lo, q_hi, lane,
                [=](int col) { return *(const float4*)(v0 + col); },
                [=](int row, int col) { return VR{ *(const u32x2*)(V + (size_t)row * D + col), *(const u32x2*)(VF + (size_t)row * D + col) }; },
                [=](const f32x4& v, const float4& b, const VR& rr) {
                const float cur[4] = { bf_lo(rr.cur[0]), bf_hi(rr.cur[0]), bf_lo(rr.cur[1]), bf_hi(rr.cur[1]) }, vf[4] = { bf_lo(rr.vf[0]), bf_hi(rr.vf[0]), bf_lo(rr.vf[1]), bf_hi(rr.vf[1]) };
                return (f32x4){ cur[0] + (vf[0] - cur[0]) * sigmoidf_(b.x + v[0]), cur[1] + (vf[1] - cur[1]) * sigmoidf_(b.y + v[1]),
                                cur[2] + (vf[2] - cur[2]) * sigmoidf_(b.z + v[2]), cur[3] + (vf[3] - cur[3]) * sigmoidf_(b.w + v[3]) };
            });
        }
        u = run_end;
    }
}
constexpr int WK_CH = 32;
constexpr int WK_VEC = 5 * WK_CH * 64 * 4, WK_VQ = WK_CH * 16 * 4, WK_BUF = WK_VEC + WK_VQ;
constexpr int WK_YP = WK_CH * 16 * 4 * 4;
typedef float f32x2 __attribute__((ext_vector_type(2)));
__device__ __forceinline__ void phase_wkv(const Args& a, unsigned char* lds, int j) {
    const int tid = otid(), lane = tid & 63, wid = tid >> 6;
    unsigned char* base = lds + LDS_USER;
    float* ypart = (float*)(base + 2 * WK_BUF);
    const float* R = (const float*)(a.ws + RW_R); const float* K = (const float*)(a.ws + RW_K);
    const float* V = (const float*)(a.ws + (j == 0 ? WS_VFIRST : RW_V));
    for (int unit = blockIdx.x; unit < 256; unit += gridDim.x) {
        const int chain = unit >> 2, qv = unit & 3, b = chain >> 5, h = (chain >> 1) & 15, d = chain & 1;
        const float* WD = (const float*)(a.ws + (d == 0 ? RW_WD0 : RW_WD1));
        const float* AD = (const float*)(a.ws + (d == 0 ? RW_AD0 : RW_AD1));
        float* Y = (float*)(a.ws + (d == 0 ? RW_Y0 : RW_Y1));
        const int ch0 = h * 64;
        auto rowof = [&](int t) -> size_t { const int p = (d == 0) ? t : ((t < CTX) ? (CTX - 1 - t) : (RPB + CTX - 1 - t)); return (size_t)b * RPB + p; };
        constexpr int NCH = RPB / WK_CH;
        if (wid >= 4) {
            const int sw = wid - 4;
            const float kkw = a.in[I_RKK][j * D + ch0 + lane], kaw = a.in[I_RKA][j * D + ch0 + lane];
            float fr[8], fk[8], fw[8], fa[8], fv[8];
            auto issue = [&](int c) {
#pragma unroll
                for (int i = 0; i < 8; ++i) {
                    const size_t row = rowof(c * WK_CH + sw * 8 + i); const size_t o = row * D + ch0 + lane;
                    fr[i] = R[o]; fk[i] = K[o]; fw[i] = WD[o]; fa[i] = AD[o];
                    fv[i] = V[row * D + ch0 + qv * 16 + (lane & 15)];
                }
            };
            auto process = [&](int buf) {
                float* vec = (float*)(base + buf * WK_BUF); float* vq = (float*)(base + buf * WK_BUF + WK_VEC);
                float kkv[8], n2[8];
#pragma unroll
                for (int i = 0; i < 8; ++i) { kkv[i] = fk[i] * kkw; n2[i] = row16_sum(kkv[i] * kkv[i]); }
#pragma unroll
                for (int i = 0; i < 8; ++i) n2[i] += __shfl_xor(n2[i], 16);
#pragma unroll
                for (int i = 0; i < 8; ++i) n2[i] += __shfl_xor(n2[i], 32);
#pragma unroll
                for (int i = 0; i < 8; ++i) {
                    const int s = sw * 8 + i;
                    const float kk = kkv[i] / fmaxf(sqrtf(n2[i]), 1e-12f);
                    vec[(0 * WK_CH + s) * 64 + lane] = fr[i]; vec[(1 * WK_CH + s) * 64 + lane] = fw[i]; vec[(2 * WK_CH + s) * 64 + lane] = kk;
                    vec[(3 * WK_CH + s) * 64 + lane] = kk * fa[i]; vec[(4 * WK_CH + s) * 64 + lane] = fk[i] * (1.f + (fa[i] - 1.f) * kaw);
                    if (lane < 16) vq[s * 16 + lane] = fv[i];
                }
            };
            auto yout = [&](int c, int buf) {
                const int st = tid - 256;
#pragma unroll
                for (int i = 0; i < 2; ++i) {
                    const int idx = st + i * 256, s = idx >> 4, i16 = idx & 15;
                    const float4 p = *(const float4*)(ypart + buf * (WK_CH * 64) + idx * 4);
                    Y[rowof(c * WK_CH + s) * D + ch0 + qv * 16 + i16] = (p.x + p.y) + (p.z + p.w);
                }
            };
            issue(0); process(0); issue(1);
            __syncthreads();
            for (int c = 0; c < NCH; ++c) {
                if (c > 0) yout(c - 1, (c - 1) & 1);
                if (c + 1 < NCH) { process((c + 1) & 1); if (c + 2 < NCH) issue(c + 2); }
                __syncthreads();
            }
            yout(NCH - 1, (NCH - 1) & 1);
        } else {
            f32x2 S01 = {0.f, 0.f}, S23 = {0.f, 0.f};
            const int vl = wid * 4 + (lane >> 4), k0 = (lane & 15) * 4;
            __syncthreads();
            for (int c = 0; c < NCH; ++c) {
                const float* vec = (const float*)(base + (c & 1) * WK_BUF); const float* vq = (const float*)(base + (c & 1) * WK_BUF + WK_VEC);
                float* yp = ypart + (c & 1) * (WK_CH * 64) + vl * 4 + (lane & 3);
#pragma unroll 2
                for (int g = 0; g < WK_CH / 4; ++g) {
                    float yv[4];
#pragma unroll
                    for (int uu = 0; uu < 4; ++uu) {
                        const int s = g * 4 + uu;
                        const float4 r4 = *(const float4*)(vec + (0 * WK_CH + s) * 64 + k0), w4 = *(const float4*)(vec + (1 * WK_CH + s) * 64 + k0);
                        const float4 kk4 = *(const float4*)(vec + (2 * WK_CH + s) * 64 + k0), ka4 = *(const float4*)(vec + (3 * WK_CH + s) * 64 + k0);
                        const float4 kd4 = *(const float4*)(vec + (4 * WK_CH + s) * 64 + k0);
                        const float vv = vq[s * 16 + vl];
                        const f32x2 p = S01 * (f32x2){kk4.x, kk4.y} + S23 * (f32x2){kk4.z, kk4.w};
                        const float sa = -row16_sum(p.x + p.y);
                        S01 = S01 * (f32x2){w4.x, w4.y} + (f32x2){ka4.x, ka4.y} * sa + (f32x2){kd4.x, kd4.y} * vv;
                        S23 = S23 * (f32x2){w4.z, w4.w} + (f32x2){ka4.z, ka4.w} * sa + (f32x2){kd4.z, kd4.w} * vv;
                        const f32x2 q = S01 * (f32x2){r4.x, r4.y} + S23 * (f32x2){r4.z, r4.w};
                        float y = q.x + q.y;
                        y += dpp_f<0x128>(y); y += dpp_f<0x124>(y);
                        yv[uu] = y;
                    }
                    if ((lane & 15) < 4) {
#pragma unroll
                        for (int uu = 0; uu < 4; ++uu) yp[(g * 4 + uu) * 64] = yv[uu];
                    }
                }
                __syncthreads();
            }
        }
        __syncthreads();
    }
}
__device__ __forceinline__ void phase_rwkv_readout(const Args& a, int j) {
    const int tid = otid(), lane = tid & 63, wid = tid >> 6;
    const bf16_t* R = (const bf16_t*)(a.ws + RW_R); const bf16_t* K = (const bf16_t*)(a.ws + RW_K);
    const bf16_t* V = (const bf16_t*)(a.ws + (j == 0 ? WS_VFIRST : RW_V)); const bf16_t* G = (const bf16_t*)(a.ws + RW_G);
    const bf16_t* A0 = (const bf16_t*)(a.ws + RW_AD0); const bf16_t* A1 = (const bf16_t*)(a.ws + RW_AD1);
    const float* Y0 = (const float*)(a.ws + RW_Y0); const float* Y1 = (const float*)(a.ws + RW_Y1);
    bf16_t* Z = (bf16_t*)(a.ws + RW_Z);
    const float* lng = a.in[I_RLNG] + j * D; const float* lnb = a.in[I_RLNB] + j * D; const float* rk = a.in[I_RRK] + j * D; const float* ka = a.in[I_RKA] + j * D;
    for (int row = blockIdx.x * 8 + wid; row < T; row += gridDim.x * 8) {
        float4 y0v[4], y1v[4]; u32x2 r4v[4], k4v[4], v4v[4], g4v[4], a0v[4], a1v[4];
#pragma unroll
        for (int q = 0; q < 4; ++q) {
            const size_t o = (size_t)row * D + q * 256 + lane * 4;
            y0v[q] = *(const float4*)(Y0 + o); y1v[q] = *(const float4*)(Y1 + o); r4v[q] = *(const u32x2*)(R + o); k4v[q] = *(const u32x2*)(K + o);
            v4v[q] = *(const u32x2*)(V + o); g4v[q] = *(const u32x2*)(G + o); a0v[q] = *(const u32x2*)(A0 + o); a1v[q] = *(const u32x2*)(A1 + o);
        }
#pragma unroll
        for (int q = 0; q < 4; ++q) {
            const int c = q * 256 + lane * 4; const size_t o = (size_t)row * D + c;
            const float4 y0 = y0v[q], y1 = y1v[q];
            const float y[4] = { y0.x + y1.x, y0.y + y1.y, y0.z + y1.z, y0.w + y1.w };
            const float mean = row16_sum(y[0] + y[1] + y[2] + y[3]) * (1.f / 64.f);
            float dv = 0.f;
#pragma unroll
            for (int i = 0; i < 4; ++i) dv += (y[i] - mean) * (y[i] - mean);
            const float rs = rsqrtf(row16_sum(dv) * (1.f / 64.f) + 64e-5f);
            const u32x2 r4 = r4v[q], k4 = k4v[q], v4 = v4v[q], g4 = g4v[q], a04 = a0v[q], a14 = a1v[q];
            const float4 lg = *(const float4*)(lng + c), lb = *(const float4*)(lnb + c), rk4 = *(const float4*)(rk + c), ka4 = *(const float4*)(ka + c);
            const float rr[4] = { bf_lo(r4[0]), bf_hi(r4[0]), bf_lo(r4[1]), bf_hi(r4[1]) }, kk[4] = { bf_lo(k4[0]), bf_hi(k4[0]), bf_lo(k4[1]), bf_hi(k4[1]) };
            const float vv[4] = { bf_lo(v4[0]), bf_hi(v4[0]), bf_lo(v4[1]), bf_hi(v4[1]) }, gg[4] = { bf_lo(g4[0]), bf_hi(g4[0]), bf_lo(g4[1]), bf_hi(g4[1]) };
            const float aa[4] = { bf_lo(a04[0]) + bf_lo(a14[0]), bf_hi(a04[0]) + bf_hi(a14[0]), bf_lo(a04[1]) + bf_lo(a14[1]), bf_hi(a04[1]) + bf_hi(a14[1]) };
            const float lgv[4] = { lg.x, lg.y, lg.z, lg.w }, lbv[4] = { lb.x, lb.y, lb.z, lb.w }, rkv[4] = { rk4.x, rk4.y, rk4.z, rk4.w }, kav[4] = { ka4.x, ka4.y, ka4.z, ka4.w };
            float bp = 0.f;
#pragma unroll
            for (int i = 0; i < 4; ++i) bp += rr[i] * kk[i] * rkv[i] * (2.f + (aa[i] - 2.f) * kav[i]);
            const float bonus = row16_sum(bp);
            float o4[4];
#pragma unroll
            for (int i = 0; i < 4; ++i) o4[i] = ((y[i] - mean) * rs * lgv[i] + lbv[i] + bonus * vv[i]) * gg[i];
            u32x2 w = { cvt_pk_bf16(o4[0], o4[1]), cvt_pk_bf16(o4[2], o4[3]) };
            *(u32x2*)(Z + o) = w;
        }
    }
}
struct GB { float4 g, b; };
__device__ __forceinline__ void phase_outproj(const Args& a, unsigned char* lds, int layer, const bf16_t* A, const bf16_t* Bt, const float* bias) {
    unsigned char* gl = lds + LDS_USER;
    float* X = (float*)(a.ws + WS_X);
    const float* modbase = (const float*)(a.ws + WS_MOD) + (size_t)layer * 3 * 6144 + 2 * 1024;
    constexpr int OP_FULL = ((130 * 4) / 256) * 256 / 4;
    constexpr int TAIL_R0 = OP_FULL * 256, TAIL_RB = (T - TAIL_R0) / 16;
    {
        const int tid = otid(), lane = tid & 63, wid = tid >> 6, fr = lane & 15, fq = lane >> 4;
        for (int w = blockIdx.x * 8 + wid; w < TAIL_RB * 64; w += gridDim.x * 8) {
            const int rblk = w >> 6, cblk = w & 63, row = TAIL_R0 + rblk * 16 + fr, colb = cblk * 16;
            const bf16_t* ap = A + (size_t)row * D + fq * 8;
            const bf16_t* bp = Bt + (size_t)(colb + fr) * D + fq * 8;
            f32x4 acc = {0.f, 0.f, 0.f, 0.f};
#pragma unroll
            for (int kc = 0; kc < 4; ++kc) {
                bf16x8 af[8], bf[8];
#pragma unroll
                for (int ks = 0; ks < 8; ++ks) { af[ks] = *(const bf16x8*)(ap + (kc * 8 + ks) * 32); bf[ks] = *(const bf16x8*)(bp + (kc * 8 + ks) * 32); }
#pragma unroll
                for (int ks = 0; ks < 8; ++ks) acc = __builtin_amdgcn_mfma_f32_16x16x32_bf16(bf[ks], af[ks], acc, 0, 0, 0);
            }
            const int col = colb + fq * 4;
            const float4 g = *(const float4*)(modbase + (size_t)mod_index(row) * 6144 + col);
            float4 bv = make_float4(0.f, 0.f, 0.f, 0.f);
            if (bias) bv = *(const float4*)(bias + col);
            f32x4 x = *(const f32x4*)(X + (size_t)row * D + col);
            x[0] += g.x * (acc[0] + bv.x); x[1] += g.y * (acc[1] + bv.y); x[2] += g.z * (acc[2] + bv.z); x[3] += g.w * (acc[3] + bv.w);
            *(f32x4*)(X + (size_t)row * D + col) = x;
        }
    }
    const int xq = blockIdx.x & 7, nxw = (gridDim.x + 7 - xq) >> 3;
    int si = blockIdx.x >> 3;
    auto next = [&](g8::UTile& t) -> bool {
        const int mt = 8 * (si >> 2) + xq;
        if (mt >= OP_FULL) return false;
        t.mt = mt; t.nt = si & 3; t.g = 0; si += nxw;
        return true;
    };
    const auto ctx = g8::make_ctx(
        [=](const g8::UTile& t) { return A + (size_t)t.mt * 256 * D; },
        [=](const g8::UTile& t) { return Bt + (size_t)t.nt * 256 * D; },
        [=](const g8::UTile&, f32x4 (&acc)[2][2][4][2], int col0) { g8::bias_acc(acc, bias, col0); },
        [=](const g8::UTile& t, const f32x4 (&acc)[2][2][4][2], int row0, int col0) {
            const float* gp = uniform_ptr(modbase + (size_t)mod_index(t.mt * 256) * 6144);
            float4 gv[2][2];
#pragma unroll
            for (int bj = 0; bj < 2; ++bj)
#pragma unroll
                for (int n = 0; n < 2; ++n) gv[bj][n] = *(const float4*)(gp + col0 + bj * 128 + n * 16);
#pragma unroll
            for (int ai = 0; ai < 2; ++ai) {
                f32x4 x[4][2][2];
#pragma unroll
                for (int m = 0; m < 4; ++m)
#pragma unroll
                    for (int bj = 0; bj < 2; ++bj)
#pragma unroll
                        for (int n = 0; n < 2; ++n) x[m][bj][n] = *(const f32x4*)(X + (size_t)(row0 + ai * 128 + m * 16) * D + col0 + bj * 128 + n * 16);
#pragma unroll
                for (int m = 0; m < 4; ++m)
#pragma unroll
                    for (int bj = 0; bj < 2; ++bj)
#pragma unroll
                        for (int n = 0; n < 2; ++n) {
                            f32x4 o = x[m][bj][n]; const f32x4 v = acc[ai][bj][m][n]; const float4 g = gv[bj][n];
                            o[0] += g.x * v[0]; o[1] += g.y * v[1]; o[2] += g.z * v[2]; o[3] += g.w * v[3];
                            *(f32x4*)(X + (size_t)(row0 + ai * 128 + m * 16) * D + col0 + bj * 128 + n * 16) = o;
                        }
            }
        });
    g8::gemm256_stream<false, g8::UTile>(D, (unsigned)D, gl, ctx, next);
}

struct ALoadGather {
    const bf16_t* H; const int* tl; int rowbase, cnt;
    __device__ __forceinline__ u32x4 load(int row, int k) const {
        int idx = row - rowbase; idx = idx < cnt ? idx : cnt - 1;
        return *(const u32x4*)(H + (size_t)tl[idx] * D + k);
    }
};
__device__ __forceinline__ void moe_tiles(const Args& a, int layer, int* tp) {
    if (threadIdx.x == 0) {
        const int* cnt = (const int*)(a.ws + WS_CNT2) + layer * 32 * CSTR;
        int acc = 0;
        for (int e = 0; e < 32; ++e) { tp[e] = acc; acc += (cnt[e * CSTR] + 255) >> 8; }
        tp[32] = acc;
    }
    __syncthreads();
}
struct UMoe1 { int rt, nt, e, tile, ce; };
struct CMoe1 {
    const unsigned char* ws; const float* binbase; int layer;
    __device__ __forceinline__ const bf16_t* A(const UMoe1&) const { return (const bf16_t*)(ws + WS_H); }
    __device__ __forceinline__ const bf16_t* B(const UMoe1& u) const { return (const bf16_t*)(ws + WS_EWINT) + ((size_t)layer * 32 + u.e) * 2048 * D + (size_t)u.nt * 256 * D; }
    __device__ __forceinline__ int brow(const UMoe1& u) const { return u.rt * 256; }
    __device__ __forceinline__ int bcol(const UMoe1& u) const { return u.nt * 256; }
    __device__ __forceinline__ unsigned aoff(const UMoe1& u, int r) const {
        const int* tl = uniform_ptr((const int*)(ws + WS_TOKL) + (size_t)u.e * T); int idx = u.tile * 256 + r; idx = idx < u.ce ? idx : u.ce - 1; return (unsigned)tl[(unsigned)idx] * (unsigned)D; }
    __device__ __forceinline__ void init(const UMoe1& u, f32x4 (&acc)[2][2][4][2], int col0) const {
        const float* bin = uniform_ptr(binbase + ((size_t)layer * 32 + u.e) * 2048);
#pragma unroll
        for (int n = 0; n < 2; ++n) {
            const float4 bg = *(const float4*)(bin + col0 - u.nt * 128 + n * 16), bl = *(const float4*)(bin + 1024 + col0 - u.nt * 128 + n * 16);
#pragma unroll
            for (int ai = 0; ai < 2; ++ai)
#pragma unroll
                for (int m = 0; m < 4; ++m) { acc[ai][0][m][n] = (f32x4){ bg.x, bg.y, bg.z, bg.w }; acc[ai][1][m][n] = (f32x4){ bl.x, bl.y, bl.z, bl.w }; }
        }
    }
    __device__ __forceinline__ void epi(const UMoe1& u, const f32x4 (&acc)[2][2][4][2], int row0, int col0) const {
        bf16_t* ACT = uniform_ptr((bf16_t*)(ws + WS_ACT));
#pragma unroll
        for (int ai = 0; ai < 2; ++ai)
#pragma unroll
            for (int m = 0; m < 4; ++m)
#pragma unroll
                for (int n = 0; n < 2; ++n) {
                    const int row = row0 + ai * 128 + m * 16, colg = col0 - u.nt * 128 + n * 16;
                    float o[4];
#pragma unroll
                    for (int i = 0; i < 4; ++i) {
                        const float glu = fminf(acc[ai][0][m][n][i], 7.f);
                        const float lin = fminf(fmaxf(acc[ai][1][m][n][i], -7.f), 7.f);
                        o[i] = glu * sigmoidf_(1.702f * glu) * (lin + 1.f);
                    }
                    u32x2 w = { cvt_pk_bf16(o[0], o[1]), cvt_pk_bf16(o[2], o[3]) };
                    *(u32x2*)(ACT + (size_t)row * D + colg) = w;
                }
    }
};
__device__ __forceinline__ void phase_moe1(const Args& a, unsigned char* lds, int layer) {
    int* tp = (int*)(lds + LDS_USER); unsigned char* gl = lds + LDS_USER + 256;
    moe_tiles(a, layer, tp);
    const int total = tp[32];
    const int* cnt = (const int*)(a.ws + WS_CNT2) + layer * 32 * CSTR;
    const int xq = blockIdx.x & 7, xr = xq >> 1, xc = xq & 1, nxw = (gridDim.x + 7 - xq) >> 3;
    int si = blockIdx.x >> 3, ecur = 0;
    auto next = [&](UMoe1& u) -> bool {
        const int rt = MOE1_MAP == 2 ? 8 * (si >> 3) + xq : (MOE1_MAP == 4 ? 2 * (si >> 1) + (xq >> 2) : 4 * (si >> 2) + xr), nt = MOE1_MAP == 2 ? (si & 7) : (MOE1_MAP == 4 ? (xq & 3) * 2 + (si & 1) : xc * 4 + (si & 3));
        if (rt >= total) return false;
        si += nxw;
        int e = ecur;
        while (tp[e + 1] <= rt) ++e;
        e = __builtin_amdgcn_readfirstlane(e); ecur = e;
        u.rt = rt; u.nt = nt; u.e = e; u.tile = rt - __builtin_amdgcn_readfirstlane(tp[e]); u.ce = __builtin_amdgcn_readfirstlane(cnt[e * CSTR]);
        return true;
    };
    const CMoe1 ctx{ a.ws, a.in[I_EBIN], layer };
    g8::gemm256_stream<true, UMoe1>(D, (unsigned)D, gl, ctx, next);
}
struct UMoe2 { int rt, nt, e; };
struct CMoe2 {
    const unsigned char* ws; const float* boutbase; int layer;
    __device__ __forceinline__ const bf16_t* A(const UMoe2& u) const { return (const bf16_t*)(ws + WS_ACT) + (size_t)u.rt * 256 * D; }
    __device__ __forceinline__ const bf16_t* B(const UMoe2& u) const { return (const bf16_t*)(ws + WS_EWOUTT) + ((size_t)layer * 32 + u.e) * D * D + (size_t)u.nt * 256 * D; }
    __device__ __forceinline__ int brow(const UMoe2& u) const { return u.rt * 256; }
    __device__ __forceinline__ int bcol(const UMoe2& u) const { return u.nt * 256; }
    __device__ __forceinline__ unsigned aoff(const UMoe2&, int) const { return 0u; }
    __device__ __forceinline__ void init(const UMoe2& u, f32x4 (&acc)[2][2][4][2], int col0) const {
        const float* bout = uniform_ptr(boutbase + ((size_t)layer * 32 + u.e) * D);
#pragma unroll
        for (int bj = 0; bj < 2; ++bj)
#pragma unroll
            for (int n = 0; n < 2; ++n) {
                const float4 bv = *(const float4*)(bout + col0 + bj * 128 + n * 16);
#pragma unroll
                for (int ai = 0; ai < 2; ++ai)
#pragma unroll
                    for (int m = 0; m < 4; ++m) acc[ai][bj][m][n] = (f32x4){ bv.x, bv.y, bv.z, bv.w };
            }
    }
    __device__ __forceinline__ void epi(const UMoe2&, const f32x4 (&acc)[2][2][4][2], int row0, int col0) const {
        bf16_t* YB = uniform_ptr((bf16_t*)(ws + WS_YB));
#pragma unroll
        for (int ai = 0; ai < 2; ++ai)
#pragma unroll
            for (int m = 0; m < 4; ++m)
#pragma unroll
                for (int bj = 0; bj < 2; ++bj)
#pragma unroll
                    for (int n = 0; n < 2; ++n) {
                        const f32x4 v = acc[ai][bj][m][n];
                        u32x2 w = { cvt_pk_bf16(v[0], v[1]), cvt_pk_bf16(v[2], v[3]) };
                        *(u32x2*)(YB + (size_t)(row0 + ai * 128 + m * 16) * D + col0 + bj * 128 + n * 16) = w;
                    }
    }
};
__device__ __forceinline__ void phase_moe2(const Args& a, unsigned char* lds, int layer) {
    int* tp = (int*)(lds + LDS_USER); unsigned char* gl = lds + LDS_USER + 256;
    moe_tiles(a, layer, tp);
    const int total = tp[32];
    const int xq = blockIdx.x & 7, nxw = (gridDim.x + 7 - xq) >> 3;
    int si = blockIdx.x >> 3, ecur = 0;
    auto next = [&](UMoe2& u) -> bool {
        const int rt = 8 * (si >> 2) + xq, nt = si & 3;
        if (rt >= total) return false;
        si += nxw;
        int e = ecur;
        while (tp[e + 1] <= rt) ++e;
        e = __builtin_amdgcn_readfirstlane(e); ecur = e;
        u.rt = rt; u.nt = nt; u.e = e;
        return true;
    };
    const CMoe2 ctx{ a.ws, a.in[I_EBOUT], layer };
    g8::gemm256_stream<false, UMoe2>(D, (unsigned)D, gl, ctx, next);
}
namespace wk2 {
constexpr int AST = 144;
constexpr int SST = 80;
constexpr int OFF_AAT = 0, OFF_RT = 16 * AST, OFF_MT = 2 * 16 * AST, OFF_TT = OFF_MT + 16 * SST, OFF_PQ = OFF_TT + 16 * SST, OFF_BK = OFF_PQ + 16 * SST,
              OFF_WC = OFF_BK + 64 * SST, SETB = OFF_WC + 256, NSET = 8, NCHK = RPB / 16;
static_assert(SETB == (int)WKSET_B && SETB % 16 == 0, "image size");
constexpr int PW_AAT = 0, PW_RT = 16 * AST, PW_BT = 2 * 16 * AST, PW_KT = 3 * 16 * AST, PW_TT = 4 * 16 * AST, PW_N = PW_TT + 16 * SST, PWB = PW_N + 1024;
static_assert(LDS_USER + 8 * PWB <= LDS_BYTES && LDS_USER + 256 + NSET * SETB <= LDS_BYTES, "LDS budget");
constexpr int SLOTB = SETB;
constexpr int G_AAT = 0, G_RT = 2048, G_PQ = 4096, G_BK = 5120, G_MT = 9216, G_TT = 9728, G_WC = 10240, GSETB = 10496;
static_assert(GSETB <= SETB && GSETB % 128 == 0, "compact image");
typedef volatile LAS int* vflag;
}
__device__ __forceinline__ void phase_wkv_prep(const Args& a, unsigned char* lds, int j, int c_lo, int c_hi, int blk_lo, int nblk) {
    using namespace wk2;
    const int tid = otid(), lane = tid & 63, wid = tid >> 6;
    LAS unsigned char* scr = (LAS unsigned char*)(lds + LDS_USER) + wid * PWB;
    const bf16_t* R = (const bf16_t*)(a.ws + RW_R); const bf16_t* K = (const bf16_t*)(a.ws + RW_K);
    const int kc = lane >> 4, kg = (lane >> 2) & 3, kr = lane & 3, kq = kc >> 1, kj = (kc & 1) * 4 + kr;
    const int ti = lane & 15, g = lane >> 4;
    const int nch = c_hi - c_lo, nunits = 64 * nch, wstride = nblk * 8;
    unsigned qr[16], qk[16], qw[16], qa[16];
    auto issue = [&](int u) {
        const int chain = u / nch, c = c_lo + (u - chain * nch), b = chain >> 5, h = (chain >> 1) & 15, d = chain & 1;
        const bf16_t* WD = (const bf16_t*)(a.ws + (d == 0 ? RW_WD0 : RW_WD1)); const bf16_t* AD = (const bf16_t*)(a.ws + (d == 0 ? RW_AD0 : RW_AD1));
        const int t0 = c * 16, p0 = (d == 0) ? t0 : ((t0 < CTX) ? (CTX - 1 - t0) : (RPB + CTX - 1 - t0));
        const long rstep = (d == 0) ? (long)D : -(long)D;
        const size_t o0 = ((size_t)b * RPB + p0) * D + h * 64 + lane;
#pragma unroll
        for (int t = 0; t < 16; ++t) { const size_t o = o0 + t * rstep; qr[t] = R[o]; qk[t] = K[o]; qw[t] = WD[o]; qa[t] = AD[o]; }
    };
    int u = ((int)blockIdx.x - blk_lo) * 8 + wid;
    if (u < 0) u = nunits;
    if (u < nunits) issue(u);
    for (; u < nunits; u += wstride) {
        const int chain = u / nch, c = c_lo + (u - chain * nch), h = (chain >> 1) & 15;
        unsigned char* gset = a.ws + RW_SETS + ((size_t)chain * NCHK + c) * GSETB;
        const float kkw = a.in[I_RKK][j * D + h * 64 + lane], kaw = a.in[I_RKA][j * D + h * 64 + lane];
        float fr[16], fk[16], fw[16], fa[16];
#pragma unroll
        for (int t = 0; t < 16; ++t) { fr[t] = __uint_as_float(qr[t] << 16); fk[t] = __uint_as_float(qk[t] << 16); fw[t] = __expf(-__uint_as_float(qw[t] << 16)); fa[t] = __uint_as_float(qa[t] << 16); }
        float kkv[16], n2[16];
#pragma unroll
        for (int t = 0; t < 16; ++t) { kkv[t] = fk[t] * kkw; n2[t] = row16_sum(kkv[t] * kkv[t]); }
#pragma unroll
        for (int t = 0; t < 16; ++t) n2[t] += __shfl_xor(n2[t], 16);
#pragma unroll
        for (int t = 0; t < 16; ++t) n2[t] += __shfl_xor(n2[t], 32);
        float Wc = 1.f;
        unsigned bkp[16];
#pragma unroll
        for (int t = 0; t < 16; ++t) {
            const float kk = kkv[t] * rsqrtf(fmaxf(n2[t], 1e-24f));
            const float Wp = Wc; Wc *= fw[t];
            const float iw = __builtin_amdgcn_rcpf(Wc);
            const unsigned ab = cvt_pk_bf16(-kk * Wp, fr[t] * Wc);
            const unsigned bk = cvt_pk_bf16(kk * fa[t] * iw, fk[t] * (1.f + (fa[t] - 1.f) * kaw) * iw);
            bkp[t] = bk;
            const int o1 = t * AST + (((kq * 4 + kg) * 8 + kj) * 2);
            *(LAS bf16_t*)(scr + PW_AAT + o1) = (bf16_t)(ab & 0xffffu); *(LAS bf16_t*)(scr + PW_RT + o1) = (bf16_t)(ab >> 16);
            *(LAS bf16_t*)(scr + PW_BT + o1) = (bf16_t)(bk & 0xffffu);  *(LAS bf16_t*)(scr + PW_KT + o1) = (bf16_t)(bk >> 16);
        }
#pragma unroll
        for (int gg = 0; gg < 4; ++gg) {
            const unsigned b0 = bkp[4 * gg], b1 = bkp[4 * gg + 1], b2 = bkp[4 * gg + 2], b3 = bkp[4 * gg + 3];
            *(u32x4*)(gset + G_BK + lane * 64 + gg * 16) = (u32x4){ (b0 & 0xffffu) | (b1 << 16), (b2 & 0xffffu) | (b3 << 16), (b0 >> 16) | (b1 & 0xffff0000u), (b2 >> 16) | (b3 & 0xffff0000u) };
        }
        *(float*)(gset + G_WC + ((kg * 4 + kc) * 4 + kr) * 4) = Wc;
        if (u + wstride < nunits) issue(u + wstride);
        asm volatile("s_waitcnt lgkmcnt(0)" ::: "memory");
        f32x4 cN = {0.f, 0.f, 0.f, 0.f}, cM = cN, cP = cN, cQ = cN;
#pragma unroll
        for (int q = 0; q < 2; ++q) {
            const int oo = ti * AST + (q * 4 + g) * 16;
            const bf16x8 fa8 = *(const LAS bf16x8*)(scr + PW_AAT + oo), fr8 = *(const LAS bf16x8*)(scr + PW_RT + oo);
            const bf16x8 fb8 = *(const LAS bf16x8*)(scr + PW_BT + oo), fk8 = *(const LAS bf16x8*)(scr + PW_KT + oo);
            cN = __builtin_amdgcn_mfma_f32_16x16x32_bf16(fb8, fa8, cN, 0, 0, 0); cM = __builtin_amdgcn_mfma_f32_16x16x32_bf16(fk8, fa8, cM, 0, 0, 0);
            cP = __builtin_amdgcn_mfma_f32_16x16x32_bf16(fb8, fr8, cP, 0, 0, 0); cQ = __builtin_amdgcn_mfma_f32_16x16x32_bf16(fk8, fr8, cQ, 0, 0, 0);
        }
#pragma unroll
        for (int rr = 0; rr < 4; ++rr) { const int s = 4 * g + rr; if (!(s < ti)) { cN[rr] = 0.f; cM[rr] = 0.f; } if (!(s <= ti)) { cP[rr] = 0.f; cQ[rr] = 0.f; } }
#pragma unroll
        for (int rr = 0; rr < 4; ++rr) *(LAS float*)(scr + PW_N + ((4 * g + rr) * 16 + ti) * 4) = cN[rr];
        *(u32x2*)(gset + G_MT + ti * 32 + g * 8) = (u32x2){ cvt_pk_bf16(cM[0], cM[1]), cvt_pk_bf16(cM[2], cM[3]) };
        *(u32x4*)(gset + G_PQ + ti * 64 + g * 16) = (u32x4){ cvt_pk_bf16(cP[0], cP[1]), cvt_pk_bf16(cP[2], cP[3]), cvt_pk_bf16(cQ[0], cQ[1]), cvt_pk_bf16(cQ[2], cQ[3]) };
#pragma unroll
        for (int i = 0; i < 4; ++i) { const int idx = lane + i * 64, r = (idx & 127) >> 3, jj = idx & 7; *(u32x4*)(gset + G_AAT + idx * 16) = *(const LAS u32x4*)(scr + (i < 2 ? PW_AAT : PW_RT) + r * AST + jj * 16); }
        asm volatile("s_waitcnt lgkmcnt(0)" ::: "memory");
        if (lane < 16) {
            float Tr[16];
#pragma unroll
            for (int t = 0; t < 16; ++t) Tr[t] = (lane == t) ? 1.f : 0.f;
#pragma unroll
            for (int s = 0; s < 15; ++s) {
                const LAS float* nr = (const LAS float*)(scr + PW_N + s * 64);
                const float ts = Tr[s];
#pragma unroll
                for (int t = s + 1; t < 16; ++t) Tr[t] += ts * nr[t];
            }
            const int ig = lane >> 2, ij = lane & 3;
#pragma unroll
            for (int s = 0; s < 16; ++s) {
                const bf16_t tv = (bf16_t)(cvt_pk_bf16(Tr[s], 0.f) & 0xffffu);
                *(LAS bf16_t*)(scr + PW_TT + s * SST + ((ig * 8 + ij) * 2)) = tv; *(LAS bf16_t*)(scr + PW_TT + s * SST + ((ig * 8 + 4 + ij) * 2)) = tv;
            }
        }
        asm volatile("s_waitcnt lgkmcnt(0)" ::: "memory");
        if (lane < 32) {
            const int s = lane >> 1, hh = lane & 1;
            const u32x2 t0 = *(const LAS u32x2*)(scr + PW_TT + s * SST + (2 * hh) * 16), t1 = *(const LAS u32x2*)(scr + PW_TT + s * SST + (2 * hh + 1) * 16);
            *(u32x4*)(gset + G_TT + lane * 16) = (u32x4){ t0[0], t0[1], t1[0], t1[1] };
        }
        asm volatile("s_waitcnt lgkmcnt(0)" ::: "memory");
    }
}
constexpr int WK_NSEG = WKNSEG, WK_SEGC = wk2::NCHK / WK_NSEG;
static_assert(WK_SEGC * WK_NSEG == wk2::NCHK, "segments");
__device__ __forceinline__ void phase_wkv_pipe(const Args& a, unsigned char* lds, int j, const XcdBarrier& bar) {
    using namespace wk2;
    const int tid = otid(), lane = tid & 63, wid = tid >> 6;
    LAS unsigned char* base = (LAS unsigned char*)(lds + LDS_USER);
    vflag ready = (vflag)base, done = (vflag)(base + 64);
    const bf16_t* V = (const bf16_t*)(a.ws + (j == 0 ? WS_VFIRST : RW_V));
    const int nprep = (int)gridDim.x - 64;
#if WKV_SERIAL
    for (int r = 0; r < REP_WKVP; ++r) phase_wkv_prep(a, lds, j, 0, NCHK, 0, gridDim.x);
#else
    phase_wkv_prep(a, lds, j, 0, WK_SEGC, 0, gridDim.x);
#endif
    xcd_barrier(bar);
    const int chain = blockIdx.x; const bool scanner = chain < 64;
    if (!scanner) {
#pragma unroll 1
        for (int seg = 0; seg < WK_NSEG; ++seg) {
#if !WKV_SERIAL
            for (int r = 0; r < REP_WKVP; ++r) if (seg + 1 < WK_NSEG) phase_wkv_prep(a, lds, j, (seg + 1) * WK_SEGC, (seg + 2) * WK_SEGC, 64, nprep);
#endif
            deferred_transposes(a, lds, j == 0 ? NJ_PRO : NJ_PRO + 4, j == 0 ? NJ_PRO + 4 : NJOBS, seg, WK_NSEG, 64, nprep);
            xcd_barrier(bar);
        }
        return;
    }
    const int b = (chain >> 5) & 1, h = (chain >> 1) & 15, d = chain & 1, ch0 = h * 64;
    float* Y = (float*)(a.ws + (d == 0 ? RW_Y0 : RW_Y1));
    const int v = lane & 15, g = lane >> 4;
    auto chunk_p0 = [&](int c) -> int { const int t0 = c * 16; return (d == 0) ? t0 : ((t0 < CTX) ? (CTX - 1 - t0) : (RPB + CTX - 1 - t0)); };
    const int dir = (d == 0) ? 1 : -1;
    const unsigned char* Vb = (const unsigned char*)uniform_ptr(V + (size_t)b * RPB * D); unsigned char* Yb = (unsigned char*)uniform_ptr(Y + (size_t)b * RPB * D);
    int loff[4];
#pragma unroll
    for (int i = 0; i < 4; ++i) loff[i] = (4 * g + i) * dir * D + ch0 + (wid & 3) * 16 + v;
    if (tid < 16) ready[tid] = -1;
    if (tid >= 16 && tid < 20) done[tid - 16] = -1;
    __syncthreads();
    if (wid >= 4) {
#pragma unroll 1
        for (int seg = 0; seg < WK_NSEG; ++seg) {
            const int c_lo = seg * WK_SEGC, c_hi = c_lo + WK_SEGC;
            {
                const int sw = wid - 4;
                const unsigned char* gs = a.ws + RW_SETS + (size_t)chain * NCHK * GSETB;
                u32x4 preA[11], preB[11], preC[11];
                auto issueA = [&](int c) { const unsigned char* p = gs + (size_t)c * GSETB;
#pragma unroll
                    for (int i = 0; i < 11; ++i) { const int idx = lane + i * 64; if (idx < GSETB / 16) preA[i] = *(const u32x4*)(p + idx * 16); } };
                auto issueB = [&](int c) { const unsigned char* p = gs + (size_t)c * GSETB;
#pragma unroll
                    for (int i = 0; i < 11; ++i) { const int idx = lane + i * 64; if (idx < GSETB / 16) preB[i] = *(const u32x4*)(p + idx * 16); } };
                auto issueC = [&](int c) { const unsigned char* p = gs + (size_t)c * GSETB;
#pragma unroll
                    for (int i = 0; i < 11; ++i) { const int idx = lane + i * 64; if (idx < GSETB / 16) preC[i] = *(const u32x4*)(p + idx * 16); } };
                auto scatter = [&](LAS unsigned char* set, const u32x4 (&pre)[11]) {
#pragma unroll
                    for (int i = 0; i < 4; ++i) { const int r = ((lane + i * 64) & 127) >> 3, jj = lane & 7; *(LAS u32x4*)(set + (i < 2 ? OFF_AAT : OFF_RT) + r * AST + jj * 16) = pre[i]; }
                    *(LAS u32x4*)(set + OFF_PQ + (lane >> 2) * SST + (lane & 3) * 16) = pre[4];
#pragma unroll
                    for (int i = 5; i < 9; ++i) { const int k = lane + (i - 5) * 64; *(LAS u32x4*)(set + OFF_BK + (k >> 2) * SST + (k & 3) * 16) = pre[i]; }
                    {
                        const int kk = lane & 31, r = kk >> 1, hh = kk & 1;
                        LAS unsigned char* d = set + (lane < 32 ? OFF_MT : OFF_TT) + r * SST + (2 * hh) * 16;
                        *(LAS u32x4*)d = (u32x4){ pre[9][0], pre[9][1], 0u, 0u }; *(LAS u32x4*)(d + 16) = (u32x4){ pre[9][2], pre[9][3], 0u, 0u };
                    }
                    if (lane < 16) *(LAS u32x4*)(set + OFF_WC + lane * 16) = pre[10];
                };
                auto waitslot = [&](int c) { while (min(min(done[0], done[1]), min(done[2], done[3])) < c - NSET) __builtin_amdgcn_s_sleep(8); };
                if (c_lo + sw < c_hi) issueA(c_lo + sw);
                if (c_lo + sw + 4 < c_hi) issueB(c_lo + sw + 4);
                if (c_lo + sw + 8 < c_hi) issueC(c_lo + sw + 8);
                for (int c = c_lo + sw; c < c_hi; c += 12) {
                    {
                        LAS unsigned char* set = base + 256 + (c % NSET) * SLOTB;
                        waitslot(c);
                        scatter(set, preA);
                        if (c + 12 < c_hi) issueA(c + 12);
                        asm volatile("s_waitcnt lgkmcnt(0)" ::: "memory");
                        if (lane == 0) ready[c % NSET] = c;
                    }
                    if (c + 4 < c_hi) {
                        const int c2 = c + 4;
                        LAS unsigned char* set = base + 256 + (c2 % NSET) * SLOTB;
                        waitslot(c2);
                        scatter(set, preB);
                        if (c2 + 12 < c_hi) issueB(c2 + 12);
                        asm volatile("s_waitcnt lgkmcnt(0)" ::: "memory");
                        if (lane == 0) ready[c2 % NSET] = c2;
                    }
                    if (c + 8 < c_hi) {
                        const int c3 = c + 8;
                        LAS unsigned char* set = base + 256 + (c3 % NSET) * SLOTB;
                        waitslot(c3);
                        scatter(set, preC);
                        if (c3 + 12 < c_hi) issueC(c3 + 12);
                        asm volatile("s_waitcnt lgkmcnt(0)" ::: "memory");
                        if (lane == 0) ready[c3 % NSET] = c3;
                    }
                }
            }
            xcd_barrier(bar);
        }
    } else {
    f32x4 St[4];
#pragma unroll
    for (int c4 = 0; c4 < 4; ++c4) St[c4] = (f32x4){0.f, 0.f, 0.f, 0.f};
    bf16x8 Bhi[2];
#pragma unroll
    for (int q = 0; q < 2; ++q) Bhi[q] = (bf16x8){0, 0, 0, 0, 0, 0, 0, 0};
#pragma unroll 1
        for (int seg = 0; seg < WK_NSEG; ++seg) {
            const int c_lo = seg * WK_SEGC, c_hi = c_lo + WK_SEGC;
            {
                constexpr int VPD = 4;
                unsigned vq[VPD][4];
#pragma unroll
                for (int k = 0; k < VPD; ++k) if (c_lo + k < c_hi) { const int p0 = __builtin_amdgcn_readfirstlane(chunk_p0(c_lo + k));
#pragma unroll
                  for (int i = 0; i < 4; ++i) vq[k][i] = *(const bf16_t*)(Vb + (unsigned)((p0 * D + loff[i]) * 2)); }
                bf16x8 oA[2][2], oR[2][2], oM[2], oT[2], oPQ[2], oBK[2][4]; f32x4 oW[2][4];
                auto load_ops = [&](int c, bf16x8 (&xA)[2], bf16x8 (&xR)[2], bf16x8& xM, bf16x8& xT, bf16x8& xPQ, bf16x8 (&xBK)[4], f32x4 (&xW)[4]) {
                    const LAS unsigned char* set = base + 256 + (c % NSET) * SLOTB;
#pragma unroll
                    for (int q = 0; q < 2; ++q) { xA[q] = *(const LAS bf16x8*)(set + OFF_AAT + v * AST + (q * 4 + g) * 16); xR[q] = *(const LAS bf16x8*)(set + OFF_RT + v * AST + (q * 4 + g) * 16); }
                    xM = *(const LAS bf16x8*)(set + OFF_MT + v * SST + g * 16); xT = *(const LAS bf16x8*)(set + OFF_TT + v * SST + g * 16); xPQ = *(const LAS bf16x8*)(set + OFF_PQ + v * SST + g * 16);
#pragma unroll
                    for (int c4 = 0; c4 < 4; ++c4) { xBK[c4] = *(const LAS bf16x8*)(set + OFF_BK + (c4 * 16 + v) * SST + g * 16); xW[c4] = *(const LAS f32x4*)(set + OFF_WC + ((g * 4 + c4) * 4) * 4); }
                };
                __builtin_amdgcn_s_setprio(2);
                while (ready[c_lo % NSET] != c_lo) __builtin_amdgcn_s_sleep(1);
                asm volatile("" ::: "memory");
                load_ops(c_lo, oA[0], oR[0], oM[0], oT[0], oPQ[0], oBK[0], oW[0]);
                for (int cb = c_lo; cb < c_hi; cb += VPD) {
#pragma unroll
                  for (int kk = 0; kk < VPD; ++kk) {
                    const int c = cb + kk;
                    constexpr int dummy = 0; (void)dummy;
                    const int P = kk & 1, Q = P ^ 1;
                    if (c >= c_hi) break;
                    const u32x2 vmw = { vq[kk][0] | (vq[kk][1] << 16), vq[kk][2] | (vq[kk][3] << 16) };
                    if (c + VPD < c_hi) { const int p1 = __builtin_amdgcn_readfirstlane(chunk_p0(c + VPD));
#pragma unroll
                        for (int i = 0; i < 4; ++i) vq[kk][i] = *(const bf16_t*)(Vb + (unsigned)((p1 * D + loff[i]) * 2)); }
                    asm volatile("s_waitcnt lgkmcnt(0)" ::: "memory");
                    if (lane == 0) done[wid] = c;
                    if (c + 1 < c_hi) {
                        while (ready[(c + 1) % NSET] != c + 1) __builtin_amdgcn_s_sleep(1);
                        asm volatile("" ::: "memory");
                        load_ops(c + 1, oA[Q], oR[Q], oM[Q], oT[Q], oPQ[Q], oBK[Q], oW[Q]);
                    }
                    const f32x4 z4 = {0.f, 0.f, 0.f, 0.f};
                    const bf16x8 bv = __builtin_bit_cast(bf16x8, ((u32x4){ vmw[0], vmw[1], 0u, 0u }));
                    f32x4 a1 = __builtin_amdgcn_mfma_f32_16x16x32_bf16(oA[P][0], Bhi[0], z4, 0, 0, 0);
                    f32x4 a1m = __builtin_amdgcn_mfma_f32_16x16x32_bf16(oM[P], bv, z4, 0, 0, 0);
                    a1 = __builtin_amdgcn_mfma_f32_16x16x32_bf16(oA[P][1], Bhi[1], a1, 0, 0, 0);
                    f32x4 a2 = __builtin_amdgcn_mfma_f32_16x16x32_bf16(oR[P][0], Bhi[0], z4, 0, 0, 0);
                    a2 = __builtin_amdgcn_mfma_f32_16x16x32_bf16(oR[P][1], Bhi[1], a2, 0, 0, 0);
                    a1 = a1 + a1m;
                    const bf16x8 b3 = __builtin_bit_cast(bf16x8, ((u32x4){ cvt_pk_bf16(a1[0], a1[1]), cvt_pk_bf16(a1[2], a1[3]), 0u, 0u }));
                    const f32x4 a3 = __builtin_amdgcn_mfma_f32_16x16x32_bf16(oT[P], b3, z4, 0, 0, 0);
                    const bf16x8 b45 = __builtin_bit_cast(bf16x8, ((u32x4){ cvt_pk_bf16(a3[0], a3[1]), cvt_pk_bf16(a3[2], a3[3]), vmw[0], vmw[1] }));
#pragma unroll
                    for (int c4 = 0; c4 < 4; ++c4) St[c4] = __builtin_amdgcn_mfma_f32_16x16x32_bf16(oBK[P][c4], b45, St[c4], 0, 0, 0);
                    a2 = __builtin_amdgcn_mfma_f32_16x16x32_bf16(oPQ[P], b45, a2, 0, 0, 0);
#pragma unroll
                    for (int c4 = 0; c4 < 4; ++c4) St[c4] = St[c4] * oW[P][c4];
#pragma unroll
                    for (int q = 0; q < 2; ++q)
                        Bhi[q] = __builtin_bit_cast(bf16x8, ((u32x4){ cvt_pk_bf16(St[2 * q][0], St[2 * q][1]), cvt_pk_bf16(St[2 * q][2], St[2 * q][3]), cvt_pk_bf16(St[2 * q + 1][0], St[2 * q + 1][1]), cvt_pk_bf16(St[2 * q + 1][2], St[2 * q + 1][3]) }));
                    {
                        const int p0 = __builtin_amdgcn_readfirstlane(chunk_p0(c));
#pragma unroll
                        for (int rr = 0; rr < 4; ++rr) *(float*)(Yb + (unsigned)((p0 * D + loff[rr]) * 4)) = a2[rr];
                    }
                  }
                }
            }
            __builtin_amdgcn_s_setprio(0);
            xcd_barrier(bar);
        }
    }
}
__device__ __forceinline__ void phase_wkv2(const Args& a, unsigned char* lds, int j) { }
constexpr size_t HY_UU   = WS_MIX;
constexpr size_t HY_X0   = HY_UU + (size_t)T * 3072 * 2;
constexpr size_t HY_X0ZB = HY_X0 + (size_t)T * D * 2;
constexpr size_t HY_P    = HY_X0ZB + (size_t)T * D * 2;
constexpr size_t HY_ZT   = HY_P + (size_t)T * D * 2;
constexpr size_t HY_ZC   = HY_ZT + (size_t)D * 2 * SEQ * 4;
constexpr size_t HY_HF   = HY_ZC + (size_t)2 * CTX * D * 4;
constexpr size_t HY_HB   = HY_HF + (size_t)D * SEQ * 4;
constexpr size_t HY_HFC  = HY_HB + (size_t)D * SEQ * 4;
constexpr size_t HY_HBC  = HY_HFC + (size_t)CTX * D * 4;
constexpr size_t HY_FS   = HY_HBC + (size_t)CTX * D * 4;
constexpr size_t HY_U    = HY_FS + (size_t)2 * D * SEQ * 8;
constexpr size_t HY_END  = HY_U + (size_t)2 * D * 2 * SEQ * 4;
constexpr int FFT_N = 16384;

__device__ __forceinline__ float2 cmul(float2 a, float2 b) { return make_float2(a.x * b.x - a.y * b.y, a.x * b.y + a.y * b.x); }
__device__ __forceinline__ float2 cmulc(float2 a, float2 b) { return make_float2(a.x * b.x + a.y * b.y, a.y * b.x - a.x * b.y); }

__device__ __forceinline__ float2 tw_get(const float2* twl, int e) { return cmul(twl[e & 127], twl[128 + (e >> 7)]); }
__device__ __forceinline__ void fft_fwd(float2* x, const float2* tw) {
    const int tid = otid();
#pragma unroll 1
    for (int lq = 12; lq >= 0; lq -= 2) {
        const int q = 1 << lq, tws = FFT_N >> (lq + 2);
#pragma unroll 4
        for (int i = 0; i < 8; ++i) {
            const int u = tid + i * 512, j = u & (q - 1), B = (u >> lq) << (lq + 2);
            float2* p = x + B + j;
            const float2 a0 = p[0], a1 = p[q], a2 = p[2 * q], a3 = p[3 * q];
            const float2 t0 = make_float2(a0.x + a2.x, a0.y + a2.y), t1 = make_float2(a0.x - a2.x, a0.y - a2.y);
            const float2 t2 = make_float2(a1.x + a3.x, a1.y + a3.y);
            const float2 d = make_float2(a1.x - a3.x, a1.y - a3.y), t3 = make_float2(d.y, -d.x);
            const float2 y0 = make_float2(t0.x + t2.x, t0.y + t2.y), y1 = make_float2(t1.x + t3.x, t1.y + t3.y);
            const float2 y2 = make_float2(t0.x - t2.x, t0.y - t2.y), y3 = make_float2(t1.x - t3.x, t1.y - t3.y);
            if (q > 1) {
                const float2 w1 = tw_get(tw, j * tws), w2 = cmul(w1, w1), w3 = cmul(w2, w1);
                p[0] = y0; p[q] = cmul(y1, w1); p[2 * q] = cmul(y2, w2); p[3 * q] = cmul(y3, w3);
            } else { p[0] = y0; p[1] = y1; p[2] = y2; p[3] = y3; }
        }
        __syncthreads();
    }
}
__device__ __forceinline__ void fft_inv(float2* x, const float2* tw) {
    const int tid = otid();
#pragma unroll 1
    for (int lq = 0; lq <= 12; lq += 2) {
        const int q = 1 << lq, tws = FFT_N >> (lq + 2);
#pragma unroll 4
        for (int i = 0; i < 8; ++i) {
            const int u = tid + i * 512, j = u & (q - 1), B = (u >> lq) << (lq + 2);
            float2* p = x + B + j;
            float2 b0 = p[0], b1 = p[q], b2 = p[2 * q], b3 = p[3 * q];
            if (q > 1) { const float2 w1 = tw_get(tw, j * tws), w2 = cmul(w1, w1), w3 = cmul(w2, w1); b1 = cmulc(b1, w1); b2 = cmulc(b2, w2); b3 = cmulc(b3, w3); }
            const float2 t0 = make_float2(b0.x + b2.x, b0.y + b2.y), t1 = make_float2(b0.x - b2.x, b0.y - b2.y);
            const float2 t2 = make_float2(b1.x + b3.x, b1.y + b3.y);
            const float2 d = make_float2(b1.x - b3.x, b1.y - b3.y), t3 = make_float2(-d.y, d.x);
            p[0] = make_float2(t0.x + t2.x, t0.y + t2.y); p[q] = make_float2(t1.x + t3.x, t1.y + t3.y);
            p[2 * q] = make_float2(t0.x - t2.x, t0.y - t2.y); p[3 * q] = make_float2(t1.x - t3.x, t1.y - t3.y);
        }
        __syncthreads();
    }
}

__device__ __forceinline__ void phase_hy_filters(const Args& a, unsigned char* lds) {
    const int tid = otid();
    float* zemb = (float*)(lds + LDS_USER);
    float* hA = zemb + 64 * 36;
    float* hB = hA + 64 * 68;
    const float* w1 = a.in[I_HFW1]; const float* b1 = a.in[I_HFB1]; const float* w2 = a.in[I_HFW2]; const float* b2 = a.in[I_HFB2];
    const float* w3 = a.in[I_HFW3]; const float* b3 = a.in[I_HFB3]; const float* fr = a.in[I_HFREQ]; const float* wo = a.in[I_HFWOUT];
    for (int u = blockIdx.x; u < 260; u += gridDim.x) {
        const bool isctx = u >= 256;
        const int Lh = isctx ? CTX : SEQ, n0 = (isctx ? (u - 256) : u) * 64;
        for (int it = tid; it < 64 * 33; it += NT) {
            const int p = it / 33, e = it - p * 33, n = n0 + p;
            float v;
            if (e == 0) v = (float)n / (float)(Lh - 1);
            else {
                const int bi = (e - 1) & 15;
                const float f = 1e-4f + (float)bi * ((15.0f - 1e-4f) / 15.0f);
                const float ang = 2.0f * 3.14159265358979323846f * f * (float)n / (float)Lh;
                v = (e <= 16) ? cos_acc(ang) : -sin_acc(ang);
            }
            zemb[p * 36 + e] = v;
        }
        __syncthreads();
        {
            const int p = tid & 63, h0 = (tid >> 6) * 8;
            float acc[8];
#pragma unroll
            for (int i = 0; i < 8; ++i) acc[i] = b1[h0 + i];
#pragma unroll 1
            for (int k = 0; k < 33; ++k) { const float zv = zemb[p * 36 + k];
#pragma unroll
                for (int i = 0; i < 8; ++i) acc[i] += zv * w1[k * 64 + h0 + i]; }
#pragma unroll
            for (int i = 0; i < 8; ++i) hA[p * 68 + h0 + i] = sin_acc(fr[h0 + i] * acc[i]);
            __syncthreads();
#pragma unroll
            for (int i = 0; i < 8; ++i) acc[i] = b2[h0 + i];
#pragma unroll 2
            for (int k = 0; k < 64; ++k) { const float hv = hA[p * 68 + k];
#pragma unroll
                for (int i = 0; i < 8; ++i) acc[i] += hv * w2[k * 64 + h0 + i]; }
#pragma unroll
            for (int i = 0; i < 8; ++i) hB[p * 68 + h0 + i] = sin_acc(fr[64 + h0 + i] * acc[i]);
            __syncthreads();
#pragma unroll
            for (int i = 0; i < 8; ++i) acc[i] = b3[h0 + i];
#pragma unroll 2
            for (int k = 0; k < 64; ++k) { const float hv = hB[p * 68 + k];
#pragma unroll
                for (int i = 0; i < 8; ++i) acc[i] += hv * w3[k * 64 + h0 + i]; }
            __syncthreads();
#pragma unroll
            for (int i = 0; i < 8; ++i) hA[p * 68 + h0 + i] = sin_acc(fr[128 + h0 + i] * acc[i]);
            __syncthreads();
        }
        {
            const int lane = tid & 63, wid = tid >> 6, fr = lane & 15, fq = lane >> 4;
            bf16x8 Ah[4][2], Al[4][2];
#pragma unroll
            for (int mb = 0; mb < 4; ++mb)
#pragma unroll
                for (int ks = 0; ks < 2; ++ks) {
                    const float* hp = hA + (mb * 16 + fr) * 68 + ks * 32 + fq * 8;
                    const float4 x0 = *(const float4*)hp, x1 = *(const float4*)(hp + 4);
                    u32x4 h, l;
                    h[0] = cvt_pk_bf16(x0.x, x0.y); h[1] = cvt_pk_bf16(x0.z, x0.w); h[2] = cvt_pk_bf16(x1.x, x1.y); h[3] = cvt_pk_bf16(x1.z, x1.w);
                    l[0] = cvt_pk_bf16(x0.x - bf_lo(h[0]), x0.y - bf_hi(h[0])); l[1] = cvt_pk_bf16(x0.z - bf_lo(h[1]), x0.w - bf_hi(h[1]));
                    l[2] = cvt_pk_bf16(x1.x - bf_lo(h[2]), x1.y - bf_hi(h[2])); l[3] = cvt_pk_bf16(x1.z - bf_lo(h[3]), x1.w - bf_hi(h[3]));
                    Ah[mb][ks] = __builtin_bit_cast(bf16x8, h); Al[mb][ks] = __builtin_bit_cast(bf16x8, l);
                }
            const bf16_t* WH = (const bf16_t*)(a.ws + WS_HWOT); const bf16_t* WL = WH + 2048 * 64;
            bf16x8 Bh[2], Bl[2], Nh[2], Nl[2];
            auto ldB = [&](int nb, bf16x8 (&bh)[2], bf16x8 (&bl)[2]) {
                const size_t o = (size_t)(wid * 256 + nb * 16 + fr) * 64 + fq * 8;
#pragma unroll
                for (int ks = 0; ks < 2; ++ks) { bh[ks] = *(const bf16x8*)(WH + o + ks * 32); bl[ks] = *(const bf16x8*)(WL + o + ks * 32); }
            };
            ldB(0, Bh, Bl);
#pragma unroll 1
            for (int nb = 0; nb < 16; ++nb) {
                if (nb + 1 < 16) ldB(nb + 1, Nh, Nl);
                f32x4 acc[4];
#pragma unroll
                for (int mb = 0; mb < 4; ++mb) {
                    acc[mb] = (f32x4){0.f, 0.f, 0.f, 0.f};
#pragma unroll
                    for (int ks = 0; ks < 2; ++ks) {
                        acc[mb] = __builtin_amdgcn_mfma_f32_16x16x32_bf16(Ah[mb][ks], Bh[ks], acc[mb], 0, 0, 0);
                        acc[mb] = __builtin_amdgcn_mfma_f32_16x16x32_bf16(Al[mb][ks], Bh[ks], acc[mb], 0, 0, 0);
                        acc[mb] = __builtin_amdgcn_mfma_f32_16x16x32_bf16(Ah[mb][ks], Bl[ks], acc[mb], 0, 0, 0);
                    }
                }
                const int col = wid * 256 + nb * 16 + fr, ch = col & 1023;
                const float dl = fabsf(-15.350567286626973f + (float)ch * ((-3.0701134573253946f + 15.350567286626973f) / 1023.0f));
                if (!isctx) {
                    float* dst = (float*)(a.ws + (col < 1024 ? HY_HF : HY_HB)) + (size_t)ch * SEQ + n0;
#pragma unroll
                    for (int mb = 0; mb < 4; ++mb) {
                        float o[4];
#pragma unroll
                        for (int r = 0; r < 4; ++r) { const int n = n0 + mb * 16 + fq * 4 + r; o[r] = acc[mb][r] * __expf(-((float)n / (float)(SEQ - 1)) * dl); }
                        *(float4*)(dst + mb * 16 + fq * 4) = make_float4(o[0], o[1], o[2], o[3]);
                    }
                } else {
                    float* dst = (float*)(a.ws + (col < 1024 ? HY_HFC : HY_HBC));
#pragma unroll
                    for (int mb = 0; mb < 4; ++mb)
#pragma unroll
                        for (int r = 0; r < 4; ++r) { const int n = n0 + mb * 16 + fq * 4 + r; dst[(size_t)n * D + ch] = acc[mb][r] * __expf(-((float)n / (float)(CTX - 1)) * dl); }
                }
#pragma unroll
                for (int ks = 0; ks < 2; ++ks) { Bh[ks] = Nh[ks]; Bl[ks] = Nl[ks]; }
            }
        }
        __syncthreads();
    }
}
__device__ __forceinline__ void phase_hy_filter_fft(const Args& a, unsigned char* lds) {
    const int tid = otid();
    float2* x = (float2*)(lds + LDS_USER);
    const float2* tw1g = (const float2*)(a.ws + WS_TW1); const float2* tw2 = (const float2*)(a.ws + WS_TW2);
    float2* tw1 = x + FFT_N;
    if (tid < 128) tw1[tid] = tw1g[tid]; else if (tid < 160) tw1[tid] = tw1g[(tid - 128) * 128];
    __syncthreads();
    for (int u = blockIdx.x; u < 2048; u += gridDim.x) {
        const int c = u >> 1, par = u & 1;
        const float* hf = (const float*)(a.ws + HY_HF) + (size_t)c * SEQ; const float* hb = (const float*)(a.ws + HY_HB) + (size_t)c * SEQ;
#pragma unroll
        for (int it = 0; it < 8; ++it) {
            const int n = (tid + it * NT) * 4;
            const float4 f0 = *(const float4*)(hf + n);
            float f1[4];
            if (n == 0) { f1[0] = 0.f; f1[1] = hb[SEQ - 1]; f1[2] = hb[SEQ - 2]; f1[3] = hb[SEQ - 3]; }
            else { const float4 t = *(const float4*)(hb + SEQ - n - 4); const float s0 = hb[SEQ - n]; f1[0] = s0; f1[1] = t.w; f1[2] = t.z; f1[3] = t.y; }
            const float f0v[4] = { f0.x, f0.y, f0.z, f0.w };
            float2 o[4];
            if (par == 0) {
#pragma unroll
                for (int q = 0; q < 4; ++q) o[q] = make_float2(f0v[q] + f1[q], 0.f);
            } else {
                const float4 wa = *(const float4*)(tw2 + n), wb = *(const float4*)(tw2 + n + 2);
                const float wr[4] = { wa.x, wa.z, wb.x, wb.z }, wi[4] = { wa.y, wa.w, wb.y, wb.w };
#pragma unroll
                for (int q = 0; q < 4; ++q) { const float dd = f0v[q] - f1[q]; o[q] = make_float2(dd * wr[q], dd * wi[q]); }
            }
            *(float4*)(x + n) = make_float4(o[0].x, o[0].y, o[1].x, o[1].y); *(float4*)(x + n + 2) = make_float4(o[2].x, o[2].y, o[3].x, o[3].y);
        }
        __syncthreads();
        fft_fwd(x, tw1);
        float2* dst = (float2*)(a.ws + HY_FS) + ((size_t)par * D + c) * SEQ;
#pragma unroll
        for (int it = 0; it < 16; ++it) { const int n = (tid + it * NT) * 2; *(float4*)(dst + n) = *(const float4*)(x + n); }
        __syncthreads();
    }
}
__device__ __forceinline__ void phase_hy_in(const Args& a, unsigned char* lds) {
    unsigned char* gl = lds + LDS_USER;
    bf16_t* UU = (bf16_t*)(a.ws + HY_UU);
    const float* bin = a.in[I_HBIN];
    int u = blockIdx.x;
    const unsigned char* ws = a.ws;
    const int xq = blockIdx.x & 7, nxw = (gridDim.x + 7 - xq) >> 3;
    int si = blockIdx.x >> 3;
    auto next = [&](g8::UTile& t) -> bool {
        const int m4 = si / 6, mt = 4 * m4 + (xq >> 1);
        if (mt >= 130) return false;
        t.mt = mt; t.nt = (xq & 1) * 6 + (si - m4 * 6); t.g = 0; si += nxw;
        return true;
    };
    const auto ctx = g8::make_ctx(
        [=](const g8::UTile& t) { return (const bf16_t*)(ws + WS_H) + (size_t)t.mt * 256 * D; },
        [=](const g8::UTile& t) { return (const bf16_t*)(ws + WS_HYINT) + (size_t)t.nt * 256 * D; },
        [=](const g8::UTile&, f32x4 (&acc)[2][2][4][2], int col0) { g8::bias_acc(acc, bin, col0); },
        [=](const g8::UTile&, const f32x4 (&acc)[2][2][4][2], int row0, int col0) {
            g8::each_acc(acc, row0, col0, [=](int row, int col, const f32x4& v) {
                u32x2 w = { cvt_pk_bf16(v[0], v[1]), cvt_pk_bf16(v[2], v[3]) };
                *(u32x2*)(UU + (size_t)row * 3072 + col) = w;
            });
        });
    g8::gemm256_stream<false, g8::UTile>(D, (unsigned)D, gl, ctx, next);
}
__device__ __forceinline__ void phase_hy_short(const Args& a, unsigned char* lds) {
    const int tid = otid();
    float* zt = (float*)(lds + LDS_USER);
    const bf16_t* UU = (const bf16_t*)(a.ws + HY_UU);
    const float* sw = a.in[I_HSW]; const float* sb = a.in[I_HSB]; const float* bias = a.in[I_HBIAS];
    for (int u = blockIdx.x; u < 520 * 4; u += gridDim.x) {
        const int rb = u >> 2, cc = u & 3, row0 = rb * 64, b = row0 / RPB, within0 = row0 - b * RPB;
        const bool isctx = within0 < CTX;
        const int c4 = tid & 63, rg = tid >> 6, cl = c4 * 4, c = cc * 256 + cl;
        float wt[3][3][4], bs[3][4];
#pragma unroll
        for (int g = 0; g < 3; ++g) {
#pragma unroll
            for (int tp = 0; tp < 3; ++tp) { const float4 w = *(const float4*)(sw + (size_t)tp * 3072 + g * 1024 + c); wt[g][tp][0] = w.x; wt[g][tp][1] = w.y; wt[g][tp][2] = w.z; wt[g][tp][3] = w.w; }
            const float4 bb = *(const float4*)(sb + g * 1024 + c); bs[g][0] = bb.x; bs[g][1] = bb.y; bs[g][2] = bb.z; bs[g][3] = bb.w;
        }
        const float4 bi4 = *(const float4*)(bias + c); const float bi[4] = { bi4.x, bi4.y, bi4.z, bi4.w };
        auto ld = [&](int row, int g, float (&o)[4]) {
            const int w = row - b * RPB;
            const bool valid = isctx ? (w >= 0 && w < CTX) : (w >= CTX && w < RPB);
            if (valid) { const u32x2 v = *(const u32x2*)(UU + (size_t)row * 3072 + g * 1024 + c); o[0] = bf_lo(v[0]); o[1] = bf_hi(v[0]); o[2] = bf_lo(v[1]); o[3] = bf_hi(v[1]); }
            else { o[0] = o[1] = o[2] = o[3] = 0.f; }
        };
        float pv[3][4], cv[3][4], nv[3][4];
        const int r0 = row0 + rg * 8;
#pragma unroll
        for (int g = 0; g < 3; ++g) { ld(r0 - 1, g, pv[g]); ld(r0, g, cv[g]); }
#pragma unroll 1
        for (int i = 0; i < 8; ++i) {
            const int row = r0 + i;
#pragma unroll
            for (int g = 0; g < 3; ++g) ld(row + 1, g, nv[g]);
            float uo[3][4];
#pragma unroll
            for (int g = 0; g < 3; ++g)
#pragma unroll
                for (int q = 0; q < 4; ++q) uo[g][q] = pv[g][q] * wt[g][0][q] + cv[g][q] * wt[g][1][q] + nv[g][q] * wt[g][2][q] + bs[g][q];
            float z[4], xz[4];
#pragma unroll
            for (int q = 0; q < 4; ++q) { z[q] = uo[2][q] * uo[1][q]; xz[q] = uo[0][q] * z[q] * bi[q]; }
            u32x2 o0 = { cvt_pk_bf16(uo[0][0], uo[0][1]), cvt_pk_bf16(uo[0][2], uo[0][3]) }, o1 = { cvt_pk_bf16(xz[0], xz[1]), cvt_pk_bf16(xz[2], xz[3]) };
            *(u32x2*)((bf16_t*)(a.ws + HY_X0) + (size_t)row * D + c) = o0;
            *(u32x2*)((bf16_t*)(a.ws + HY_X0ZB) + (size_t)row * D + c) = o1;
            if (isctx) *(float4*)((float*)(a.ws + HY_ZC) + ((size_t)b * CTX + (within0 + rg * 8 + i)) * D + c) = make_float4(z[0], z[1], z[2], z[3]);
            else {
#pragma unroll
                for (int q = 0; q < 4; ++q) zt[(cl + q) * 65 + rg * 8 + i] = z[q];
            }
#pragma unroll
            for (int g = 0; g < 3; ++g)
#pragma unroll
                for (int q = 0; q < 4; ++q) { pv[g][q] = cv[g][q]; cv[g][q] = nv[g][q]; }
        }
        __syncthreads();
        if (!isctx) {
            const int t0 = within0 - CTX;
#pragma unroll
            for (int i = 0; i < 8; ++i) {
                const int idx = tid + i * 512, ch = idx >> 4, t4 = (idx & 15) * 4;
                const float* s = zt + ch * 65 + t4;
                *(float4*)((float*)(a.ws + HY_ZT) + ((size_t)(cc * 256 + ch) * 2 + b) * SEQ + t0 + t4) = make_float4(s[0], s[1], s[2], s[3]);
            }
        }
        __syncthreads();
    }
}
__device__ __forceinline__ void phase_hy_fftconv(const Args& a, unsigned char* lds) {
    const int tid = otid();
    float2* x = (float2*)(lds + LDS_USER);
    const float2* tw1g = (const float2*)(a.ws + WS_TW1); const float2* tw2 = (const float2*)(a.ws + WS_TW2);
    float2* tw1 = x + FFT_N;
    if (tid < 128) tw1[tid] = tw1g[tid]; else if (tid < 160) tw1[tid] = tw1g[(tid - 128) * 128];
    __syncthreads();
    float4 zin[8][2];
    auto ld_in = [&](int uu) {
        const int cc = uu >> 1;
        const float* q0 = (const float*)(a.ws + HY_ZT) + (size_t)cc * 2 * SEQ; const float* q1 = q0 + SEQ;
#pragma unroll
        for (int it = 0; it < 8; ++it) { const int n = (tid + it * NT) * 4; zin[it][0] = *(const float4*)(q0 + n); zin[it][1] = *(const float4*)(q1 + n); }
    };
    if (blockIdx.x < 2048) ld_in(blockIdx.x);
    for (int u = blockIdx.x; u < 2048; u += gridDim.x) {
        const int c = u >> 1, par = u & 1;
#pragma unroll
        for (int it = 0; it < 8; ++it) {
            const int n = (tid + it * NT) * 4;
            const float4 a0 = zin[it][0], a1 = zin[it][1];
            float2 v[4] = { make_float2(a0.x, a1.x), make_float2(a0.y, a1.y), make_float2(a0.z, a1.z), make_float2(a0.w, a1.w) };
            if (par) {
                const float4 wa = *(const float4*)(tw2 + n), wb = *(const float4*)(tw2 + n + 2);
                v[0] = cmul(v[0], make_float2(wa.x, wa.y)); v[1] = cmul(v[1], make_float2(wa.z, wa.w)); v[2] = cmul(v[2], make_float2(wb.x, wb.y)); v[3] = cmul(v[3], make_float2(wb.z, wb.w));
            }
            *(float4*)(x + n) = make_float4(v[0].x, v[0].y, v[1].x, v[1].y); *(float4*)(x + n + 2) = make_float4(v[2].x, v[2].y, v[3].x, v[3].y);
        }
        const float2* fs = (const float2*)(a.ws + HY_FS) + ((size_t)par * D + c) * SEQ;
        float4 fsp[16];
#pragma unroll
        for (int it = 0; it < 16; ++it) fsp[it] = *(const float4*)(fs + (tid + it * NT) * 2);
        __syncthreads();
        fft_fwd(x, tw1);
#pragma unroll
        for (int it = 0; it < 16; ++it) {
            const int n = (tid + it * NT) * 2;
            const float4 f = fsp[it], xv = *(const float4*)(x + n);
            const float2 r0 = cmul(make_float2(xv.x, xv.y), make_float2(f.x, f.y)), r1 = cmul(make_float2(xv.z, xv.w), make_float2(f.z, f.w));
            *(float4*)(x + n) = make_float4(r0.x, r0.y, r1.x, r1.y);
        }
        if (u + (int)gridDim.x < 2048) ld_in(u + gridDim.x);
        __syncthreads();
        fft_inv(x, tw1);
        float* u0 = (float*)(a.ws + HY_U) + ((size_t)par * D + c) * 2 * SEQ; float* u1 = u0 + SEQ;
#pragma unroll
        for (int it = 0; it < 8; ++it) {
            const int n = (tid + it * NT) * 4;
            const float4 va = *(const float4*)(x + n), vb = *(const float4*)(x + n + 2);
            *(float4*)(u0 + n) = make_float4(va.x, va.z, vb.x, vb.z); *(float4*)(u1 + n) = make_float4(va.y, va.w, vb.y, vb.w);
        }
        __syncthreads();
    }
}
__device__ __forceinline__ void phase_hy_combine(const Args& a, unsigned char* lds) {
    const int tid = otid();
    float* tile = (float*)(lds + LDS_USER);
    const float2* tw2 = (const float2*)(a.ws + WS_TW2);
    bf16_t* P = (bf16_t*)(a.ws + HY_P);
    const bf16_t* X0 = (const bf16_t*)(a.ws + HY_X0); const bf16_t* X0ZB = (const bf16_t*)(a.ws + HY_X0ZB);
    for (int u = blockIdx.x; u < 128; u += gridDim.x) {
        const int b = u >> 6, tg = (u >> 1) & 31, c = (u & 1) * 512 + tid, t0 = tg * 8;
        const float* z = (const float*)(a.ws + HY_ZC) + (size_t)b * CTX * D + c;
        const float* hf = (const float*)(a.ws + HY_HFC) + c; const float* hb = (const float*)(a.ws + HY_HBC) + c;
        float w[8], acc[8];
#pragma unroll
        for (int i = 0; i < 8; ++i) { acc[i] = 0.f; w[i] = hf[(size_t)(t0 + i) * D]; }
#pragma unroll 1
        for (int s = 0; s < CTX; ++s) {
            const float zv = z[(size_t)s * D];
#pragma unroll
            for (int i = 0; i < 8; ++i) acc[i] += w[i] * zv;
#pragma unroll
            for (int i = 7; i >= 1; --i) w[i] = w[i - 1];
            const int s1 = s + 1;
            w[0] = (s1 <= t0) ? hf[(size_t)(t0 - s1) * D] : ((s1 - t0) < CTX ? hb[(size_t)(s1 - t0) * D] : 0.f);
        }
#pragma unroll
        for (int i = 0; i < 8; ++i) {
            const size_t row = (size_t)b * RPB + t0 + i;
            const float x0 = __uint_as_float((unsigned)X0[row * D + c] << 16), xz = __uint_as_float((unsigned)X0ZB[row * D + c] << 16);
            P[row * D + c] = (bf16_t)(cvt_pk_bf16(x0 * acc[i] + xz, 0.f) & 0xffffu);
        }
    }
    for (int u = blockIdx.x; u < 256 * 8; u += gridDim.x) {
        const int tb = u >> 3, cc = u & 7, t0 = tb * 64, c0 = cc * 128;
#pragma unroll
        for (int i = 0; i < 4; ++i) {
            const int idx = tid + i * 512, ch = idx >> 4, t4 = (idx & 15) * 4;
            const float* ue = (const float*)(a.ws + HY_U) + ((size_t)0 * D + c0 + ch) * 2 * SEQ + t0 + t4;
            const float* uo = (const float*)(a.ws + HY_U) + ((size_t)1 * D + c0 + ch) * 2 * SEQ + t0 + t4;
            const float4 er = *(const float4*)ue, ei = *(const float4*)(ue + SEQ), orr = *(const float4*)uo, oi = *(const float4*)(uo + SEQ);
            const float4 wa = *(const float4*)(tw2 + t0 + t4), wb = *(const float4*)(tw2 + t0 + t4 + 2);
            const float e_r[4] = { er.x, er.y, er.z, er.w }, e_i[4] = { ei.x, ei.y, ei.z, ei.w }, o_r[4] = { orr.x, orr.y, orr.z, orr.w }, o_i[4] = { oi.x, oi.y, oi.z, oi.w };
            const float wr[4] = { wa.x, wa.z, wb.x, wb.z }, wi[4] = { wa.y, wa.w, wb.y, wb.w };
#pragma unroll
            for (int q = 0; q < 4; ++q) {
                const float cr = wr[q], ci = -wi[q];
                const float yr = (e_r[q] + (o_r[q] * cr - o_i[q] * ci)) * (1.f / 32768.f), yi = (e_i[q] + (o_r[q] * ci + o_i[q] * cr)) * (1.f / 32768.f);
                tile[(0 * 64 + t4 + q) * 129 + ch] = yr; tile[(1 * 64 + t4 + q) * 129 + ch] = yi;
            }
        }
        __syncthreads();
#pragma unroll
        for (int i = 0; i < 4; ++i) {
            const int idx = tid + i * 512, b = idx >> 10, t = (idx >> 4) & 63, c8 = (idx & 15) * 8;
            const size_t row = (size_t)b * RPB + CTX + t0 + t;
            const u32x4 x0 = *(const u32x4*)(X0 + row * D + c0 + c8), xz = *(const u32x4*)(X0ZB + row * D + c0 + c8);
            const float* y = tile + (b * 64 + t) * 129 + c8;
            u32x4 o;
#pragma unroll
            for (int q = 0; q < 4; ++q) o[q] = cvt_pk_bf16(bf_lo(x0[q]) * y[2 * q] + bf_lo(xz[q]), bf_hi(x0[q]) * y[2 * q + 1] + bf_hi(xz[q]));
            *(u32x4*)(P + row * D + c0 + c8) = o;
        }
        __syncthreads();
    }
}
constexpr size_t ML_QKVA = WS_MIX;
constexpr size_t ML_QC   = ML_QKVA + (size_t)T * 768 * 4;
constexpr size_t ML_KVC  = ML_QC + (size_t)T * 384 * 2;
constexpr size_t ML_QF   = ML_KVC + (size_t)T * 256 * 2;
constexpr size_t ML_KVF  = ML_QF + (size_t)T * 1536 * 4;
constexpr size_t ML_Q    = ML_KVF + (size_t)T * 2048 * 4;
constexpr size_t ML_K    = ML_Q + (size_t)T * 1536 * 2;
constexpr size_t ML_VT   = ML_K + (size_t)T * 1536 * 2;
constexpr size_t ML_O    = ML_VT + (size_t)T * 1024 * 2;
constexpr size_t ML_QM   = ML_O + (size_t)T * 1024 * 2;
constexpr size_t ML_END  = ML_QM + (size_t)T * 8 * 4;

__device__ __forceinline__ void phase_mla_a(const Args& a, unsigned char* lds) {
    unsigned char* gl = lds + LDS_USER;
    float* out = (float*)(a.ws + ML_QKVA);
    const int xq = blockIdx.x & 7, nxw = (gridDim.x + 7 - xq) >> 3;
    for (int si = blockIdx.x >> 3; ; si += nxw) {
        const int m8 = si / 3, mt = 8 * m8 + xq, nt = si - m8 * 3;
        if (mt >= 130) break;
        g8::gemm256<false>((const bf16_t*)(a.ws + WS_H), g8::AOffPlain{ (unsigned)(mt * 256), (unsigned)D }, (const bf16_t*)(a.ws + WS_MWAT) + (size_t)nt * 256 * D, D, gl,
            make_epi3(nil_col, nil_row, [=](int row, int col, const f32x4& v, Nil, Nil) { *(f32x4*)(out + (size_t)row * 768 + col) = v; }), mt * 256, nt * 256);
        __syncthreads();
    }
}
__device__ __forceinline__ void phase_mla_norm(const Args& a) {
    const int tid = otid(), lane = tid & 63, wid = tid >> 6;
    const float* qg = a.in[I_MQNG]; const float* kg = a.in[I_MKVNG];
    for (int row = blockIdx.x * 8 + wid; row < T; row += gridDim.x * 8) {
        const float* src = (const float*)(a.ws + ML_QKVA) + (size_t)row * 768;
        const float4 q0 = *(const float4*)(src + lane * 4);
        float4 q1 = make_float4(0.f, 0.f, 0.f, 0.f);
        if (lane < 32) q1 = *(const float4*)(src + 256 + lane * 4);
        float ss = q0.x * q0.x + q0.y * q0.y + q0.z * q0.z + q0.w * q0.w + q1.x * q1.x + q1.y * q1.y + q1.z * q1.z + q1.w * q1.w;
        ss = wave_sum(ss);
        const float rq = rsqrtf(ss * (1.f / 384.f) + 1e-6f);
        bf16_t* qc = (bf16_t*)(a.ws + ML_QC) + (size_t)row * 384;
        { const float4 g = *(const float4*)(qg + lane * 4); u32x2 o = { cvt_pk_bf16(q0.x * rq * g.x, q0.y * rq * g.y), cvt_pk_bf16(q0.z * rq * g.z, q0.w * rq * g.w) }; *(u32x2*)(qc + lane * 4) = o; }
        if (lane < 32) { const float4 g = *(const float4*)(qg + 256 + lane * 4); u32x2 o = { cvt_pk_bf16(q1.x * rq * g.x, q1.y * rq * g.y), cvt_pk_bf16(q1.z * rq * g.z, q1.w * rq * g.w) }; *(u32x2*)(qc + 256 + lane * 4) = o; }
        const float4 k0 = *(const float4*)(src + 384 + lane * 4);
        float s2 = k0.x * k0.x + k0.y * k0.y + k0.z * k0.z + k0.w * k0.w;
        s2 = wave_sum(s2);
        const float rk = rsqrtf(s2 * (1.f / 256.f) + 1e-6f);
        { const float4 g = *(const float4*)(kg + lane * 4); u32x2 o = { cvt_pk_bf16(k0.x * rk * g.x, k0.y * rk * g.y), cvt_pk_bf16(k0.z * rk * g.z, k0.w * rk * g.w) }; *(u32x2*)((bf16_t*)(a.ws + ML_KVC) + (size_t)row * 256 + lane * 4) = o; }
    }
}
__device__ __forceinline__ void phase_mla_b(const Args& a, unsigned char* lds) {
    unsigned char* gl = lds + LDS_USER;
    const unsigned char* ws = a.ws;
    {
        const int xq = blockIdx.x & 7, nxw = (gridDim.x + 7 - xq) >> 3;
        int si = blockIdx.x >> 3;
        auto next = [&](g8::UTile& t) -> bool { const int m8 = si / 6, mt = 8 * m8 + xq; if (mt >= 130) return false; t.mt = mt; t.nt = si - m8 * 6; t.g = 0; si += nxw; return true; };
        const auto ctx = g8::make_ctx(
            [=](const g8::UTile& t) { return (const bf16_t*)(ws + ML_QC) + (size_t)t.mt * 256 * 384; },
            [=](const g8::UTile& t) { return (const bf16_t*)(ws + WS_MWQBT) + (size_t)t.nt * 256 * 384; },
            [=](const g8::UTile&, f32x4 (&acc)[2][2][4][2], int) { g8::zero_acc(acc); },
            [=](const g8::UTile&, const f32x4 (&acc)[2][2][4][2], int row0, int col0) {
                float* out = uniform_ptr((float*)(ws + ML_QF));
                g8::each_acc(acc, row0, col0, [=](int row, int col, const f32x4& v) { *(f32x4*)(out + (size_t)row * 1536 + col) = v; });
            });
        g8::gemm256_stream<false, g8::UTile>(384, 384u, gl, ctx, next);
    }
    {
        const int xq = blockIdx.x & 7, nxw = (gridDim.x + 7 - xq) >> 3;
        int si = nxw - 1 - (int)(blockIdx.x >> 3);
        auto next = [&](g8::UTile& t) -> bool { const int mt = 8 * (si >> 3) + xq; if (mt >= 130) return false; t.mt = mt; t.nt = si & 7; t.g = 0; si += nxw; return true; };
        const auto ctx = g8::make_ctx(
            [=](const g8::UTile& t) { return (const bf16_t*)(ws + ML_KVC) + (size_t)t.mt * 256 * 256; },
            [=](const g8::UTile& t) { return (const bf16_t*)(ws + WS_MWKVBT) + (size_t)t.nt * 256 * 256; },
            [=](const g8::UTile&, f32x4 (&acc)[2][2][4][2], int) { g8::zero_acc(acc); },
            [=](const g8::UTile&, const f32x4 (&acc)[2][2][4][2], int row0, int col0) {
                float* out = uniform_ptr((float*)(ws + ML_KVF));
                g8::each_acc(acc, row0, col0, [=](int row, int col, const f32x4& v) { *(f32x4*)(out + (size_t)row * 2048 + col) = v; });
            });
        g8::gemm256_stream<false, g8::UTile>(256, 256u, gl, ctx, next);
    }
}
__device__ __forceinline__ void phase_mla_rope(const Args& a, unsigned char* lds) {
    const int tid = otid();
    bf16_t* vt = (bf16_t*)(lds + LDS_USER);
    const float* qn = a.in[I_MQN]; const float* kn = a.in[I_MKN];
    const float QSCALE = 0.07216878364870322f * 1.4426950408889634f;
    for (int u = blockIdx.x; u < 520 * 8; u += gridDim.x) {
        const int rb = u >> 3, h = u & 7, row0 = rb * 64, b = row0 / RPB, within0 = row0 - b * RPB;
        const bool lat = within0 >= CTX;
#pragma unroll 1
        for (int pass = 0; pass < 2; ++pass) {
            const int rl = pass * 32 + (tid >> 4), g = tid & 15, row = row0 + rl;
            const int tpos = within0 + rl - CTX;
            float cs[4], sn[4];
            {
                const float inv = exp2f(-(float)g * (13.287712379549449f / 16.f));
                const float ar = (float)(tpos >> 6) * inv, ac = (float)(tpos & 63) * inv;
                cs[0] = lat ? cos_acc(ar) : 1.f; sn[0] = lat ? sin_acc(ar) : 0.f; cs[1] = lat ? cos_acc(ac) : 1.f; sn[1] = lat ? sin_acc(ac) : 0.f;
            }
            {
                const float* src = (const float*)(a.ws + ML_QF) + (size_t)row * 1536 + h * 192;
                const float4 n0 = *(const float4*)(src + g * 8), n1 = *(const float4*)(src + g * 8 + 4);
                float r0 = src[128 + g], r1 = src[144 + g], c0 = src[160 + g], c1 = src[176 + g];
                float ss = n0.x * n0.x + n0.y * n0.y + n0.z * n0.z + n0.w * n0.w + n1.x * n1.x + n1.y * n1.y + n1.z * n1.z + n1.w * n1.w + r0 * r0 + r1 * r1 + c0 * c0 + c1 * c1;
                ss = row16_sum(ss);
                const float rs = rsqrtf(ss * (1.f / 192.f) + 1e-6f) * QSCALE;
                const float4 g0 = *(const float4*)(qn + g * 8), g1 = *(const float4*)(qn + g * 8 + 4);
                bf16_t* dst = (bf16_t*)(a.ws + ML_Q) + (size_t)row * 1536 + h * 192;
                u32x4 o = { cvt_pk_bf16(n0.x * rs * g0.x, n0.y * rs * g0.y), cvt_pk_bf16(n0.z * rs * g0.z, n0.w * rs * g0.w), cvt_pk_bf16(n1.x * rs * g1.x, n1.y * rs * g1.y), cvt_pk_bf16(n1.z * rs * g1.z, n1.w * rs * g1.w) };
                *(u32x4*)(dst + g * 8) = o;
                r0 *= rs * qn[128 + g]; r1 *= rs * qn[144 + g]; c0 *= rs * qn[160 + g]; c1 *= rs * qn[176 + g];
                const unsigned pr = cvt_pk_bf16(r0 * cs[0] - r1 * sn[0], r0 * sn[0] + r1 * cs[0]), pc = cvt_pk_bf16(c0 * cs[1] - c1 * sn[1], c0 * sn[1] + c1 * cs[1]);
                dst[128 + g] = (bf16_t)(pr & 0xffffu); dst[144 + g] = (bf16_t)(pr >> 16); dst[160 + g] = (bf16_t)(pc & 0xffffu); dst[176 + g] = (bf16_t)(pc >> 16);
                float q2 = 0.f;
                { const float e[8] = { n0.x * rs * g0.x, n0.y * rs * g0.y, n0.z * rs * g0.z, n0.w * rs * g0.w, n1.x * rs * g1.x, n1.y * rs * g1.y, n1.z * rs * g1.z, n1.w * rs * g1.w };
#pragma unroll
                  for (int i = 0; i < 8; ++i) q2 += e[i] * e[i]; }
                q2 += r0 * r0 + r1 * r1 + c0 * c0 + c1 * c1;
                q2 = row16_sum(q2);
                const float4 k0g = *(const float4*)(kn + g * 8), k1g = *(const float4*)(kn + g * 8 + 4);
                float km = fmaxf(fmaxf(fmaxf(fabsf(k0g.x), fabsf(k0g.y)), fmaxf(fabsf(k0g.z), fabsf(k0g.w))), fmaxf(fmaxf(fabsf(k1g.x), fabsf(k1g.y)), fmaxf(fabsf(k1g.z), fabsf(k1g.w))));
                km = fmaxf(km, fmaxf(fmaxf(fabsf(kn[128 + g]), fabsf(kn[144 + g])), fmaxf(fabsf(kn[160 + g]), fabsf(kn[176 + g]))));
                km = fmaxf(km, dpp_f<0x128>(km)); km = fmaxf(km, dpp_f<0x124>(km)); km = fmaxf(km, dpp_f<0x122>(km)); km = fmaxf(km, dpp_f<0x121>(km));
                if (g == 0) ((float*)(a.ws + ML_QM))[(size_t)row * 8 + h] = 1.02f * sqrtf(q2) * km * 13.856406460551018f;
            }
            {
                const float* src = (const float*)(a.ws + ML_KVF) + (size_t)row * 2048 + h * 256;
                const float* pe = (const float*)(a.ws + ML_QKVA) + (size_t)row * 768 + 640;
                const float4 n0 = *(const float4*)(src + g * 8), n1 = *(const float4*)(src + g * 8 + 4);
                float r0 = pe[g], r1 = pe[16 + g], c0 = pe[32 + g], c1 = pe[48 + g];
                float ss = n0.x * n0.x + n0.y * n0.y + n0.z * n0.z + n0.w * n0.w + n1.x * n1.x + n1.y * n1.y + n1.z * n1.z + n1.w * n1.w + r0 * r0 + r1 * r1 + c0 * c0 + c1 * c1;
                ss = row16_sum(ss);
                const float rs = rsqrtf(ss * (1.f / 192.f) + 1e-6f);
                const float4 g0 = *(const float4*)(kn + g * 8), g1 = *(const float4*)(kn + g * 8 + 4);
                bf16_t* dst = (bf16_t*)(a.ws + ML_K) + (size_t)row * 1536 + h * 192;
                u32x4 o = { cvt_pk_bf16(n0.x * rs * g0.x, n0.y * rs * g0.y), cvt_pk_bf16(n0.z * rs * g0.z, n0.w * rs * g0.w), cvt_pk_bf16(n1.x * rs * g1.x, n1.y * rs * g1.y), cvt_pk_bf16(n1.z * rs * g1.z, n1.w * rs * g1.w) };
                *(u32x4*)(dst + g * 8) = o;
                r0 *= rs * kn[128 + g]; r1 *= rs * kn[144 + g]; c0 *= rs * kn[160 + g]; c1 *= rs * kn[176 + g];
                const unsigned pr = cvt_pk_bf16(r0 * cs[0] - r1 * sn[0], r0 * sn[0] + r1 * cs[0]), pc = cvt_pk_bf16(c0 * cs[1] - c1 * sn[1], c0 * sn[1] + c1 * cs[1]);
                dst[128 + g] = (bf16_t)(pr & 0xffffu); dst[144 + g] = (bf16_t)(pr >> 16); dst[160 + g] = (bf16_t)(pc & 0xffffu); dst[176 + g] = (bf16_t)(pc >> 16);
                const float4 v0 = *(const float4*)(src + 128 + g * 8), v1 = *(const float4*)(src + 128 + g * 8 + 4);
                const unsigned p0 = cvt_pk_bf16(v0.x, v0.y), p1 = cvt_pk_bf16(v0.z, v0.w), p2 = cvt_pk_bf16(v1.x, v1.y), p3 = cvt_pk_bf16(v1.z, v1.w);
                bf16_t* vd = vt + (g * 8) * 72 + rl;
                vd[0 * 72] = (bf16_t)(p0 & 0xffffu); vd[1 * 72] = (bf16_t)(p0 >> 16); vd[2 * 72] = (bf16_t)(p1 & 0xffffu); vd[3 * 72] = (bf16_t)(p1 >> 16);
                vd[4 * 72] = (bf16_t)(p2 & 0xffffu); vd[5 * 72] = (bf16_t)(p2 >> 16); vd[6 * 72] = (bf16_t)(p3 & 0xffffu); vd[7 * 72] = (bf16_t)(p3 >> 16);
            }
        }
        __syncthreads();
        {
            bf16_t* VT = (bf16_t*)(a.ws + ML_VT) + ((size_t)(b * 8 + h) * 128) * RPB + within0;
#pragma unroll
            for (int i = 0; i < 2; ++i) {
                const int idx = tid + i * 512, d = idx >> 3, c = idx & 7;
                *(u32x4*)(VT + (size_t)d * RPB + c * 8) = *(const u32x4*)(vt + d * 72 + c * 8);
            }
        }
        __syncthreads();
    }
}
constexpr int AT_KROW = 400, AT_VROW = 136, AT_KB = 64 * AT_KROW, AT_VB = 128 * AT_VROW, AT_BUF = AT_KB + AT_VB;
__device__ __forceinline__ void phase_mla_attn(const Args& a, unsigned char* lds) {
    const int tid = otid(), lane = tid & 63, wid = tid >> 6, ln = lane & 31, hk = lane >> 5;
    unsigned char* base = lds + LDS_USER;
    const bf16_t* Qg = (const bf16_t*)(a.ws + ML_Q); const bf16_t* Kg = (const bf16_t*)(a.ws + ML_K); const bf16_t* VTg = (const bf16_t*)(a.ws + ML_VT);
    bf16_t* Og = (bf16_t*)(a.ws + ML_O);
    if (wid >= 4) __builtin_amdgcn_s_setprio(1);
    const int xq = blockIdx.x & 7, nxw = (gridDim.x + 7 - xq) >> 3;
    for (int si = blockIdx.x >> 3; ; si += nxw) {
        int u;
        { const int pp = 8 * (si >> 6) + xq; u = pp < 16 ? pp * 64 + (si & 63) : 1024 + (si - 128) * 8 + xq; if (pp >= 16 && (si - 128) >= 2) break; }
        int b, h, qrow0, nkeys;
        if (u < 1024) { b = u >> 9; h = (u >> 6) & 7; qrow0 = b * RPB + CTX + (u & 63) * 256; nkeys = RPB; }
        else { const int v = u - 1024; b = v >> 3; h = v & 7; qrow0 = b * RPB; nkeys = CTX; }
        const int ntiles = nkeys >> 6;
        const bf16_t* Kb = Kg + (size_t)b * RPB * 1536 + h * 192;
        const bf16_t* Vb = VTg + (size_t)(b * 8 + h) * 128 * RPB;
        bf16x8 qf[12];
        {
            const bf16_t* qp = Qg + (size_t)(qrow0 + wid * 32 + ln) * 1536 + h * 192 + hk * 8;
#pragma unroll
            for (int ks = 0; ks < 12; ++ks) qf[ks] = *(const bf16x8*)(qp + ks * 16);
        }
        f32x16 o[4];
#pragma unroll
        for (int i = 0; i < 4; ++i)
#pragma unroll
            for (int r = 0; r < 16; ++r) o[i][r] = 0.f;
        float lrun = 0.f;
        const float nqm = -((const float*)(a.ws + ML_QM))[(size_t)(qrow0 + wid * 32 + ln) * 8 + h];
        u32x4 rk[3];
        auto gloadK = [&](int t) {
            const int k0 = t * 64;
#pragma unroll
            for (int i = 0; i < 3; ++i) { const int id = tid + i * 512, key = id / 24, c = id - key * 24; rk[i] = *(const u32x4*)(Kb + (size_t)(k0 + key) * 1536 + c * 8); }
        };
        auto gloadV = [&](int t) {
            const int k0 = t * 64;
#pragma unroll
            for (int i = 0; i < 2; ++i) { const int id = tid + i * 512, d = id >> 3, c = id & 7; rk[i] = *(const u32x4*)(Vb + (size_t)d * RPB + k0 + c * 8); }
        };
        auto lstoreK = [&](int buf) {
            unsigned char* kb = base + buf * AT_BUF;
#pragma unroll
            for (int i = 0; i < 3; ++i) { const int id = tid + i * 512, key = id / 24, c = id - key * 24; *(u32x4*)(kb + key * AT_KROW + c * 16) = rk[i]; }
        };
        auto lstoreV = [&](int buf) {
            unsigned char* vb = base + buf * AT_BUF + AT_KB;
#pragma unroll
            for (int i = 0; i < 2; ++i) { const int id = tid + i * 512, d = id >> 3, c = id & 7; *(u32x2*)(vb + d * AT_VROW + c * 16) = (u32x2){ rk[i][0], rk[i][1] }; *(u32x2*)(vb + d * AT_VROW + c * 16 + 8) = (u32x2){ rk[i][2], rk[i][3] }; }
        };
        gloadK(0); lstoreK(0); gloadV(0); lstoreV(0);
        __syncthreads();
        for (int t = 0; t < ntiles; ++t) {
            const bool more = t + 1 < ntiles;
            if (more) gloadK(t + 1);
            const unsigned char* kb = base + (t & 1) * AT_BUF; const unsigned char* vb = kb + AT_KB;
            f32x16 s0, s1;
#pragma unroll
            for (int r = 0; r < 16; ++r) { s0[r] = nqm; s1[r] = nqm; }
#pragma unroll
            for (int ks = 0; ks < 12; ++ks) {
                const bf16x8 k0f = *(const bf16x8*)(kb + ln * AT_KROW + ks * 32 + hk * 16);
                const bf16x8 k1f = *(const bf16x8*)(kb + (32 + ln) * AT_KROW + ks * 32 + hk * 16);
                s0 = __builtin_amdgcn_mfma_f32_32x32x16_bf16(k0f, qf[ks], s0, 0, 0, 0);
                s1 = __builtin_amdgcn_mfma_f32_32x32x16_bf16(k1f, qf[ks], s1, 0, 0, 0);
            }
            if (more) { lstoreK((t + 1) & 1); gloadV(t + 1); }
            float ps = 0.f;
#pragma unroll
            for (int r = 0; r < 16; ++r) { s0[r] = __builtin_amdgcn_exp2f(s0[r]); ps += s0[r]; }
#pragma unroll
            for (int r = 0; r < 16; ++r) { s1[r] = __builtin_amdgcn_exp2f(s1[r]); ps += s1[r]; }
            lrun += ps;
#pragma unroll
            for (int kb2 = 0; kb2 < 2; ++kb2) {
#pragma unroll
                for (int s = 0; s < 2; ++s) {
                    u32x4 pw;
                    if (kb2 == 0) pw = (u32x4){ cvt_pk_bf16(s0[8 * s + 0], s0[8 * s + 1]), cvt_pk_bf16(s0[8 * s + 2], s0[8 * s + 3]), cvt_pk_bf16(s0[8 * s + 4], s0[8 * s + 5]), cvt_pk_bf16(s0[8 * s + 6], s0[8 * s + 7]) };
                    else          pw = (u32x4){ cvt_pk_bf16(s1[8 * s + 0], s1[8 * s + 1]), cvt_pk_bf16(s1[8 * s + 2], s1[8 * s + 3]), cvt_pk_bf16(s1[8 * s + 4], s1[8 * s + 5]), cvt_pk_bf16(s1[8 * s + 6], s1[8 * s + 7]) };
                    const bf16x8 pf = __builtin_bit_cast(bf16x8, pw);
                    const int koff = (kb2 * 32 + s * 16 + hk * 4) * 2;
#pragma unroll
                    for (int db = 0; db < 4; ++db) {
                        const unsigned char* vp = vb + (db * 32 + ln) * AT_VROW + koff;
                        const u32x2 va = *(const u32x2*)vp, vc = *(const u32x2*)(vp + 16);
                        const bf16x8 vf = __builtin_bit_cast(bf16x8, ((u32x4){ va[0], va[1], vc[0], vc[1] }));
                        o[db] = __builtin_amdgcn_mfma_f32_32x32x16_bf16(vf, pf, o[db], 0, 0, 0);
                    }
                }
            }
            if (more) lstoreV((t + 1) & 1);
            __syncthreads();
        }
        const float ltot = lrun + __shfl_xor(lrun, 32);
        const float inv = 1.f / ltot;
        bf16_t* op = Og + (size_t)(qrow0 + wid * 32 + ln) * 1024 + h * 128;
#pragma unroll
        for (int db = 0; db < 4; ++db)
#pragma unroll
            for (int r4 = 0; r4 < 4; ++r4) {
                const int d = db * 32 + 8 * r4 + 4 * hk;
                u32x2 w = { cvt_pk_bf16(o[db][4 * r4 + 0] * inv, o[db][4 * r4 + 1] * inv), cvt_pk_bf16(o[db][4 * r4 + 2] * inv, o[db][4 * r4 + 3] * inv) };
                *(u32x2*)(op + d) = w;
            }
    }
    __builtin_amdgcn_s_setprio(0);
}
#if SELFTEST
constexpr size_t WS_FLAGS = WS_CNT + 1024;
__device__ __forceinline__ bool st_close(float got, float ref, float rtol = 0.03f, float atol = 0.03f) { return fabsf(got - ref) <= rtol * fabsf(ref) + atol && got == got; }
__device__ __forceinline__ void st_fail(const Args& a, unsigned bit) { atomicOr((unsigned*)(a.ws + WS_FLAGS), bit); }
__device__ __forceinline__ float st_h(const Args& a, int row, int k) { const bf16_t* H = (const bf16_t*)(a.ws + WS_H); return __uint_as_float((unsigned)H[(size_t)row * D + k] << 16); }
__device__ __forceinline__ float st_mix(const Args& a, int row, int k, const float* mu) {
    const int within = row % RPB;
    const float h = st_h(a, row, k);
    const float hp = (within == 0 || within == CTX) ? 0.f : st_h(a, row - 1, k);
    const float hn = (within == CTX - 1 || within == RPB - 1) ? 0.f : st_h(a, row + 1, k);
    return h + (0.5f * (hp + hn) - h) * mu[k];
}
__constant__ int st_rows[8] = { 0, 255, 256, 257, 16639, 16640, 20000, 33279 };
__constant__ int st_toks[6] = { 0, 300, 9000, 16640, 20000, 33279 };
__device__ __forceinline__ void selftest_rwkv_proj(const Args& a, int j) {
    const int tid = otid(), bid = blockIdx.x;
    if (bid >= 8) return;
    const int row = st_rows[bid];
    const float* mu = a.in[I_RMU] + (size_t)j * 6 * D;
    for (int it = tid; it < 3 * 64; it += NT) {
        const int g = it / 64, col = (it % 64) * 16 + 3 + g;
        const int mi = g == 0 ? 0 : (g == 1 ? 2 : 3);
        const float* W = a.in[I_RWRKV] + (size_t)(j * 3 + g) * D * D;
        float s = 0.f;
        for (int k = 0; k < D; ++k) s += st_mix(a, row, k, mu + mi * D) * W[(size_t)k * D + col];
        const float* out = (const float*)(a.ws + (g == 0 ? RW_R : (g == 1 ? RW_K : (j == 0 ? WS_VFIRST : RW_V))));
        float got = out[(size_t)row * D + col];
        if (g == 2 && j == 1) continue;
        if (!st_close(got, s)) st_fail(a, 1u);
    }
    if (j == 1 && tid >= 32 && tid < 40) {
        const int col = (tid - 32) * 128 + 9;
        const float* W = a.in[I_RWRKV] + (size_t)(j * 3 + 2) * D * D;
        float v = 0.f;
        for (int k = 0; k < D; ++k) v += st_mix(a, row, k, mu + 3 * D) * W[(size_t)k * D + col];
        float acc = 0.f;
        for (int q = 0; q < 32; ++q) { float hsum = 0.f; for (int k = 0; k < D; ++k) hsum += st_mix(a, row, k, mu + 3 * D) * a.in[I_RV1][(size_t)k * 32 + q]; acc += hsum * a.in[I_RV2][(size_t)q * D + col]; }
        const float gate = 1.f / (1.f + expf(-(a.in[I_RV0][col] + acc)));
        const float vf = ((const float*)(a.ws + WS_VFIRST))[(size_t)row * D + col];
        const float ref = v + (vf - v) * gate;
        const float got = ((const float*)(a.ws + RW_V))[(size_t)row * D + col];
        if (!st_close(got, ref)) st_fail(a, 1u);
    }
    if (tid < 24) {
        const int kind = tid / 8, col = (tid % 8) * 128 + 5 + kind;
        float got, ref;
        if (kind == 0) {
            const float* w1 = a.in[I_RW1] + (size_t)(j * 2 + 1) * D * 64; const float* w2 = a.in[I_RW2] + (size_t)(j * 2 + 1) * 64 * D;
            float acc = 0.f;
            for (int q = 0; q < 64; ++q) { float hsum = 0.f; for (int k = 0; k < D; ++k) hsum += st_mix(a, row, k, mu + 1 * D) * w1[(size_t)k * 64 + q]; acc += tanhf(hsum) * w2[(size_t)q * D + col]; }
            const float z = -(a.in[I_RW0][(j * 2 + 1) * D + col] + acc);
            const float sp = z > 20.f ? z : log1pf(expf(z));
            ref = expf(-expf(-sp - 0.5f));
            got = ((const float*)(a.ws + RW_WD1))[(size_t)row * D + col];
            if (!st_close(got, ref, 0.005f, 0.002f)) st_fail(a, 1u);
        } else if (kind == 1) {
            const float* a1 = a.in[I_RA1] + (size_t)(j * 2 + 0) * D * 64; const float* a2 = a.in[I_RA2] + (size_t)(j * 2 + 0) * 64 * D;
            float acc = 0.f;
            for (int q = 0; q < 64; ++q) { float hsum = 0.f; for (int k = 0; k < D; ++k) hsum += st_mix(a, row, k, mu + 4 * D) * a1[(size_t)k * 64 + q]; acc += hsum * a2[(size_t)q * D + col]; }
            ref = 1.f / (1.f + expf(-(a.in[I_RA0][(j * 2 + 0) * D + col] + acc)));
            got = ((const float*)(a.ws + RW_AD0))[(size_t)row * D + col];
            if (!st_close(got, ref, 0.02f, 0.01f)) st_fail(a, 1u);
        } else {
            const float* g1 = a.in[I_RG1] + (size_t)j * D * 160; const float* g2 = a.in[I_RG2] + (size_t)j * 160 * D;
            float acc = 0.f;
            for (int q = 0; q < 160; ++q) { float hsum = 0.f; for (int k = 0; k < D; ++k) hsum += st_mix(a, row, k, mu + 5 * D) * g1[(size_t)k * 160 + q]; acc += (1.f / (1.f + expf(-hsum))) * g2[(size_t)q * D + col]; }
            ref = acc; got = ((const float*)(a.ws + RW_G))[(size_t)row * D + col];
            if (!st_close(got, ref)) st_fail(a, 1u);
        }
    }
}
__device__ __forceinline__ void selftest_wkv(const Args& a, unsigned char* lds, int j) {
    const int tid = otid(), bid = blockIdx.x;
    if (bid >= 2 || tid >= 64) return;
    const int b = bid, h = bid ? 5 : 0, d = bid, vrow = tid;
    const float* R = (const float*)(a.ws + RW_R); const float* K = (const float*)(a.ws + RW_K);
    const float* V = (const float*)(a.ws + (j == 0 ? WS_VFIRST : RW_V));
    const float* WD = (const float*)(a.ws + (d == 0 ? RW_WD0 : RW_WD1)); const float* AD = (const float*)(a.ws + (d == 0 ? RW_AD0 : RW_AD1));
    const float* Y = (const float*)(a.ws + (d == 0 ? RW_Y0 : RW_Y1));
    float* S = (float*)(lds + LDS_USER) + tid;
    for (int k = 0; k < 64; ++k) S[k * 64] = 0.f;
    bool bad = false;
    for (int t = 0; t < 330; ++t) {
        const int p = (d == 0) ? t : ((t < CTX) ? (CTX - 1 - t) : (RPB + CTX - 1 - t));
        const size_t o = ((size_t)b * RPB + p) * D + h * 64;
        float n2 = 0.f;
        for (int k = 0; k < 64; ++k) { const float x = K[o + k] * a.in[I_RKK][j * D + h * 64 + k]; n2 += x * x; }
        const float inv = 1.f / fmaxf(sqrtf(n2), 1e-12f);
        float sa = 0.f;
        for (int k = 0; k < 64; ++k) sa += S[k * 64] * (-(K[o + k] * a.in[I_RKK][j * D + h * 64 + k] * inv));
        const float vv = V[o + vrow];
        float y = 0.f;
        for (int k = 0; k < 64; ++k) {
            const float kr = K[o + k], av = AD[o + k], kk = kr * a.in[I_RKK][j * D + h * 64 + k] * inv;
            const float sn = S[k * 64] * WD[o + k] + sa * (kk * av) + vv * (kr * (1.f + (av - 1.f) * a.in[I_RKA][j * D + h * 64 + k]));
            S[k * 64] = sn;
            y += sn * R[o + k];
        }
        if (!st_close(Y[o + vrow], y, 0.01f, 0.01f)) bad = true;
    }
    if (bad) st_fail(a, 2u);
}
__device__ __forceinline__ void selftest_moe(const Args& a, unsigned char* lds, int layer) {
    const int tid = otid(), bid = blockIdx.x;
    if (bid >= 6) return;
    const int row = st_toks[bid], midx = mod_index(row);
    float* h2 = (float*)(lds + LDS_USER);
    float* act = h2 + 1024;
    float* red = act + 1024;
    float* outv = red + 512;
    float* lg = outv + 1024;
    const float* X = (const float*)(a.ws + WS_X) + (size_t)row * D;
    const float* mod = (const float*)(a.ws + WS_MOD) + ((size_t)layer * 3 + midx) * 6144;
    float ss = 0.f;
    for (int k = tid; k < D; k += NT) ss += X[k] * X[k];
    red[tid] = ss; __syncthreads();
    if (tid == 0) { float s = 0.f; for (int i = 0; i < NT; ++i) s += red[i]; red[0] = rsqrtf(s / 1024.f + 1e-6f); }
    __syncthreads();
    const float rstd = red[0];
    __syncthreads();
    for (int k = tid; k < D; k += NT) h2[k] = X[k] * rstd * a.in[I_NFFN][layer * D + k] * (1.f + mod[4 * 1024 + k]) + mod[3 * 1024 + k];
    for (int k = tid; k < D; k += NT) outv[k] = 0.f;
    __syncthreads();
    if (tid < 32) { float s = a.in[I_ERB][layer * 32 + tid]; for (int k = 0; k < D; ++k) s += h2[k] * a.in[I_ERW][(size_t)layer * 32768 + k * 32 + tid]; lg[tid] = s; }
    __syncthreads();
    int te[4]; float tvv[4];
    if (tid == 0) {
        for (int r = 0; r < 4; ++r) { int bi = 0; float bv = -INFINITY; for (int e = 0; e < 32; ++e) if (lg[e] > bv) { bv = lg[e]; bi = e; } lg[32 + r] = bv; ((int*)lg)[36 + r] = bi; lg[bi] = -INFINITY; }
    }
    __syncthreads();
#pragma unroll
    for (int r = 0; r < 4; ++r) { tvv[r] = lg[32 + r]; te[r] = ((int*)lg)[36 + r]; }
    float gs = 0.f; float gt[4];
#pragma unroll
    for (int r = 0; r < 4; ++r) { gt[r] = expf(tvv[r] - tvv[0]); gs += gt[r]; }
#pragma unroll
    for (int r = 0; r < 4; ++r) gt[r] /= gs;
    if (tid == 0) {
        const int* ae = (const int*)(a.ws + WS_ASGE) + (size_t)row * 4; const float* ag = (const float*)(a.ws + WS_ASGG) + (size_t)row * 4;
#pragma unroll
        for (int r = 0; r < 4; ++r) { if ((ae[r] >> 24) != te[r]) st_fail(a, 4u); if (!st_close(ag[r], gt[r], 0.02f, 0.005f)) st_fail(a, 4u); }
    }
#pragma unroll 1
    for (int rr = 0; rr < 4; ++rr) {
        const int e = rr == 0 ? te[0] : (rr == 1 ? te[1] : (rr == 2 ? te[2] : te[3])); const float gtr = rr == 0 ? gt[0] : (rr == 1 ? gt[1] : (rr == 2 ? gt[2] : gt[3]));
        const float* win = a.in[I_EWIN] + ((size_t)layer * 32 + e) * 1024 * 2048; const float* bin = a.in[I_EBIN] + ((size_t)layer * 32 + e) * 2048;
        const float* wout = a.in[I_EWOUT] + ((size_t)layer * 32 + e) * 1024 * 1024; const float* bout = a.in[I_EBOUT] + ((size_t)layer * 32 + e) * 1024;
        for (int c = tid; c < 1024; c += NT) {
            float g = bin[c], l = bin[1024 + c];
            for (int k = 0; k < D; ++k) { g += h2[k] * win[(size_t)k * 2048 + c]; l += h2[k] * win[(size_t)k * 2048 + 1024 + c]; }
            g = fminf(g, 7.f); l = fminf(fmaxf(l, -7.f), 7.f);
            act[c] = g * (1.f / (1.f + expf(-1.702f * g))) * (l + 1.f);
        }
        __syncthreads();
        for (int c = tid; c < 1024; c += NT) { float s = bout[c]; for (int k = 0; k < 1024; ++k) s += act[k] * wout[(size_t)k * 1024 + c]; outv[c] += gtr * s; }
        __syncthreads();
    }
    {
        const int* cnt = (const int*)(a.ws + WS_CNT2) + layer * 32 * CSTR;
        const int* ae = (const int*)(a.ws + WS_ASGE) + (size_t)row * 4; const float* ag = (const float*)(a.ws + WS_ASGG) + (size_t)row * 4;
        for (int c = tid; c < 1024; c += NT) {
            float s = 0.f;
            for (int r = 0; r < 4; ++r) {
                const int e = ae[r] >> 24, slot = ae[r] & 0xffffff; int ps = 0; for (int q = 0; q < e; ++q) ps += ((cnt[q * CSTR] + 255) >> 8) << 8;
                s += ag[r] * __uint_as_float((unsigned)((const bf16_t*)(a.ws + WS_YB))[((size_t)ps + slot) * D + c] << 16);
            }
            if (!st_close(s, outv[c], 0.03f, 0.03f)) st_fail(a, 4u);
        }
    }
    __syncthreads();
}

#if HAVE_HYENA
__device__ __forceinline__ void selftest_hy_filters(const Args& a, unsigned char* lds) {
    const int tid = otid();
    if (blockIdx.x != 0 || tid >= 32) return;
    const int isctx = tid >> 4, q = tid & 15, ni = q >> 2, ci = q & 3;
    const int Lh = isctx ? CTX : SEQ;
    const int n = ni == 0 ? 0 : (ni == 1 ? 1 : (ni == 2 ? (isctx ? 100 : 7777) : Lh - 1));
    const int c = ci == 0 ? 0 : (ci == 1 ? 513 : (ci == 2 ? 1023 : 1024 + 300));
    float* h1 = (float*)(lds + LDS_USER) + tid * 200; float* h2 = h1 + 64; float* zz = h2 + 64;
    zz[0] = (float)n / (float)(Lh - 1);
    for (int i = 0; i < 16; ++i) { const float f = 1e-4f + (float)i * ((15.0f - 1e-4f) / 15.0f); const float ang = 2.0f * 3.14159265358979323846f * f * (float)n / (float)Lh; zz[1 + i] = cos_acc(ang); zz[17 + i] = -sin_acc(ang); }
    for (int h = 0; h < 64; ++h) { float s = a.in[I_HFB1][h]; for (int k = 0; k < 33; ++k) s += zz[k] * a.in[I_HFW1][k * 64 + h]; h1[h] = sin_acc(a.in[I_HFREQ][h] * s); }
    for (int h = 0; h < 64; ++h) { float s = a.in[I_HFB2][h]; for (int k = 0; k < 64; ++k) s += h1[k] * a.in[I_HFW2][k * 64 + h]; h2[h] = sin_acc(a.in[I_HFREQ][64 + h] * s); }
    for (int h = 0; h < 64; ++h) { float s = a.in[I_HFB3][h]; for (int k = 0; k < 64; ++k) s += h2[k] * a.in[I_HFW3][k * 64 + h]; h1[h] = sin_acc(a.in[I_HFREQ][128 + h] * s); }
    float s = 0.f; for (int k = 0; k < 64; ++k) s += h1[k] * a.in[I_HFWOUT][(size_t)k * 2048 + c];
    const int ch = c & 1023;
    const float dl = fabsf(-15.350567286626973f + (float)ch * ((-3.0701134573253946f + 15.350567286626973f) / 1023.0f));
    const float ref = s * expf(-zz[0] * dl);
    float got;
    if (isctx) got = ((const float*)(a.ws + (c < 1024 ? HY_HFC : HY_HBC)))[(size_t)n * D + ch];
    else got = ((const float*)(a.ws + (c < 1024 ? HY_HF : HY_HB)))[(size_t)ch * SEQ + n];
    if (!st_close(got, ref, 0.01f, 2e-4f)) st_fail(a, 16u);
}
__device__ __forceinline__ float st_uu(const Args& a, int b, bool isctx, int t, int col) {
    const int Lh = isctx ? CTX : SEQ;
    if (t < 0 || t >= Lh) return 0.f;
    const size_t row = (size_t)b * RPB + (isctx ? 0 : CTX) + t;
    return __uint_as_float((unsigned)((const bf16_t*)(a.ws + HY_UU))[row * 3072 + col] << 16);
}
__device__ __forceinline__ float st_dw(const Args& a, int b, bool isctx, int t, int col) {
    const float* sw = a.in[I_HSW];
    return st_uu(a, b, isctx, t - 1, col) * sw[col] + st_uu(a, b, isctx, t, col) * sw[3072 + col] + st_uu(a, b, isctx, t + 1, col) * sw[2 * 3072 + col] + a.in[I_HSB][col];
}
__device__ __forceinline__ void selftest_hy_p(const Args& a) {
    const int tid = otid(), lane = tid & 63, wid = tid >> 6;
    if (blockIdx.x >= 2) return;
    const int sidx = blockIdx.x * 8 + wid;
    const bool isctx = sidx >= 10;
    const int b = sidx & 1, Lh = isctx ? CTX : SEQ;
    const int tsel = (sidx >> 1) % 5;
    const int t = tsel == 0 ? 0 : (tsel == 1 ? 3 : (tsel == 2 ? Lh / 2 + 1 : (tsel == 3 ? Lh - 2 : Lh - 1)));
    const int c = (sidx * 197 + 11) & 1023;
    float acc = 0.f;
    for (int s = lane; s < Lh; s += 64) {
        const float z = st_dw(a, b, isctx, s, 2048 + c) * st_dw(a, b, isctx, s, 1024 + c);
        float tap;
        if (isctx) tap = (s <= t) ? ((const float*)(a.ws + HY_HFC))[(size_t)(t - s) * D + c] : ((const float*)(a.ws + HY_HBC))[(size_t)(s - t) * D + c];
        else tap = (s <= t) ? ((const float*)(a.ws + HY_HF))[(size_t)c * SEQ + (t - s)] : ((const float*)(a.ws + HY_HB))[(size_t)c * SEQ + (s - t)];
        acc += tap * z;
    }
    acc = wave_sum(acc);
    const float zt = st_dw(a, b, isctx, t, 2048 + c) * st_dw(a, b, isctx, t, 1024 + c), x0 = st_dw(a, b, isctx, t, c);
    const float ref = x0 * (acc + zt * a.in[I_HBIAS][c]);
    const size_t row = (size_t)b * RPB + (isctx ? 0 : CTX) + t;
    const float got = __uint_as_float((unsigned)((const bf16_t*)(a.ws + HY_P))[row * D + c] << 16);
    if (lane == 0 && !st_close(got, ref, 0.03f, 0.02f)) st_fail(a, 16u);
}
#endif

#if HAVE_MLA
__device__ __forceinline__ void st_mla_vec(const Args& a, int row, int h, bool isq, float* o  ) {
    const int b = row / RPB, within = row - b * RPB; const bool lat = within >= CTX; const int tpos = within - CTX;
    float ss = 0.f;
    for (int i = 0; i < 192; ++i) {
        float v;
        if (isq) v = ((const float*)(a.ws + ML_QF))[(size_t)row * 1536 + h * 192 + i];
        else v = i < 128 ? ((const float*)(a.ws + ML_KVF))[(size_t)row * 2048 + h * 256 + i] : ((const float*)(a.ws + ML_QKVA))[(size_t)row * 768 + 640 + (i - 128)];
        o[i] = v; ss += v * v;
    }
    const float rs = rsqrtf(ss / 192.f + 1e-6f);
    const float* gn = a.in[isq ? I_MQN : I_MKN];
    for (int i = 0; i < 192; ++i) o[i] = o[i] * rs * gn[i];
    if (lat) {
        for (int part = 0; part < 2; ++part) {
            const int pos = part == 0 ? (tpos >> 6) : (tpos & 63);
            for (int i = 0; i < 16; ++i) {
                const float inv = exp2f(-(float)i * (13.287712379549449f / 16.f)), ang = (float)pos * inv, c = cos_acc(ang), s = sin_acc(ang);
                const float x1 = o[128 + part * 32 + i], x2 = o[128 + part * 32 + 16 + i];
                o[128 + part * 32 + i] = x1 * c - x2 * s; o[128 + part * 32 + 16 + i] = x1 * s + x2 * c;
            }
        }
    }
}
__device__ __forceinline__ float st_mla_kraw(const Args& a, int row, int h, int i) {
    return i < 128 ? ((const float*)(a.ws + ML_KVF))[(size_t)row * 2048 + h * 256 + i] : ((const float*)(a.ws + ML_QKVA))[(size_t)row * 768 + 640 + (i - 128)];
}
__device__ __forceinline__ float st_mla_qk(const Args& a, const float* qv, int row, int h) {
    const int b = row / RPB, within = row - b * RPB; const bool lat = within >= CTX; const int tpos = within - CTX;
    float ss = 0.f;
#pragma unroll 1
    for (int i = 0; i < 192; ++i) { const float v = st_mla_kraw(a, row, h, i); ss += v * v; }
    const float rs = rsqrtf(ss / 192.f + 1e-6f);
    const float* gn = a.in[I_MKN];
    float dot = 0.f;
#pragma unroll 1
    for (int i = 0; i < 128; ++i) dot += qv[i] * st_mla_kraw(a, row, h, i) * rs * gn[i];
#pragma unroll 1
    for (int part = 0; part < 2; ++part) {
        const int pos = part == 0 ? (tpos >> 6) : (tpos & 63);
#pragma unroll 1
        for (int i = 0; i < 16; ++i) {
            const int i1 = 128 + part * 32 + i, i2 = i1 + 16;
            const float x1 = st_mla_kraw(a, row, h, i1) * rs * gn[i1], x2 = st_mla_kraw(a, row, h, i2) * rs * gn[i2];
            float c = 1.f, s = 0.f;
            if (lat) { const float inv = exp2f(-(float)i * (13.287712379549449f / 16.f)), ang = (float)pos * inv; c = cos_acc(ang); s = sin_acc(ang); }
            dot += qv[i1] * (x1 * c - x2 * s) + qv[i2] * (x1 * s + x2 * c);
        }
    }
    return dot;
}
__device__ __forceinline__ void selftest_mla(const Args& a, unsigned char* lds) {
    const int tid = otid(), lane = tid & 63, wid = tid >> 6;
    if (blockIdx.x != 0) return;
    float* qv = (float*)(lds + LDS_USER) + wid * 192;
    const int b = wid & 1;
    const int within = wid < 2 ? CTX : (wid < 4 ? RPB - 1 : (wid < 6 ? CTX + 5000 + wid : 100 + wid));
    const int h = (wid * 3) & 7, row = b * RPB + within;
    const bool qctx = within < CTX;
    if (lane == 0) st_mla_vec(a, row, h, true, qv);
    __syncthreads();
    const int nkeys = qctx ? CTX : RPB;
    float m = -INFINITY, l = 0.f, acc[8];
#pragma unroll
    for (int i = 0; i < 8; ++i) acc[i] = 0.f;
#pragma unroll 1
    for (int t = lane; t < nkeys; t += 64) {
        const int krow = b * RPB + t;
        const float s = st_mla_qk(a, qv, krow, h) * 0.07216878364870322f;
        const float mn = fmaxf(m, s), al = expf(m - mn), p = expf(s - mn);
        l = l * al + p;
#pragma unroll
        for (int i = 0; i < 8; ++i) acc[i] = acc[i] * al + p * ((const float*)(a.ws + ML_KVF))[(size_t)krow * 2048 + h * 256 + 128 + i * 16 + 3];
        m = mn;
    }
    float mg = m;
#pragma unroll
    for (int o = 32; o >= 1; o >>= 1) mg = fmaxf(mg, __shfl_xor(mg, o));
    const float sc = expf(m - mg);
    const float lt = wave_sum(l * sc);
    bool bad = false;
#pragma unroll
    for (int i = 0; i < 8; ++i) {
        const float ref = wave_sum(acc[i] * sc) / lt;
        const float got = __uint_as_float((unsigned)((const bf16_t*)(a.ws + ML_O))[(size_t)row * 1024 + h * 128 + i * 16 + 3] << 16);
        if (!st_close(got, ref, 0.03f, 0.01f)) bad = true;
    }
    if (bad && lane == 0) st_fail(a, 32u);
}
#endif
__device__ __forceinline__ void selftest_finish(const Args& a) {
    if (blockIdx.x == 0 && otid() == 0) {
        unsigned m = __hip_atomic_load((unsigned*)(a.ws + WS_FLAGS), __ATOMIC_RELAXED, __HIP_MEMORY_SCOPE_AGENT);
        if (__hip_atomic_load((unsigned*)(a.ws + WS_BAR) + XB_TMO, __ATOMIC_RELAXED, __HIP_MEMORY_SCOPE_AGENT)) m |= 8u;
        if (m) a.out[0] = 1e4f * exp2f((float)m);
    }
}
#endif
#if HAVE_HYENA
__device__ __forceinline__ void hyena_layer(const Args& a, unsigned char* lds, int layer, const XcdBarrier& bar) {
    for (int r = 0; r < REP_EW * REPI(1); ++r) { phase_hy_filters(a, lds); xcd_barrier(bar); }
#if SELFTEST
    selftest_hy_filters(a, lds); __syncthreads();
#endif
    for (int r = 0; r < REP_FFT * REPI(7); ++r) { phase_hy_filter_fft(a, lds); xcd_barrier(bar); }
    for (int r = 0; r < REP_PROJ * REPI(11); ++r) { phase_hy_in(a, lds); xcd_barrier(bar); }
    for (int r = 0; r < REP_EW * REPI(2); ++r) { phase_hy_short(a, lds); xcd_barrier(bar); }
    for (int r = 0; r < REP_FFT * REPI(8); ++r) { phase_hy_fftconv(a, lds); xcd_barrier(bar); }
    for (int r = 0; r < REP_EW * REPI(3); ++r) { phase_hy_combine(a, lds); xcd_barrier(bar); }
#if SELFTEST
    selftest_hy_p(a);
#endif
    phase_outproj(a, lds, layer, (const bf16_t*)(a.ws + HY_P), (const bf16_t*)(a.ws + WS_HYOUTT), a.in[I_HBOUT]); xcd_barrier(bar);
}
#endif
#if HAVE_MLA
__device__ __forceinline__ void mla_layer(const Args& a, unsigned char* lds, int layer, const XcdBarrier& bar) {
    for (int r = 0; r < REP_PROJ * REPI(9); ++r) { phase_mla_a(a, lds); xcd_barrier(bar); }
    for (int r = 0; r < REP_EW * REPI(4); ++r) { phase_mla_norm(a); xcd_barrier(bar); }
    for (int r = 0; r < REP_PROJ * REPI(10); ++r) { phase_mla_b(a, lds); xcd_barrier(bar); }
    for (int r = 0; r < REP_EW * REPI(5); ++r) { phase_mla_rope(a, lds); xcd_barrier(bar); }
    for (int r = 0; r < REP_ATT; ++r) { phase_mla_attn(a, lds); xcd_barrier(bar); }
#if SELFTEST
    selftest_mla(a, lds); __syncthreads();
#endif
    phase_outproj(a, lds, layer, (const bf16_t*)(a.ws + ML_O), (const bf16_t*)(a.ws + WS_MWOT), nullptr); xcd_barrier(bar);
}
#endif
constexpr size_t WS_END0 = RW_END > HY_END ? RW_END : HY_END;
constexpr size_t WS_END = WS_END0 > ML_END ? WS_END0 : ML_END;
static_assert(WS_END <= WS_SHADOW_ABS, "shadow tables overlap the workspace");
#ifndef NLAYERS
#define NLAYERS 4
#endif
template <int J> __device__ __forceinline__ void rwkv_layer(const Args& a, unsigned char* lds, int l, const XcdBarrier& bar) {
    for (int r = 0; r < REP_MIX; ++r) { phase_rwkv_mix(a, J); xcd_barrier(bar); }
    for (int r = 0; r < REP_PROJ * REPI(12); ++r) { phase_rwkv_proj1(a, lds, J); xcd_barrier(bar); }
    for (int r = 0; r < (J == 0 ? REP_P2 : 1); ++r) { phase_rwkv_proj2(a, lds, J); xcd_barrier(bar); }
#if SELFTEST
    selftest_rwkv_proj(a, J);
#endif
    for (int r = 0; r < REP_WKV; ++r) phase_wkv_pipe(a, lds, J, bar);
#if SELFTEST
    selftest_wkv(a, lds, J); __syncthreads();
#endif
    for (int r = 0; r < REP_EW * REPI(6); ++r) { phase_rwkv_readout(a, J);    xcd_barrier(bar); }
    phase_outproj(a, lds, l, (const bf16_t*)(a.ws + RW_Z), (const bf16_t*)(a.ws + WS_RWOT) + (size_t)J * D * D, nullptr);
    xcd_barrier(bar);
}
template <int L> __device__ __forceinline__ void ffn_layer(const Args& a, unsigned char* lds, const XcdBarrier& bar) {
    for (int r = 1; r < REP_RT; ++r) { phase_norm_router(a, lds, L, 1); xcd_barrier(bar); }
    phase_norm_router(a, lds, L); xcd_barrier(bar);
    for (int r = 0; r < REP_MOE * REPI(21); ++r) { phase_moe1(a, lds, L); xcd_barrier(bar); }
    for (int r = 0; r < REP_MOE * REPI(22); ++r) { phase_moe2(a, lds, L); xcd_barrier(bar); }
#if SELFTEST
    selftest_moe(a, lds, L); xcd_barrier(bar);
#endif
}
__global__ void __launch_bounds__(NT, 2) mega(Args a) {
    extern __shared__ __attribute__((aligned(16))) unsigned char lds[];
    if (threadIdx.x < 16) ((volatile LAS unsigned*)lds)[threadIdx.x] = 0u;
    __syncthreads();
    XcdBarrier bar = xcd_barrier_post((unsigned*)(a.ws + WS_BAR), (volatile LAS unsigned*)lds);
#if TIMING
    if (blockIdx.x == 0 && threadIdx.x == 0) ((unsigned long long*)(a.ws + WS_CNT + 2048))[0] = wall_clock64();
#endif
    for (int r = 0; r < REP_PRO; ++r) { phase_prologue(a, lds);
    xcd_barrier(bar); }
    for (int r = 0; r < REP_N0; ++r) { phase_norm<true, false, false, false>(a, lds, 0); xcd_barrier(bar); }
    rwkv_layer<0>(a, lds, 0, bar);
    ffn_layer<0>(a, lds, bar);
#if NLAYERS > 1
    for (int r = 1; r < REP_NC; ++r) { phase_norm<false, true, false, false>(a, lds, 1, 1); xcd_barrier(bar); }
    phase_norm<false, true, false, false>(a, lds, 1); xcd_barrier(bar);
    hyena_layer(a, lds, 1, bar);
    ffn_layer<1>(a, lds, bar);
#endif
#if NLAYERS > 2
    for (int r = 1; r < REP_NC; ++r) { phase_norm<false, true, false, false>(a, lds, 2, 1); xcd_barrier(bar); }
    phase_norm<false, true, false, false>(a, lds, 2); xcd_barrier(bar);
    mla_layer(a, lds, 2, bar);
    ffn_layer<2>(a, lds, bar);
#endif
#if NLAYERS > 3
    for (int r = 1; r < REP_NC; ++r) { phase_norm<false, true, false, false>(a, lds, 3, 1); xcd_barrier(bar); }
    phase_norm<false, true, false, false>(a, lds, 3); xcd_barrier(bar);
    rwkv_layer<1>(a, lds, 3, bar);
    ffn_layer<3>(a, lds, bar);
#endif
    for (int r = 0; r < REP_BAR; ++r) xcd_barrier(bar);
    phase_norm<false, true, false, true>(a, lds, NLAYERS);
#if SELFTEST
    xcd_barrier(bar); selftest_finish(a);
#endif
#if TIMING
    xcd_barrier(bar);
    {
        const unsigned long long* ts = (const unsigned long long*)(a.ws + WS_CNT + 2048);
        const float t1 = (float)(ts[TS_A] - ts[0]) * 0.01f, t2 = (float)(ts[TS_B] - ts[0]) * 0.01f;
        if (blockIdx.x == 0 && threadIdx.x == 0) a.out[0] = 1e4f * t1;
        for (int i = blockIdx.x * NT + threadIdx.x; i < (1 << 20); i += gridDim.x * NT) a.out[1024 + i] = 1e2f * t2;
    }
#endif
}

extern "C" void kernel_launch(void* const* d_in, const int* in_sizes, int n_in, void* d_out, int out_size, void* d_ws, size_t ws_size, hipStream_t stream) {
    static int grid = 0;
    if (grid == 0) {
        int dev = 0, cus = 0, per_cu = 0;
        if (hipGetDevice(&dev) != hipSuccess || hipDeviceGetAttribute(&cus, hipDeviceAttributeMultiprocessorCount, dev) != hipSuccess) { grid = -1; return; }
        if (hipFuncSetAttribute((const void*)mega, hipFuncAttributeMaxDynamicSharedMemorySize, LDS_BYTES) != hipSuccess) { grid = -1; return; }
        if (hipOccupancyMaxActiveBlocksPerMultiprocessor(&per_cu, (const void*)mega, NT, LDS_BYTES) != hipSuccess || per_cu < 1) fprintf(stderr, "occupancy query: %d\n", per_cu);
        (void)hipGetLastError();
        if (n_in != N_IN || ws_size < WS_END) { fprintf(stderr, "kernel_launch: n_in %d ws %zu (need %zu)\n", n_in, ws_size, (size_t)WS_END); grid = -1; return; }
        grid = cus;
        if ((T + grid * 8 - 1) / (grid * 8) > rt::RCAP / 8) { fprintf(stderr, "kernel_launch: %d workgroups are too few\n", grid); grid = -1; return; }
    }
    if (grid < 0) return;
    (void)hipMemsetAsync(d_ws, 0, WS_ZERO_BYTES, stream);
    Args a{};
    for (int i = 0; i < N_IN; ++i) a.in[i] = (const float*)d_in[i];
    a.out = (float*)d_out; a.ws = (unsigned char*)d_ws;
    hipLaunchKernelGGL(mega, dim3(grid), dim3(NT), LDS_BYTES, stream, a);
}
```

```cpp
#ifndef HAVE_HYENA
#define HAVE_HYENA 1
#endif
#ifndef HAVE_MLA
#define HAVE_MLA 1
#endif
#ifndef REP_MOE
#define REP_MOE 1
#endif
#ifndef REP_WKV
#define REP_WKV 1
#endif
#ifndef REP_PROJ
#define REP_PROJ 1
#endif
#ifndef REP_PRO
#define REP_PRO 1
#endif
#ifndef REP_ATT
#define REP_ATT 1
#endif
#ifndef REP_FFT
#define REP_FFT 1
#endif
#ifndef REP_EW
#define REP_EW 1
#endif
#ifndef WKV_PHASE
#define WKV_PHASE phase_wkv2
#endif
#ifndef REP_WKVP
#define REP_WKVP 1
#endif
#ifndef REP_WKVS
#define REP_WKVS 1
#endif
#ifndef REP_N0
#define REP_N0 1
#endif
#ifndef REP_MIX
#define REP_MIX 1
#endif
#ifndef REP_P2
#define REP_P2 1
#endif
#ifndef REP_BAR
#define REP_BAR 0
#endif
#ifndef REP_RT
#define REP_RT 1
#endif
#ifndef SHADOW_NOATOM
#define SHADOW_NOATOM 0
#endif
#ifndef REP_NC
#define REP_NC 1
#endif
#ifndef REP_ID
#define REP_ID 0
#endif
#define REPI(id) ((id) == REP_ID ? 2 : 1)
#ifndef WKV_SERIAL
#define WKV_SERIAL 0
#endif
#ifndef MOE1_MAP
#define MOE1_MAP 3
#endif
#ifndef WKNSEG
#define WKNSEG 8
#endif
#include <hip/hip_runtime.h>
#include <cstdio>
#include <cstdint>

#define XB_TMO      128
#define XB_XCNT(j)  (256  + 64 * (j))
#define XB_XSUB(j)  (1280 + 64 * (j))
#define XB_XGEN(j)  (2304 + 64 * (j))
#define XB_TOP      3328
#define XB_TOPGEN   3392
#define XCD_BAR_WORDS 3456
#define XB_SPIN_CAP (1u << 22)
#define LAS __attribute__((address_space(3)))

__device__ __forceinline__ unsigned xb_ld(unsigned* p)              { return __hip_atomic_load(p, __ATOMIC_RELAXED, __HIP_MEMORY_SCOPE_AGENT); }
__device__ __forceinline__ unsigned xb_add(unsigned* p, unsigned v) { return __hip_atomic_fetch_add(p, v, __ATOMIC_RELAXED, __HIP_MEMORY_SCOPE_AGENT); }
__device__ __forceinline__ unsigned xb_xcc_id() { return (unsigned)__builtin_amdgcn_s_getreg((3 << 11) | 20) & 0xFu; }
#define XB_SPIN(cond, bar) do { unsigned _sp = 0; while (cond) { __builtin_amdgcn_s_sleep(SL); \
    if ((++_sp & 255u) == 0u) { if (xb_ld(&(bar)[XB_TMO])) break; if (_sp > XB_SPIN_CAP) { atomicAdd(&(bar)[XB_TMO], 1u); break; } } } } while (0)

struct XcdBarrier { unsigned* bar; unsigned x; volatile LAS unsigned* st; };

__device__ __forceinline__ XcdBarrier xcd_barrier_post(unsigned* bar, volatile LAS unsigned* st) {
    XcdBarrier b; b.bar = bar; b.x = xb_xcc_id(); b.st = st;
    if (threadIdx.x == 0) (void)xb_add(&bar[XB_XCNT(b.x)], 1u);
    return b;
}
__device__ __forceinline__ void xcd_barrier_complete(unsigned* bar, unsigned x, unsigned& nloc, unsigned& nx) {
    const unsigned G = gridDim.x * gridDim.y * gridDim.z;
    unsigned sum, cnt, mine, sp = 0u;
    for (;;) {
        sum = 0u; cnt = 0u; mine = 0u;
#pragma unroll
        for (unsigned j = 0; j < 16; ++j) { const unsigned c = xb_ld(&bar[XB_XCNT(j)]); sum += c; cnt += (c > 0u) ? 1u : 0u; mine = (j == x) ? c : mine; }
        if (sum == G) break;
        __builtin_amdgcn_s_sleep(1);
        if ((++sp & 255u) == 0u) { if (xb_ld(&bar[XB_TMO])) break; if (sp > XB_SPIN_CAP) { atomicAdd(&bar[XB_TMO], 1u); break; } }
    }
    nloc = mine > 0u ? mine : 1u; nx = cnt > 0u ? cnt : 1u;
}
template <int SL = 1> __device__ __forceinline__ void xcd_barrier(const XcdBarrier& b) {
    asm volatile("s_waitcnt vmcnt(0)" ::: "memory");
    __syncthreads();
    if (threadIdx.x == 0) {
        unsigned* bar = b.bar;
        __builtin_amdgcn_s_waitcnt(0);
        unsigned nloc = b.st[0], nx = b.st[1];
        if (nloc == 0u) { xcd_barrier_complete(bar, b.x, nloc, nx); b.st[0] = nloc; b.st[1] = nx; }
        const unsigned old = xb_add(&bar[XB_XSUB(b.x)], 1u);
        const unsigned gen = old / nloc;
        if (old + 1u == (gen + 1u) * nloc) {
            __builtin_amdgcn_fence(__ATOMIC_RELEASE, "agent");
            asm volatile("s_waitcnt vmcnt(0)" ::: "memory");
            const unsigned og = xb_add(&bar[XB_TOP], 1u);
            const unsigned tg = og / nx;
            if (og + 1u == (tg + 1u) * nx) xb_add(&bar[XB_TOPGEN], 1u);
            else XB_SPIN(xb_ld(&bar[XB_TOPGEN]) == tg, bar);
            __builtin_amdgcn_fence(__ATOMIC_ACQUIRE, "agent");
            xb_add(&bar[XB_XGEN(b.x)], 1u);
            asm volatile("s_waitcnt vmcnt(0)" ::: "memory");
        } else {
            XB_SPIN(xb_ld(&bar[XB_XGEN(b.x)]) == gen, bar);
            __builtin_amdgcn_fence(__ATOMIC_ACQUIRE, "agent");
            asm volatile("s_waitcnt vmcnt(0)" ::: "memory");
        }
#if TIMING
        if (blockIdx.x == 0) { const unsigned k = b.st[2] + 1u; b.st[2] = k; ((unsigned long long*)(b.bar + 4608))[k] = wall_clock64(); }
#endif
    }
    __syncthreads();
}

typedef unsigned short bf16_t;
typedef short bf16x8 __attribute__((ext_vector_type(8)));
typedef float f32x4 __attribute__((ext_vector_type(4)));
typedef float f32x16 __attribute__((ext_vector_type(16)));
typedef unsigned u32x4 __attribute__((ext_vector_type(4)));
typedef unsigned u32x2 __attribute__((ext_vector_type(2)));

constexpr int NT = 512;
constexpr int LDS_BYTES = 147456;
constexpr int LDS_CTL = 0;
constexpr int LDS_USER = 256;
constexpr int D = 1024, BATCH = 2, SEQ = 16384, CTX = 256, DEPTH = 4;
constexpr int RPB = CTX + SEQ;
constexpr int T = BATCH * RPB;
constexpr int NEXP = 32, TOPK = 4, DEXP = 1024;
constexpr int MAXROWS = T * TOPK + NEXP * 256;

enum { I_X = 0, I_C, I_CTX, I_CCTX, I_ADAW, I_ADAB, I_NMIX, I_NFFN,
       I_RMU, I_RWRKV, I_RW0, I_RW1, I_RW2, I_RA0, I_RA1, I_RA2, I_RG1, I_RG2, I_RKK, I_RKA, I_RRK, I_RLNG, I_RLNB, I_RWO, I_RV0, I_RV1, I_RV2,
       I_HWIN, I_HBIN, I_HSW, I_HSB, I_HFW1, I_HFB1, I_HFW2, I_HFB2, I_HFW3, I_HFB3, I_HFREQ, I_HFWOUT, I_HBIAS, I_HWOUT, I_HBOUT,
       I_MWA, I_MQNG, I_MKVNG, I_MWQB, I_MWKVB, I_MQN, I_MKN, I_MWO,
       I_ERW, I_ERB, I_EWIN, I_EBIN, I_EWOUT, I_EBOUT, N_IN };

struct Args { const float* in[56]; float* out; unsigned char* ws; };

constexpr size_t al256(size_t x) { return (x + 255) & ~(size_t)255; }
constexpr size_t WS_BAR    = 0;
constexpr size_t WS_CNT    = 16384;
constexpr size_t WS_ZERO_BYTES = 1u << 20;
constexpr size_t WS_CNT2   = 65536;
constexpr int    CSTR      = 1088;
constexpr size_t WS_SHADOW_ABS = 4170000000ull;
constexpr size_t WS_MOD    = 1u << 20;
constexpr size_t WS_TW1    = al256(WS_MOD + (size_t)4 * 3 * 6144 * 4);
constexpr size_t WS_TW2    = WS_TW1 + 16384 * 8;
constexpr size_t WS_RWT    = WS_TW2 + 16384 * 8;
constexpr size_t WS_HWOT   = WS_RWT + (size_t)4 * 32 * 1024 * 4;
constexpr size_t WS_X      = WS_HWOT + (size_t)2 * 2048 * 64 * 2;
constexpr size_t WS_H      = WS_X + (size_t)T * D * 4;
constexpr size_t WS_ASGE   = WS_H + (size_t)T * D * 2;
constexpr size_t WS_ASGG   = WS_ASGE + (size_t)T * 4 * 4;
constexpr size_t WS_TOKL   = WS_ASGG + (size_t)T * 4 * 4;
constexpr size_t WS_ACT    = WS_TOKL + (size_t)NEXP * T * 4;
constexpr size_t WS_YB     = WS_ACT + (size_t)MAXROWS * D * 2;
constexpr size_t WS_RKVT   = WS_YB + (size_t)MAXROWS * D * 2;
constexpr size_t WS_RWOT   = WS_RKVT + (size_t)6 * D * D * 2;
constexpr size_t WS_L1T    = WS_RWOT + (size_t)2 * D * D * 2;
constexpr size_t WS_W2T    = WS_L1T + (size_t)2 * 640 * D * 2;
constexpr size_t WS_A2T    = WS_W2T + (size_t)4 * D * 64 * 2;
constexpr size_t WS_G2T    = WS_A2T + (size_t)4 * D * 64 * 2;
constexpr size_t WS_V2T    = WS_G2T + (size_t)2 * D * 192 * 2;
constexpr size_t WS_HYINT  = WS_V2T + (size_t)D * 64 * 2;
constexpr size_t WS_HYOUTT = WS_HYINT + (size_t)3072 * D * 2;
constexpr size_t WS_MWAT   = WS_HYOUTT + (size_t)D * D * 2;
constexpr size_t WS_MWQBT  = WS_MWAT + (size_t)768 * D * 2;
constexpr size_t WS_MWKVBT = WS_MWQBT + (size_t)1536 * 384 * 2;
constexpr size_t WS_MWOT   = WS_MWKVBT + (size_t)2048 * 256 * 2;
constexpr size_t WS_EWINT  = WS_MWOT + (size_t)D * D * 2;
constexpr size_t WS_EWOUTT = WS_EWINT + (size_t)4 * 32 * 2048 * D * 2;
constexpr size_t WS_VFIRST = WS_EWOUTT + (size_t)4 * 32 * D * D * 2;
constexpr size_t WS_MIX    = WS_VFIRST + (size_t)T * D * 4;
constexpr size_t TD4 = (size_t)T * D * 4;
constexpr size_t RW_R   = WS_MIX;
constexpr size_t RW_K   = RW_R + TD4;
constexpr size_t RW_V   = RW_K + TD4;
constexpr size_t RW_G   = RW_V + TD4;
constexpr size_t RW_WD0 = RW_G + TD4;
constexpr size_t RW_WD1 = RW_WD0 + TD4;
constexpr size_t RW_AD0 = RW_WD1 + TD4;
constexpr size_t RW_AD1 = RW_AD0 + TD4;
constexpr size_t RW_Y0  = RW_AD1 + TD4;
constexpr size_t RW_Y1  = RW_Y0 + TD4;
constexpr size_t RW_HL  = RW_Y1 + TD4;
constexpr size_t RW_Z   = RW_HL + (size_t)T * 640 * 2;
constexpr size_t RW_XR  = RW_Z + (size_t)T * D * 2;
constexpr size_t RW_XK  = RW_XR + (size_t)T * D * 2;
constexpr size_t RW_XV  = RW_XK + (size_t)T * D * 2;
constexpr size_t WKSET_B = 13824;
constexpr size_t RW_SETS = RW_XR;
constexpr size_t RW_END = RW_SETS + (size_t)64 * (RPB / 16) * WKSET_B;

template <class TP> __device__ __forceinline__ TP* uniform_ptr(TP* p) {
    const unsigned long long v = (unsigned long long)p;
    const unsigned lo = __builtin_amdgcn_readfirstlane((unsigned)v), hi = __builtin_amdgcn_readfirstlane((unsigned)(v >> 32));
    return (TP*)(__attribute__((address_space(1))) TP*)(((unsigned long long)hi << 32) | lo);
}
__device__ __forceinline__ int otid() { int t = threadIdx.x; asm volatile("" : "+v"(t)); return t; }
typedef float f32x2v __attribute__((ext_vector_type(2)));
typedef __bf16 bf16x2v __attribute__((ext_vector_type(2)));
__device__ __forceinline__ unsigned cvt_pk_bf16(float lo, float hi) { const f32x2v v = {lo, hi}; return __builtin_bit_cast(unsigned, __builtin_convertvector(v, bf16x2v)); }
__device__ __forceinline__ float bf_lo(unsigned u) { return __uint_as_float(u << 16); }
__device__ __forceinline__ float bf_hi(unsigned u) { return __uint_as_float(u & 0xffff0000u); }
template <int CTRL> __device__ __forceinline__ float dpp_f(float v) { return __int_as_float(__builtin_amdgcn_update_dpp(0, __float_as_int(v), CTRL, 0xf, 0xf, false)); }
__device__ __forceinline__ float row16_sum(float v) {
    v += dpp_f<0x128>(v); v += dpp_f<0x124>(v); v += dpp_f<0x122>(v); v += dpp_f<0x121>(v); return v;
}
__device__ __forceinline__ float lane_bcast(float v, int l) { return __int_as_float(__builtin_amdgcn_readlane(__float_as_int(v), l)); }
__device__ __forceinline__ float wave_sum(float v) {
    v = row16_sum(v);
    return (lane_bcast(v, 0) + lane_bcast(v, 16)) + (lane_bcast(v, 32) + lane_bcast(v, 48));
}
__device__ __forceinline__ float sin_acc(float x) {
    const float k = rintf(x * 0.15915494309189535f);
    float r = fmaf(-k, 6.28125f, x); r = fmaf(-k, 1.9353071795864769e-3f, r);
    const float pi = 3.14159265358979f;
    r = r > 0.5f * pi ? pi - r : (r < -0.5f * pi ? -pi - r : r);
    const float r2 = r * r;
    float p = -2.5052108e-8f; p = fmaf(p, r2, 2.7557319e-6f); p = fmaf(p, r2, -1.9841270e-4f); p = fmaf(p, r2, 8.3333333e-3f); p = fmaf(p, r2, -1.6666667e-1f);
    return fmaf(r * r2, p, r);
}
__device__ __forceinline__ float cos_acc(float x) { return sin_acc(x + 1.57079632679489662f); }
__device__ __forceinline__ float sigmoidf_(float x) { return __builtin_amdgcn_rcpf(1.f + __expf(-x)); }
__device__ __forceinline__ int mod_index(int row) { const int b = row / RPB; return (row - b * RPB) < CTX ? 2 : b; }

constexpr int G_A_BYTES = 256 * 64 * 2, G_B_BYTES = 128 * 64 * 2, G_BUF = G_A_BYTES + G_B_BYTES, G_LDS = 2 * G_BUF;
__device__ __forceinline__ int gswz(int row, int ch) { return row * 128 + ((ch ^ ((row >> 1) & 7)) << 4); }

struct ALoadPlain {
    const bf16_t* A; int lda;
    __device__ __forceinline__ u32x4 load(int row, int k) const { return *(const u32x4*)(A + (size_t)row * lda + k); }
};

template <class AL, class EP>
__device__ __forceinline__ void gemm_tile(const AL& al, const bf16_t* __restrict__ Bt, int ldb, int nk, unsigned char* lds, const EP& ep, int m0, int n0) {
    const int tid = otid(), lane = tid & 63, wid = tid >> 6, wm = wid >> 1, wn = wid & 1, fr = lane & 15, fq = lane >> 4;
    f32x4 acc[4][4];
#pragma unroll
    for (int i = 0; i < 4; ++i)
#pragma unroll
        for (int j = 0; j < 4; ++j) acc[i][j] = (f32x4){0.f, 0.f, 0.f, 0.f};
    u32x4 ra[4], rb[2];
    const int srow = tid >> 3, sch = tid & 7;
    {
#pragma unroll
        for (int i = 0; i < 4; ++i) ra[i] = al.load(m0 + srow + i * 64, sch * 8);
#pragma unroll
        for (int i = 0; i < 2; ++i) rb[i] = *(const u32x4*)(Bt + (size_t)(n0 + srow + i * 64) * ldb + sch * 8);
#pragma unroll
        for (int i = 0; i < 4; ++i) *(u32x4*)(lds + gswz(srow + i * 64, sch)) = ra[i];
#pragma unroll
        for (int i = 0; i < 2; ++i) *(u32x4*)(lds + G_A_BYTES + gswz(srow + i * 64, sch)) = rb[i];
    }
    __syncthreads();
    for (int kt = 0; kt < nk; ++kt) {
        const bool more = (kt + 1 < nk);
        if (more) {
#pragma unroll
            for (int i = 0; i < 4; ++i) ra[i] = al.load(m0 + srow + i * 64, (kt + 1) * 64 + sch * 8);
#pragma unroll
            for (int i = 0; i < 2; ++i) rb[i] = *(const u32x4*)(Bt + (size_t)(n0 + srow + i * 64) * ldb + (kt + 1) * 64 + sch * 8);
        }
        const unsigned char* base = lds + (kt & 1) * G_BUF;
#pragma unroll
        for (int ks = 0; ks < 2; ++ks) {
            bf16x8 af[4], bfr[4];
#pragma unroll
            for (int mi = 0; mi < 4; ++mi) af[mi] = *(const bf16x8*)(base + gswz(wm * 64 + mi * 16 + fr, ks * 4 + fq));
#pragma unroll
            for (int ni = 0; ni < 4; ++ni) bfr[ni] = *(const bf16x8*)(base + G_A_BYTES + gswz(wn * 64 + ni * 16 + fr, ks * 4 + fq));
#pragma unroll
            for (int mi = 0; mi < 4; ++mi)
#pragma unroll
                for (int ni = 0; ni < 4; ++ni) acc[mi][ni] = __builtin_amdgcn_mfma_f32_16x16x32_bf16(bfr[ni], af[mi], acc[mi][ni], 0, 0, 0);
        }
        if (more) {
            unsigned char* nb = lds + ((kt + 1) & 1) * G_BUF;
#pragma unroll
            for (int i = 0; i < 4; ++i) *(u32x4*)(nb + gswz(srow + i * 64, sch)) = ra[i];
#pragma unroll
            for (int i = 0; i < 2; ++i) *(u32x4*)(nb + G_A_BYTES + gswz(srow + i * 64, sch)) = rb[i];
        }
        __syncthreads();
    }
    ep(acc, m0 + wm * 64, n0 + wn * 64, fr, fq);
}
template <class F> struct EpiElem {
    F f;
    __device__ __forceinline__ void operator()(const f32x4 (&acc)[4][4], int rbase, int cbase, int fr, int fq) const {
#pragma unroll
        for (int mi = 0; mi < 4; ++mi)
#pragma unroll
            for (int ni = 0; ni < 4; ++ni) f(rbase + mi * 16 + fr, cbase + ni * 16 + fq * 4, acc[mi][ni]);
    }
};
template <class F> __device__ __forceinline__ EpiElem<F> make_epi(F f) { return EpiElem<F>{f}; }

struct Nil {};
template <class FC, class FR, class FS> struct Epi3 {
    FC fc; FR frow; FS fs;
    __device__ __forceinline__ void operator()(const f32x4 (&acc)[4][4], int rbase, int cbase, int fr, int fq) const {
        decltype(fc(0)) ci[4];
#pragma unroll
        for (int ni = 0; ni < 4; ++ni) ci[ni] = fc(cbase + ni * 16 + fq * 4);
        decltype(frow(0, 0)) ri[4][4];
#pragma unroll
        for (int mi = 0; mi < 4; ++mi)
#pragma unroll
            for (int ni = 0; ni < 4; ++ni) ri[mi][ni] = frow(rbase + mi * 16 + fr, cbase + ni * 16 + fq * 4);
#pragma unroll
        for (int mi = 0; mi < 4; ++mi)
#pragma unroll
            for (int ni = 0; ni < 4; ++ni) fs(rbase + mi * 16 + fr, cbase + ni * 16 + fq * 4, acc[mi][ni], ci[ni], ri[mi][ni]);
    }
    __device__ __forceinline__ void operator()(const f32x4 (&acc)[2][2][4][2], int row0, int col0) const {
        decltype(fc(0)) ci[2][2];
#pragma unroll
        for (int bj = 0; bj < 2; ++bj)
#pragma unroll
            for (int n = 0; n < 2; ++n) ci[bj][n] = fc(col0 + bj * 128 + n * 16);
#pragma unroll
        for (int ai = 0; ai < 2; ++ai) {
            decltype(frow(0, 0)) ri[4][2][2];
#pragma unroll
            for (int m = 0; m < 4; ++m)
#pragma unroll
                for (int bj = 0; bj < 2; ++bj)
#pragma unroll
                    for (int n = 0; n < 2; ++n) ri[m][bj][n] = frow(row0 + ai * 128 + m * 16, col0 + bj * 128 + n * 16);
#pragma unroll
            for (int m = 0; m < 4; ++m)
#pragma unroll
                for (int bj = 0; bj < 2; ++bj)
#pragma unroll
                    for (int n = 0; n < 2; ++n) fs(row0 + ai * 128 + m * 16, col0 + bj * 128 + n * 16, acc[ai][bj][m][n], ci[bj][n], ri[m][bj][n]);
        }
    }
};
template <class FC, class FR, class FS> __device__ __forceinline__ Epi3<FC, FR, FS> make_epi3(FC fc, FR fr, FS fs) { return Epi3<FC, FR, FS>{fc, fr, fs}; }
__device__ __forceinline__ Nil nil_col(int) { return Nil{}; }
__device__ __forceinline__ Nil nil_row(int, int) { return Nil{}; }
namespace g8 {
constexpr int BK = 64, HALF = 128, HT = HALF * BK, SHM_B = 8 * HT * 2;
__device__ __forceinline__ int lds_byte(int r, int c) { const int st = (r >> 4) * 2 + (c >> 5), rr = r & 15, cc = c & 31, ob = rr * 64 + cc * 2; return st * 1024 + (ob ^ (((ob >> 9) & 1) << 5)); }
__device__ __forceinline__ void stage_rc(int b, int& R, int& C) { const int st = b / 1024, sb = b % 1024, swz = sb ^ (((sb >> 9) & 1) << 5); R = (st >> 1) * 16 + swz / 64; C = (st & 1) * 32 + (swz % 64) / 2; }

struct AOffPlain { unsigned row0; unsigned lda; __device__ __forceinline__ unsigned operator()(int r) const { return (row0 + (unsigned)r) * lda; } };
template <bool GATHER, class AOff, class Epi>
__device__ __forceinline__ void gemm256(const bf16_t* __restrict__ Abase, const AOff& aoff, const bf16_t* __restrict__ Bt  , int K,
                                        unsigned char* shmb, const Epi& epi, int brow, int bcol) {
    LAS bf16_t* shm = (LAS bf16_t*)shmb;
#define G8_SA(b, h) (shm + ((b) * 2 + (h)) * HT)
#define G8_SB(b, h) (shm + (4 + (b) * 2 + (h)) * HT)
#define G8_STAGE_A(P, h, dk) do { _Pragma("unroll") for (int _i = 0; _i < 2; ++_i) \
        __builtin_amdgcn_raw_ptr_buffer_load_lds(rsA, (LAS void*)((LAS char*)(P) + wid * 1024 + _i * 8192), 16, GATHER ? oa[h][_i] : oa[0][0], \
            sK + (unsigned)((dk) * (BK * 2)) + (GATHER ? 0u : (unsigned)((h) * HALF + _i * 64) * arow_bytes), 0, 0); } while (0)
#define G8_STAGE_B(P, h, dk) do { _Pragma("unroll") for (int _i = 0; _i < 2; ++_i) \
        __builtin_amdgcn_raw_ptr_buffer_load_lds(rsB, (LAS void*)((LAS char*)(P) + wid * 1024 + _i * 8192), 16, ob, \
            sK + (unsigned)((dk) * (BK * 2)) + (unsigned)((h) * HALF + _i * 64) * brow_bytes, 0, 0); } while (0)
#define G8_LDA(dst, b, h) _Pragma("unroll") for (int m = 0; m < 4; ++m) _Pragma("unroll") for (int k = 0; k < 2; ++k) \
        dst[m][k] = *(const LAS bf16x8*)((LAS char*)G8_SA(b, h) + lds_byte(wr * 64 + m * 16 + fr, k * 32 + fq * 8))
#define G8_LDB(dst, b, h) _Pragma("unroll") for (int n = 0; n < 2; ++n) _Pragma("unroll") for (int k = 0; k < 2; ++k) \
        dst[n][k] = *(const LAS bf16x8*)((LAS char*)G8_SB(b, h) + lds_byte(wc * 32 + n * 16 + fr, k * 32 + fq * 8))
#define G8_MMA(ai, bj, At, Bx) do { __builtin_amdgcn_s_setprio(1); \
        _Pragma("unroll") for (int m = 0; m < 4; ++m) _Pragma("unroll") for (int n = 0; n < 2; ++n) _Pragma("unroll") for (int k = 0; k < 2; ++k) \
            acc[ai][bj][m][n] = __builtin_amdgcn_mfma_f32_16x16x32_bf16(Bx[n][k], At[m][k], acc[ai][bj][m][n], 0, 0, 0); \
        __builtin_amdgcn_s_setprio(0); } while (0)
#define G8_WAIT_V(n) asm volatile("s_waitcnt vmcnt(" #n ")" ::: "memory")
#define G8_WAIT_L(n) asm volatile("s_waitcnt lgkmcnt(" #n ")" ::: "memory")
#define G8_BAR __builtin_amdgcn_s_barrier()
#define G8_SCHED __builtin_amdgcn_sched_barrier(0)
    int tz = threadIdx.x; asm volatile("" : "+v"(tz));
    int wid = tz >> 6, lane = tz & 63, wr = wid >> 2, wc = wid & 3, fr = lane & 15, fq = lane >> 4;
    unsigned oa[2][2], ob;
    {
        int R0, C0; stage_rc(tz * 16, R0, C0);
        ob = ((unsigned)R0 * (unsigned)K + (unsigned)C0) * 2u;
        if (GATHER) {
#pragma unroll
            for (int h = 0; h < 2; ++h)
#pragma unroll
                for (int i = 0; i < 2; ++i) oa[h][i] = (aoff(h * HALF + R0 + i * 64) + (unsigned)C0) * 2u;
        } else { oa[0][0] = ((aoff(R0) - aoff(0)) + (unsigned)C0) * 2u; oa[0][1] = oa[1][0] = oa[1][1] = 0u; }
    }
    f32x4 acc[2][2][4][2];
#pragma unroll
    for (int x = 0; x < 2; ++x)
#pragma unroll
        for (int y = 0; y < 2; ++y)
#pragma unroll
            for (int m = 0; m < 4; ++m)
#pragma unroll
                for (int n = 0; n < 2; ++n) acc[x][y][m][n] = (f32x4){0.f, 0.f, 0.f, 0.f};
    bf16x8 At[4][2], B0[2][2], B1[2][2];
    const int nt = K / BK;
    const __amdgpu_buffer_rsrc_t rsA = __builtin_amdgcn_make_buffer_rsrc((void*)(Abase + (GATHER ? 0u : aoff(0))), (short)0, 0x7ffffff0, 0x00020000);
    const __amdgpu_buffer_rsrc_t rsB = __builtin_amdgcn_make_buffer_rsrc((void*)Bt, (short)0, 0x7ffffff0, 0x00020000);
    const unsigned arow_bytes = GATHER ? 0u : (aoff(1) - aoff(0)) * 2u, brow_bytes = (unsigned)K * 2u;
    unsigned sK = 0;
    asm volatile("s_waitcnt vmcnt(0)" ::: "memory");
    G8_STAGE_B(G8_SB(0, 0), 0, 0); G8_STAGE_A(G8_SA(0, 0), 0, 0);
    G8_STAGE_B(G8_SB(0, 1), 1, 0); G8_STAGE_A(G8_SA(0, 1), 1, 0);
    if (wr == 1) G8_BAR;
    G8_WAIT_V(4); G8_BAR;
    G8_STAGE_B(G8_SB(1, 0), 0, 1); G8_STAGE_A(G8_SA(1, 0), 0, 1); G8_STAGE_B(G8_SB(1, 1), 1, 1);
    G8_WAIT_V(6); G8_BAR;
    for (int t = 0; t < nt - 2; t += 2) {
        G8_LDB(B0, 0, 0); G8_SCHED; G8_LDA(At, 0, 0); G8_STAGE_A(G8_SA(1, 1), 1, 1);
        G8_WAIT_L(8); G8_BAR; G8_WAIT_L(0); G8_MMA(0, 0, At, B0); G8_BAR; G8_SCHED;
        G8_LDB(B1, 0, 1); G8_STAGE_B(G8_SB(0, 0), 0, 2);
        G8_BAR; G8_WAIT_L(0); G8_MMA(0, 1, At, B1); G8_BAR;
        G8_LDA(At, 0, 1); G8_STAGE_A(G8_SA(0, 0), 0, 2);
        G8_BAR; G8_WAIT_L(0); G8_MMA(1, 0, At, B0); G8_BAR; G8_SCHED;
        G8_STAGE_B(G8_SB(0, 1), 1, 2);
        G8_WAIT_V(6); G8_BAR; G8_MMA(1, 1, At, B1); G8_BAR;
        G8_LDB(B0, 1, 0); G8_SCHED; G8_LDA(At, 1, 0); G8_STAGE_A(G8_SA(0, 1), 1, 2);
        G8_WAIT_L(8); G8_BAR; G8_WAIT_L(0); G8_MMA(0, 0, At, B0); G8_BAR; G8_SCHED;
        G8_LDB(B1, 1, 1); G8_STAGE_B(G8_SB(1, 0), 0, 3);
        G8_BAR; G8_WAIT_L(0); G8_MMA(0, 1, At, B1); G8_BAR;
        G8_LDA(At, 1, 1); G8_STAGE_A(G8_SA(1, 0), 0, 3);
        G8_BAR; G8_WAIT_L(0); G8_MMA(1, 0, At, B0); G8_BAR; G8_SCHED;
        G8_STAGE_B(G8_SB(1, 1), 1, 3);
        G8_WAIT_V(6); G8_BAR; G8_MMA(1, 1, At, B1); G8_BAR;
        sK += 2 * BK * 2;
    }
    { G8_LDB(B0, 0, 0); G8_WAIT_V(0); G8_LDA(At, 0, 0); G8_STAGE_A(G8_SA(1, 1), 1, 1);
      G8_BAR; G8_WAIT_L(0); G8_MMA(0, 0, At, B0); G8_BAR;
      G8_LDB(B1, 0, 1); G8_BAR; G8_WAIT_L(0); G8_MMA(0, 1, At, B1); G8_BAR;
      G8_LDA(At, 0, 1); G8_WAIT_V(4); G8_BAR; G8_WAIT_L(0); G8_MMA(1, 0, At, B0); G8_MMA(1, 1, At, B1); G8_BAR; }
    { G8_LDB(B0, 1, 0); G8_LDA(At, 1, 0); G8_WAIT_V(2); G8_BAR; G8_WAIT_L(0); G8_MMA(0, 0, At, B0); G8_BAR;
      G8_LDB(B1, 1, 1); G8_WAIT_V(0); G8_BAR; G8_WAIT_L(0); G8_MMA(0, 1, At, B1); G8_BAR;
      G8_LDA(At, 1, 1); G8_BAR; G8_WAIT_L(0); G8_MMA(1, 0, At, B0); G8_MMA(1, 1, At, B1); G8_BAR; }
    if (wr == 0) G8_BAR;
    tz = threadIdx.x; asm volatile("" : "+v"(tz)); wid = tz >> 6; lane = tz & 63; wr = wid >> 2; wc = wid & 3; fr = lane & 15; fq = lane >> 4;
    epi(acc, brow + wr * 64 + fr, bcol + wc * 32 + fq * 4);
#undef G8_SA
#undef G8_SB
#undef G8_STAGE_A
#undef G8_STAGE_B
#undef G8_LDA
#undef G8_LDB
#undef G8_MMA
#undef G8_WAIT_V
#undef G8_WAIT_L
#undef G8_BAR
#undef G8_SCHED
}
template <bool GATHER, class U, class Ctx, class NextFn>
__device__ __forceinline__ void gemm256_stream(int K, unsigned lda, unsigned char* shmb, const Ctx& ctx, NextFn next) {
    LAS bf16_t* shm = (LAS bf16_t*)shmb;
#define G8_SA(b, h) (shm + ((b) * 2 + (h)) * HT)
#define G8_SB(b, h) (shm + (4 + (b) * 2 + (h)) * HT)
#define G8_STAGE_A(P, h, dk, NXT) do { const bool _n = (NXT) && last; const __amdgpu_buffer_rsrc_t _rs = __builtin_amdgcn_make_buffer_rsrc((void*)(_n ? pA_n : pA_c), (short)0, 0x7ffffff0, 0x00020000); \
        _Pragma("unroll") for (int _i = 0; _i < 2; ++_i) \
        __builtin_amdgcn_raw_ptr_buffer_load_lds(_rs, (LAS void*)((LAS char*)(P) + wid * 1024 + _i * 8192), 16, GATHER ? (_n ? oa_n[h][_i] : oa_c[h][_i]) : oa_c[0][0], \
            (_n ? (unsigned)(((dk) - 2) * (BK * 2)) : sK + (unsigned)((dk) * (BK * 2))) + (GATHER ? 0u : (unsigned)((h) * HALF + _i * 64) * arow_bytes), 0, 0); } while (0)
#define G8_STAGE_B(P, h, dk, NXT) do { const bool _n = (NXT) && last; const __amdgpu_buffer_rsrc_t _rs = __builtin_amdgcn_make_buffer_rsrc((void*)(_n ? pB_n : pB_c), (short)0, 0x7ffffff0, 0x00020000); \
        _Pragma("unroll") for (int _i = 0; _i < 2; ++_i) \
        __builtin_amdgcn_raw_ptr_buffer_load_lds(_rs, (LAS void*)((LAS char*)(P) + wid * 1024 + _i * 8192), 16, ob, \
            (_n ? (unsigned)(((dk) - 2) * (BK * 2)) : sK + (unsigned)((dk) * (BK * 2))) + (unsigned)((h) * HALF + _i * 64) * brow_bytes, 0, 0); } while (0)
#define G8_LDA(dst, b, h) _Pragma("unroll") for (int m = 0; m < 4; ++m) _Pragma("unroll") for (int k = 0; k < 2; ++k) \
        dst[m][k] = *(const LAS bf16x8*)((LAS char*)G8_SA(b, h) + lds_byte(wr * 64 + m * 16 + fr, k * 32 + fq * 8))
#define G8_LDB(dst, b, h) _Pragma("unroll") for (int n = 0; n < 2; ++n) _Pragma("unroll") for (int k = 0; k < 2; ++k) \
        dst[n][k] = *(const LAS bf16x8*)((LAS char*)G8_SB(b, h) + lds_byte(wc * 32 + n * 16 + fr, k * 32 + fq * 8))
#define G8_MMA(ai, bj, At, Bx) do { __builtin_amdgcn_s_setprio(1); \
        _Pragma("unroll") for (int m = 0; m < 4; ++m) _Pragma("unroll") for (int n = 0; n < 2; ++n) _Pragma("unroll") for (int k = 0; k < 2; ++k) \
            acc[ai][bj][m][n] = __builtin_amdgcn_mfma_f32_16x16x32_bf16(Bx[n][k], At[m][k], acc[ai][bj][m][n], 0, 0, 0); \
        __builtin_amdgcn_s_setprio(0); } while (0)
#define G8_WAIT_V(n) asm volatile("s_waitcnt vmcnt(" #n ")" ::: "memory")
#define G8_WAIT_L(n) asm volatile("s_waitcnt lgkmcnt(" #n ")" ::: "memory")
#define G8_BAR __builtin_amdgcn_s_barrier()
#define G8_SCHED __builtin_amdgcn_sched_barrier(0)
    int tz = threadIdx.x; asm volatile("" : "+v"(tz));
    int wid = tz >> 6, lane = tz & 63, wr = wid >> 2, wc = wid & 3, fr = lane & 15, fq = lane >> 4;
    unsigned ob;
    { int R0, C0; stage_rc(tz * 16, R0, C0); ob = ((unsigned)R0 * (unsigned)K + (unsigned)C0) * 2u; }
    const unsigned arow_bytes = GATHER ? 0u : lda * 2u, brow_bytes = (unsigned)K * 2u;
    U cur, nxt;
    if (!next(cur)) return;
    const bf16_t* pA_c; const bf16_t* pB_c; const bf16_t* pA_n; const bf16_t* pB_n; unsigned oa_c[2][2], oa_n[2][2];
    auto setup = [&](const U& u, const bf16_t*& pa, const bf16_t*& pb, unsigned (&oa)[2][2]) {
        int tq = threadIdx.x; asm volatile("" : "+v"(tq));
        int R0, C0; stage_rc(tq * 16, R0, C0);
        pa = uniform_ptr(ctx.A(u)); pb = uniform_ptr(ctx.B(u));
        if (GATHER) {
#pragma unroll
            for (int h = 0; h < 2; ++h)
#pragma unroll
                for (int i = 0; i < 2; ++i) oa[h][i] = (ctx.aoff(u, h * HALF + R0 + i * 64) + (unsigned)C0) * 2u;
        } else { oa[0][0] = ((unsigned)R0 * lda + (unsigned)C0) * 2u; oa[0][1] = oa[1][0] = oa[1][1] = 0u; }
    };
    setup(cur, pA_c, pB_c, oa_c);
    bool have_n = next(nxt);
    if (have_n) setup(nxt, pA_n, pB_n, oa_n);
    else { pA_n = pA_c; pB_n = pB_c;
#pragma unroll
        for (int h = 0; h < 2; ++h)
#pragma unroll
            for (int i = 0; i < 2; ++i) oa_n[h][i] = oa_c[h][i]; }
    f32x4 acc[2][2][4][2];
    bf16x8 At[4][2], B0[2][2], B1[2][2];
    const int nt = K / BK;
    unsigned sK = 0;
    {
        const bool last = false;
        asm volatile("s_waitcnt vmcnt(0)" ::: "memory");
        G8_STAGE_B(G8_SB(0, 0), 0, 0, 0); G8_STAGE_A(G8_SA(0, 0), 0, 0, 0);
        G8_STAGE_B(G8_SB(0, 1), 1, 0, 0); G8_STAGE_A(G8_SA(0, 1), 1, 0, 0);
        if (wr == 1) G8_BAR;
        G8_WAIT_V(4); G8_BAR;
        G8_STAGE_B(G8_SB(1, 0), 0, 1, 0); G8_STAGE_A(G8_SA(1, 0), 0, 1, 0); G8_STAGE_B(G8_SB(1, 1), 1, 1, 0);
        G8_WAIT_V(6); G8_BAR;
    }
    for (;;) {
        {
            int t2 = threadIdx.x; asm volatile("" : "+v"(t2));
            ctx.init(cur, acc, ctx.bcol(cur) + ((t2 >> 6) & 3) * 32 + ((t2 & 63) >> 4) * 4);
        }
        sK = 0;
        for (int t = 0; t < nt; t += 2) {
            const bool last = (t + 2 >= nt);
            G8_LDB(B0, 0, 0); G8_SCHED; G8_LDA(At, 0, 0); G8_STAGE_A(G8_SA(1, 1), 1, 1, 0);
            G8_WAIT_L(8); G8_BAR; G8_WAIT_L(0); G8_MMA(0, 0, At, B0); G8_BAR; G8_SCHED;
            G8_LDB(B1, 0, 1); G8_STAGE_B(G8_SB(0, 0), 0, 2, 1);
            G8_BAR; G8_WAIT_L(0); G8_MMA(0, 1, At, B1); G8_BAR;
            G8_LDA(At, 0, 1); G8_STAGE_A(G8_SA(0, 0), 0, 2, 1);
            G8_BAR; G8_WAIT_L(0); G8_MMA(1, 0, At, B0); G8_BAR; G8_SCHED;
            G8_STAGE_B(G8_SB(0, 1), 1, 2, 1);
            G8_WAIT_V(6); G8_BAR; G8_MMA(1, 1, At, B1); G8_BAR;
            G8_LDB(B0, 1, 0); G8_SCHED; G8_LDA(At, 1, 0); G8_STAGE_A(G8_SA(0, 1), 1, 2, 1);
            G8_WAIT_L(8); G8_BAR; G8_WAIT_L(0); G8_MMA(0, 0, At, B0); G8_BAR; G8_SCHED;
            G8_LDB(B1, 1, 1); G8_STAGE_B(G8_SB(1, 0), 0, 3, 1);
            G8_BAR; G8_WAIT_L(0); G8_MMA(0, 1, At, B1); G8_BAR;
            G8_LDA(At, 1, 1); G8_STAGE_A(G8_SA(1, 0), 0, 3, 1);
            G8_BAR; G8_WAIT_L(0); G8_MMA(1, 0, At, B0); G8_BAR; G8_SCHED;
            G8_STAGE_B(G8_SB(1, 1), 1, 3, 1);
            G8_WAIT_V(6); G8_BAR; G8_MMA(1, 1, At, B1); G8_BAR;
            sK += 2 * BK * 2;
        }
        {
            int t2 = threadIdx.x; asm volatile("" : "+v"(t2));
            const int w2 = t2 >> 6, l2 = t2 & 63;
            ctx.epi(cur, acc, ctx.brow(cur) + (w2 >> 2) * 64 + (l2 & 15), ctx.bcol(cur) + (w2 & 3) * 32 + (l2 >> 4) * 4);
        }
        if (!have_n) break;
        cur = nxt; pA_c = pA_n; pB_c = pB_n;
#pragma unroll
        for (int h = 0; h < 2; ++h)
#pragma unroll
            for (int i = 0; i < 2; ++i) oa_c[h][i] = oa_n[h][i];
        have_n = next(nxt);
        if (have_n) setup(nxt, pA_n, pB_n, oa_n);
    }
    G8_WAIT_V(0);
    if (wr == 0) G8_BAR;
    __syncthreads();
#undef G8_SA
#undef G8_SB
#undef G8_STAGE_A
#undef G8_STAGE_B
#undef G8_LDA
#undef G8_LDB
#undef G8_MMA
#undef G8_WAIT_V
#undef G8_WAIT_L
#undef G8_BAR
#undef G8_SCHED
}
template <class F> struct EpiElem256 {
    F f;
    __device__ __forceinline__ void operator()(const f32x4 (&acc)[2][2][4][2], int row0, int col0) const {
#pragma unroll
        for (int ai = 0; ai < 2; ++ai)
#pragma unroll
            for (int m = 0; m < 4; ++m)
#pragma unroll
                for (int bj = 0; bj < 2; ++bj)
#pragma unroll
                    for (int n = 0; n < 2; ++n) f(row0 + ai * HALF + m * 16, col0 + bj * HALF + n * 16, acc[ai][bj][m][n]);
    }
};
template <class F> __device__ __forceinline__ EpiElem256<F> make_epi256(F f) { return EpiElem256<F>{f}; }
struct UTile { int mt, nt, g; };
__device__ __forceinline__ void zero_acc(f32x4 (&acc)[2][2][4][2]) {
#pragma unroll
    for (int ai = 0; ai < 2; ++ai)
#pragma unroll
        for (int bj = 0; bj < 2; ++bj)
#pragma unroll
            for (int m = 0; m < 4; ++m)
#pragma unroll
                for (int n = 0; n < 2; ++n) acc[ai][bj][m][n] = (f32x4){ 0.f, 0.f, 0.f, 0.f };
}
__device__ __forceinline__ void bias_acc(f32x4 (&acc)[2][2][4][2], const float* bias, int col0) {
#pragma unroll
    for (int bj = 0; bj < 2; ++bj)
#pragma unroll
        for (int n = 0; n < 2; ++n) {
            float4 bv = make_float4(0.f, 0.f, 0.f, 0.f);
            if (bias) bv = *(const float4*)(bias + col0 + bj * 128 + n * 16);
#pragma unroll
            for (int ai = 0; ai < 2; ++ai)
#pragma unroll
                for (int m = 0; m < 4; ++m) acc[ai][bj][m][n] = (f32x4){ bv.x, bv.y, bv.z, bv.w };
        }
}
template <class F> __device__ __forceinline__ void each_acc(const f32x4 (&acc)[2][2][4][2], int row0, int col0, F f) {
#pragma unroll
    for (int ai = 0; ai < 2; ++ai)
#pragma unroll
        for (int m = 0; m < 4; ++m)
#pragma unroll
            for (int bj = 0; bj < 2; ++bj)
#pragma unroll
                for (int n = 0; n < 2; ++n) f(row0 + ai * HALF + m * 16, col0 + bj * HALF + n * 16, acc[ai][bj][m][n]);
}
template <class FA, class FB, class FI, class FE> struct CtxL {
    FA fa; FB fb; FI fi; FE fe;
    __device__ __forceinline__ const bf16_t* A(const UTile& u) const { return fa(u); }
    __device__ __forceinline__ const bf16_t* B(const UTile& u) const { return fb(u); }
    __device__ __forceinline__ int brow(const UTile& u) const { return u.mt * 256; }
    __device__ __forceinline__ int bcol(const UTile& u) const { return u.nt * 256; }
    __device__ __forceinline__ unsigned aoff(const UTile&, int) const { return 0u; }
    __device__ __forceinline__ void init(const UTile& u, f32x4 (&acc)[2][2][4][2], int col0) const { fi(u, acc, col0); }
    __device__ __forceinline__ void epi(const UTile& u, const f32x4 (&acc)[2][2][4][2], int row0, int col0) const { fe(u, acc, row0, col0); }
};
template <class FA, class FB, class FI, class FE> __device__ __forceinline__ CtxL<FA, FB, FI, FE> make_ctx(FA fa, FB fb, FI fi, FE fe) { return CtxL<FA, FB, FI, FE>{ fa, fb, fi, fe }; }
}
struct TJob { int in_idx, src_off, K, N, Kpad, Npad, batch, sbs, dbs, perm; size_t dst; };
constexpr int NJOBS = 27;
__constant__ TJob g_jobs[NJOBS] = {
    { I_RWRKV, 0,             1024, 1024, 1024, 1024, 6,   1024 * 1024, 1024 * 1024, 0, WS_RKVT },
    { I_RWO,   0,             1024, 1024, 1024, 1024, 2,   1024 * 1024, 1024 * 1024, 0, WS_RWOT },
    { I_RW1,   0,             1024, 64,   1024, 64,   2,   1024 * 64,   64 * 1024,   0, WS_L1T + (size_t)0 * 1024 * 2 },
    { I_RW1,   2 * 1024 * 64, 1024, 64,   1024, 64,   2,   1024 * 64,   64 * 1024,   0, WS_L1T + (size_t)640 * 1024 * 2 },
    { I_RA1,   0,             1024, 64,   1024, 64,   2,   1024 * 64,   64 * 1024,   0, WS_L1T + (size_t)128 * 1024 * 2 },
    { I_RA1,   2 * 1024 * 64, 1024, 64,   1024, 64,   2,   1024 * 64,   64 * 1024,   0, WS_L1T + (size_t)(640 + 128) * 1024 * 2 },
    { I_RG1,   0,             1024, 160,  1024, 256,  1,   0,           0,           0, WS_L1T + (size_t)256 * 1024 * 2 },
    { I_RG1,   1024 * 160,    1024, 160,  1024, 256,  1,   0,           0,           0, WS_L1T + (size_t)(640 + 256) * 1024 * 2 },
    { I_RV1,   0,             1024, 32,   1024, 128,  1,   0,           0,           0, WS_L1T + (size_t)(640 + 512) * 1024 * 2 },
    { I_RW2,   0,             64,   1024, 64,   1024, 4,   64 * 1024,   1024 * 64,   0, WS_W2T },
    { I_RA2,   0,             64,   1024, 64,   1024, 4,   64 * 1024,   1024 * 64,   0, WS_A2T },
    { I_RG2,   0,             160,  1024, 192,  1024, 2,   160 * 1024,  1024 * 192,  0, WS_G2T },
    { I_RV2,   0,             32,   1024, 64,   1024, 1,   0,           0,           0, WS_V2T },
    { I_HWIN,  0,             1024, 3072, 1024, 3072, 1,   0,           0,           0, WS_HYINT },
    { I_HWOUT, 0,             1024, 1024, 1024, 1024, 1,   0,           0,           0, WS_HYOUTT },
    { I_MWA,   0,             1024, 704,  1024, 768,  1,   0,           0,           0, WS_MWAT },
    { I_MWQB,  0,             384,  1536, 384,  1536, 1,   0,           0,           0, WS_MWQBT },
    { I_MWKVB, 0,             256,  2048, 256,  2048, 1,   0,           0,           0, WS_MWKVBT },
    { I_MWO,   0,             1024, 1024, 1024, 1024, 1,   0,           0,           0, WS_MWOT },
    { I_EWIN,  0 * 32 * 1024 * 2048, 1024, 2048, 1024, 2048, 32, 1024 * 2048, 2048 * 1024, 1, WS_EWINT  + (size_t)0 * 32 * 2048 * 1024 * 2 },
    { I_EWOUT, 0 * 32 * 1024 * 1024, 1024, 1024, 1024, 1024, 32, 1024 * 1024, 1024 * 1024, 0, WS_EWOUTT + (size_t)0 * 32 * 1024 * 1024 * 2 },
    { I_EWIN,  1 * 32 * 1024 * 2048, 1024, 2048, 1024, 2048, 32, 1024 * 2048, 2048 * 1024, 1, WS_EWINT  + (size_t)1 * 32 * 2048 * 1024 * 2 },
    { I_EWOUT, 1 * 32 * 1024 * 1024, 1024, 1024, 1024, 1024, 32, 1024 * 1024, 1024 * 1024, 0, WS_EWOUTT + (size_t)1 * 32 * 1024 * 1024 * 2 },
    { I_EWIN,  2 * 32 * 1024 * 2048, 1024, 2048, 1024, 2048, 32, 1024 * 2048, 2048 * 1024, 1, WS_EWINT  + (size_t)2 * 32 * 2048 * 1024 * 2 },
    { I_EWOUT, 2 * 32 * 1024 * 1024, 1024, 1024, 1024, 1024, 32, 1024 * 1024, 1024 * 1024, 0, WS_EWOUTT + (size_t)2 * 32 * 1024 * 1024 * 2 },
    { I_EWIN,  3 * 32 * 1024 * 2048, 1024, 2048, 1024, 2048, 32, 1024 * 2048, 2048 * 1024, 1, WS_EWINT  + (size_t)3 * 32 * 2048 * 1024 * 2 },
    { I_EWOUT, 3 * 32 * 1024 * 1024, 1024, 1024, 1024, 1024, 32, 1024 * 1024, 1024 * 1024, 0, WS_EWOUTT + (size_t)3 * 32 * 1024 * 1024 * 2 },
};
constexpr int NJ_PRO = NJOBS - 6;
__device__ __forceinline__ int swiglu_perm(int np) { const int nt = np >> 8, bj = (np >> 7) & 1, c = np & 127; return (bj ? 1024 : 0) + nt * 128 + c; }

__device__ __forceinline__ void transpose_unit(const Args& a, float* lt, const TJob& jb, int t, int tid) {
    const int tk = jb.Kpad >> 6, tn = jb.Npad >> 6, gk = (tk + 3) >> 2, per = gk * tn;
    const int bi = t / per, r = t - bi * per, ti_n = r / gk, kg = r - ti_n * gk;
    const float* src = a.in[jb.in_idx] + jb.src_off + (size_t)bi * jb.sbs;
    bf16_t* dst = (bf16_t*)(a.ws + jb.dst) + (size_t)bi * jb.dbs;
    const int kt0 = kg * 4, nkt = (tk - kt0) < 4 ? (tk - kt0) : 4, n0 = ti_n * 64;
    float4 v[4][2];
#pragma unroll
    for (int g = 0; g < 4; ++g)
#pragma unroll
        for (int i = 0; i < 2; ++i) {
            const int item = tid + i * 512, kl = item >> 4, n4 = (item & 15) * 4, k = (kt0 + g) * 64 + kl, np = n0 + n4;
            v[g][i] = make_float4(0.f, 0.f, 0.f, 0.f);
            if (g < nkt && k < jb.K && np < jb.N) { const int col = jb.perm ? swiglu_perm(np) : np; v[g][i] = *(const float4*)(src + (size_t)k * jb.N + col); }
        }
#pragma unroll
    for (int g = 0; g < 4; ++g)
#pragma unroll
        for (int i = 0; i < 2; ++i) {
            const int item = tid + i * 512, kl = item >> 4, n4 = (item & 15) * 4;
            float* p = lt + (g * 64 + kl) * 65 + n4; p[0] = v[g][i].x; p[1] = v[g][i].y; p[2] = v[g][i].z; p[3] = v[g][i].w;
        }
    __syncthreads();
    {
        const int nl = tid >> 3, kc = tid & 7;
#pragma unroll
        for (int g = 0; g < 4; ++g) {
            if (g < nkt) {
                float f[8];
#pragma unroll
                for (int q = 0; q < 8; ++q) f[q] = lt[(g * 64 + kc * 8 + q) * 65 + nl];
                u32x4 o = { cvt_pk_bf16(f[0], f[1]), cvt_pk_bf16(f[2], f[3]), cvt_pk_bf16(f[4], f[5]), cvt_pk_bf16(f[6], f[7]) };
                *(u32x4*)(dst + (size_t)(n0 + nl) * jb.Kpad + (kt0 + g) * 64 + kc * 8) = o;
            }
        }
    }
    __syncthreads();
}
__device__ __forceinline__ int transpose_units_of(const TJob& jb) { const int tk = jb.Kpad >> 6, tn = jb.Npad >> 6, gk = (tk + 3) >> 2; return jb.batch * gk * tn; }
__device__ __forceinline__ void deferred_transposes(const Args& a, unsigned char* lds, int j0, int j1, int part, int nparts, int blk_lo, int nblk) {
    const int tid = otid();
    float* lt = (float*)(lds + LDS_USER);
    const int bl = (int)blockIdx.x - blk_lo;
    if (bl < 0 || bl >= nblk) return;
    __syncthreads();
    for (int j = j0; j < j1; ++j) {
        const TJob jb = g_jobs[j];
        const int total = transpose_units_of(jb), per_part = (total + nparts - 1) / nparts, lo = part * per_part, hi = (lo + per_part) < total ? (lo + per_part) : total;
        for (int t = lo + bl; t < hi; t += nblk) transpose_unit(a, lt, jb, t, tid);
    }
}

__device__ __forceinline__ void phase_prologue(const Args& a, unsigned char* lds) {
    const int tid = otid(), nb = gridDim.x, bid = blockIdx.x;
    float* lt = (float*)(lds + LDS_USER);
    int base = 0;
    for (int j = 0; j < NJ_PRO; ++j) {
        const TJob jb = g_jobs[j];
        const int total = transpose_units_of(jb);
        int t = (bid - base % nb + nb) % nb;
        for (; t < total; t += nb) transpose_unit(a, lt, jb, t, tid);
        base += total;
    }
    for (int u = bid; u < 4 * 96; u += nb) {
        const int l = u / 96, cg = u - l * 96, kg = tid >> 6, cl = tid & 63, col = cg * 64 + cl;
        const float* w = a.in[I_ADAW] + (size_t)l * 1024 * 6144 + col;
        float s0 = 0.f, s1 = 0.f, s2 = 0.f;
        for (int k = kg * 128; k < kg * 128 + 128; ++k) {
            const float wv = w[(size_t)k * 6144];
            float c0 = a.in[I_C][k], c1 = a.in[I_C][1024 + k], c2 = a.in[I_CCTX][k];
            c0 = c0 / (1.f + __expf(-c0)); c1 = c1 / (1.f + __expf(-c1)); c2 = c2 / (1.f + __expf(-c2));
            s0 += c0 * wv; s1 += c1 * wv; s2 += c2 * wv;
        }
        lt[(kg * 3 + 0) * 64 + cl] = s0; lt[(kg * 3 + 1) * 64 + cl] = s1; lt[(kg * 3 + 2) * 64 + cl] = s2;
        __syncthreads();
        if (tid < 192) {
            const int m = tid >> 6;
            float s = a.in[I_ADAB][l * 6144 + col];
#pragma unroll
            for (int g = 0; g < 8; ++g) s += lt[(g * 3 + m) * 64 + cl];
            ((float*)(a.ws + WS_MOD))[((size_t)l * 3 + m) * 6144 + col] = s;
        }
        __syncthreads();
    }
    for (int i = bid * NT + tid; i < 16384; i += nb * NT) {
        float s, c;
        sincospif((float)i / 8192.0f, &s, &c);  ((float2*)(a.ws + WS_TW1))[i] = make_float2(c, -s);
        sincospif((float)i / 16384.0f, &s, &c); ((float2*)(a.ws + WS_TW2))[i] = make_float2(c, -s);
    }
    for (int i = bid * NT + tid; i < 4 * 32 * 1024; i += nb * NT) {
        const int l = i >> 15, e = (i >> 10) & 31, col = i & 1023;
        ((float*)(a.ws + WS_RWT))[i] = a.in[I_ERW][(size_t)l * 32768 + col * 32 + e];
    }
    for (int i = bid * NT + tid; i < 2048 * 64; i += nb * NT) {
        const int col = i >> 6, k = i & 63;
        const float w = a.in[I_HFWOUT][(size_t)k * 2048 + col];
        const unsigned hi = cvt_pk_bf16(w, 0.f) & 0xffffu, lo = cvt_pk_bf16(w - bf_lo(hi), 0.f) & 0xffffu;
        ((bf16_t*)(a.ws + WS_HWOT))[i] = (bf16_t)hi; ((bf16_t*)(a.ws + WS_HWOT))[2048 * 64 + i] = (bf16_t)lo;
    }
}


template <bool SRC_IN, bool COMBINE, bool ROUTER, bool FINAL>
__device__ __forceinline__ void phase_norm(const Args& a, unsigned char* lds, int layer, int shadow = 0) {
    const size_t shoff = shadow ? (size_t)(WS_SHADOW_ABS - WS_ASGE) : 0;
    const int tid = otid(), lane = tid & 63, wid = tid >> 6;
    float* X = (float*)(a.ws + WS_X);
    int* padstart = (int*)(lds + LDS_USER);
    float* rwt = (float*)(lds + LDS_USER + 256);
    if (COMBINE) {
        if (tid == 0) {
            const int* cnt = (const int*)(a.ws + WS_CNT2) + (layer - 1) * 32 * CSTR;
            int acc = 0;
            for (int e = 0; e < 32; ++e) { padstart[e] = acc; acc += ((cnt[e * CSTR] + 255) >> 8) << 8; }
        }
    }
    if (ROUTER) {
        const float4* src = (const float4*)(a.ws + WS_RWT) + (size_t)layer * 8192;
        for (int i = tid; i < 8192; i += NT) ((float4*)rwt)[i] = src[i];
    }
    if (COMBINE || ROUTER) __syncthreads();
    const float* modbase = (const float*)(a.ws + WS_MOD);
    const int rstride = gridDim.x * 8;
    auto ldx = [&](int r, float4 (&x)[4]) {
        if (SRC_IN) {
            const int bb = r / RPB, ww = r - bb * RPB;
            const float* src = ww < CTX ? a.in[I_CTX] + ((size_t)bb * CTX + ww) * D : a.in[I_X] + ((size_t)bb * SEQ + (ww - CTX)) * D;
#pragma unroll
            for (int q = 0; q < 4; ++q) x[q] = *(const float4*)(src + q * 256 + lane * 4);
        } else {
#pragma unroll
            for (int q = 0; q < 4; ++q) x[q] = *(const float4*)(X + (size_t)r * D + q * 256 + lane * 4);
        }
    };
    auto ldasg = [&](int r, int4& e4, float4& g4) { e4 = *(const int4*)((const int*)(a.ws + WS_ASGE) + (size_t)r * 4); g4 = *(const float4*)((const float*)(a.ws + WS_ASGG) + (size_t)r * 4); };
    auto ldyb = [&](const int4& e4, u32x2 (&y)[4][4]) {
        const int es[4] = { e4.x, e4.y, e4.z, e4.w };
#pragma unroll
        for (int k = 0; k < 4; ++k) {
            const size_t yrow = (size_t)padstart[es[k] >> 24] + (es[k] & 0xffffff);
            const bf16_t* yb = (const bf16_t*)(a.ws + WS_YB) + yrow * D;
#pragma unroll
            for (int q = 0; q < 4; ++q) y[k][q] = *(const u32x2*)(yb + q * 256 + lane * 4);
        }
    };
    float4 xn[4]; int4 ae0 = {0, 0, 0, 0}, ae1 = {0, 0, 0, 0}; float4 ag0 = {0.f, 0.f, 0.f, 0.f}, ag1 = ag0; u32x2 ybn[4][4];
    int row = blockIdx.x * 8 + wid;
    if (row < T) {
        ldx(row, xn);
        if (COMBINE) { ldasg(row, ae0, ag0); if (row + rstride < T) ldasg(row + rstride, ae1, ag1); ldyb(ae0, ybn); }
    }
    for (; row < T; row += rstride) {
        const int b = row / RPB, within = row - b * RPB, midx = within < CTX ? 2 : b;
        float4 xv[4]; float4 agc = ag0; u32x2 ybc[4][4];
#pragma unroll
        for (int q = 0; q < 4; ++q) xv[q] = xn[q];
        if (COMBINE) {
#pragma unroll
            for (int k = 0; k < 4; ++k)
#pragma unroll
                for (int q = 0; q < 4; ++q) ybc[k][q] = ybn[k][q];
        }
        {
            const int nrow = row + rstride;
            if (nrow < T) {
                ldx(nrow, xn);
                if (COMBINE) { ae0 = ae1; ag0 = ag1; ldyb(ae0, ybn); if (nrow + rstride < T) ldasg(nrow + rstride, ae1, ag1); }
            }
        }
        if (SRC_IN) {
#pragma unroll
            for (int q = 0; q < 4; ++q) *(float4*)(X + (size_t)row * D + q * 256 + lane * 4) = xv[q];
        }
        if (COMBINE) {
            const float gk[4] = { agc.x, agc.y, agc.z, agc.w };
            float4 f[4];
#pragma unroll
            for (int q = 0; q < 4; ++q) f[q] = make_float4(0.f, 0.f, 0.f, 0.f);
#pragma unroll
            for (int k = 0; k < 4; ++k) {
                const float gate = gk[k];
#pragma unroll
                for (int q = 0; q < 4; ++q) {
                    const u32x2 u = ybc[k][q];
                    f[q].x += gate * bf_lo(u[0]); f[q].y += gate * bf_hi(u[0]); f[q].z += gate * bf_lo(u[1]); f[q].w += gate * bf_hi(u[1]);
                }
            }
            const float* g2 = modbase + ((size_t)(layer - 1) * 3 + midx) * 6144 + 5 * 1024;
#pragma unroll
            for (int q = 0; q < 4; ++q) {
                const float4 g = *(const float4*)(g2 + q * 256 + lane * 4);
                xv[q].x += g.x * f[q].x; xv[q].y += g.y * f[q].y; xv[q].z += g.z * f[q].z; xv[q].w += g.w * f[q].w;
                if (!FINAL) *(float4*)((shadow ? (float*)(a.ws + WS_MIX) : X) + (size_t)row * D + q * 256 + lane * 4) = xv[q];
            }
        }
        if (FINAL) {
            if (within >= CTX) {
                float* o = a.out + ((size_t)b * SEQ + (within - CTX)) * D;
#pragma unroll
                for (int q = 0; q < 4; ++q) *(float4*)(o + q * 256 + lane * 4) = xv[q];
            }
            continue;
        }
        float ss = 0.f;
#pragma unroll
        for (int q = 0; q < 4; ++q) ss += xv[q].x * xv[q].x + xv[q].y * xv[q].y + xv[q].z * xv[q].z + xv[q].w * xv[q].w;
        ss = wave_sum(ss);
        const float rstd = rsqrtf(ss * (1.f / 1024.f) + 1e-6f);
        const float* gn = a.in[ROUTER ? I_NFFN : I_NMIX] + layer * 1024;
        const float* mod = modbase + ((size_t)layer * 3 + midx) * 6144 + (ROUTER ? 3 * 1024 : 0);
        float4 hv[4];
#pragma unroll
        for (int q = 0; q < 4; ++q) {
            const int c = q * 256 + lane * 4;
            const float4 g = *(const float4*)(gn + c), sh = *(const float4*)(mod + c), sc = *(const float4*)(mod + 1024 + c);
            hv[q].x = xv[q].x * rstd * g.x * (1.f + sc.x) + sh.x; hv[q].y = xv[q].y * rstd * g.y * (1.f + sc.y) + sh.y;
            hv[q].z = xv[q].z * rstd * g.z * (1.f + sc.z) + sh.z; hv[q].w = xv[q].w * rstd * g.w * (1.f + sc.w) + sh.w;
            u32x2 o = { cvt_pk_bf16(hv[q].x, hv[q].y), cvt_pk_bf16(hv[q].z, hv[q].w) };
            *(u32x2*)((bf16_t*)(a.ws + WS_H) + (size_t)row * D + c) = o;
        }
        if (ROUTER) {
            float p[32];
#pragma unroll
            for (int e = 0; e < 32; ++e) {
                float s = 0.f;
#pragma unroll
                for (int q = 0; q < 4; ++q) { const float4 w = *(const float4*)(rwt + e * 1024 + q * 256 + lane * 4); s += hv[q].x * w.x + hv[q].y * w.y + hv[q].z * w.z + hv[q].w * w.w; }
                p[e] = s;
                if ((e & 3) == 3) __builtin_amdgcn_sched_barrier(0);
            }
#pragma unroll
            for (int i = 0; i < 16; ++i) { const bool hi = lane & 32; const float snd = hi ? p[i] : p[i + 16], kp = hi ? p[i + 16] : p[i]; p[i] = kp + __shfl_xor(snd, 32); }
#pragma unroll
            for (int i = 0; i < 8; ++i)  { const bool hi = lane & 16; const float snd = hi ? p[i] : p[i + 8],  kp = hi ? p[i + 8]  : p[i]; p[i] = kp + __shfl_xor(snd, 16); }
#pragma unroll
            for (int i = 0; i < 4; ++i)  { const bool hi = lane & 8;  const float snd = hi ? p[i] : p[i + 4],  kp = hi ? p[i + 4]  : p[i]; p[i] = kp + __shfl_xor(snd, 8); }
#pragma unroll
            for (int i = 0; i < 2; ++i)  { const bool hi = lane & 4;  const float snd = hi ? p[i] : p[i + 2],  kp = hi ? p[i + 2]  : p[i]; p[i] = kp + __shfl_xor(snd, 4); }
            { const bool hi = lane & 2; const float snd = hi ? p[0] : p[1], kp = hi ? p[1] : p[0]; p[0] = kp + __shfl_xor(snd, 2); }
            p[0] += __shfl_xor(p[0], 1);
            const int myE = ((lane >> 5) & 1) * 16 + ((lane >> 4) & 1) * 8 + ((lane >> 3) & 1) * 4 + ((lane >> 2) & 1) * 2 + ((lane >> 1) & 1);
            float v = p[0] + a.in[I_ERB][layer * 32 + myE];
            float tv[4]; int ti[4];
#pragma unroll
            for (int r = 0; r < 4; ++r) {
                float bv = v; int bi = myE;
#pragma unroll
                for (int o = 32; o >= 1; o >>= 1) { const float ov = __shfl_xor(bv, o); const int oi = __shfl_xor(bi, o); if (ov > bv || (ov == bv && oi < bi)) { bv = ov; bi = oi; } }
                tv[r] = bv; ti[r] = bi;
                if (myE == bi) v = -INFINITY;
            }
            {
                const float e1 = __expf(tv[1] - tv[0]), e2 = __expf(tv[2] - tv[0]), e3 = __expf(tv[3] - tv[0]);
                const float inv = 1.f / (1.f + e1 + e2 + e3);
                const int   me = lane == 0 ? ti[0] : (lane == 1 ? ti[1] : (lane == 2 ? ti[2] : ti[3]));
                const float mg = lane == 0 ? inv : (lane == 1 ? e1 * inv : (lane == 2 ? e2 * inv : e3 * inv));
                if (lane < 4) {
                    int* cnt = (int*)(a.ws + WS_CNT2) + layer * 32 * CSTR + (shadow ? CSTR / 2 : 0);
                    const int slot = (SHADOW_NOATOM && shadow) ? (row & 4095) : atomicAdd(&cnt[me * CSTR], 1);
                    ((int*)(a.ws + shoff + WS_TOKL))[(size_t)me * T + slot] = row;
                    ((int*)(a.ws + shoff + WS_ASGE))[(size_t)row * 4 + lane] = (me << 24) | slot;
                    ((float*)(a.ws + shoff + WS_ASGG))[(size_t)row * 4 + lane] = mg;
                }
            }
        }
    }
}

namespace rt {
constexpr int RCAP = 320;
constexpr int TROW = 2064;
constexpr int PS = 36;
constexpr int OFF_CNT = LDS_USER;
constexpr int OFF_ABE = OFF_CNT + 256;
constexpr int OFF_ABG = OFF_ABE + RCAP * 16;
constexpr int OFF_TILE = OFF_ABG + RCAP * 16;
constexpr int OFF_PART = OFF_TILE + 2 * 16 * TROW;
constexpr int OFF_END = OFF_PART + 8 * 16 * PS * 4;
static_assert(OFF_END <= LDS_BYTES && OFF_TILE % 16 == 0 && OFF_PART % 16 == 0, "router LDS layout");
}
__device__ __forceinline__ void phase_norm_router(const Args& a, unsigned char* lds, int layer, int shadow = 0) {
    const size_t shoff = shadow ? (size_t)(WS_SHADOW_ABS - WS_ASGE) : 0;
    const int tid = otid(), lane = tid & 63, wid = tid >> 6, fr = lane & 15, fq = lane >> 4;
    const float* X = (const float*)(a.ws + WS_X);
    int* lcnt = (int*)(lds + rt::OFF_CNT); int* gbase = lcnt + 32;
    int* abe = (int*)(lds + rt::OFF_ABE); float* abg = (float*)(lds + rt::OFF_ABG);
    unsigned char* tile = lds + rt::OFF_TILE; float* part = (float*)(lds + rt::OFF_PART);
    if (tid < 32) lcnt[tid] = 0;
    bf16x8 Wh[4][2], Wl[4][2];
    {
        const float* rw = (const float*)(a.ws + WS_RWT) + (size_t)layer * 32768;
#pragma unroll
        for (int ks = 0; ks < 4; ++ks)
#pragma unroll
            for (int b = 0; b < 2; ++b) {
                const float* p = rw + (size_t)(b * 16 + fr) * 1024 + wid * 128 + ks * 32 + fq * 8;
                const float4 w0 = *(const float4*)p, w1 = *(const float4*)(p + 4);
                u32x4 h, l;
                h[0] = cvt_pk_bf16(w0.x, w0.y); h[1] = cvt_pk_bf16(w0.z, w0.w); h[2] = cvt_pk_bf16(w1.x, w1.y); h[3] = cvt_pk_bf16(w1.z, w1.w);
                l[0] = cvt_pk_bf16(w0.x - bf_lo(h[0]), w0.y - bf_hi(h[0])); l[1] = cvt_pk_bf16(w0.z - bf_lo(h[1]), w0.w - bf_hi(h[1]));
                l[2] = cvt_pk_bf16(w1.x - bf_lo(h[2]), w1.y - bf_hi(h[2])); l[3] = cvt_pk_bf16(w1.z - bf_lo(h[3]), w1.w - bf_hi(h[3]));
                Wh[ks][b] = __builtin_bit_cast(bf16x8, h); Wl[ks][b] = __builtin_bit_cast(bf16x8, l);
            }
    }
    const float* modbase = (const float*)(a.ws + WS_MOD);
    const int rstride = gridDim.x * 8, row0 = blockIdx.x * 8 + wid;
    const int niter = (T - (int)blockIdx.x * 8 + rstride - 1) / rstride;
    auto ldx = [&](int r, float4 (&x)[4]) {
#pragma unroll
        for (int q = 0; q < 4; ++q) x[q] = *(const float4*)(X + (size_t)r * D + q * 256 + lane * 4);
    };
    float4 xn[4];
    if (row0 < T) ldx(row0, xn);
    const float biasv = a.in[I_ERB][layer * 32 + (lane & 31)];
    __syncthreads();
    for (int i0 = 0; i0 < niter; i0 += 2) {
#pragma unroll
        for (int ii = 0; ii < 2; ++ii) {
            const int row = row0 + (i0 + ii) * rstride;
            if (row < T) {
                const int b = row / RPB, within = row - b * RPB, midx = within < CTX ? 2 : b;
                float4 xv[4];
#pragma unroll
                for (int q = 0; q < 4; ++q) xv[q] = xn[q];
                if (row + rstride < T) ldx(row + rstride, xn);
                float ss = 0.f;
#pragma unroll
                for (int q = 0; q < 4; ++q) ss += xv[q].x * xv[q].x + xv[q].y * xv[q].y + xv[q].z * xv[q].z + xv[q].w * xv[q].w;
                ss = wave_sum(ss);
                const float rstd = rsqrtf(ss * (1.f / 1024.f) + 1e-6f);
                const float* gn = a.in[I_NFFN] + layer * 1024;
                const float* mod = modbase + ((size_t)layer * 3 + midx) * 6144 + 3 * 1024;
                unsigned char* trow = tile + (ii * 8 + wid) * rt::TROW;
#pragma unroll
                for (int q = 0; q < 4; ++q) {
                    const int c = q * 256 + lane * 4;
                    const float4 g = *(const float4*)(gn + c), sh = *(const float4*)(mod + c), sc = *(const float4*)(mod + 1024 + c);
                    float4 hv;
                    hv.x = xv[q].x * rstd * g.x * (1.f + sc.x) + sh.x; hv.y = xv[q].y * rstd * g.y * (1.f + sc.y) + sh.y;
                    hv.z = xv[q].z * rstd * g.z * (1.f + sc.z) + sh.z; hv.w = xv[q].w * rstd * g.w * (1.f + sc.w) + sh.w;
                    const u32x2 hi = { cvt_pk_bf16(hv.x, hv.y), cvt_pk_bf16(hv.z, hv.w) };
                    const u32x2 lo = { cvt_pk_bf16(hv.x - bf_lo(hi[0]), hv.y - bf_hi(hi[0])), cvt_pk_bf16(hv.z - bf_lo(hi[1]), hv.w - bf_hi(hi[1])) };
                    *(u32x2*)((bf16_t*)(a.ws + WS_H) + (size_t)row * D + c) = hi;
                    *(u32x2*)(trow + c * 2) = hi;
                    *(u32x2*)(trow + 16 * rt::TROW + c * 2) = lo;
                }
            }
        }
        __syncthreads();
        {
            f32x4 acc[2] = { (f32x4){0.f, 0.f, 0.f, 0.f}, (f32x4){0.f, 0.f, 0.f, 0.f} };
#pragma unroll
            for (int ks = 0; ks < 4; ++ks) {
                const unsigned char* p = tile + fr * rt::TROW + (wid * 128 + ks * 32 + fq * 8) * 2;
                const bf16x8 Bh = *(const bf16x8*)p, Bl = *(const bf16x8*)(p + 16 * rt::TROW);
#pragma unroll
                for (int b = 0; b < 2; ++b) {
                    acc[b] = __builtin_amdgcn_mfma_f32_16x16x32_bf16(Wh[ks][b], Bh, acc[b], 0, 0, 0);
                    acc[b] = __builtin_amdgcn_mfma_f32_16x16x32_bf16(Wl[ks][b], Bh, acc[b], 0, 0, 0);
                    acc[b] = __builtin_amdgcn_mfma_f32_16x16x32_bf16(Wh[ks][b], Bl, acc[b], 0, 0, 0);
                }
            }
#pragma unroll
            for (int b = 0; b < 2; ++b) *(f32x4*)(part + (wid * 16 + fr) * rt::PS + b * 16 + fq * 4) = acc[b];
        }
        __syncthreads();
        {
            const int hf = lane >> 5, tr = 2 * wid + hf, e = lane & 31;
            float v = biasv;
#pragma unroll
            for (int w = 0; w < 8; ++w) v += part[(w * 16 + tr) * rt::PS + e];
            const int ww = tr & 7, it = i0 + (tr >> 3);
            const int row = blockIdx.x * 8 + ww + it * rstride;
            float tv[4]; int ti[4];
#pragma unroll
            for (int r = 0; r < 4; ++r) {
                float m = v;
                m = fmaxf(m, dpp_f<0x128>(m)); m = fmaxf(m, dpp_f<0x124>(m)); m = fmaxf(m, dpp_f<0x122>(m)); m = fmaxf(m, dpp_f<0x121>(m));
                const float m0 = __int_as_float(__builtin_amdgcn_readlane(__float_as_int(m), 0)),  m1 = __int_as_float(__builtin_amdgcn_readlane(__float_as_int(m), 16));
                const float m2 = __int_as_float(__builtin_amdgcn_readlane(__float_as_int(m), 32)), m3 = __int_as_float(__builtin_amdgcn_readlane(__float_as_int(m), 48));
                const float mx = hf ? fmaxf(m2, m3) : fmaxf(m0, m1);
                const unsigned long long bal = __ballot(v == mx);
                const unsigned hm = hf ? (unsigned)(bal >> 32) : (unsigned)bal;
                const int first = __ffs(hm) - 1;
                tv[r] = mx; ti[r] = first;
                if (e == first) v = -INFINITY;
            }
            const float e1 = __expf(tv[1] - tv[0]), e2 = __expf(tv[2] - tv[0]), e3 = __expf(tv[3] - tv[0]);
            const float inv = 1.f / (1.f + e1 + e2 + e3);
            const int   me = e == 0 ? ti[0] : (e == 1 ? ti[1] : (e == 2 ? ti[2] : ti[3]));
            const float mg = e == 0 ? inv : (e == 1 ? e1 * inv : (e == 2 ? e2 * inv : e3 * inv));
            if (e < 4 && row < T && it < niter) {
                const int ls = atomicAdd(&lcnt[me], 1);
                const int li = it * 8 + ww;
                abe[li * 4 + e] = (me << 24) | ls;
                abg[li * 4 + e] = mg;
            }
        }
    }
    __syncthreads();
    if (tid < 32) {
        int* cnt = (int*)(a.ws + WS_CNT2) + layer * 32 * CSTR + (shadow ? CSTR / 2 : 0);
        gbase[tid] = atomicAdd(&cnt[tid * CSTR], lcnt[tid]);
    }
    __syncthreads();
    for (int idx = tid; idx < niter * 32; idx += NT) {
        const int li = idx >> 2, k = idx & 3, row = blockIdx.x * 8 + (li & 7) + (li >> 3) * rstride;
        if (row < T) {
            const int ev = abe[idx], e = ev >> 24, slot = gbase[e] + (ev & 0xffffff);
            ((int*)(a.ws + shoff + WS_TOKL))[(size_t)e * T + slot] = row;
            ((int*)(a.ws + shoff + WS_ASGE))[(size_t)row * 4 + k] = (e << 24) | slot;
            ((float*)(a.ws + shoff + WS_ASGG))[(size_t)row * 4 + k] = abg[idx];
        }
    }
}
struct ALoadMix {
    const bf16_t* H; const float* mu;
    __device__ __forceinline__ u32x4 load(int row, int k) const {
        const int within = row % RPB;
        const bool first = (within == 0) || (within == CTX), last = (within == CTX - 1) || (within == RPB - 1);
        const bf16_t* p = H + (size_t)row * D + k;
        const u32x4 c = *(const u32x4*)p;
        u32x4 pv = {0u, 0u, 0u, 0u}, nv = {0u, 0u, 0u, 0u};
        if (!first) pv = *(const u32x4*)(p - D);
        if (!last)  nv = *(const u32x4*)(p + D);
        const float4 m0 = *(const float4*)(mu + k), m1 = *(const float4*)(mu + k + 4);
        const float mm[8] = { m0.x, m0.y, m0.z, m0.w, m1.x, m1.y, m1.z, m1.w };
        u32x4 o;
#pragma unroll
        for (int i = 0; i < 4; ++i) {
            const float h0 = bf_lo(c[i]), h1 = bf_hi(c[i]);
            const float x0 = h0 + (0.5f * (bf_lo(pv[i]) + bf_lo(nv[i])) - h0) * mm[2 * i];
            const float x1 = h1 + (0.5f * (bf_hi(pv[i]) + bf_hi(nv[i])) - h1) * mm[2 * i + 1];
            o[i] = cvt_pk_bf16(x0, x1);
        }
        return o;
    }
};

__device__ __forceinline__ void phase_rwkv_mix(const Args& a, int j) {
    const int tid = otid();
    const bf16_t* H = (const bf16_t*)(a.ws + WS_H);
    const float* mu = a.in[I_RMU] + (size_t)j * 6 * D;
#pragma unroll 2
    for (int it = blockIdx.x * NT + tid; it < T * 128; it += gridDim.x * NT) {
        const int row = it >> 7, k = (it & 127) * 8;
        const int within = row % RPB;
        const bool first = (within == 0) || (within == CTX), last = (within == CTX - 1) || (within == RPB - 1);
        const bf16_t* p = H + (size_t)row * D + k;
        const u32x4 c = *(const u32x4*)p;
        u32x4 pv = {0u, 0u, 0u, 0u}, nv = {0u, 0u, 0u, 0u};
        if (!first) pv = *(const u32x4*)(p - D);
        if (!last)  nv = *(const u32x4*)(p + D);
        float hc[8], xx[8];
#pragma unroll
        for (int i = 0; i < 4; ++i) {
            hc[2 * i] = bf_lo(c[i]); hc[2 * i + 1] = bf_hi(c[i]);
            xx[2 * i] = 0.5f * (bf_lo(pv[i]) + bf_lo(nv[i])) - hc[2 * i]; xx[2 * i + 1] = 0.5f * (bf_hi(pv[i]) + bf_hi(nv[i])) - hc[2 * i + 1];
        }
#pragma unroll
        for (int g = 0; g < 3; ++g) {
            const int mi = (g == 0) ? 0 : (g == 1 ? 2 : 3);
            const float4 m0 = *(const float4*)(mu + mi * D + k), m1 = *(const float4*)(mu + mi * D + k + 4);
            const float mm[8] = { m0.x, m0.y, m0.z, m0.w, m1.x, m1.y, m1.z, m1.w };
            u32x4 o;
#pragma unroll
            for (int i = 0; i < 4; ++i) o[i] = cvt_pk_bf16(hc[2 * i] + xx[2 * i] * mm[2 * i], hc[2 * i + 1] + xx[2 * i + 1] * mm[2 * i + 1]);
            *(u32x4*)((bf16_t*)(a.ws + (g == 0 ? RW_XR : (g == 1 ? RW_XK : RW_XV))) + (size_t)row * D + k) = o;
        }
    }
}
__device__ __forceinline__ void phase_rwkv_proj1(const Args& a, unsigned char* lds, int j) {
    unsigned char* gl = lds + LDS_USER;
    const bf16_t* H = (const bf16_t*)(a.ws + WS_H);
    const int nl = (j == 0) ? 4 : 5, NL = 130 * nl;
    const float* mu = a.in[I_RMU] + (size_t)j * 6 * D;
    int u = blockIdx.x;
    for (; u < NL; u += gridDim.x) {
        const int mt = u / nl, nt = u - mt * nl, m0 = mt * 256;
        const int mi = (nt == 0) ? 1 : (nt == 1 ? 4 : (nt < 4 ? 5 : 3));
        const bf16_t* Bt = (const bf16_t*)(a.ws + WS_L1T) + (size_t)j * 640 * D;
        bf16_t* HL = (bf16_t*)(a.ws + RW_HL);
        ALoadMix al{ H, mu + mi * D };
        gemm_tile(al, Bt, D, 16, gl, make_epi([=](int row, int col, const f32x4& v) {
            float o[4];
#pragma unroll
            for (int i = 0; i < 4; ++i) { float x = v[i]; if (nt == 0) x = 1.f - 2.f * __builtin_amdgcn_rcpf(1.f + __expf(2.f * x));   else if (nt == 2 || nt == 3) x = sigmoidf_(x); o[i] = x; }
            u32x2 w = { cvt_pk_bf16(o[0], o[1]), cvt_pk_bf16(o[2], o[3]) };
            *(u32x2*)(HL + (size_t)row * 640 + col) = w;
        }), m0, nt * 128);
    }
    __syncthreads();
    const unsigned char* ws = a.ws;
    const int xq = blockIdx.x & 7, nxw = (gridDim.x + 7 - xq) >> 3;
    int si = blockIdx.x >> 3;
    auto next = [&](g8::UTile& t) -> bool {
        const int m4 = si / 6, s = (xq & 1) * 6 + (si - m4 * 6), mt = 4 * m4 + (xq >> 1);
        if (mt >= 130) return false;
        si += nxw;
        t.mt = mt; t.g = s >> 2; t.nt = s & 3;
        return true;
    };
    const auto ctx = g8::make_ctx(
        [=](const g8::UTile& t) { return (const bf16_t*)(ws + (t.g == 0 ? RW_XR : (t.g == 1 ? RW_XK : RW_XV))) + (size_t)t.mt * 256 * D; },
        [=](const g8::UTile& t) { return (const bf16_t*)(ws + WS_RKVT) + (size_t)(j * 3 + t.g) * D * D + (size_t)t.nt * 256 * D; },
        [=](const g8::UTile&, f32x4 (&acc)[2][2][4][2], int) { g8::zero_acc(acc); },
        [=](const g8::UTile& t, const f32x4 (&acc)[2][2][4][2], int row0, int col0) {
            bf16_t* out = uniform_ptr((bf16_t*)(ws + (t.g == 0 ? RW_R : (t.g == 1 ? RW_K : (j == 0 ? WS_VFIRST : RW_V)))));
            g8::each_acc(acc, row0, col0, [=](int row, int col, const f32x4& vv) { *(u32x2*)(out + (size_t)row * D + col) = (u32x2){ cvt_pk_bf16(vv[0], vv[1]), cvt_pk_bf16(vv[2], vv[3]) }; });
        });
    g8::gemm256_stream<false, g8::UTile>(D, (unsigned)D, gl, ctx, next);
}
template <int KS, bool DBUF, class FB, class FR, class FE>
__device__ __forceinline__ void p2_wave_run(const bf16_t* A, const bf16_t* Bt, bf16_t* out, int row0, int q_lo, int q_hi, int lane, FB fbias, FR frow, FE fe) {
    const int fr = lane & 15, fq = lane >> 4;
    bf16x8 Af[4][KS];
#pragma unroll
    for (int mb = 0; mb < 4; ++mb)
#pragma unroll
        for (int ks = 0; ks < KS; ++ks) Af[mb][ks] = *(const bf16x8*)(A + (size_t)(row0 + mb * 16 + fr) * 640 + ks * 32 + fq * 8);
    const int bcol = (fr >> 2) * 8 + (fr & 3);
    bf16x8 Bf[2][KS], Bn[2][KS];
    decltype(fbias(0)) bi[2], bn[2];
    auto ldB = [&](int q, bf16x8 (&bf)[2][KS], decltype(fbias(0)) (&bb)[2]) {
#pragma unroll
        for (int nb = 0; nb < 2; ++nb) {
#pragma unroll
            for (int ks = 0; ks < KS; ++ks) bf[nb][ks] = *(const bf16x8*)(Bt + (size_t)(q * 32 + bcol + nb * 4) * (KS * 32) + ks * 32 + fq * 8);
            bb[nb] = fbias(q * 32 + fq * 8 + nb * 4);
        }
    };
    ldB(q_lo, Bf, bi);
#pragma unroll 1
    for (int q = q_lo; q < q_hi; ++q) {
        if (DBUF) { if (q + 1 < q_hi) ldB(q + 1, Bn, bn); }
        const int c0 = q * 32 + fq * 8;
        decltype(frow(0, 0)) ex[4][2];
#pragma unroll
        for (int nb = 0; nb < 2; ++nb)
#pragma unroll
            for (int mb = 0; mb < 4; ++mb) ex[mb][nb] = frow(row0 + mb * 16 + fr, c0 + nb * 4);
        f32x4 acc[4][2];
#pragma unroll
        for (int mb = 0; mb < 4; ++mb)
#pragma unroll
            for (int nb = 0; nb < 2; ++nb) {
                acc[mb][nb] = (f32x4){0.f, 0.f, 0.f, 0.f};
#pragma unroll
                for (int ks = 0; ks < KS; ++ks) acc[mb][nb] = __builtin_amdgcn_mfma_f32_16x16x32_bf16(Bf[nb][ks], Af[mb][ks], acc[mb][nb], 0, 0, 0);
            }
#pragma unroll
        for (int mb = 0; mb < 4; ++mb) {
            const f32x4 o0 = fe(acc[mb][0], bi[0], ex[mb][0]), o1 = fe(acc[mb][1], bi[1], ex[mb][1]);
            *(u32x4*)(out + (size_t)(row0 + mb * 16 + fr) * D + c0) = (u32x4){ cvt_pk_bf16(o0[0], o0[1]), cvt_pk_bf16(o0[2], o0[3]), cvt_pk_bf16(o1[0], o1[1]), cvt_pk_bf16(o1[2], o1[3]) };
        }
        if (DBUF) {
#pragma unroll
            for (int nb = 0; nb < 2; ++nb) { bi[nb] = bn[nb];
#pragma unroll
                for (int ks = 0; ks < KS; ++ks) Bf[nb][ks] = Bn[nb][ks]; }
        } else if (q + 1 < q_hi) ldB(q + 1, Bf, bi);
    }
}
__device__ __forceinline__ void phase_rwkv_proj2(const Args& a, unsigned char* lds, int j) {
    const int tid = otid(), lane = tid & 63, wid = tid >> 6;
    const bf16_t* HL = (const bf16_t*)(a.ws + RW_HL);
    const int NG = (j == 0) ? 5 : 6;
    const int U = 520 * NG * 8, nw = gridDim.x * 8, gw = blockIdx.x * 8 + wid;
    int u = (int)(((long long)U * gw) / nw);
    const int u_hi = (int)(((long long)U * (gw + 1)) / nw);
    while (u < u_hi) {
        const int grp = u >> 3, rb = grp / NG, g = grp - rb * NG, row0 = rb * 64;
        const int run_end = ((grp + 1) << 3) < u_hi ? ((grp + 1) << 3) : u_hi;
        const int q_lo = (u & 7) * 4, q_hi = q_lo + (run_end - u) * 4;
        if (g < 2) {
            const int d = g;
            const float* w0 = a.in[I_RW0] + (size_t)(j * 2 + d) * D;
            p2_wave_run<2, true>(HL + d * 64, (const bf16_t*)(a.ws + WS_W2T) + (size_t)(j * 2 + d) * D * 64, (bf16_t*)(a.ws + (d == 0 ? RW_WD0 : RW_WD1)), row0, q_lo, q_hi, lane,
                [=](int col) { return *(const float4*)(w0 + col); }, nil_row, [=](const f32x4& v, const float4& b, Nil) {
                return (f32x4){ 0.6065306597126334f * sigmoidf_(b.x + v[0]), 0.6065306597126334f * sigmoidf_(b.y + v[1]), 0.6065306597126334f * sigmoidf_(b.z + v[2]), 0.6065306597126334f * sigmoidf_(b.w + v[3]) };
            });
        } else if (g < 4) {
            const int d = g - 2;
            const float* a0 = a.in[I_RA0] + (size_t)(j * 2 + d) * D;
            p2_wave_run<2, true>(HL + 128 + d * 64, (const bf16_t*)(a.ws + WS_A2T) + (size_t)(j * 2 + d) * D * 64, (bf16_t*)(a.ws + (d == 0 ? RW_AD0 : RW_AD1)), row0, q_lo, q_hi, lane,
                [=](int col) { return *(const float4*)(a0 + col); }, nil_row, [=](const f32x4& v, const float4& b, Nil) {
                return (f32x4){ sigmoidf_(b.x + v[0]), sigmoidf_(b.y + v[1]), sigmoidf_(b.z + v[2]), sigmoidf_(b.w + v[3]) };
            });
        } else if (g == 4) {
            p2_wave_run<6, false>(HL + 256, (const bf16_t*)(a.ws + WS_G2T) + (size_t)j * D * 192, (bf16_t*)(a.ws + RW_G), row0, q_lo, q_hi, lane,
                nil_col, nil_row, [=](const f32x4& v, Nil, Nil) { return v; });
        } else {
            bf16_t* V = (bf16_t*)(a.ws + RW_V);
            const bf16_t* VF = (const bf16_t*)(a.ws + WS_VFIRST);
            const float* v0 = a.in[I_RV0];
            struct VR { u32x2 cur, vf; };
            p2_wave_run<2, true>(HL + 512, (const bf16_t*)(a.ws + WS_V2T), V, row0, q_lo, q_hi, lane,
                [=](int col) { return *(const float4*)(v0 + col); },
                [=](int row, int col) { return VR{ *(const u32x2*)(V + (size_t)row * D + col), *(const u32x2*)(VF + (size_t)row * D + col) }; },
                [=](const f32x4& v, const float4& b, const VR& rr) {
                const float cur[4] = { bf_lo(rr.cur[0]), bf_hi(rr.cur[0]), bf_lo(rr.cur[1]), bf_hi(rr.cur[1]) }, vf[4] = { bf_lo(rr.vf[0]), bf_hi(rr.vf[0]), bf_lo(rr.vf[1]), bf_hi(rr.vf[1]) };
                return (f32x4){ cur[0] + (vf[0] - cur[0]) * sigmoidf_(b.x + v[0]), cur[1] + (vf[1] - cur[1]) * sigmoidf_(b.y + v[1]),
                                cur[2] + (vf[2] - cur[2]) * sigmoidf_(b.z + v[2]), cur[3] + (vf[3] - cur[3]) * sigmoidf_(b.w + v[3]) };
            });
        }
        u = run_end;
    }
}
constexpr int WK_CH = 32;
constexpr int WK_VEC = 5 * WK_CH * 64 * 4, WK_VQ = WK_CH * 16 * 4, WK_BUF = WK_VEC + WK_VQ;
constexpr int WK_YP = WK_CH * 16 * 4 * 4;
typedef float f32x2 __attribute__((ext_vector_type(2)));
__device__ __forceinline__ void phase_wkv(const Args& a, unsigned char* lds, int j) {
    const int tid = otid(), lane = tid & 63, wid = tid >> 6;
    unsigned char* base = lds + LDS_USER;
    float* ypart = (float*)(base + 2 * WK_BUF);
    const float* R = (const float*)(a.ws + RW_R); const float* K = (const float*)(a.ws + RW_K);
    const float* V = (const float*)(a.ws + (j == 0 ? WS_VFIRST : RW_V));
    for (int unit = blockIdx.x; unit < 256; unit += gridDim.x) {
        const int chain = unit >> 2, qv = unit & 3, b = chain >> 5, h = (chain >> 1) & 15, d = chain & 1;
        const float* WD = (const float*)(a.ws + (d == 0 ? RW_WD0 : RW_WD1));
        const float* AD = (const float*)(a.ws + (d == 0 ? RW_AD0 : RW_AD1));
        float* Y = (float*)(a.ws + (d == 0 ? RW_Y0 : RW_Y1));
        const int ch0 = h * 64;
        auto rowof = [&](int t) -> size_t { const int p = (d == 0) ? t : ((t < CTX) ? (CTX - 1 - t) : (RPB + CTX - 1 - t)); return (size_t)b * RPB + p; };
        constexpr int NCH = RPB / WK_CH;
        if (wid >= 4) {
            const int sw = wid - 4;
            const float kkw = a.in[I_RKK][j * D + ch0 + lane], kaw = a.in[I_RKA][j * D + ch0 + lane];
            float fr[8], fk[8], fw[8], fa[8], fv[8];
            auto issue = [&](int c) {
#pragma unroll
                for (int i = 0; i < 8; ++i) {
                    const size_t row = rowof(c * WK_CH + sw * 8 + i); const size_t o = row * D + ch0 + lane;
                    fr[i] = R[o]; fk[i] = K[o]; fw[i] = WD[o]; fa[i] = AD[o];
                    fv[i] = V[row * D + ch0 + qv * 16 + (lane & 15)];
                }
            };
            auto process = [&](int buf) {
                float* vec = (float*)(base + buf * WK_BUF); float* vq = (float*)(base + buf * WK_BUF + WK_VEC);
                float kkv[8], n2[8];
#pragma unroll
                for (int i = 0; i < 8; ++i) { kkv[i] = fk[i] * kkw; n2[i] = row16_sum(kkv[i] * kkv[i]); }
#pragma unroll
                for (int i = 0; i < 8; ++i) n2[i] += __shfl_xor(n2[i], 16);
#pragma unroll
                for (int i = 0; i < 8; ++i) n2[i] += __shfl_xor(n2[i], 32);
#pragma unroll
                for (int i = 0; i < 8; ++i) {
                    const int s = sw * 8 + i;
                    const float kk = kkv[i] / fmaxf(sqrtf(n2[i]), 1e-12f);
                    vec[(0 * WK_CH + s) * 64 + lane] = fr[i]; vec[(1 * WK_CH + s) * 64 + lane] = fw[i]; vec[(2 * WK_CH + s) * 64 + lane] = kk;
                    vec[(3 * WK_CH + s) * 64 + lane] = kk * fa[i]; vec[(4 * WK_CH + s) * 64 + lane] = fk[i] * (1.f + (fa[i] - 1.f) * kaw);
                    if (lane < 16) vq[s * 16 + lane] = fv[i];
                }
            };
            auto yout = [&](int c, int buf) {
                const int st = tid - 256;
#pragma unroll
                for (int i = 0; i < 2; ++i) {
                    const int idx = st + i * 256, s = idx >> 4, i16 = idx & 15;
                    const float4 p = *(const float4*)(ypart + buf * (WK_CH * 64) + idx * 4);
                    Y[rowof(c * WK_CH + s) * D + ch0 + qv * 16 + i16] = (p.x + p.y) + (p.z + p.w);
                }
            };
            issue(0); process(0); issue(1);
            __syncthreads();
            for (int c = 0; c < NCH; ++c) {
                if (c > 0) yout(c - 1, (c - 1) & 1);
                if (c + 1 < NCH) { process((c + 1) & 1); if (c + 2 < NCH) issue(c + 2); }
                __syncthreads();
            }
            yout(NCH - 1, (NCH - 1) & 1);
        } else {
            f32x2 S01 = {0.f, 0.f}, S23 = {0.f, 0.f};
            const int vl = wid * 4 + (lane >> 4), k0 = (lane & 15) * 4;
            __syncthreads();
            for (int c = 0; c < NCH; ++c) {
                const float* vec = (const float*)(base + (c & 1) * WK_BUF); const float* vq = (const float*)(base + (c & 1) * WK_BUF + WK_VEC);
                float* yp = ypart + (c & 1) * (WK_CH * 64) + vl * 4 + (lane & 3);
#pragma unroll 2
                for (int g = 0; g < WK_CH / 4; ++g) {
                    float yv[4];
#pragma unroll
                    for (int uu = 0; uu < 4; ++uu) {
                        const int s = g * 4 + uu;
                        const float4 r4 = *(const float4*)(vec + (0 * WK_CH + s) * 64 + k0), w4 = *(const float4*)(vec + (1 * WK_CH + s) * 64 + k0);
                        const float4 kk4 = *(const float4*)(vec + (2 * WK_CH + s) * 64 + k0), ka4 = *(const float4*)(vec + (3 * WK_CH + s) * 64 + k0);
                        const float4 kd4 = *(const float4*)(vec + (4 * WK_CH + s) * 64 + k0);
                        const float vv = vq[s * 16 + vl];
                        const f32x2 p = S01 * (f32x2){kk4.x, kk4.y} + S23 * (f32x2){kk4.z, kk4.w};
                        const float sa = -row16_sum(p.x + p.y);
                        S01 = S01 * (f32x2){w4.x, w4.y} + (f32x2){ka4.x, ka4.y} * sa + (f32x2){kd4.x, kd4.y} * vv;
                        S23 = S23 * (f32x2){w4.z, w4.w} + (f32x2){ka4.z, ka4.w} * sa + (f32x2){kd4.z, kd4.w} * vv;
                        const f32x2 q = S01 * (f32x2){r4.x, r4.y} + S23 * (f32x2){r4.z, r4.w};
                        float y = q.x + q.y;
                        y += dpp_f<0x128>(y); y += dpp_f<0x124>(y);
                        yv[uu] = y;
                    }
                    if ((lane & 15) < 4) {
#pragma unroll
                        for (int uu = 0; uu < 4; ++uu) yp[(g * 4 + uu) * 64] = yv[uu];
                    }
                }
                __syncthreads();
            }
        }
        __syncthreads();
    }
}
__device__ __forceinline__ void phase_rwkv_readout(const Args& a, int j) {
    const int tid = otid(), lane = tid & 63, wid = tid >> 6;
    const bf16_t* R = (const bf16_t*)(a.ws + RW_R); const bf16_t* K = (const bf16_t*)(a.ws + RW_K);
    const bf16_t* V = (const bf16_t*)(a.ws + (j == 0 ? WS_VFIRST : RW_V)); const bf16_t* G = (const bf16_t*)(a.ws + RW_G);
    const bf16_t* A0 = (const bf16_t*)(a.ws + RW_AD0); const bf16_t* A1 = (const bf16_t*)(a.ws + RW_AD1);
    const float* Y0 = (const float*)(a.ws + RW_Y0); const float* Y1 = (const float*)(a.ws + RW_Y1);
    bf16_t* Z = (bf16_t*)(a.ws + RW_Z);
    const float* lng = a.in[I_RLNG] + j * D; const float* lnb = a.in[I_RLNB] + j * D; const float* rk = a.in[I_RRK] + j * D; const float* ka = a.in[I_RKA] + j * D;
    for (int row = blockIdx.x * 8 + wid; row < T; row += gridDim.x * 8) {
        float4 y0v[4], y1v[4]; u32x2 r4v[4], k4v[4], v4v[4], g4v[4], a0v[4], a1v[4];
#pragma unroll
        for (int q = 0; q < 4; ++q) {
            const size_t o = (size_t)row * D + q * 256 + lane * 4;
            y0v[q] = *(const float4*)(Y0 + o); y1v[q] = *(const float4*)(Y1 + o); r4v[q] = *(const u32x2*)(R + o); k4v[q] = *(const u32x2*)(K + o);
            v4v[q] = *(const u32x2*)(V + o); g4v[q] = *(const u32x2*)(G + o); a0v[q] = *(const u32x2*)(A0 + o); a1v[q] = *(const u32x2*)(A1 + o);
        }
#pragma unroll
        for (int q = 0; q < 4; ++q) {
            const int c = q * 256 + lane * 4; const size_t o = (size_t)row * D + c;
            const float4 y0 = y0v[q], y1 = y1v[q];
            const float y[4] = { y0.x + y1.x, y0.y + y1.y, y0.z + y1.z, y0.w + y1.w };
            const float mean = row16_sum(y[0] + y[1] + y[2] + y[3]) * (1.f / 64.f);
            float dv = 0.f;
#pragma unroll
            for (int i = 0; i < 4; ++i) dv += (y[i] - mean) * (y[i] - mean);
            const float rs = rsqrtf(row16_sum(dv) * (1.f / 64.f) + 64e-5f);
            const u32x2 r4 = r4v[q], k4 = k4v[q], v4 = v4v[q], g4 = g4v[q], a04 = a0v[q], a14 = a1v[q];
            const float4 lg = *(const float4*)(lng + c), lb = *(const float4*)(lnb + c), rk4 = *(const float4*)(rk + c), ka4 = *(const float4*)(ka + c);
            const float rr[4] = { bf_lo(r4[0]), bf_hi(r4[0]), bf_lo(r4[1]), bf_hi(r4[1]) }, kk[4] = { bf_lo(k4[0]), bf_hi(k4[0]), bf_lo(k4[1]), bf_hi(k4[1]) };
            const float vv[4] = { bf_lo(v4[0]), bf_hi(v4[0]), bf_lo(v4[1]), bf_hi(v4[1]) }, gg[4] = { bf_lo(g4[0]), bf_hi(g4[0]), bf_lo(g4[1]), bf_hi(g4[1]) };
            const float aa[4] = { bf_lo(a04[0]) + bf_lo(a14[0]), bf_hi(a04[0]) + bf_hi(a14[0]), bf_lo(a04[1]) + bf_lo(a14[1]), bf_hi(a04[1]) + bf_hi(a14[1]) };
            const float lgv[4] = { lg.x, lg.y, lg.z, lg.w }, lbv[4] = { lb.x, lb.y, lb.z, lb.w }, rkv[4] = { rk4.x, rk4.y, rk4.z, rk4.w }, kav[4] = { ka4.x, ka4.y, ka4.z, ka4.w };
            float bp = 0.f;
#pragma unroll
            for (int i = 0; i < 4; ++i) bp += rr[i] * kk[i] * rkv[i] * (2.f + (aa[i] - 2.f) * kav[i]);
            const float bonus = row16_sum(bp);
            float o4[4];
#pragma unroll
            for (int i = 0; i < 4; ++i) o4[i] = ((y[i] - mean) * rs * lgv[i] + lbv[i] + bonus * vv[i]) * gg[i];
            u32x2 w = { cvt_pk_bf16(o4[0], o4[1]), cvt_pk_bf16(o4[2], o4[3]) };
            *(u32x2*)(Z + o) = w;
        }
    }
}
struct GB { float4 g, b; };
__device__ __forceinline__ void phase_outproj(const Args& a, unsigned char* lds, int layer, const bf16_t* A, const bf16_t* Bt, const float* bias) {
    unsigned char* gl = lds + LDS_USER;
    float* X = (float*)(a.ws + WS_X);
    const float* modbase = (const float*)(a.ws + WS_MOD) + (size_t)layer * 3 * 6144 + 2 * 1024;
    constexpr int OP_FULL = ((130 * 4) / 256) * 256 / 4;
    constexpr int TAIL_R0 = OP_FULL * 256, TAIL_RB = (T - TAIL_R0) / 16;
    {
        const int tid = otid(), lane = tid & 63, wid = tid >> 6, fr = lane & 15, fq = lane >> 4;
        for (int w = blockIdx.x * 8 + wid; w < TAIL_RB * 64; w += gridDim.x * 8) {
            const int rblk = w >> 6, cblk = w & 63, row = TAIL_R0 + rblk * 16 + fr, colb = cblk * 16;
            const bf16_t* ap = A + (size_t)row * D + fq * 8;
            const bf16_t* bp = Bt + (size_t)(colb + fr) * D + fq * 8;
            f32x4 acc = {0.f, 0.f, 0.f, 0.f};
#pragma unroll
            for (int kc = 0; kc < 4; ++kc) {
                bf16x8 af[8], bf[8];
#pragma unroll
                for (int ks = 0; ks < 8; ++ks) { af[ks] = *(const bf16x8*)(ap + (kc * 8 + ks) * 32); bf[ks] = *(const bf16x8*)(bp + (kc * 8 + ks) * 32); }
#pragma unroll
                for (int ks = 0; ks < 8; ++ks) acc = __builtin_amdgcn_mfma_f32_16x16x32_bf16(bf[ks], af[ks], acc, 0, 0, 0);
            }
            const int col = colb + fq * 4;
            const float4 g = *(const float4*)(modbase + (size_t)mod_index(row) * 6144 + col);
            float4 bv = make_float4(0.f, 0.f, 0.f, 0.f);
            if (bias) bv = *(const float4*)(bias + col);
            f32x4 x = *(const f32x4*)(X + (size_t)row * D + col);
            x[0] += g.x * (acc[0] + bv.x); x[1] += g.y * (acc[1] + bv.y); x[2] += g.z * (acc[2] + bv.z); x[3] += g.w * (acc[3] + bv.w);
            *(f32x4*)(X + (size_t)row * D + col) = x;
        }
    }
    const int xq = blockIdx.x & 7, nxw = (gridDim.x + 7 - xq) >> 3;
    int si = blockIdx.x >> 3;
    auto next = [&](g8::UTile& t) -> bool {
        const int mt = 8 * (si >> 2) + xq;
        if (mt >= OP_FULL) return false;
        t.mt = mt; t.nt = si & 3; t.g = 0; si += nxw;
        return true;
    };
    const auto ctx = g8::make_ctx(
        [=](const g8::UTile& t) { return A + (size_t)t.mt * 256 * D; },
        [=](const g8::UTile& t) { return Bt + (size_t)t.nt * 256 * D; },
        [=](const g8::UTile&, f32x4 (&acc)[2][2][4][2], int col0) { g8::bias_acc(acc, bias, col0); },
        [=](const g8::UTile& t, const f32x4 (&acc)[2][2][4][2], int row0, int col0) {
            const float* gp = uniform_ptr(modbase + (size_t)mod_index(t.mt * 256) * 6144);
            float4 gv[2][2];
#pragma unroll
            for (int bj = 0; bj < 2; ++bj)
#pragma unroll
                for (int n = 0; n < 2; ++n) gv[bj][n] = *(const float4*)(gp + col0 + bj * 128 + n * 16);
#pragma unroll
            for (int ai = 0; ai < 2; ++ai) {
                f32x4 x[4][2][2];
#pragma unroll
                for (int m = 0; m < 4; ++m)
#pragma unroll
                    for (int bj = 0; bj < 2; ++bj)
#pragma unroll
                        for (int n = 0; n < 2; ++n) x[m][bj][n] = *(const f32x4*)(X + (size_t)(row0 + ai * 128 + m * 16) * D + col0 + bj * 128 + n * 16);
#pragma unroll
                for (int m = 0; m < 4; ++m)
#pragma unroll
                    for (int bj = 0; bj < 2; ++bj)
#pragma unroll
                        for (int n = 0; n < 2; ++n) {
                            f32x4 o = x[m][bj][n]; const f32x4 v = acc[ai][bj][m][n]; const float4 g = gv[bj][n];
                            o[0] += g.x * v[0]; o[1] += g.y * v[1]; o[2] += g.z * v[2]; o[3] += g.w * v[3];
                            *(f32x4*)(X + (size_t)(row0 + ai * 128 + m * 16) * D + col0 + bj * 128 + n * 16) = o;
                        }
            }
        });
    g8::gemm256_stream<false, g8::UTile>(D, (unsigned)D, gl, ctx, next);
}

struct ALoadGather {
    const bf16_t* H; const int* tl; int rowbase, cnt;
    __device__ __forceinline__ u32x4 load(int row, int k) const {
        int idx = row - rowbase; idx = idx < cnt ? idx : cnt - 1;
        return *(const u32x4*)(H + (size_t)tl[idx] * D + k);
    }
};
__device__ __forceinline__ void moe_tiles(const Args& a, int layer, int* tp) {
    if (threadIdx.x == 0) {
        const int* cnt = (const int*)(a.ws + WS_CNT2) + layer * 32 * CSTR;
        int acc = 0;
        for (int e = 0; e < 32; ++e) { tp[e] = acc; acc += (cnt[e * CSTR] + 255) >> 8; }
        tp[32] = acc;
    }
    __syncthreads();
}
struct UMoe1 { int rt, nt, e, tile, ce; };
struct CMoe1 {
    const unsigned char* ws; const float* binbase; int layer;
    __device__ __forceinline__ const bf16_t* A(const UMoe1&) const { return (const bf16_t*)(ws + WS_H); }
    __device__ __forceinline__ const bf16_t* B(const UMoe1& u) const { return (const bf16_t*)(ws + WS_EWINT) + ((size_t)layer * 32 + u.e) * 2048 * D + (size_t)u.nt * 256 * D; }
    __device__ __forceinline__ int brow(const UMoe1& u) const { return u.rt * 256; }
    __device__ __forceinline__ int bcol(const UMoe1& u) const { return u.nt * 256; }
    __device__ __forceinline__ unsigned aoff(const UMoe1& u, int r) const {
        const int* tl = uniform_ptr((const int*)(ws + WS_TOKL) + (size_t)u.e * T); int idx = u.tile * 256 + r; idx = idx < u.ce ? idx : u.ce - 1; return (unsigned)tl[(unsigned)idx] * (unsigned)D; }
    __device__ __forceinline__ void init(const UMoe1& u, f32x4 (&acc)[2][2][4][2], int col0) const {
        const float* bin = uniform_ptr(binbase + ((size_t)layer * 32 + u.e) * 2048);
#pragma unroll
        for (int n = 0; n < 2; ++n) {
            const float4 bg = *(const float4*)(bin + col0 - u.nt * 128 + n * 16), bl = *(const float4*)(bin + 1024 + col0 - u.nt * 128 + n * 16);
#pragma unroll
            for (int ai = 0; ai < 2; ++ai)
#pragma unroll
                for (int m = 0; m < 4; ++m) { acc[ai][0][m][n] = (f32x4){ bg.x, bg.y, bg.z, bg.w }; acc[ai][1][m][n] = (f32x4){ bl.x, bl.y, bl.z, bl.w }; }
        }
    }
    __device__ __forceinline__ void epi(const UMoe1& u, const f32x4 (&acc)[2][2][4][2], int row0, int col0) const {
        bf16_t* ACT = uniform_ptr((bf16_t*)(ws + WS_ACT));
#pragma unroll
        for (int ai = 0; ai < 2; ++ai)
#pragma unroll
            for (int m = 0; m < 4; ++m)
#pragma unroll
                for (int n = 0; n < 2; ++n) {
                    const int row = row0 + ai * 128 + m * 16, colg = col0 - u.nt * 128 + n * 16;
                    float o[4];
#pragma unroll
                    for (int i = 0; i < 4; ++i) {
                        const float glu = fminf(acc[ai][0][m][n][i], 7.f);
                        const float lin = fminf(fmaxf(acc[ai][1][m][n][i], -7.f), 7.f);
                        o[i] = glu * sigmoidf_(1.702f * glu) * (lin + 1.f);
                    }
                    u32x2 w = { cvt_pk_bf16(o[0], o[1]), cvt_pk_bf16(o[2], o[3]) };
                    *(u32x2*)(ACT + (size_t)row * D + colg) = w;
                }
    }
};
__device__ __forceinline__ void phase_moe1(const Args& a, unsigned char* lds, int layer) {
    int* tp = (int*)(lds + LDS_USER); unsigned char* gl = lds + LDS_USER + 256;
    moe_tiles(a, layer, tp);
    const int total = tp[32];
    const int* cnt = (const int*)(a.ws + WS_CNT2) + layer * 32 * CSTR;
    const int xq = blockIdx.x & 7, xr = xq >> 1, xc = xq & 1, nxw = (gridDim.x + 7 - xq) >> 3;
    int si = blockIdx.x >> 3, ecur = 0;
    auto next = [&](UMoe1& u) -> bool {
        const int rt = MOE1_MAP == 2 ? 8 * (si >> 3) + xq : (MOE1_MAP == 4 ? 2 * (si >> 1) + (xq >> 2) : 4 * (si >> 2) + xr), nt = MOE1_MAP == 2 ? (si & 7) : (MOE1_MAP == 4 ? (xq & 3) * 2 + (si & 1) : xc * 4 + (si & 3));
        if (rt >= total) return false;
        si += nxw;
        int e = ecur;
        while (tp[e + 1] <= rt) ++e;
        e = __builtin_amdgcn_readfirstlane(e); ecur = e;
        u.rt = rt; u.nt = nt; u.e = e; u.tile = rt - __builtin_amdgcn_readfirstlane(tp[e]); u.ce = __builtin_amdgcn_readfirstlane(cnt[e * CSTR]);
        return true;
    };
    const CMoe1 ctx{ a.ws, a.in[I_EBIN], layer };
    g8::gemm256_stream<true, UMoe1>(D, (unsigned)D, gl, ctx, next);
}
struct UMoe2 { int rt, nt, e; };
struct CMoe2 {
    const unsigned char* ws; const float* boutbase; int layer;
    __device__ __forceinline__ const bf16_t* A(const UMoe2& u) const { return (const bf16_t*)(ws + WS_ACT) + (size_t)u.rt * 256 * D; }
    __device__ __forceinline__ const bf16_t* B(const UMoe2& u) const { return (const bf16_t*)(ws + WS_EWOUTT) + ((size_t)layer * 32 + u.e) * D * D + (size_t)u.nt * 256 * D; }
    __device__ __forceinline__ int brow(const UMoe2& u) const { return u.rt * 256; }
    __device__ __forceinline__ int bcol(const UMoe2& u) const { return u.nt * 256; }
    __device__ __forceinline__ unsigned aoff(const UMoe2&, int) const { return 0u; }
    __device__ __forceinline__ void init(const UMoe2& u, f32x4 (&acc)[2][2][4][2], int col0) const {
        const float* bout = uniform_ptr(boutbase + ((size_t)layer * 32 + u.e) * D);
#pragma unroll
        for (int bj = 0; bj < 2; ++bj)
#pragma unroll
            for (int n = 0; n < 2; ++n) {
                const float4 bv = *(const float4*)(bout + col0 + bj * 128 + n * 16);
#pragma unroll
                for (int ai = 0; ai < 2; ++ai)
#pragma unroll
                    for (int m = 0; m < 4; ++m) acc[ai][bj][m][n] = (f32x4){ bv.x, bv.y, bv.z, bv.w };
            }
    }
    __device__ __forceinline__ void epi(const UMoe2&, const f32x4 (&acc)[2][2][4][2], int row0, int col0) const {
        bf16_t* YB = uniform_ptr((bf16_t*)(ws + WS_YB));
#pragma unroll
        for (int ai = 0; ai < 2; ++ai)
#pragma unroll
            for (int m = 0; m < 4; ++m)
#pragma unroll
                for (int bj = 0; bj < 2; ++bj)
#pragma unroll
                    for (int n = 0; n < 2; ++n) {
                        const f32x4 v = acc[ai][bj][m][n];
                        u32x2 w = { cvt_pk_bf16(v[0], v[1]), cvt_pk_bf16(v[2], v[3]) };
                        *(u32x2*)(YB + (size_t)(row0 + ai * 128 + m * 16) * D + col0 + bj * 128 + n * 16) = w;
                    }
    }
};
__device__ __forceinline__ void phase_moe2(const Args& a, unsigned char* lds, int layer) {
    int* tp = (int*)(lds + LDS_USER); unsigned char* gl = lds + LDS_USER + 256;
    moe_tiles(a, layer, tp);
    const int total = tp[32];
    const int xq = blockIdx.x & 7, nxw = (gridDim.x + 7 - xq) >> 3;
    int si = blockIdx.x >> 3, ecur = 0;
    auto next = [&](UMoe2& u) -> bool {
        const int rt = 8 * (si >> 2) + xq, nt = si & 3;
        if (rt >= total) return false;
        si += nxw;
        int e = ecur;
        while (tp[e + 1] <= rt) ++e;
        e = __builtin_amdgcn_readfirstlane(e); ecur = e;
        u.rt = rt; u.nt = nt; u.e = e;
        return true;
    };
    const CMoe2 ctx{ a.ws, a.in[I_EBOUT], layer };
    g8::gemm256_stream<false, UMoe2>(D, (unsigned)D, gl, ctx, next);
}
namespace wk2 {
constexpr int AST = 144;
constexpr int SST = 80;
constexpr int OFF_AAT = 0, OFF_RT = 16 * AST, OFF_MT = 2 * 16 * AST, OFF_TT = OFF_MT + 16 * SST, OFF_PQ = OFF_TT + 16 * SST, OFF_BK = OFF_PQ + 16 * SST,
              OFF_WC = OFF_BK + 64 * SST, SETB = OFF_WC + 256, NSET = 8, NCHK = RPB / 16;
static_assert(SETB == (int)WKSET_B && SETB % 16 == 0, "image size");
constexpr int PW_AAT = 0, PW_RT = 16 * AST, PW_BT = 2 * 16 * AST, PW_KT = 3 * 16 * AST, PW_TT = 4 * 16 * AST, PW_N = PW_TT + 16 * SST, PWB = PW_N + 1024;
static_assert(LDS_USER + 8 * PWB <= LDS_BYTES && LDS_USER + 256 + NSET * SETB <= LDS_BYTES, "LDS budget");
constexpr int SLOTB = SETB;
constexpr int G_AAT = 0, G_RT = 2048, G_PQ = 4096, G_BK = 5120, G_MT = 9216, G_TT = 9728, G_WC = 10240, GSETB = 10496;
static_assert(GSETB <= SETB && GSETB % 128 == 0, "compact image");
typedef volatile LAS int* vflag;
}
__device__ __forceinline__ void phase_wkv_prep(const Args& a, unsigned char* lds, int j, int c_lo, int c_hi, int blk_lo, int nblk) {
    using namespace wk2;
    const int tid = otid(), lane = tid & 63, wid = tid >> 6;
    LAS unsigned char* scr = (LAS unsigned char*)(lds + LDS_USER) + wid * PWB;
    const bf16_t* R = (const bf16_t*)(a.ws + RW_R); const bf16_t* K = (const bf16_t*)(a.ws + RW_K);
    const int kc = lane >> 4, kg = (lane >> 2) & 3, kr = lane & 3, kq = kc >> 1, kj = (kc & 1) * 4 + kr;
    const int ti = lane & 15, g = lane >> 4;
    const int nch = c_hi - c_lo, nunits = 64 * nch, wstride = nblk * 8;
    unsigned qr[16], qk[16], qw[16], qa[16];
    auto issue = [&](int u) {
        const int chain = u / nch, c = c_lo + (u - chain * nch), b = chain >> 5, h = (chain >> 1) & 15, d = chain & 1;
        const bf16_t* WD = (const bf16_t*)(a.ws + (d == 0 ? RW_WD0 : RW_WD1)); const bf16_t* AD = (const bf16_t*)(a.ws + (d == 0 ? RW_AD0 : RW_AD1));
        const int t0 = c * 16, p0 = (d == 0) ? t0 : ((t0 < CTX) ? (CTX - 1 - t0) : (RPB + CTX - 1 - t0));
        const long rstep = (d == 0) ? (long)D : -(long)D;
        const size_t o0 = ((size_t)b * RPB + p0) * D + h * 64 + lane;
#pragma unroll
        for (int t = 0; t < 16; ++t) { const size_t o = o0 + t * rstep; qr[t] = R[o]; qk[t] = K[o]; qw[t] = WD[o]; qa[t] = AD[o]; }
    };
    int u = ((int)blockIdx.x - blk_lo) * 8 + wid;
    if (u < 0) u = nunits;
    if (u < nunits) issue(u);
    for (; u < nunits; u += wstride) {
        const int chain = u / nch, c = c_lo + (u - chain * nch), h = (chain >> 1) & 15;
        unsigned char* gset = a.ws + RW_SETS + ((size_t)chain * NCHK + c) * GSETB;
        const float kkw = a.in[I_RKK][j * D + h * 64 + lane], kaw = a.in[I_RKA][j * D + h * 64 + lane];
        float fr[16], fk[16], fw[16], fa[16];
#pragma unroll
        for (int t = 0; t < 16; ++t) { fr[t] = __uint_as_float(qr[t] << 16); fk[t] = __uint_as_float(qk[t] << 16); fw[t] = __expf(-__uint_as_float(qw[t] << 16)); fa[t] = __uint_as_float(qa[t] << 16); }
        float kkv[16], n2[16];
#pragma unroll
        for (int t = 0; t < 16; ++t) { kkv[t] = fk[t] * kkw; n2[t] = row16_sum(kkv[t] * kkv[t]); }
#pragma unroll
        for (int t = 0; t < 16; ++t) n2[t] += __shfl_xor(n2[t], 16);
#pragma unroll
        for (int t = 0; t < 16; ++t) n2[t] += __shfl_xor(n2[t], 32);
        float Wc = 1.f;
        unsigned bkp[16];
#pragma unroll
        for (int t = 0; t < 16; ++t) {
            const float kk = kkv[t] * rsqrtf(fmaxf(n2[t], 1e-24f));
            const float Wp = Wc; Wc *= fw[t];
            const float iw = __builtin_amdgcn_rcpf(Wc);
            const unsigned ab = cvt_pk_bf16(-kk * Wp, fr[t] * Wc);
            const unsigned bk = cvt_pk_bf16(kk * fa[t] * iw, fk[t] * (1.f + (fa[t] - 1.f) * kaw) * iw);
            bkp[t] = bk;
            const int o1 = t * AST + (((kq * 4 + kg) * 8 + kj) * 2);
            *(LAS bf16_t*)(scr + PW_AAT + o1) = (bf16_t)(ab & 0xffffu); *(LAS bf16_t*)(scr + PW_RT + o1) = (bf16_t)(ab >> 16);
            *(LAS bf16_t*)(scr + PW_BT + o1) = (bf16_t)(bk & 0xffffu);  *(LAS bf16_t*)(scr + PW_KT + o1) = (bf16_t)(bk >> 16);
        }
#pragma unroll
        for (int gg = 0; gg < 4; ++gg) {
            const unsigned b0 = bkp[4 * gg], b1 = bkp[4 * gg + 1], b2 = bkp[4 * gg + 2], b3 = bkp[4 * gg + 3];
            *(u32x4*)(gset + G_BK + lane * 64 + gg * 16) = (u32x4){ (b0 & 0xffffu) | (b1 << 16), (b2 & 0xffffu) | (b3 << 16), (b0 >> 16) | (b1 & 0xffff0000u), (b2 >> 16) | (b3 & 0xffff0000u) };
        }
        *(float*)(gset + G_WC + ((kg * 4 + kc) * 4 + kr) * 4) = Wc;
        if (u + wstride < nunits) issue(u + wstride);
        asm volatile("s_waitcnt lgkmcnt(0)" ::: "memory");
        f32x4 cN = {0.f, 0.f, 0.f, 0.f}, cM = cN, cP = cN, cQ = cN;
#pragma unroll
        for (int q = 0; q < 2; ++q) {
            const int oo = ti * AST + (q * 4 + g) * 16;
            const bf16x8 fa8 = *(const LAS bf16x8*)(scr + PW_AAT + oo), fr8 = *(const LAS bf16x8*)(scr + PW_RT + oo);
            const bf16x8 fb8 = *(const LAS bf16x8*)(scr + PW_BT + oo), fk8 = *(const LAS bf16x8*)(scr + PW_KT + oo);
            cN = __builtin_amdgcn_mfma_f32_16x16x32_bf16(fb8, fa8, cN, 0, 0, 0); cM = __builtin_amdgcn_mfma_f32_16x16x32_bf16(fk8, fa8, cM, 0, 0, 0);
            cP = __builtin_amdgcn_mfma_f32_16x16x32_bf16(fb8, fr8, cP, 0, 0, 0); cQ = __builtin_amdgcn_mfma_f32_16x16x32_bf16(fk8, fr8, cQ, 0, 0, 0);
        }
#pragma unroll
        for (int rr = 0; rr < 4; ++rr) { const int s = 4 * g + rr; if (!(s < ti)) { cN[rr] = 0.f; cM[rr] = 0.f; } if (!(s <= ti)) { cP[rr] = 0.f; cQ[rr] = 0.f; } }
#pragma unroll
        for (int rr = 0; rr < 4; ++rr) *(LAS float*)(scr + PW_N + ((4 * g + rr) * 16 + ti) * 4) = cN[rr];
        *(u32x2*)(gset + G_MT + ti * 32 + g * 8) = (u32x2){ cvt_pk_bf16(cM[0], cM[1]), cvt_pk_bf16(cM[2], cM[3]) };
        *(u32x4*)(gset + G_PQ + ti * 64 + g * 16) = (u32x4){ cvt_pk_bf16(cP[0], cP[1]), cvt_pk_bf16(cP[2], cP[3]), cvt_pk_bf16(cQ[0], cQ[1]), cvt_pk_bf16(cQ[2], cQ[3]) };
#pragma unroll
        for (int i = 0; i < 4; ++i) { const int idx = lane + i * 64, r = (idx & 127) >> 3, jj = idx & 7; *(u32x4*)(gset + G_AAT + idx * 16) = *(const LAS u32x4*)(scr + (i < 2 ? PW_AAT : PW_RT) + r * AST + jj * 16); }
        asm volatile("s_waitcnt lgkmcnt(0)" ::: "memory");
        if (lane < 16) {
            float Tr[16];
#pragma unroll
            for (int t = 0; t < 16; ++t) Tr[t] = (lane == t) ? 1.f : 0.f;
#pragma unroll
            for (int s = 0; s < 15; ++s) {
                const LAS float* nr = (const LAS float*)(scr + PW_N + s * 64);
                const float ts = Tr[s];
#pragma unroll
                for (int t = s + 1; t < 16; ++t) Tr[t] += ts * nr[t];
            }
            const int ig = lane >> 2, ij = lane & 3;
#pragma unroll
            for (int s = 0; s < 16; ++s) {
                const bf16_t tv = (bf16_t)(cvt_pk_bf16(Tr[s], 0.f) & 0xffffu);
                *(LAS bf16_t*)(scr + PW_TT + s * SST + ((ig * 8 + ij) * 2)) = tv; *(LAS bf16_t*)(scr + PW_TT + s * SST + ((ig * 8 + 4 + ij) * 2)) = tv;
            }
        }
        asm volatile("s_waitcnt lgkmcnt(0)" ::: "memory");
        if (lane < 32) {
            const int s = lane >> 1, hh = lane & 1;
            const u32x2 t0 = *(const LAS u32x2*)(scr + PW_TT + s * SST + (2 * hh) * 16), t1 = *(const LAS u32x2*)(scr + PW_TT + s * SST + (2 * hh + 1) * 16);
            *(u32x4*)(gset + G_TT + lane * 16) = (u32x4){ t0[0], t0[1], t1[0], t1[1] };
        }
        asm volatile("s_waitcnt lgkmcnt(0)" ::: "memory");
    }
}
constexpr int WK_NSEG = WKNSEG, WK_SEGC = wk2::NCHK / WK_NSEG;
static_assert(WK_SEGC * WK_NSEG == wk2::NCHK, "segments");
__device__ __forceinline__ void phase_wkv_pipe(const Args& a, unsigned char* lds, int j, const XcdBarrier& bar) {
    using namespace wk2;
    const int tid = otid(), lane = tid & 63, wid = tid >> 6;
    LAS unsigned char* base = (LAS unsigned char*)(lds + LDS_USER);
    vflag ready = (vflag)base, done = (vflag)(base + 64);
    const bf16_t* V = (const bf16_t*)(a.ws + (j == 0 ? WS_VFIRST : RW_V));
    const int nprep = (int)gridDim.x - 64;
#if WKV_SERIAL
    for (int r = 0; r < REP_WKVP; ++r) phase_wkv_prep(a, lds, j, 0, NCHK, 0, gridDim.x);
#else
    phase_wkv_prep(a, lds, j, 0, WK_SEGC, 0, gridDim.x);
#endif
    xcd_barrier(bar);
    const int chain = blockIdx.x; const bool scanner = chain < 64;
    if (!scanner) {
#pragma unroll 1
        for (int seg = 0; seg < WK_NSEG; ++seg) {
#if !WKV_SERIAL
            for (int r = 0; r < REP_WKVP; ++r) if (seg + 1 < WK_NSEG) phase_wkv_prep(a, lds, j, (seg + 1) * WK_SEGC, (seg + 2) * WK_SEGC, 64, nprep);
#endif
            deferred_transposes(a, lds, j == 0 ? NJ_PRO : NJ_PRO + 4, j == 0 ? NJ_PRO + 4 : NJOBS, seg, WK_NSEG, 64, nprep);
            xcd_barrier<8>(bar);
        }
        return;
    }
    const int b = (chain >> 5) & 1, h = (chain >> 1) & 15, d = chain & 1, ch0 = h * 64;
    float* Y = (float*)(a.ws + (d == 0 ? RW_Y0 : RW_Y1));
    const int v = lane & 15, g = lane >> 4;
    auto chunk_p0 = [&](int c) -> int { const int t0 = c * 16; return (d == 0) ? t0 : ((t0 < CTX) ? (CTX - 1 - t0) : (RPB + CTX - 1 - t0)); };
    const int dir = (d == 0) ? 1 : -1;
    const unsigned char* Vb = (const unsigned char*)uniform_ptr(V + (size_t)b * RPB * D); unsigned char* Yb = (unsigned char*)uniform_ptr(Y + (size_t)b * RPB * D);
    int loff[4];
#pragma unroll
    for (int i = 0; i < 4; ++i) loff[i] = (4 * g + i) * dir * D + ch0 + (wid & 3) * 16 + v;
    if (tid < 16) ready[tid] = -1;
    if (tid >= 16 && tid < 20) done[tid - 16] = -1;
    __syncthreads();
    if (wid >= 4) {
#pragma unroll 1
        for (int seg = 0; seg < WK_NSEG; ++seg) {
            const int c_lo = seg * WK_SEGC, c_hi = c_lo + WK_SEGC;
            {
                const int sw = wid - 4;
                const unsigned char* gs = a.ws + RW_SETS + (size_t)chain * NCHK * GSETB;
                u32x4 preA[11], preB[11], preC[11];
                auto issueA = [&](int c) { const unsigned char* p = gs + (size_t)c * GSETB;
#pragma unroll
                    for (int i = 0; i < 11; ++i) { const int idx = lane + i * 64; if (idx < GSETB / 16) preA[i] = *(const u32x4*)(p + idx * 16); } };
                auto issueB = [&](int c) { const unsigned char* p = gs + (size_t)c * GSETB;
#pragma unroll
                    for (int i = 0; i < 11; ++i) { const int idx = lane + i * 64; if (idx < GSETB / 16) preB[i] = *(const u32x4*)(p + idx * 16); } };
                auto issueC = [&](int c) { const unsigned char* p = gs + (size_t)c * GSETB;
#pragma unroll
                    for (int i = 0; i < 11; ++i) { const int idx = lane + i * 64; if (idx < GSETB / 16) preC[i] = *(const u32x4*)(p + idx * 16); } };
                auto scatter = [&](LAS unsigned char* set, const u32x4 (&pre)[11]) {
#pragma unroll
                    for (int i = 0; i < 4; ++i) { const int r = ((lane + i * 64) & 127) >> 3, jj = lane & 7; *(LAS u32x4*)(set + (i < 2 ? OFF_AAT : OFF_RT) + r * AST + jj * 16) = pre[i]; }
                    *(LAS u32x4*)(set + OFF_PQ + (lane >> 2) * SST + (lane & 3) * 16) = pre[4];
#pragma unroll
                    for (int i = 5; i < 9; ++i) { const int k = lane + (i - 5) * 64; *(LAS u32x4*)(set + OFF_BK + (k >> 2) * SST + (k & 3) * 16) = pre[i]; }
                    {
                        const int kk = lane & 31, r = kk >> 1, hh = kk & 1;
                        LAS unsigned char* d = set + (lane < 32 ? OFF_MT : OFF_TT) + r * SST + (2 * hh) * 16;
                        *(LAS u32x4*)d = (u32x4){ pre[9][0], pre[9][1], 0u, 0u }; *(LAS u32x4*)(d + 16) = (u32x4){ pre[9][2], pre[9][3], 0u, 0u };
                    }
                    if (lane < 16) *(LAS u32x4*)(set + OFF_WC + lane * 16) = pre[10];
                };
                auto waitslot = [&](int c) { while (min(min(done[0], done[1]), min(done[2], done[3])) < c - NSET) __builtin_amdgcn_s_sleep(8); };
                if (c_lo + sw < c_hi) issueA(c_lo + sw);
                if (c_lo + sw + 4 < c_hi) issueB(c_lo + sw + 4);
                if (c_lo + sw + 8 < c_hi) issueC(c_lo + sw + 8);
                for (int c = c_lo + sw; c < c_hi; c += 12) {
                    {
                        LAS unsigned char* set = base + 256 + (c % NSET) * SLOTB;
                        waitslot(c);
                        scatter(set, preA);
                        if (c + 12 < c_hi) issueA(c + 12);
                        asm volatile("s_waitcnt lgkmcnt(0)" ::: "memory");
                        if (lane == 0) ready[c % NSET] = c;
                    }
                    if (c + 4 < c_hi) {
                        const int c2 = c + 4;
                        LAS unsigned char* set = base + 256 + (c2 % NSET) * SLOTB;
                        waitslot(c2);
                        scatter(set, preB);
                        if (c2 + 12 < c_hi) issueB(c2 + 12);
                        asm volatile("s_waitcnt lgkmcnt(0)" ::: "memory");
                        if (lane == 0) ready[c2 % NSET] = c2;
                    }
                    if (c + 8 < c_hi) {
                        const int c3 = c + 8;
                        LAS unsigned char* set = base + 256 + (c3 % NSET) * SLOTB;
                        waitslot(c3);
                        scatter(set, preC);
                        if (c3 + 12 < c_hi) issueC(c3 + 12);
                        asm volatile("s_waitcnt lgkmcnt(0)" ::: "memory");
                        if (lane == 0) ready[c3 % NSET] = c3;
                    }
                }
            }
            xcd_barrier(bar);
        }
    } else {
    f32x4 St[4];
#pragma unroll
    for (int c4 = 0; c4 < 4; ++c4) St[c4] = (f32x4){0.f, 0.f, 0.f, 0.f};
    bf16x8 Bhi[2];
#pragma unroll
    for (int q = 0; q < 2; ++q) Bhi[q] = (bf16x8){0, 0, 0, 0, 0, 0, 0, 0};
#pragma unroll 1
        for (int seg = 0; seg < WK_NSEG; ++seg) {
            const int c_lo = seg * WK_SEGC, c_hi = c_lo + WK_SEGC;
            {
                constexpr int VPD = 4;
                unsigned vq[VPD][4];
#pragma unroll
                for (int k = 0; k < VPD; ++k) if (c_lo + k < c_hi) { const int p0 = __builtin_amdgcn_readfirstlane(chunk_p0(c_lo + k));
#pragma unroll
                  for (int i = 0; i < 4; ++i) vq[k][i] = *(const bf16_t*)(Vb + (unsigned)((p0 * D + loff[i]) * 2)); }
                bf16x8 oA[2][2], oR[2][2], oM[2], oT[2], oPQ[2], oBK[2][4]; f32x4 oW[2][4];
                auto load_ops = [&](int c, bf16x8 (&xA)[2], bf16x8 (&xR)[2], bf16x8& xM, bf16x8& xT, bf16x8& xPQ, bf16x8 (&xBK)[4], f32x4 (&xW)[4]) {
                    const LAS unsigned char* set = base + 256 + (c % NSET) * SLOTB;
#pragma unroll
                    for (int q = 0; q < 2; ++q) { xA[q] = *(const LAS bf16x8*)(set + OFF_AAT + v * AST + (q * 4 + g) * 16); xR[q] = *(const LAS bf16x8*)(set + OFF_RT + v * AST + (q * 4 + g) * 16); }
                    xM = *(const LAS bf16x8*)(set + OFF_MT + v * SST + g * 16); xT = *(const LAS bf16x8*)(set + OFF_TT + v * SST + g * 16); xPQ = *(const LAS bf16x8*)(set + OFF_PQ + v * SST + g * 16);
#pragma unroll
                    for (int c4 = 0; c4 < 4; ++c4) { xBK[c4] = *(const LAS bf16x8*)(set + OFF_BK + (c4 * 16 + v) * SST + g * 16); xW[c4] = *(const LAS f32x4*)(set + OFF_WC + ((g * 4 + c4) * 4) * 4); }
                };
                while (ready[c_lo % NSET] != c_lo) __builtin_amdgcn_s_sleep(1);
                asm volatile("" ::: "memory");
                load_ops(c_lo, oA[0], oR[0], oM[0], oT[0], oPQ[0], oBK[0], oW[0]);
                for (int cb = c_lo; cb < c_hi; cb += VPD) {
#pragma unroll
                  for (int kk = 0; kk < VPD; ++kk) {
                    const int c = cb + kk;
                    constexpr int dummy = 0; (void)dummy;
                    const int P = kk & 1, Q = P ^ 1;
                    if (c >= c_hi) break;
                    const u32x2 vmw = { vq[kk][0] | (vq[kk][1] << 16), vq[kk][2] | (vq[kk][3] << 16) };
                    if (c + VPD < c_hi) { const int p1 = __builtin_amdgcn_readfirstlane(chunk_p0(c + VPD));
#pragma unroll
                        for (int i = 0; i < 4; ++i) vq[kk][i] = *(const bf16_t*)(Vb + (unsigned)((p1 * D + loff[i]) * 2)); }
                    asm volatile("s_waitcnt lgkmcnt(0)" ::: "memory");
                    if (lane == 0) done[wid] = c;
                    if (c + 1 < c_hi) {
                        while (ready[(c + 1) % NSET] != c + 1) __builtin_amdgcn_s_sleep(1);
                        asm volatile("" ::: "memory");
                        load_ops(c + 1, oA[Q], oR[Q], oM[Q], oT[Q], oPQ[Q], oBK[Q], oW[Q]);
                    }
                    const f32x4 z4 = {0.f, 0.f, 0.f, 0.f};
                    const bf16x8 bv = __builtin_bit_cast(bf16x8, ((u32x4){ vmw[0], vmw[1], 0u, 0u }));
                    f32x4 a1 = __builtin_amdgcn_mfma_f32_16x16x32_bf16(oA[P][0], Bhi[0], z4, 0, 0, 0);
                    f32x4 a1m = __builtin_amdgcn_mfma_f32_16x16x32_bf16(oM[P], bv, z4, 0, 0, 0);
                    a1 = __builtin_amdgcn_mfma_f32_16x16x32_bf16(oA[P][1], Bhi[1], a1, 0, 0, 0);
                    f32x4 a2 = __builtin_amdgcn_mfma_f32_16x16x32_bf16(oR[P][0], Bhi[0], z4, 0, 0, 0);
                    a2 = __builtin_amdgcn_mfma_f32_16x16x32_bf16(oR[P][1], Bhi[1], a2, 0, 0, 0);
                    a1 = a1 + a1m;
                    const bf16x8 b3 = __builtin_bit_cast(bf16x8, ((u32x4){ cvt_pk_bf16(a1[0], a1[1]), cvt_pk_bf16(a1[2], a1[3]), 0u, 0u }));
                    const f32x4 a3 = __builtin_amdgcn_mfma_f32_16x16x32_bf16(oT[P], b3, z4, 0, 0, 0);
                    const bf16x8 b45 = __builtin_bit_cast(bf16x8, ((u32x4){ cvt_pk_bf16(a3[0], a3[1]), cvt_pk_bf16(a3[2], a3[3]), vmw[0], vmw[1] }));
#pragma unroll
                    for (int c4 = 0; c4 < 4; ++c4) St[c4] = __builtin_amdgcn_mfma_f32_16x16x32_bf16(oBK[P][c4], b45, St[c4], 0, 0, 0);
                    a2 = __builtin_amdgcn_mfma_f32_16x16x32_bf16(oPQ[P], b45, a2, 0, 0, 0);
#pragma unroll
                    for (int c4 = 0; c4 < 4; ++c4) St[c4] = St[c4] * oW[P][c4];
#pragma unroll
                    for (int q = 0; q < 2; ++q)
                        Bhi[q] = __builtin_bit_cast(bf16x8, ((u32x4){ cvt_pk_bf16(St[2 * q][0], St[2 * q][1]), cvt_pk_bf16(St[2 * q][2], St[2 * q][3]), cvt_pk_bf16(St[2 * q + 1][0], St[2 * q + 1][1]), cvt_pk_bf16(St[2 * q + 1][2], St[2 * q + 1][3]) }));
                    {
                        const int p0 = __builtin_amdgcn_readfirstlane(chunk_p0(c));
#pragma unroll
                        for (int rr = 0; rr < 4; ++rr) *(float*)(Yb + (unsigned)((p0 * D + loff[rr]) * 4)) = a2[rr];
                    }
                  }
                }
            }
            xcd_barrier(bar);
        }
    }
}
__device__ __forceinline__ void phase_wkv2(const Args& a, unsigned char* lds, int j) { }
constexpr size_t HY_UU   = WS_MIX;
constexpr size_t HY_X0   = HY_UU + (size_t)T * 3072 * 2;
constexpr size_t HY_X0ZB = HY_X0 + (size_t)T * D * 2;
constexpr size_t HY_P    = HY_X0ZB + (size_t)T * D * 2;
constexpr size_t HY_ZT   = HY_P + (size_t)T * D * 2;
constexpr size_t HY_ZC   = HY_ZT + (size_t)D * 2 * SEQ * 4;
constexpr size_t HY_HF   = HY_ZC + (size_t)2 * CTX * D * 4;
constexpr size_t HY_HB   = HY_HF + (size_t)D * SEQ * 4;
constexpr size_t HY_HFC  = HY_HB + (size_t)D * SEQ * 4;
constexpr size_t HY_HBC  = HY_HFC + (size_t)CTX * D * 4;
constexpr size_t HY_FS   = HY_HBC + (size_t)CTX * D * 4;
constexpr size_t HY_U    = HY_FS + (size_t)2 * D * SEQ * 8;
constexpr size_t HY_END  = HY_U + (size_t)2 * D * 2 * SEQ * 4;
constexpr int FFT_N = 16384;

__device__ __forceinline__ float2 cmul(float2 a, float2 b) { return make_float2(a.x * b.x - a.y * b.y, a.x * b.y + a.y * b.x); }
__device__ __forceinline__ float2 cmulc(float2 a, float2 b) { return make_float2(a.x * b.x + a.y * b.y, a.y * b.x - a.x * b.y); }

__device__ __forceinline__ float2 tw_get(const float2* twl, int e) { return cmul(twl[e & 127], twl[128 + (e >> 7)]); }
__device__ __forceinline__ void fft_fwd(float2* x, const float2* tw) {
    const int tid = otid();
#pragma unroll 1
    for (int lq = 12; lq >= 0; lq -= 2) {
        const int q = 1 << lq, tws = FFT_N >> (lq + 2);
#pragma unroll 4
        for (int i = 0; i < 8; ++i) {
            const int u = tid + i * 512, j = u & (q - 1), B = (u >> lq) << (lq + 2);
            float2* p = x + B + j;
            const float2 a0 = p[0], a1 = p[q], a2 = p[2 * q], a3 = p[3 * q];
            const float2 t0 = make_float2(a0.x + a2.x, a0.y + a2.y), t1 = make_float2(a0.x - a2.x, a0.y - a2.y);
            const float2 t2 = make_float2(a1.x + a3.x, a1.y + a3.y);
            const float2 d = make_float2(a1.x - a3.x, a1.y - a3.y), t3 = make_float2(d.y, -d.x);
            const float2 y0 = make_float2(t0.x + t2.x, t0.y + t2.y), y1 = make_float2(t1.x + t3.x, t1.y + t3.y);
            const float2 y2 = make_float2(t0.x - t2.x, t0.y - t2.y), y3 = make_float2(t1.x - t3.x, t1.y - t3.y);
            if (q > 1) {
                const float2 w1 = tw_get(tw, j * tws), w2 = cmul(w1, w1), w3 = cmul(w2, w1);
                p[0] = y0; p[q] = cmul(y1, w1); p[2 * q] = cmul(y2, w2); p[3 * q] = cmul(y3, w3);
            } else { p[0] = y0; p[1] = y1; p[2] = y2; p[3] = y3; }
        }
        __syncthreads();
    }
}
__device__ __forceinline__ void fft_inv(float2* x, const float2* tw) {
    const int tid = otid();
#pragma unroll 1
    for (int lq = 0; lq <= 12; lq += 2) {
        const int q = 1 << lq, tws = FFT_N >> (lq + 2);
#pragma unroll 4
        for (int i = 0; i < 8; ++i) {
            const int u = tid + i * 512, j = u & (q - 1), B = (u >> lq) << (lq + 2);
            float2* p = x + B + j;
            float2 b0 = p[0], b1 = p[q], b2 = p[2 * q], b3 = p[3 * q];
            if (q > 1) { const float2 w1 = tw_get(tw, j * tws), w2 = cmul(w1, w1), w3 = cmul(w2, w1); b1 = cmulc(b1, w1); b2 = cmulc(b2, w2); b3 = cmulc(b3, w3); }
            const float2 t0 = make_float2(b0.x + b2.x, b0.y + b2.y), t1 = make_float2(b0.x - b2.x, b0.y - b2.y);
            const float2 t2 = make_float2(b1.x + b3.x, b1.y + b3.y);
            const float2 d = make_float2(b1.x - b3.x, b1.y - b3.y), t3 = make_float2(-d.y, d.x);
            p[0] = make_float2(t0.x + t2.x, t0.y + t2.y); p[q] = make_float2(t1.x + t3.x, t1.y + t3.y);
            p[2 * q] = make_float2(t0.x - t2.x, t0.y - t2.y); p[3 * q] = make_float2(t1.x - t3.x, t1.y - t3.y);
        }
        __syncthreads();
    }
}

__device__ __forceinline__ void phase_hy_filters(const Args& a, unsigned char* lds) {
    const int tid = otid();
    float* zemb = (float*)(lds + LDS_USER);
    float* hA = zemb + 64 * 36;
    float* hB = hA + 64 * 68;
    const float* w1 = a.in[I_HFW1]; const float* b1 = a.in[I_HFB1]; const float* w2 = a.in[I_HFW2]; const float* b2 = a.in[I_HFB2];
    const float* w3 = a.in[I_HFW3]; const float* b3 = a.in[I_HFB3]; const float* fr = a.in[I_HFREQ]; const float* wo = a.in[I_HFWOUT];
    for (int u = blockIdx.x; u < 260; u += gridDim.x) {
        const bool isctx = u >= 256;
        const int Lh = isctx ? CTX : SEQ, n0 = (isctx ? (u - 256) : u) * 64;
        for (int it = tid; it < 64 * 33; it += NT) {
            const int p = it / 33, e = it - p * 33, n = n0 + p;
            float v;
            if (e == 0) v = (float)n / (float)(Lh - 1);
            else {
                const int bi = (e - 1) & 15;
                const float f = 1e-4f + (float)bi * ((15.0f - 1e-4f) / 15.0f);
                const float ang = 2.0f * 3.14159265358979323846f * f * (float)n / (float)Lh;
                v = (e <= 16) ? cos_acc(ang) : -sin_acc(ang);
            }
            zemb[p * 36 + e] = v;
        }
        __syncthreads();
        {
            const int p = tid & 63, h0 = (tid >> 6) * 8;
            float acc[8];
#pragma unroll
            for (int i = 0; i < 8; ++i) acc[i] = b1[h0 + i];
#pragma unroll 1
            for (int k = 0; k < 33; ++k) { const float zv = zemb[p * 36 + k];
#pragma unroll
                for (int i = 0; i < 8; ++i) acc[i] += zv * w1[k * 64 + h0 + i]; }
#pragma unroll
            for (int i = 0; i < 8; ++i) hA[p * 68 + h0 + i] = sin_acc(fr[h0 + i] * acc[i]);
            __syncthreads();
#pragma unroll
            for (int i = 0; i < 8; ++i) acc[i] = b2[h0 + i];
#pragma unroll 2
            for (int k = 0; k < 64; ++k) { const float hv = hA[p * 68 + k];
#pragma unroll
                for (int i = 0; i < 8; ++i) acc[i] += hv * w2[k * 64 + h0 + i]; }
#pragma unroll
            for (int i = 0; i < 8; ++i) hB[p * 68 + h0 + i] = sin_acc(fr[64 + h0 + i] * acc[i]);
            __syncthreads();
#pragma unroll
            for (int i = 0; i < 8; ++i) acc[i] = b3[h0 + i];
#pragma unroll 2
            for (int k = 0; k < 64; ++k) { const float hv = hB[p * 68 + k];
#pragma unroll
                for (int i = 0; i < 8; ++i) acc[i] += hv * w3[k * 64 + h0 + i]; }
            __syncthreads();
#pragma unroll
            for (int i = 0; i < 8; ++i) hA[p * 68 + h0 + i] = sin_acc(fr[128 + h0 + i] * acc[i]);
            __syncthreads();
        }
        {
            const int lane = tid & 63, wid = tid >> 6, fr = lane & 15, fq = lane >> 4;
            bf16x8 Ah[4][2], Al[4][2];
#pragma unroll
            for (int mb = 0; mb < 4; ++mb)
#pragma unroll
                for (int ks = 0; ks < 2; ++ks) {
                    const float* hp = hA + (mb * 16 + fr) * 68 + ks * 32 + fq * 8;
                    const float4 x0 = *(const float4*)hp, x1 = *(const float4*)(hp + 4);
                    u32x4 h, l;
                    h[0] = cvt_pk_bf16(x0.x, x0.y); h[1] = cvt_pk_bf16(x0.z, x0.w); h[2] = cvt_pk_bf16(x1.x, x1.y); h[3] = cvt_pk_bf16(x1.z, x1.w);
                    l[0] = cvt_pk_bf16(x0.x - bf_lo(h[0]), x0.y - bf_hi(h[0])); l[1] = cvt_pk_bf16(x0.z - bf_lo(h[1]), x0.w - bf_hi(h[1]));
                    l[2] = cvt_pk_bf16(x1.x - bf_lo(h[2]), x1.y - bf_hi(h[2])); l[3] = cvt_pk_bf16(x1.z - bf_lo(h[3]), x1.w - bf_hi(h[3]));
                    Ah[mb][ks] = __builtin_bit_cast(bf16x8, h); Al[mb][ks] = __builtin_bit_cast(bf16x8, l);
                }
            const bf16_t* WH = (const bf16_t*)(a.ws + WS_HWOT); const bf16_t* WL = WH + 2048 * 64;
            bf16x8 Bh[2], Bl[2], Nh[2], Nl[2];
            auto ldB = [&](int nb, bf16x8 (&bh)[2], bf16x8 (&bl)[2]) {
                const size_t o = (size_t)(wid * 256 + nb * 16 + fr) * 64 + fq * 8;
#pragma unroll
                for (int ks = 0; ks < 2; ++ks) { bh[ks] = *(const bf16x8*)(WH + o + ks * 32); bl[ks] = *(const bf16x8*)(WL + o + ks * 32); }
            };
            ldB(0, Bh, Bl);
#pragma unroll 1
            for (int nb = 0; nb < 16; ++nb) {
                if (nb + 1 < 16) ldB(nb + 1, Nh, Nl);
                f32x4 acc[4];
#pragma unroll
                for (int mb = 0; mb < 4; ++mb) {
                    acc[mb] = (f32x4){0.f, 0.f, 0.f, 0.f};
#pragma unroll
                    for (int ks = 0; ks < 2; ++ks) {
                        acc[mb] = __builtin_amdgcn_mfma_f32_16x16x32_bf16(Ah[mb][ks], Bh[ks], acc[mb], 0, 0, 0);
                        acc[mb] = __builtin_amdgcn_mfma_f32_16x16x32_bf16(Al[mb][ks], Bh[ks], acc[mb], 0, 0, 0);
                        acc[mb] = __builtin_amdgcn_mfma_f32_16x16x32_bf16(Ah[mb][ks], Bl[ks], acc[mb], 0, 0, 0);
                    }
                }
                const int col = wid * 256 + nb * 16 + fr, ch = col & 1023;
                const float dl = fabsf(-15.350567286626973f + (float)ch * ((-3.0701134573253946f + 15.350567286626973f) / 1023.0f));
                if (!isctx) {
                    float* dst = (float*)(a.ws + (col < 1024 ? HY_HF : HY_HB)) + (size_t)ch * SEQ + n0;
#pragma unroll
                    for (int mb = 0; mb < 4; ++mb) {
                        float o[4];
#pragma unroll
                        for (int r = 0; r < 4; ++r) { const int n = n0 + mb * 16 + fq * 4 + r; o[r] = acc[mb][r] * __expf(-((float)n / (float)(SEQ - 1)) * dl); }
                        *(float4*)(dst + mb * 16 + fq * 4) = make_float4(o[0], o[1], o[2], o[3]);
                    }
                } else {
                    float* dst = (float*)(a.ws + (col < 1024 ? HY_HFC : HY_HBC));
#pragma unroll
                    for (int mb = 0; mb < 4; ++mb)
#pragma unroll
                        for (int r = 0; r < 4; ++r) { const int n = n0 + mb * 16 + fq * 4 + r; dst[(size_t)n * D + ch] = acc[mb][r] * __expf(-((float)n / (float)(CTX - 1)) * dl); }
                }
#pragma unroll
                for (int ks = 0; ks < 2; ++ks) { Bh[ks] = Nh[ks]; Bl[ks] = Nl[ks]; }
            }
        }
        __syncthreads();
    }
}
__device__ __forceinline__ void phase_hy_filter_fft(const Args& a, unsigned char* lds) {
    const int tid = otid();
    float2* x = (float2*)(lds + LDS_USER);
    const float2* tw1g = (const float2*)(a.ws + WS_TW1); const float2* tw2 = (const float2*)(a.ws + WS_TW2);
    float2* tw1 = x + FFT_N;
    if (tid < 128) tw1[tid] = tw1g[tid]; else if (tid < 160) tw1[tid] = tw1g[(tid - 128) * 128];
    __syncthreads();
    for (int u = blockIdx.x; u < 2048; u += gridDim.x) {
        const int c = u >> 1, par = u & 1;
        const float* hf = (const float*)(a.ws + HY_HF) + (size_t)c * SEQ; const float* hb = (const float*)(a.ws + HY_HB) + (size_t)c * SEQ;
#pragma unroll
        for (int it = 0; it < 8; ++it) {
            const int n = (tid + it * NT) * 4;
            const float4 f0 = *(const float4*)(hf + n);
            float f1[4];
            if (n == 0) { f1[0] = 0.f; f1[1] = hb[SEQ - 1]; f1[2] = hb[SEQ - 2]; f1[3] = hb[SEQ - 3]; }
            else { const float4 t = *(const float4*)(hb + SEQ - n - 4); const float s0 = hb[SEQ - n]; f1[0] = s0; f1[1] = t.w; f1[2] = t.z; f1[3] = t.y; }
            const float f0v[4] = { f0.x, f0.y, f0.z, f0.w };
            float2 o[4];
            if (par == 0) {
#pragma unroll
                for (int q = 0; q < 4; ++q) o[q] = make_float2(f0v[q] + f1[q], 0.f);
            } else {
                const float4 wa = *(const float4*)(tw2 + n), wb = *(const float4*)(tw2 + n + 2);
                const float wr[4] = { wa.x, wa.z, wb.x, wb.z }, wi[4] = { wa.y, wa.w, wb.y, wb.w };
#pragma unroll
                for (int q = 0; q < 4; ++q) { const float dd = f0v[q] - f1[q]; o[q] = make_float2(dd * wr[q], dd * wi[q]); }
            }
            *(float4*)(x + n) = make_float4(o[0].x, o[0].y, o[1].x, o[1].y); *(float4*)(x + n + 2) = make_float4(o[2].x, o[2].y, o[3].x, o[3].y);
        }
        __syncthreads();
        fft_fwd(x, tw1);
        float2* dst = (float2*)(a.ws + HY_FS) + ((size_t)par * D + c) * SEQ;
#pragma unroll
        for (int it = 0; it < 16; ++it) { const int n = (tid + it * NT) * 2; *(float4*)(dst + n) = *(const float4*)(x + n); }
        __syncthreads();
    }
}
__device__ __forceinline__ void phase_hy_in(const Args& a, unsigned char* lds) {
    unsigned char* gl = lds + LDS_USER;
    bf16_t* UU = (bf16_t*)(a.ws + HY_UU);
    const float* bin = a.in[I_HBIN];
    int u = blockIdx.x;
    const unsigned char* ws = a.ws;
    const int xq = blockIdx.x & 7, nxw = (gridDim.x + 7 - xq) >> 3;
    int si = blockIdx.x >> 3;
    auto next = [&](g8::UTile& t) -> bool {
        const int m4 = si / 6, mt = 4 * m4 + (xq >> 1);
        if (mt >= 130) return false;
        t.mt = mt; t.nt = (xq & 1) * 6 + (si - m4 * 6); t.g = 0; si += nxw;
        return true;
    };
    const auto ctx = g8::make_ctx(
        [=](const g8::UTile& t) { return (const bf16_t*)(ws + WS_H) + (size_t)t.mt * 256 * D; },
        [=](const g8::UTile& t) { return (const bf16_t*)(ws + WS_HYINT) + (size_t)t.nt * 256 * D; },
        [=](const g8::UTile&, f32x4 (&acc)[2][2][4][2], int col0) { g8::bias_acc(acc, bin, col0); },
        [=](const g8::UTile&, const f32x4 (&acc)[2][2][4][2], int row0, int col0) {
            g8::each_acc(acc, row0, col0, [=](int row, int col, const f32x4& v) {
                u32x2 w = { cvt_pk_bf16(v[0], v[1]), cvt_pk_bf16(v[2], v[3]) };
                *(u32x2*)(UU + (size_t)row * 3072 + col) = w;
            });
        });
    g8::gemm256_stream<false, g8::UTile>(D, (unsigned)D, gl, ctx, next);
}
__device__ __forceinline__ void phase_hy_short(const Args& a, unsigned char* lds) {
    const int tid = otid();
    float* zt = (float*)(lds + LDS_USER);
    const bf16_t* UU = (const bf16_t*)(a.ws + HY_UU);
    const float* sw = a.in[I_HSW]; const float* sb = a.in[I_HSB]; const float* bias = a.in[I_HBIAS];
    for (int u = blockIdx.x; u < 520 * 4; u += gridDim.x) {
        const int rb = u >> 2, cc = u & 3, row0 = rb * 64, b = row0 / RPB, within0 = row0 - b * RPB;
        const bool isctx = within0 < CTX;
        const int c4 = tid & 63, rg = tid >> 6, cl = c4 * 4, c = cc * 256 + cl;
        float wt[3][3][4], bs[3][4];
#pragma unroll
        for (int g = 0; g < 3; ++g) {
#pragma unroll
            for (int tp = 0; tp < 3; ++tp) { const float4 w = *(const float4*)(sw + (size_t)tp * 3072 + g * 1024 + c); wt[g][tp][0] = w.x; wt[g][tp][1] = w.y; wt[g][tp][2] = w.z; wt[g][tp][3] = w.w; }
            const float4 bb = *(const float4*)(sb + g * 1024 + c); bs[g][0] = bb.x; bs[g][1] = bb.y; bs[g][2] = bb.z; bs[g][3] = bb.w;
        }
        const float4 bi4 = *(const float4*)(bias + c); const float bi[4] = { bi4.x, bi4.y, bi4.z, bi4.w };
        auto ld = [&](int row, int g, float (&o)[4]) {
            const int w = row - b * RPB;
            const bool valid = isctx ? (w >= 0 && w < CTX) : (w >= CTX && w < RPB);
            if (valid) { const u32x2 v = *(const u32x2*)(UU + (size_t)row * 3072 + g * 1024 + c); o[0] = bf_lo(v[0]); o[1] = bf_hi(v[0]); o[2] = bf_lo(v[1]); o[3] = bf_hi(v[1]); }
            else { o[0] = o[1] = o[2] = o[3] = 0.f; }
        };
        float pv[3][4], cv[3][4], nv[3][4];
        const int r0 = row0 + rg * 8;
#pragma unroll
        for (int g = 0; g < 3; ++g) { ld(r0 - 1, g, pv[g]); ld(r0, g, cv[g]); }
#pragma unroll 1
        for (int i = 0; i < 8; ++i) {
            const int row = r0 + i;
#pragma unroll
            for (int g = 0; g < 3; ++g) ld(row + 1, g, nv[g]);
            float uo[3][4];
#pragma unroll
            for (int g = 0; g < 3; ++g)
#pragma unroll
                for (int q = 0; q < 4; ++q) uo[g][q] = pv[g][q] * wt[g][0][q] + cv[g][q] * wt[g][1][q] + nv[g][q] * wt[g][2][q] + bs[g][q];
            float z[4], xz[4];
#pragma unroll
            for (int q = 0; q < 4; ++q) { z[q] = uo[2][q] * uo[1][q]; xz[q] = uo[0][q] * z[q] * bi[q]; }
            u32x2 o0 = { cvt_pk_bf16(uo[0][0], uo[0][1]), cvt_pk_bf16(uo[0][2], uo[0][3]) }, o1 = { cvt_pk_bf16(xz[0], xz[1]), cvt_pk_bf16(xz[2], xz[3]) };
            *(u32x2*)((bf16_t*)(a.ws + HY_X0) + (size_t)row * D + c) = o0;
            *(u32x2*)((bf16_t*)(a.ws + HY_X0ZB) + (size_t)row * D + c) = o1;
            if (isctx) *(float4*)((float*)(a.ws + HY_ZC) + ((size_t)b * CTX + (within0 + rg * 8 + i)) * D + c) = make_float4(z[0], z[1], z[2], z[3]);
            else {
#pragma unroll
                for (int q = 0; q < 4; ++q) zt[(cl + q) * 65 + rg * 8 + i] = z[q];
            }
#pragma unroll
            for (int g = 0; g < 3; ++g)
#pragma unroll
                for (int q = 0; q < 4; ++q) { pv[g][q] = cv[g][q]; cv[g][q] = nv[g][q]; }
        }
        __syncthreads();
        if (!isctx) {
            const int t0 = within0 - CTX;
#pragma unroll
            for (int i = 0; i < 8; ++i) {
                const int idx = tid + i * 512, ch = idx >> 4, t4 = (idx & 15) * 4;
                const float* s = zt + ch * 65 + t4;
                *(float4*)((float*)(a.ws + HY_ZT) + ((size_t)(cc * 256 + ch) * 2 + b) * SEQ + t0 + t4) = make_float4(s[0], s[1], s[2], s[3]);
            }
        }
        __syncthreads();
    }
}
__device__ __forceinline__ void phase_hy_fftconv(const Args& a, unsigned char* lds) {
    const int tid = otid();
    float2* x = (float2*)(lds + LDS_USER);
    const float2* tw1g = (const float2*)(a.ws + WS_TW1); const float2* tw2 = (const float2*)(a.ws + WS_TW2);
    float2* tw1 = x + FFT_N;
    if (tid < 128) tw1[tid] = tw1g[tid]; else if (tid < 160) tw1[tid] = tw1g[(tid - 128) * 128];
    __syncthreads();
    float4 zin[8][2];
    auto ld_in = [&](int uu) {
        const int cc = uu >> 1;
        const float* q0 = (const float*)(a.ws + HY_ZT) + (size_t)cc * 2 * SEQ; const float* q1 = q0 + SEQ;
#pragma unroll
        for (int it = 0; it < 8; ++it) { const int n = (tid + it * NT) * 4; zin[it][0] = *(const float4*)(q0 + n); zin[it][1] = *(const float4*)(q1 + n); }
    };
    if (blockIdx.x < 2048) ld_in(blockIdx.x);
    for (int u = blockIdx.x; u < 2048; u += gridDim.x) {
        const int c = u >> 1, par = u & 1;
#pragma unroll
        for (int it = 0; it < 8; ++it) {
            const int n = (tid + it * NT) * 4;
            const float4 a0 = zin[it][0], a1 = zin[it][1];
            float2 v[4] = { make_float2(a0.x, a1.x), make_float2(a0.y, a1.y), make_float2(a0.z, a1.z), make_float2(a0.w, a1.w) };
            if (par) {
                const float4 wa = *(const float4*)(tw2 + n), wb = *(const float4*)(tw2 + n + 2);
                v[0] = cmul(v[0], make_float2(wa.x, wa.y)); v[1] = cmul(v[1], make_float2(wa.z, wa.w)); v[2] = cmul(v[2], make_float2(wb.x, wb.y)); v[3] = cmul(v[3], make_float2(wb.z, wb.w));
            }
            *(float4*)(x + n) = make_float4(v[0].x, v[0].y, v[1].x, v[1].y); *(float4*)(x + n + 2) = make_float4(v[2].x, v[2].y, v[3].x, v[3].y);
        }
        const float2* fs = (const float2*)(a.ws + HY_FS) + ((size_t)par * D + c) * SEQ;
        float4 fsp[16];
#pragma unroll
        for (int it = 0; it < 16; ++it) fsp[it] = *(const float4*)(fs + (tid + it * NT) * 2);
        __syncthreads();
        fft_fwd(x, tw1);
#pragma unroll
        for (int it = 0; it < 16; ++it) {
            const int n = (tid + it * NT) * 2;
            const float4 f = fsp[it], xv = *(const float4*)(x + n);
            const float2 r0 = cmul(make_float2(xv.x, xv.y), make_float2(f.x, f.y)), r1 = cmul(make_float2(xv.z, xv.w), make_float2(f.z, f.w));
            *(float4*)(x + n) = make_float4(r0.x, r0.y, r1.x, r1.y);
        }
        if (u + (int)gridDim.x < 2048) ld_in(u + gridDim.x);
        __syncthreads();
        fft_inv(x, tw1);
        float* u0 = (float*)(a.ws + HY_U) + ((size_t)par * D + c) * 2 * SEQ; float* u1 = u0 + SEQ;
#pragma unroll
        for (int it = 0; it < 8; ++it) {
            const int n = (tid + it * NT) * 4;
            const float4 va = *(const float4*)(x + n), vb = *(const float4*)(x + n + 2);
            *(float4*)(u0 + n) = make_float4(va.x, va.z, vb.x, vb.z); *(float4*)(u1 + n) = make_float4(va.y, va.w, vb.y, vb.w);
        }
        __syncthreads();
    }
}
__device__ __forceinline__ void phase_hy_combine(const Args& a, unsigned char* lds) {
    const int tid = otid();
    float* tile = (float*)(lds + LDS_USER);
    const float2* tw2 = (const float2*)(a.ws + WS_TW2);
    bf16_t* P = (bf16_t*)(a.ws + HY_P);
    const bf16_t* X0 = (const bf16_t*)(a.ws + HY_X0); const bf16_t* X0ZB = (const bf16_t*)(a.ws + HY_X0ZB);
    for (int u = blockIdx.x; u < 128; u += gridDim.x) {
        const int b = u >> 6, tg = (u >> 1) & 31, c = (u & 1) * 512 + tid, t0 = tg * 8;
        const float* z = (const float*)(a.ws + HY_ZC) + (size_t)b * CTX * D + c;
        const float* hf = (const float*)(a.ws + HY_HFC) + c; const float* hb = (const float*)(a.ws + HY_HBC) + c;
        float w[8], acc[8];
#pragma unroll
        for (int i = 0; i < 8; ++i) { acc[i] = 0.f; w[i] = hf[(size_t)(t0 + i) * D]; }
#pragma unroll 1
        for (int s = 0; s < CTX; ++s) {
            const float zv = z[(size_t)s * D];
#pragma unroll
            for (int i = 0; i < 8; ++i) acc[i] += w[i] * zv;
#pragma unroll
            for (int i = 7; i >= 1; --i) w[i] = w[i - 1];
            const int s1 = s + 1;
            w[0] = (s1 <= t0) ? hf[(size_t)(t0 - s1) * D] : ((s1 - t0) < CTX ? hb[(size_t)(s1 - t0) * D] : 0.f);
        }
#pragma unroll
        for (int i = 0; i < 8; ++i) {
            const size_t row = (size_t)b * RPB + t0 + i;
            const float x0 = __uint_as_float((unsigned)X0[row * D + c] << 16), xz = __uint_as_float((unsigned)X0ZB[row * D + c] << 16);
            P[row * D + c] = (bf16_t)(cvt_pk_bf16(x0 * acc[i] + xz, 0.f) & 0xffffu);
        }
    }
    for (int u = blockIdx.x; u < 256 * 8; u += gridDim.x) {
        const int tb = u >> 3, cc = u & 7, t0 = tb * 64, c0 = cc * 128;
#pragma unroll
        for (int i = 0; i < 4; ++i) {
            const int idx = tid + i * 512, ch = idx >> 4, t4 = (idx & 15) * 4;
            const float* ue = (const float*)(a.ws + HY_U) + ((size_t)0 * D + c0 + ch) * 2 * SEQ + t0 + t4;
            const float* uo = (const float*)(a.ws + HY_U) + ((size_t)1 * D + c0 + ch) * 2 * SEQ + t0 + t4;
            const float4 er = *(const float4*)ue, ei = *(const float4*)(ue + SEQ), orr = *(const float4*)uo, oi = *(const float4*)(uo + SEQ);
            const float4 wa = *(const float4*)(tw2 + t0 + t4), wb = *(const float4*)(tw2 + t0 + t4 + 2);
            const float e_r[4] = { er.x, er.y, er.z, er.w }, e_i[4] = { ei.x, ei.y, ei.z, ei.w }, o_r[4] = { orr.x, orr.y, orr.z, orr.w }, o_i[4] = { oi.x, oi.y, oi.z, oi.w };
            const float wr[4] = { wa.x, wa.z, wb.x, wb.z }, wi[4] = { wa.y, wa.w, wb.y, wb.w };
#pragma unroll
            for (int q = 0; q < 4; ++q) {
                const float cr = wr[q], ci = -wi[q];
                const float yr = (e_r[q] + (o_r[q] * cr - o_i[q] * ci)) * (1.f / 32768.f), yi = (e_i[q] + (o_r[q] * ci + o_i[q] * cr)) * (1.f / 32768.f);
                tile[(0 * 64 + t4 + q) * 129 + ch] = yr; tile[(1 * 64 + t4 + q) * 129 + ch] = yi;
            }
        }
        __syncthreads();
#pragma unroll
        for (int i = 0; i < 4; ++i) {
            const int idx = tid + i * 512, b = idx >> 10, t = (idx >> 4) & 63, c8 = (idx & 15) * 8;
            const size_t row = (size_t)b * RPB + CTX + t0 + t;
            const u32x4 x0 = *(const u32x4*)(X0 + row * D + c0 + c8), xz = *(const u32x4*)(X0ZB + row * D + c0 + c8);
            const float* y = tile + (b * 64 + t) * 129 + c8;
            u32x4 o;
#pragma unroll
            for (int q = 0; q < 4; ++q) o[q] = cvt_pk_bf16(bf_lo(x0[q]) * y[2 * q] + bf_lo(xz[q]), bf_hi(x0[q]) * y[2 * q + 1] + bf_hi(xz[q]));
            *(u32x4*)(P + row * D + c0 + c8) = o;
        }
        __syncthreads();
    }
}
constexpr size_t ML_QKVA = WS_MIX;
constexpr size_t ML_QC   = ML_QKVA + (size_t)T * 768 * 4;
constexpr size_t ML_KVC  = ML_QC + (size_t)T * 384 * 2;
constexpr size_t ML_QF   = ML_KVC + (size_t)T * 256 * 2;
constexpr size_t ML_KVF  = ML_QF + (size_t)T * 1536 * 4;
constexpr size_t ML_Q    = ML_KVF + (size_t)T * 2048 * 4;
constexpr size_t ML_K    = ML_Q + (size_t)T * 1536 * 2;
constexpr size_t ML_VT   = ML_K + (size_t)T * 1536 * 2;
constexpr size_t ML_O    = ML_VT + (size_t)T * 1024 * 2;
constexpr size_t ML_QM   = ML_O + (size_t)T * 1024 * 2;
constexpr size_t ML_END  = ML_QM + (size_t)T * 8 * 4;

__device__ __forceinline__ void phase_mla_a(const Args& a, unsigned char* lds) {
    unsigned char* gl = lds + LDS_USER;
    float* out = (float*)(a.ws + ML_QKVA);
    const int xq = blockIdx.x & 7, nxw = (gridDim.x + 7 - xq) >> 3;
    for (int si = blockIdx.x >> 3; ; si += nxw) {
        const int m8 = si / 3, mt = 8 * m8 + xq, nt = si - m8 * 3;
        if (mt >= 130) break;
        g8::gemm256<false>((const bf16_t*)(a.ws + WS_H), g8::AOffPlain{ (unsigned)(mt * 256), (unsigned)D }, (const bf16_t*)(a.ws + WS_MWAT) + (size_t)nt * 256 * D, D, gl,
            make_epi3(nil_col, nil_row, [=](int row, int col, const f32x4& v, Nil, Nil) { *(f32x4*)(out + (size_t)row * 768 + col) = v; }), mt * 256, nt * 256);
        __syncthreads();
    }
}
__device__ __forceinline__ void phase_mla_norm(const Args& a) {
    const int tid = otid(), lane = tid & 63, wid = tid >> 6;
    const float* qg = a.in[I_MQNG]; const float* kg = a.in[I_MKVNG];
    for (int row = blockIdx.x * 8 + wid; row < T; row += gridDim.x * 8) {
        const float* src = (const float*)(a.ws + ML_QKVA) + (size_t)row * 768;
        const float4 q0 = *(const float4*)(src + lane * 4);
        float4 q1 = make_float4(0.f, 0.f, 0.f, 0.f);
        if (lane < 32) q1 = *(const float4*)(src + 256 + lane * 4);
        float ss = q0.x * q0.x + q0.y * q0.y + q0.z * q0.z + q0.w * q0.w + q1.x * q1.x + q1.y * q1.y + q1.z * q1.z + q1.w * q1.w;
        ss = wave_sum(ss);
        const float rq = rsqrtf(ss * (1.f / 384.f) + 1e-6f);
        bf16_t* qc = (bf16_t*)(a.ws + ML_QC) + (size_t)row * 384;
        { const float4 g = *(const float4*)(qg + lane * 4); u32x2 o = { cvt_pk_bf16(q0.x * rq * g.x, q0.y * rq * g.y), cvt_pk_bf16(q0.z * rq * g.z, q0.w * rq * g.w) }; *(u32x2*)(qc + lane * 4) = o; }
        if (lane < 32) { const float4 g = *(const float4*)(qg + 256 + lane * 4); u32x2 o = { cvt_pk_bf16(q1.x * rq * g.x, q1.y * rq * g.y), cvt_pk_bf16(q1.z * rq * g.z, q1.w * rq * g.w) }; *(u32x2*)(qc + 256 + lane * 4) = o; }
        const float4 k0 = *(const float4*)(src + 384 + lane * 4);
        float s2 = k0.x * k0.x + k0.y * k0.y + k0.z * k0.z + k0.w * k0.w;
        s2 = wave_sum(s2);
        const float rk = rsqrtf(s2 * (1.f / 256.f) + 1e-6f);
        { const float4 g = *(const float4*)(kg + lane * 4); u32x2 o = { cvt_pk_bf16(k0.x * rk * g.x, k0.y * rk * g.y), cvt_pk_bf16(k0.z * rk * g.z, k0.w * rk * g.w) }; *(u32x2*)((bf16_t*)(a.ws + ML_KVC) + (size_t)row * 256 + lane * 4) = o; }
    }
}
__device__ __forceinline__ void phase_mla_b(const Args& a, unsigned char* lds) {
    unsigned char* gl = lds + LDS_USER;
    const unsigned char* ws = a.ws;
    {
        const int xq = blockIdx.x & 7, nxw = (gridDim.x + 7 - xq) >> 3;
        int si = blockIdx.x >> 3;
        auto next = [&](g8::UTile& t) -> bool { const int m8 = si / 6, mt = 8 * m8 + xq; if (mt >= 130) return false; t.mt = mt; t.nt = si - m8 * 6; t.g = 0; si += nxw; return true; };
        const auto ctx = g8::make_ctx(
            [=](const g8::UTile& t) { return (const bf16_t*)(ws + ML_QC) + (size_t)t.mt * 256 * 384; },
            [=](const g8::UTile& t) { return (const bf16_t*)(ws + WS_MWQBT) + (size_t)t.nt * 256 * 384; },
            [=](const g8::UTile&, f32x4 (&acc)[2][2][4][2], int) { g8::zero_acc(acc); },
            [=](const g8::UTile&, const f32x4 (&acc)[2][2][4][2], int row0, int col0) {
                float* out = uniform_ptr((float*)(ws + ML_QF));
                g8::each_acc(acc, row0, col0, [=](int row, int col, const f32x4& v) { *(f32x4*)(out + (size_t)row * 1536 + col) = v; });
            });
        g8::gemm256_stream<false, g8::UTile>(384, 384u, gl, ctx, next);
    }
    {
        const int xq = blockIdx.x & 7, nxw = (gridDim.x + 7 - xq) >> 3;
        int si = nxw - 1 - (int)(blockIdx.x >> 3);
        auto next = [&](g8::UTile& t) -> bool { const int mt = 8 * (si >> 3) + xq; if (mt >= 130) return false; t.mt = mt; t.nt = si & 7; t.g = 0; si += nxw; return true; };
        const auto ctx = g8::make_ctx(
            [=](const g8::UTile& t) { return (const bf16_t*)(ws + ML_KVC) + (size_t)t.mt * 256 * 256; },
            [=](const g8::UTile& t) { return (const bf16_t*)(ws + WS_MWKVBT) + (size_t)t.nt * 256 * 256; },
            [=](const g8::UTile&, f32x4 (&acc)[2][2][4][2], int) { g8::zero_acc(acc); },
            [=](const g8::UTile&, const f32x4 (&acc)[2][2][4][2], int row0, int col0) {
                float* out = uniform_ptr((float*)(ws + ML_KVF));
                g8::each_acc(acc, row0, col0, [=](int row, int col, const f32x4& v) { *(f32x4*)(out + (size_t)row * 2048 + col) = v; });
            });
        g8::gemm256_stream<false, g8::UTile>(256, 256u, gl, ctx, next);
    }
}
__device__ __forceinline__ void phase_mla_rope(const Args& a, unsigned char* lds) {
    const int tid = otid();
    bf16_t* vt = (bf16_t*)(lds + LDS_USER);
    const float* qn = a.in[I_MQN]; const float* kn = a.in[I_MKN];
    const float QSCALE = 0.07216878364870322f * 1.4426950408889634f;
    for (int u = blockIdx.x; u < 520 * 8; u += gridDim.x) {
        const int rb = u >> 3, h = u & 7, row0 = rb * 64, b = row0 / RPB, within0 = row0 - b * RPB;
        const bool lat = within0 >= CTX;
#pragma unroll 1
        for (int pass = 0; pass < 2; ++pass) {
            const int rl = pass * 32 + (tid >> 4), g = tid & 15, row = row0 + rl;
            const int tpos = within0 + rl - CTX;
            float cs[4], sn[4];
            {
                const float inv = exp2f(-(float)g * (13.287712379549449f / 16.f));
                const float ar = (float)(tpos >> 6) * inv, ac = (float)(tpos & 63) * inv;
                cs[0] = lat ? cos_acc(ar) : 1.f; sn[0] = lat ? sin_acc(ar) : 0.f; cs[1] = lat ? cos_acc(ac) : 1.f; sn[1] = lat ? sin_acc(ac) : 0.f;
            }
            {
                const float* src = (const float*)(a.ws + ML_QF) + (size_t)row * 1536 + h * 192;
                const float4 n0 = *(const float4*)(src + g * 8), n1 = *(const float4*)(src + g * 8 + 4);
                float r0 = src[128 + g], r1 = src[144 + g], c0 = src[160 + g], c1 = src[176 + g];
                float ss = n0.x * n0.x + n0.y * n0.y + n0.z * n0.z + n0.w * n0.w + n1.x * n1.x + n1.y * n1.y + n1.z * n1.z + n1.w * n1.w + r0 * r0 + r1 * r1 + c0 * c0 + c1 * c1;
                ss = row16_sum(ss);
                const float rs = rsqrtf(ss * (1.f / 192.f) + 1e-6f) * QSCALE;
                const float4 g0 = *(const float4*)(qn + g * 8), g1 = *(const float4*)(qn + g * 8 + 4);
                bf16_t* dst = (bf16_t*)(a.ws + ML_Q) + (size_t)row * 1536 + h * 192;
                u32x4 o = { cvt_pk_bf16(n0.x * rs * g0.x, n0.y * rs * g0.y), cvt_pk_bf16(n0.z * rs * g0.z, n0.w * rs * g0.w), cvt_pk_bf16(n1.x * rs * g1.x, n1.y * rs * g1.y), cvt_pk_bf16(n1.z * rs * g1.z, n1.w * rs * g1.w) };
                *(u32x4*)(dst + g * 8) = o;
                r0 *= rs * qn[128 + g]; r1 *= rs * qn[144 + g]; c0 *= rs * qn[160 + g]; c1 *= rs * qn[176 + g];
                const unsigned pr = cvt_pk_bf16(r0 * cs[0] - r1 * sn[0], r0 * sn[0] + r1 * cs[0]), pc = cvt_pk_bf16(c0 * cs[1] - c1 * sn[1], c0 * sn[1] + c1 * cs[1]);
                dst[128 + g] = (bf16_t)(pr & 0xffffu); dst[144 + g] = (bf16_t)(pr >> 16); dst[160 + g] = (bf16_t)(pc & 0xffffu); dst[176 + g] = (bf16_t)(pc >> 16);
                float q2 = 0.f;
                { const float e[8] = { n0.x * rs * g0.x, n0.y * rs * g0.y, n0.z * rs * g0.z, n0.w * rs * g0.w, n1.x * rs * g1.x, n1.y * rs * g1.y, n1.z * rs * g1.z, n1.w * rs * g1.w };
#pragma unroll
                  for (int i = 0; i < 8; ++i) q2 += e[i] * e[i]; }
                q2 += r0 * r0 + r1 * r1 + c0 * c0 + c1 * c1;
                q2 = row16_sum(q2);
                const float4 k0g = *(const float4*)(kn + g * 8), k1g = *(const float4*)(kn + g * 8 + 4);
                float km = fmaxf(fmaxf(fmaxf(fabsf(k0g.x), fabsf(k0g.y)), fmaxf(fabsf(k0g.z), fabsf(k0g.w))), fmaxf(fmaxf(fabsf(k1g.x), fabsf(k1g.y)), fmaxf(fabsf(k1g.z), fabsf(k1g.w))));
                km = fmaxf(km, fmaxf(fmaxf(fabsf(kn[128 + g]), fabsf(kn[144 + g])), fmaxf(fabsf(kn[160 + g]), fabsf(kn[176 + g]))));
                km = fmaxf(km, dpp_f<0x128>(km)); km = fmaxf(km, dpp_f<0x124>(km)); km = fmaxf(km, dpp_f<0x122>(km)); km = fmaxf(km, dpp_f<0x121>(km));
                if (g == 0) ((float*)(a.ws + ML_QM))[(size_t)row * 8 + h] = 1.02f * sqrtf(q2) * km * 13.856406460551018f;
            }
            {
                const float* src = (const float*)(a.ws + ML_KVF) + (size_t)row * 2048 + h * 256;
                const float* pe = (const float*)(a.ws + ML_QKVA) + (size_t)row * 768 + 640;
                const float4 n0 = *(const float4*)(src + g * 8), n1 = *(const float4*)(src + g * 8 + 4);
                float r0 = pe[g], r1 = pe[16 + g], c0 = pe[32 + g], c1 = pe[48 + g];
                float ss = n0.x * n0.x + n0.y * n0.y + n0.z * n0.z + n0.w * n0.w + n1.x * n1.x + n1.y * n1.y + n1.z * n1.z + n1.w * n1.w + r0 * r0 + r1 * r1 + c0 * c0 + c1 * c1;
                ss = row16_sum(ss);
                const float rs = rsqrtf(ss * (1.f / 192.f) + 1e-6f);
                const float4 g0 = *(const float4*)(kn + g * 8), g1 = *(const float4*)(kn + g * 8 + 4);
                bf16_t* dst = (bf16_t*)(a.ws + ML_K) + (size_t)row * 1536 + h * 192;
                u32x4 o = { cvt_pk_bf16(n0.x * rs * g0.x, n0.y * rs * g0.y), cvt_pk_bf16(n0.z * rs * g0.z, n0.w * rs * g0.w), cvt_pk_bf16(n1.x * rs * g1.x, n1.y * rs * g1.y), cvt_pk_bf16(n1.z * rs * g1.z, n1.w * rs * g1.w) };
                *(u32x4*)(dst + g * 8) = o;
                r0 *= rs * kn[128 + g]; r1 *= rs * kn[144 + g]; c0 *= rs * kn[160 + g]; c1 *= rs * kn[176 + g];
                const unsigned pr = cvt_pk_bf16(r0 * cs[0] - r1 * sn[0], r0 * sn[0] + r1 * cs[0]), pc = cvt_pk_bf16(c0 * cs[1] - c1 * sn[1], c0 * sn[1] + c1 * cs[1]);
                dst[128 + g] = (bf16_t)(pr & 0xffffu); dst[144 + g] = (bf16_t)(pr >> 16); dst[160 + g] = (bf16_t)(pc & 0xffffu); dst[176 + g] = (bf16_t)(pc >> 16);
                const float4 v0 = *(const float4*)(src + 128 + g * 8), v1 = *(const float4*)(src + 128 + g * 8 + 4);
                const unsigned p0 = cvt_pk_bf16(v0.x, v0.y), p1 = cvt_pk_bf16(v0.z, v0.w), p2 = cvt_pk_bf16(v1.x, v1.y), p3 = cvt_pk_bf16(v1.z, v1.w);
                bf16_t* vd = vt + (g * 8) * 72 + rl;
                vd[0 * 72] = (bf16_t)(p0 & 0xffffu); vd[1 * 72] = (bf16_t)(p0 >> 16); vd[2 * 72] = (bf16_t)(p1 & 0xffffu); vd[3 * 72] = (bf16_t)(p1 >> 16);
                vd[4 * 72] = (bf16_t)(p2 & 0xffffu); vd[5 * 72] = (bf16_t)(p2 >> 16); vd[6 * 72] = (bf16_t)(p3 & 0xffffu); vd[7 * 72] = (bf16_t)(p3 >> 16);
            }
        }
        __syncthreads();
        {
            bf16_t* VT = (bf16_t*)(a.ws + ML_VT) + ((size_t)(b * 8 + h) * 128) * RPB + within0;
#pragma unroll
            for (int i = 0; i < 2; ++i) {
                const int idx = tid + i * 512, d = idx >> 3, c = idx & 7;
                *(u32x4*)(VT + (size_t)d * RPB + c * 8) = *(const u32x4*)(vt + d * 72 + c * 8);
            }
        }
        __syncthreads();
    }
}
constexpr int AT_KROW = 400, AT_VROW = 136, AT_KB = 64 * AT_KROW, AT_VB = 128 * AT_VROW, AT_BUF = AT_KB + AT_VB;
__device__ __forceinline__ void phase_mla_attn(const Args& a, unsigned char* lds) {
    const int tid = otid(), lane = tid & 63, wid = tid >> 6, ln = lane & 31, hk = lane >> 5;
    unsigned char* base = lds + LDS_USER;
    const bf16_t* Qg = (const bf16_t*)(a.ws + ML_Q); const bf16_t* Kg = (const bf16_t*)(a.ws + ML_K); const bf16_t* VTg = (const bf16_t*)(a.ws + ML_VT);
    bf16_t* Og = (bf16_t*)(a.ws + ML_O);
    if (wid >= 4) __builtin_amdgcn_s_setprio(1);
    const int xq = blockIdx.x & 7, nxw = (gridDim.x + 7 - xq) >> 3;
    for (int si = blockIdx.x >> 3; ; si += nxw) {
        int u;
        { const int pp = 8 * (si >> 6) + xq; u = pp < 16 ? pp * 64 + (si & 63) : 1024 + (si - 128) * 8 + xq; if (pp >= 16 && (si - 128) >= 2) break; }
        int b, h, qrow0, nkeys;
        if (u < 1024) { b = u >> 9; h = (u >> 6) & 7; qrow0 = b * RPB + CTX + (u & 63) * 256; nkeys = RPB; }
        else { const int v = u - 1024; b = v >> 3; h = v & 7; qrow0 = b * RPB; nkeys = CTX; }
        const int ntiles = nkeys >> 6;
        const bf16_t* Kb = Kg + (size_t)b * RPB * 1536 + h * 192;
        const bf16_t* Vb = VTg + (size_t)(b * 8 + h) * 128 * RPB;
        bf16x8 qf[12];
        {
            const bf16_t* qp = Qg + (size_t)(qrow0 + wid * 32 + ln) * 1536 + h * 192 + hk * 8;
#pragma unroll
            for (int ks = 0; ks < 12; ++ks) qf[ks] = *(const bf16x8*)(qp + ks * 16);
        }
        f32x16 o[4];
#pragma unroll
        for (int i = 0; i < 4; ++i)
#pragma unroll
            for (int r = 0; r < 16; ++r) o[i][r] = 0.f;
        float lrun = 0.f;
        const float nqm = -((const float*)(a.ws + ML_QM))[(size_t)(qrow0 + wid * 32 + ln) * 8 + h];
        u32x4 rk[3];
        auto gloadK = [&](int t) {
            const int k0 = t * 64;
#pragma unroll
            for (int i = 0; i < 3; ++i) { const int id = tid + i * 512, key = id / 24, c = id - key * 24; rk[i] = *(const u32x4*)(Kb + (size_t)(k0 + key) * 1536 + c * 8); }
        };
        auto gloadV = [&](int t) {
            const int k0 = t * 64;
#pragma unroll
            for (int i = 0; i < 2; ++i) { const int id = tid + i * 512, d = id >> 3, c = id & 7; rk[i] = *(const u32x4*)(Vb + (size_t)d * RPB + k0 + c * 8); }
        };
        auto lstoreK = [&](int buf) {
            unsigned char* kb = base + buf * AT_BUF;
#pragma unroll
            for (int i = 0; i < 3; ++i) { const int id = tid + i * 512, key = id / 24, c = id - key * 24; *(u32x4*)(kb + key * AT_KROW + c * 16) = rk[i]; }
        };
        auto lstoreV = [&](int buf) {
            unsigned char* vb = base + buf * AT_BUF + AT_KB;
#pragma unroll
            for (int i = 0; i < 2; ++i) { const int id = tid + i * 512, d = id >> 3, c = id & 7; *(u32x2*)(vb + d * AT_VROW + c * 16) = (u32x2){ rk[i][0], rk[i][1] }; *(u32x2*)(vb + d * AT_VROW + c * 16 + 8) = (u32x2){ rk[i][2], rk[i][3] }; }
        };
        gloadK(0); lstoreK(0); gloadV(0); lstoreV(0);
        __syncthreads();
        for (int t = 0; t < ntiles; ++t) {
            const bool more = t + 1 < ntiles;
            if (more) gloadK(t + 1);
            const unsigned char* kb = base + (t & 1) * AT_BUF; const unsigned char* vb = kb + AT_KB;
            f32x16 s0, s1;
#pragma unroll
            for (int r = 0; r < 16; ++r) { s0[r] = nqm; s1[r] = nqm; }
#pragma unroll
            for (int ks = 0; ks < 12; ++ks) {
                const bf16x8 k0f = *(const bf16x8*)(kb + ln * AT_KROW + ks * 32 + hk * 16);
                const bf16x8 k1f = *(const bf16x8*)(kb + (32 + ln) * AT_KROW + ks * 32 + hk * 16);
                s0 = __builtin_amdgcn_mfma_f32_32x32x16_bf16(k0f, qf[ks], s0, 0, 0, 0);
                s1 = __builtin_amdgcn_mfma_f32_32x32x16_bf16(k1f, qf[ks], s1, 0, 0, 0);
            }
            if (more) { lstoreK((t + 1) & 1); gloadV(t + 1); }
            float ps = 0.f;
#pragma unroll
            for (int r = 0; r < 16; ++r) { s0[r] = __builtin_amdgcn_exp2f(s0[r]); ps += s0[r]; }
#pragma unroll
            for (int r = 0; r < 16; ++r) { s1[r] = __builtin_amdgcn_exp2f(s1[r]); ps += s1[r]; }
            lrun += ps;
#pragma unroll
            for (int kb2 = 0; kb2 < 2; ++kb2) {
#pragma unroll
                for (int s = 0; s < 2; ++s) {
                    u32x4 pw;
                    if (kb2 == 0) pw = (u32x4){ cvt_pk_bf16(s0[8 * s + 0], s0[8 * s + 1]), cvt_pk_bf16(s0[8 * s + 2], s0[8 * s + 3]), cvt_pk_bf16(s0[8 * s + 4], s0[8 * s + 5]), cvt_pk_bf16(s0[8 * s + 6], s0[8 * s + 7]) };
                    else          pw = (u32x4){ cvt_pk_bf16(s1[8 * s + 0], s1[8 * s + 1]), cvt_pk_bf16(s1[8 * s + 2], s1[8 * s + 3]), cvt_pk_bf16(s1[8 * s + 4], s1[8 * s + 5]), cvt_pk_bf16(s1[8 * s + 6], s1[8 * s + 7]) };
                    const bf16x8 pf = __builtin_bit_cast(bf16x8, pw);
                    const int koff = (kb2 * 32 + s * 16 + hk * 4) * 2;
#pragma unroll
                    for (int db = 0; db < 4; ++db) {
                        const unsigned char* vp = vb + (db * 32 + ln) * AT_VROW + koff;
                        const u32x2 va = *(const u32x2*)vp, vc = *(const u32x2*)(vp + 16);
                        const bf16x8 vf = __builtin_bit_cast(bf16x8, ((u32x4){ va[0], va[1], vc[0], vc[1] }));
                        o[db] = __builtin_amdgcn_mfma_f32_32x32x16_bf16(vf, pf, o[db], 0, 0, 0);
                    }
                }
            }
            if (more) lstoreV((t + 1) & 1);
            __syncthreads();
        }
        const float ltot = lrun + __shfl_xor(lrun, 32);
        const float inv = 1.f / ltot;
        bf16_t* op = Og + (size_t)(qrow0 + wid * 32 + ln) * 1024 + h * 128;
#pragma unroll
        for (int db = 0; db < 4; ++db)
#pragma unroll
            for (int r4 = 0; r4 < 4; ++r4) {
                const int d = db * 32 + 8 * r4 + 4 * hk;
                u32x2 w = { cvt_pk_bf16(o[db][4 * r4 + 0] * inv, o[db][4 * r4 + 1] * inv), cvt_pk_bf16(o[db][4 * r4 + 2] * inv, o[db][4 * r4 + 3] * inv) };
                *(u32x2*)(op + d) = w;
            }
    }
    __builtin_amdgcn_s_setprio(0);
}
#if SELFTEST
constexpr size_t WS_FLAGS = WS_CNT + 1024;
__device__ __forceinline__ bool st_close(float got, float ref, float rtol = 0.03f, float atol = 0.03f) { return fabsf(got - ref) <= rtol * fabsf(ref) + atol && got == got; }
__device__ __forceinline__ void st_fail(const Args& a, unsigned bit) { atomicOr((unsigned*)(a.ws + WS_FLAGS), bit); }
__device__ __forceinline__ float st_h(const Args& a, int row, int k) { const bf16_t* H = (const bf16_t*)(a.ws + WS_H); return __uint_as_float((unsigned)H[(size_t)row * D + k] << 16); }
__device__ __forceinline__ float st_mix(const Args& a, int row, int k, const float* mu) {
    const int within = row % RPB;
    const float h = st_h(a, row, k);
    const float hp = (within == 0 || within == CTX) ? 0.f : st_h(a, row - 1, k);
    const float hn = (within == CTX - 1 || within == RPB - 1) ? 0.f : st_h(a, row + 1, k);
    return h + (0.5f * (hp + hn) - h) * mu[k];
}
__constant__ int st_rows[8] = { 0, 255, 256, 257, 16639, 16640, 20000, 33279 };
__constant__ int st_toks[6] = { 0, 300, 9000, 16640, 20000, 33279 };
__device__ __forceinline__ void selftest_rwkv_proj(const Args& a, int j) {
    const int tid = otid(), bid = blockIdx.x;
    if (bid >= 8) return;
    const int row = st_rows[bid];
    const float* mu = a.in[I_RMU] + (size_t)j * 6 * D;
    for (int it = tid; it < 3 * 64; it += NT) {
        const int g = it / 64, col = (it % 64) * 16 + 3 + g;
        const int mi = g == 0 ? 0 : (g == 1 ? 2 : 3);
        const float* W = a.in[I_RWRKV] + (size_t)(j * 3 + g) * D * D;
        float s = 0.f;
        for (int k = 0; k < D; ++k) s += st_mix(a, row, k, mu + mi * D) * W[(size_t)k * D + col];
        const float* out = (const float*)(a.ws + (g == 0 ? RW_R : (g == 1 ? RW_K : (j == 0 ? WS_VFIRST : RW_V))));
        float got = out[(size_t)row * D + col];
        if (g == 2 && j == 1) continue;
        if (!st_close(got, s)) st_fail(a, 1u);
    }
    if (j == 1 && tid >= 32 && tid < 40) {
        const int col = (tid - 32) * 128 + 9;
        const float* W = a.in[I_RWRKV] + (size_t)(j * 3 + 2) * D * D;
        float v = 0.f;
        for (int k = 0; k < D; ++k) v += st_mix(a, row, k, mu + 3 * D) * W[(size_t)k * D + col];
        float acc = 0.f;
        for (int q = 0; q < 32; ++q) { float hsum = 0.f; for (int k = 0; k < D; ++k) hsum += st_mix(a, row, k, mu + 3 * D) * a.in[I_RV1][(size_t)k * 32 + q]; acc += hsum * a.in[I_RV2][(size_t)q * D + col]; }
        const float gate = 1.f / (1.f + expf(-(a.in[I_RV0][col] + acc)));
        const float vf = ((const float*)(a.ws + WS_VFIRST))[(size_t)row * D + col];
        const float ref = v + (vf - v) * gate;
        const float got = ((const float*)(a.ws + RW_V))[(size_t)row * D + col];
        if (!st_close(got, ref)) st_fail(a, 1u);
    }
    if (tid < 24) {
        const int kind = tid / 8, col = (tid % 8) * 128 + 5 + kind;
        float got, ref;
        if (kind == 0) {
            const float* w1 = a.in[I_RW1] + (size_t)(j * 2 + 1) * D * 64; const float* w2 = a.in[I_RW2] + (size_t)(j * 2 + 1) * 64 * D;
            float acc = 0.f;
            for (int q = 0; q < 64; ++q) { float hsum = 0.f; for (int k = 0; k < D; ++k) hsum += st_mix(a, row, k, mu + 1 * D) * w1[(size_t)k * 64 + q]; acc += tanhf(hsum) * w2[(size_t)q * D + col]; }
            const float z = -(a.in[I_RW0][(j * 2 + 1) * D + col] + acc);
            const float sp = z > 20.f ? z : log1pf(expf(z));
            ref = expf(-expf(-sp - 0.5f));
            got = ((const float*)(a.ws + RW_WD1))[(size_t)row * D + col];
            if (!st_close(got, ref, 0.005f, 0.002f)) st_fail(a, 1u);
        } else if (kind == 1) {
            const float* a1 = a.in[I_RA1] + (size_t)(j * 2 + 0) * D * 64; const float* a2 = a.in[I_RA2] + (size_t)(j * 2 + 0) * 64 * D;
            float acc = 0.f;
            for (int q = 0; q < 64; ++q) { float hsum = 0.f; for (int k = 0; k < D; ++k) hsum += st_mix(a, row, k, mu + 4 * D) * a1[(size_t)k * 64 + q]; acc += hsum * a2[(size_t)q * D + col]; }
            ref = 1.f / (1.f + expf(-(a.in[I_RA0][(j * 2 + 0) * D + col] + acc)));
            got = ((const float*)(a.ws + RW_AD0))[(size_t)row * D + col];
            if (!st_close(got, ref, 0.02f, 0.01f)) st_fail(a, 1u);
        } else {
            const float* g1 = a.in[I_RG1] + (size_t)j * D * 160; const float* g2 = a.in[I_RG2] + (size_t)j * 160 * D;
            float acc = 0.f;
            for (int q = 0; q < 160; ++q) { float hsum = 0.f; for (int k = 0; k < D; ++k) hsum += st_mix(a, row, k, mu + 5 * D) * g1[(size_t)k * 160 + q]; acc += (1.f / (1.f + expf(-hsum))) * g2[(size_t)q * D + col]; }
            ref = acc; got = ((const float*)(a.ws + RW_G))[(size_t)row * D + col];
            if (!st_close(got, ref)) st_fail(a, 1u);
        }
    }
}
__device__ __forceinline__ void selftest_wkv(const Args& a, unsigned char* lds, int j) {
    const int tid = otid(), bid = blockIdx.x;
    if (bid >= 2 || tid >= 64) return;
    const int b = bid, h = bid ? 5 : 0, d = bid, vrow = tid;
    const float* R = (const float*)(a.ws + RW_R); const float* K = (const float*)(a.ws + RW_K);
    const float* V = (const float*)(a.ws + (j == 0 ? WS_VFIRST : RW_V));
    const float* WD = (const float*)(a.ws + (d == 0 ? RW_WD0 : RW_WD1)); const float* AD = (const float*)(a.ws + (d == 0 ? RW_AD0 : RW_AD1));
    const float* Y = (const float*)(a.ws + (d == 0 ? RW_Y0 : RW_Y1));
    float* S = (float*)(lds + LDS_USER) + tid;
    for (int k = 0; k < 64; ++k) S[k * 64] = 0.f;
    bool bad = false;
    for (int t = 0; t < 330; ++t) {
        const int p = (d == 0) ? t : ((t < CTX) ? (CTX - 1 - t) : (RPB + CTX - 1 - t));
        const size_t o = ((size_t)b * RPB + p) * D + h * 64;
        float n2 = 0.f;
        for (int k = 0; k < 64; ++k) { const float x = K[o + k] * a.in[I_RKK][j * D + h * 64 + k]; n2 += x * x; }
        const float inv = 1.f / fmaxf(sqrtf(n2), 1e-12f);
        float sa = 0.f;
        for (int k = 0; k < 64; ++k) sa += S[k * 64] * (-(K[o + k] * a.in[I_RKK][j * D + h * 64 + k] * inv));
        const float vv = V[o + vrow];
        float y = 0.f;
        for (int k = 0; k < 64; ++k) {
            const float kr = K[o + k], av = AD[o + k], kk = kr * a.in[I_RKK][j * D + h * 64 + k] * inv;
            const float sn = S[k * 64] * WD[o + k] + sa * (kk * av) + vv * (kr * (1.f + (av - 1.f) * a.in[I_RKA][j * D + h * 64 + k]));
            S[k * 64] = sn;
            y += sn * R[o + k];
        }
        if (!st_close(Y[o + vrow], y, 0.01f, 0.01f)) bad = true;
    }
    if (bad) st_fail(a, 2u);
}
__device__ __forceinline__ void selftest_moe(const Args& a, unsigned char* lds, int layer) {
    const int tid = otid(), bid = blockIdx.x;
    if (bid >= 6) return;
    const int row = st_toks[bid], midx = mod_index(row);
    float* h2 = (float*)(lds + LDS_USER);
    float* act = h2 + 1024;
    float* red = act + 1024;
    float* outv = red + 512;
    float* lg = outv + 1024;
    const float* X = (const float*)(a.ws + WS_X) + (size_t)row * D;
    const float* mod = (const float*)(a.ws + WS_MOD) + ((size_t)layer * 3 + midx) * 6144;
    float ss = 0.f;
    for (int k = tid; k < D; k += NT) ss += X[k] * X[k];
    red[tid] = ss; __syncthreads();
    if (tid == 0) { float s = 0.f; for (int i = 0; i < NT; ++i) s += red[i]; red[0] = rsqrtf(s / 1024.f + 1e-6f); }
    __syncthreads();
    const float rstd = red[0];
    __syncthreads();
    for (int k = tid; k < D; k += NT) h2[k] = X[k] * rstd * a.in[I_NFFN][layer * D + k] * (1.f + mod[4 * 1024 + k]) + mod[3 * 1024 + k];
    for (int k = tid; k < D; k += NT) outv[k] = 0.f;
    __syncthreads();
    if (tid < 32) { float s = a.in[I_ERB][layer * 32 + tid]; for (int k = 0; k < D; ++k) s += h2[k] * a.in[I_ERW][(size_t)layer * 32768 + k * 32 + tid]; lg[tid] = s; }
    __syncthreads();
    int te[4]; float tvv[4];
    if (tid == 0) {
        for (int r = 0; r < 4; ++r) { int bi = 0; float bv = -INFINITY; for (int e = 0; e < 32; ++e) if (lg[e] > bv) { bv = lg[e]; bi = e; } lg[32 + r] = bv; ((int*)lg)[36 + r] = bi; lg[bi] = -INFINITY; }
    }
    __syncthreads();
#pragma unroll
    for (int r = 0; r < 4; ++r) { tvv[r] = lg[32 + r]; te[r] = ((int*)lg)[36 + r]; }
    float gs = 0.f; float gt[4];
#pragma unroll
    for (int r = 0; r < 4; ++r) { gt[r] = expf(tvv[r] - tvv[0]); gs += gt[r]; }
#pragma unroll
    for (int r = 0; r < 4; ++r) gt[r] /= gs;
    if (tid == 0) {
        const int* ae = (const int*)(a.ws + WS_ASGE) + (size_t)row * 4; const float* ag = (const float*)(a.ws + WS_ASGG) + (size_t)row * 4;
#pragma unroll
        for (int r = 0; r < 4; ++r) { if ((ae[r] >> 24) != te[r]) st_fail(a, 4u); if (!st_close(ag[r], gt[r], 0.02f, 0.005f)) st_fail(a, 4u); }
    }
#pragma unroll 1
    for (int rr = 0; rr < 4; ++rr) {
        const int e = rr == 0 ? te[0] : (rr == 1 ? te[1] : (rr == 2 ? te[2] : te[3])); const float gtr = rr == 0 ? gt[0] : (rr == 1 ? gt[1] : (rr == 2 ? gt[2] : gt[3]));
        const float* win = a.in[I_EWIN] + ((size_t)layer * 32 + e) * 1024 * 2048; const float* bin = a.in[I_EBIN] + ((size_t)layer * 32 + e) * 2048;
        const float* wout = a.in[I_EWOUT] + ((size_t)layer * 32 + e) * 1024 * 1024; const float* bout = a.in[I_EBOUT] + ((size_t)layer * 32 + e) * 1024;
        for (int c = tid; c < 1024; c += NT) {
            float g = bin[c], l = bin[1024 + c];
            for (int k = 0; k < D; ++k) { g += h2[k] * win[(size_t)k * 2048 + c]; l += h2[k] * win[(size_t)k * 2048 + 1024 + c]; }
            g = fminf(g, 7.f); l = fminf(fmaxf(l, -7.f), 7.f);
            act[c] = g * (1.f / (1.f + expf(-1.702f * g))) * (l + 1.f);
        }
        __syncthreads();
        for (int c = tid; c < 1024; c += NT) { float s = bout[c]; for (int k = 0; k < 1024; ++k) s += act[k] * wout[(size_t)k * 1024 + c]; outv[c] += gtr * s; }
        __syncthreads();
    }
    {
        const int* cnt = (const int*)(a.ws + WS_CNT2) + layer * 32 * CSTR;
        const int* ae = (const int*)(a.ws + WS_ASGE) + (size_t)row * 4; const float* ag = (const float*)(a.ws + WS_ASGG) + (size_t)row * 4;
        for (int c = tid; c < 1024; c += NT) {
            float s = 0.f;
            for (int r = 0; r < 4; ++r) {
                const int e = ae[r] >> 24, slot = ae[r] & 0xffffff; int ps = 0; for (int q = 0; q < e; ++q) ps += ((cnt[q * CSTR] + 255) >> 8) << 8;
                s += ag[r] * __uint_as_float((unsigned)((const bf16_t*)(a.ws + WS_YB))[((size_t)ps + slot) * D + c] << 16);
            }
            if (!st_close(s, outv[c], 0.03f, 0.03f)) st_fail(a, 4u);
        }
    }
    __syncthreads();
}

#if HAVE_HYENA
__device__ __forceinline__ void selftest_hy_filters(const Args& a, unsigned char* lds) {
    const int tid = otid();
    if (blockIdx.x != 0 || tid >= 32) return;
    const int isctx = tid >> 4, q = tid & 15, ni = q >> 2, ci = q & 3;
    const int Lh = isctx ? CTX : SEQ;
    const int n = ni == 0 ? 0 : (ni == 1 ? 1 : (ni == 2 ? (isctx ? 100 : 7777) : Lh - 1));
    const int c = ci == 0 ? 0 : (ci == 1 ? 513 : (ci == 2 ? 1023 : 1024 + 300));
    float* h1 = (float*)(lds + LDS_USER) + tid * 200; float* h2 = h1 + 64; float* zz = h2 + 64;
    zz[0] = (float)n / (float)(Lh - 1);
    for (int i = 0; i < 16; ++i) { const float f = 1e-4f + (float)i * ((15.0f - 1e-4f) / 15.0f); const float ang = 2.0f * 3.14159265358979323846f * f * (float)n / (float)Lh; zz[1 + i] = cos_acc(ang); zz[17 + i] = -sin_acc(ang); }
    for (int h = 0; h < 64; ++h) { float s = a.in[I_HFB1][h]; for (int k = 0; k < 33; ++k) s += zz[k] * a.in[I_HFW1][k * 64 + h]; h1[h] = sin_acc(a.in[I_HFREQ][h] * s); }
    for (int h = 0; h < 64; ++h) { float s = a.in[I_HFB2][h]; for (int k = 0; k < 64; ++k) s += h1[k] * a.in[I_HFW2][k * 64 + h]; h2[h] = sin_acc(a.in[I_HFREQ][64 + h] * s); }
    for (int h = 0; h < 64; ++h) { float s = a.in[I_HFB3][h]; for (int k = 0; k < 64; ++k) s += h2[k] * a.in[I_HFW3][k * 64 + h]; h1[h] = sin_acc(a.in[I_HFREQ][128 + h] * s); }
    float s = 0.f; for (int k = 0; k < 64; ++k) s += h1[k] * a.in[I_HFWOUT][(size_t)k * 2048 + c];
    const int ch = c & 1023;
    const float dl = fabsf(-15.350567286626973f + (float)ch * ((-3.0701134573253946f + 15.350567286626973f) / 1023.0f));
    const float ref = s * expf(-zz[0] * dl);
    float got;
    if (isctx) got = ((const float*)(a.ws + (c < 1024 ? HY_HFC : HY_HBC)))[(size_t)n * D + ch];
    else got = ((const float*)(a.ws + (c < 1024 ? HY_HF : HY_HB)))[(size_t)ch * SEQ + n];
    if (!st_close(got, ref, 0.01f, 2e-4f)) st_fail(a, 16u);
}
__device__ __forceinline__ float st_uu(const Args& a, int b, bool isctx, int t, int col) {
    const int Lh = isctx ? CTX : SEQ;
    if (t < 0 || t >= Lh) return 0.f;
    const size_t row = (size_t)b * RPB + (isctx ? 0 : CTX) + t;
    return __uint_as_float((unsigned)((const bf16_t*)(a.ws + HY_UU))[row * 3072 + col] << 16);
}
__device__ __forceinline__ float st_dw(const Args& a, int b, bool isctx, int t, int col) {
    const float* sw = a.in[I_HSW];
    return st_uu(a, b, isctx, t - 1, col) * sw[col] + st_uu(a, b, isctx, t, col) * sw[3072 + col] + st_uu(a, b, isctx, t + 1, col) * sw[2 * 3072 + col] + a.in[I_HSB][col];
}
__device__ __forceinline__ void selftest_hy_p(const Args& a) {
    const int tid = otid(), lane = tid & 63, wid = tid >> 6;
    if (blockIdx.x >= 2) return;
    const int sidx = blockIdx.x * 8 + wid;
    const bool isctx = sidx >= 10;
    const int b = sidx & 1, Lh = isctx ? CTX : SEQ;
    const int tsel = (sidx >> 1) % 5;
    const int t = tsel == 0 ? 0 : (tsel == 1 ? 3 : (tsel == 2 ? Lh / 2 + 1 : (tsel == 3 ? Lh - 2 : Lh - 1)));
    const int c = (sidx * 197 + 11) & 1023;
    float acc = 0.f;
    for (int s = lane; s < Lh; s += 64) {
        const float z = st_dw(a, b, isctx, s, 2048 + c) * st_dw(a, b, isctx, s, 1024 + c);
        float tap;
        if (isctx) tap = (s <= t) ? ((const float*)(a.ws + HY_HFC))[(size_t)(t - s) * D + c] : ((const float*)(a.ws + HY_HBC))[(size_t)(s - t) * D + c];
        else tap = (s <= t) ? ((const float*)(a.ws + HY_HF))[(size_t)c * SEQ + (t - s)] : ((const float*)(a.ws + HY_HB))[(size_t)c * SEQ + (s - t)];
        acc += tap * z;
    }
    acc = wave_sum(acc);
    const float zt = st_dw(a, b, isctx, t, 2048 + c) * st_dw(a, b, isctx, t, 1024 + c), x0 = st_dw(a, b, isctx, t, c);
    const float ref = x0 * (acc + zt * a.in[I_HBIAS][c]);
    const size_t row = (size_t)b * RPB + (isctx ? 0 : CTX) + t;
    const float got = __uint_as_float((unsigned)((const bf16_t*)(a.ws + HY_P))[row * D + c] << 16);
    if (lane == 0 && !st_close(got, ref, 0.03f, 0.02f)) st_fail(a, 16u);
}
#endif

#if HAVE_MLA
__device__ __forceinline__ void st_mla_vec(const Args& a, int row, int h, bool isq, float* o  ) {
    const int b = row / RPB, within = row - b * RPB; const bool lat = within >= CTX; const int tpos = within - CTX;
    float ss = 0.f;
    for (int i = 0; i < 192; ++i) {
        float v;
        if (isq) v = ((const float*)(a.ws + ML_QF))[(size_t)row * 1536 + h * 192 + i];
        else v = i < 128 ? ((const float*)(a.ws + ML_KVF))[(size_t)row * 2048 + h * 256 + i] : ((const float*)(a.ws + ML_QKVA))[(size_t)row * 768 + 640 + (i - 128)];
        o[i] = v; ss += v * v;
    }
    const float rs = rsqrtf(ss / 192.f + 1e-6f);
    const float* gn = a.in[isq ? I_MQN : I_MKN];
    for (int i = 0; i < 192; ++i) o[i] = o[i] * rs * gn[i];
    if (lat) {
        for (int part = 0; part < 2; ++part) {
            const int pos = part == 0 ? (tpos >> 6) : (tpos & 63);
            for (int i = 0; i < 16; ++i) {
                const float inv = exp2f(-(float)i * (13.287712379549449f / 16.f)), ang = (float)pos * inv, c = cos_acc(ang), s = sin_acc(ang);
                const float x1 = o[128 + part * 32 + i], x2 = o[128 + part * 32 + 16 + i];
                o[128 + part * 32 + i] = x1 * c - x2 * s; o[128 + part * 32 + 16 + i] = x1 * s + x2 * c;
            }
        }
    }
}
__device__ __forceinline__ float st_mla_kraw(const Args& a, int row, int h, int i) {
    return i < 128 ? ((const float*)(a.ws + ML_KVF))[(size_t)row * 2048 + h * 256 + i] : ((const float*)(a.ws + ML_QKVA))[(size_t)row * 768 + 640 + (i - 128)];
}
__device__ __forceinline__ float st_mla_qk(const Args& a, const float* qv, int row, int h) {
    const int b = row / RPB, within = row - b * RPB; const bool lat = within >= CTX; const int tpos = within - CTX;
    float ss = 0.f;
#pragma unroll 1
    for (int i = 0; i < 192; ++i) { const float v = st_mla_kraw(a, row, h, i); ss += v * v; }
    const float rs = rsqrtf(ss / 192.f + 1e-6f);
    const float* gn = a.in[I_MKN];
    float dot = 0.f;
#pragma unroll 1
    for (int i = 0; i < 128; ++i) dot += qv[i] * st_mla_kraw(a, row, h, i) * rs * gn[i];
#pragma unroll 1
    for (int part = 0; part < 2; ++part) {
        const int pos = part == 0 ? (tpos >> 6) : (tpos & 63);
#pragma unroll 1
        for (int i = 0; i < 16; ++i) {
            const int i1 = 128 + part * 32 + i, i2 = i1 + 16;
            const float x1 = st_mla_kraw(a, row, h, i1) * rs * gn[i1], x2 = st_mla_kraw(a, row, h, i2) * rs * gn[i2];
            float c = 1.f, s = 0.f;
            if (lat) { const float inv = exp2f(-(float)i * (13.287712379549449f / 16.f)), ang = (float)pos * inv; c = cos_acc(ang); s = sin_acc(ang); }
            dot += qv[i1] * (x1 * c - x2 * s) + qv[i2] * (x1 * s + x2 * c);
        }
    }
    return dot;
}
__device__ __forceinline__ void selftest_mla(const Args& a, unsigned char* lds) {
    const int tid = otid(), lane = tid & 63, wid = tid >> 6;
    if (blockIdx.x != 0) return;
    float* qv = (float*)(lds + LDS_USER) + wid * 192;
    const int b = wid & 1;
    const int within = wid < 2 ? CTX : (wid < 4 ? RPB - 1 : (wid < 6 ? CTX + 5000 + wid : 100 + wid));
    const int h = (wid * 3) & 7, row = b * RPB + within;
    const bool qctx = within < CTX;
    if (lane == 0) st_mla_vec(a, row, h, true, qv);
    __syncthreads();
    const int nkeys = qctx ? CTX : RPB;
    float m = -INFINITY, l = 0.f, acc[8];
#pragma unroll
    for (int i = 0; i < 8; ++i) acc[i] = 0.f;
#pragma unroll 1
    for (int t = lane; t < nkeys; t += 64) {
        const int krow = b * RPB + t;
        const float s = st_mla_qk(a, qv, krow, h) * 0.07216878364870322f;
        const float mn = fmaxf(m, s), al = expf(m - mn), p = expf(s - mn);
        l = l * al + p;
#pragma unroll
        for (int i = 0; i < 8; ++i) acc[i] = acc[i] * al + p * ((const float*)(a.ws + ML_KVF))[(size_t)krow * 2048 + h * 256 + 128 + i * 16 + 3];
        m = mn;
    }
    float mg = m;
#pragma unroll
    for (int o = 32; o >= 1; o >>= 1) mg = fmaxf(mg, __shfl_xor(mg, o));
    const float sc = expf(m - mg);
    const float lt = wave_sum(l * sc);
    bool bad = false;
#pragma unroll
    for (int i = 0; i < 8; ++i) {
        const float ref = wave_sum(acc[i] * sc) / lt;
        const float got = __uint_as_float((unsigned)((const bf16_t*)(a.ws + ML_O))[(size_t)row * 1024 + h * 128 + i * 16 + 3] << 16);
        if (!st_close(got, ref, 0.03f, 0.01f)) bad = true;
    }
    if (bad && lane == 0) st_fail(a, 32u);
}
#endif
__device__ __forceinline__ void selftest_finish(const Args& a) {
    if (blockIdx.x == 0 && otid() == 0) {
        unsigned m = __hip_atomic_load((unsigned*)(a.ws + WS_FLAGS), __ATOMIC_RELAXED, __HIP_MEMORY_SCOPE_AGENT);
        if (__hip_atomic_load((unsigned*)(a.ws + WS_BAR) + XB_TMO, __ATOMIC_RELAXED, __HIP_MEMORY_SCOPE_AGENT)) m |= 8u;
        if (m) a.out[0] = 1e4f * exp2f((float)m);
    }
}
#endif
#if HAVE_HYENA
__device__ __forceinline__ void hyena_layer(const Args& a, unsigned char* lds, int layer, const XcdBarrier& bar) {
    for (int r = 0; r < REP_EW * REPI(1); ++r) { phase_hy_filters(a, lds); xcd_barrier(bar); }
#if SELFTEST
    selftest_hy_filters(a, lds); __syncthreads();
#endif
    for (int r = 0; r < REP_FFT * REPI(7); ++r) { phase_hy_filter_fft(a, lds); xcd_barrier(bar); }
    for (int r = 0; r < REP_PROJ * REPI(11); ++r) { phase_hy_in(a, lds); xcd_barrier(bar); }
    for (int r = 0; r < REP_EW * REPI(2); ++r) { phase_hy_short(a, lds); xcd_barrier(bar); }
    for (int r = 0; r < REP_FFT * REPI(8); ++r) { phase_hy_fftconv(a, lds); xcd_barrier(bar); }
    for (int r = 0; r < REP_EW * REPI(3); ++r) { phase_hy_combine(a, lds); xcd_barrier(bar); }
#if SELFTEST
    selftest_hy_p(a);
#endif
    phase_outproj(a, lds, layer, (const bf16_t*)(a.ws + HY_P), (const bf16_t*)(a.ws + WS_HYOUTT), a.in[I_HBOUT]); xcd_barrier(bar);
}
#endif
#if HAVE_MLA
__device__ __forceinline__ void mla_layer(const Args& a, unsigned char* lds, int layer, const XcdBarrier& bar) {
    for (int r = 0; r < REP_PROJ * REPI(9); ++r) { phase_mla_a(a, lds); xcd_barrier(bar); }
    for (int r = 0; r < REP_EW * REPI(4); ++r) { phase_mla_norm(a); xcd_barrier(bar); }
    for (int r = 0; r < REP_PROJ * REPI(10); ++r) { phase_mla_b(a, lds); xcd_barrier(bar); }
    for (int r = 0; r < REP_EW * REPI(5); ++r) { phase_mla_rope(a, lds); xcd_barrier(bar); }
    for (int r = 0; r < REP_ATT; ++r) { phase_mla_attn(a, lds); xcd_barrier(bar); }
#if SELFTEST
    selftest_mla(a, lds); __syncthreads();
#endif
    phase_outproj(a, lds, layer, (const bf16_t*)(a.ws + ML_O), (const bf16_t*)(a.ws + WS_MWOT), nullptr); xcd_barrier(bar);
}
#endif
constexpr size_t WS_END0 = RW_END > HY_END ? RW_END : HY_END;
constexpr size_t WS_END = WS_END0 > ML_END ? WS_END0 : ML_END;
static_assert(WS_END <= WS_SHADOW_ABS, "shadow tables overlap the workspace");
#ifndef NLAYERS
#define NLAYERS 4
#endif
template <int J> __device__ __forceinline__ void rwkv_layer(const Args& a, unsigned char* lds, int l, const XcdBarrier& bar) {
    for (int r = 0; r < REP_MIX; ++r) { phase_rwkv_mix(a, J); xcd_barrier(bar); }
    for (int r = 0; r < REP_PROJ * REPI(12); ++r) { phase_rwkv_proj1(a, lds, J); xcd_barrier(bar); }
    for (int r = 0; r < (J == 0 ? REP_P2 : 1); ++r) { phase_rwkv_proj2(a, lds, J); xcd_barrier(bar); }
#if SELFTEST
    selftest_rwkv_proj(a, J);
#endif
    for (int r = 0; r < REP_WKV; ++r) phase_wkv_pipe(a, lds, J, bar);
#if SELFTEST
    selftest_wkv(a, lds, J); __syncthreads();
#endif
    for (int r = 0; r < REP_EW * REPI(6); ++r) { phase_rwkv_readout(a, J);    xcd_barrier(bar); }
    phase_outproj(a, lds, l, (const bf16_t*)(a.ws + RW_Z), (const bf16_t*)(a.ws + WS_RWOT) + (size_t)J * D * D, nullptr);
    xcd_barrier(bar);
}
template <int L> __device__ __forceinline__ void ffn_layer(const Args& a, unsigned char* lds, const XcdBarrier& bar) {
    for (int r = 1; r < REP_RT; ++r) { phase_norm_router(a, lds, L, 1); xcd_barrier(bar); }
    phase_norm_router(a, lds, L); xcd_barrier(bar);
    for (int r = 0; r < REP_MOE * REPI(21); ++r) { phase_moe1(a, lds, L); xcd_barrier(bar); }
    for (int r = 0; r < REP_MOE * REPI(22); ++r) { phase_moe2(a, lds, L); xcd_barrier(bar); }
#if SELFTEST
    selftest_moe(a, lds, L); xcd_barrier(bar);
#endif
}
__global__ void __launch_bounds__(NT, 2) mega(Args a) {
    extern __shared__ __attribute__((aligned(16))) unsigned char lds[];
    if (threadIdx.x < 16) ((volatile LAS unsigned*)lds)[threadIdx.x] = 0u;
    __syncthreads();
    XcdBarrier bar = xcd_barrier_post((unsigned*)(a.ws + WS_BAR), (volatile LAS unsigned*)lds);
#if TIMING
    if (blockIdx.x == 0 && threadIdx.x == 0) ((unsigned long long*)(a.ws + WS_CNT + 2048))[0] = wall_clock64();
#endif
    for (int r = 0; r < REP_PRO; ++r) { phase_prologue(a, lds);
    xcd_barrier(bar); }
    for (int r = 0; r < REP_N0; ++r) { phase_norm<true, false, false, false>(a, lds, 0); xcd_barrier(bar); }
    rwkv_layer<0>(a, lds, 0, bar);
    ffn_layer<0>(a, lds, bar);
#if NLAYERS > 1
    for (int r = 1; r < REP_NC; ++r) { phase_norm<false, true, false, false>(a, lds, 1, 1); xcd_barrier(bar); }
    phase_norm<false, true, false, false>(a, lds, 1); xcd_barrier(bar);
    hyena_layer(a, lds, 1, bar);
    ffn_layer<1>(a, lds, bar);
#endif
#if NLAYERS > 2
    for (int r = 1; r < REP_NC; ++r) { phase_norm<false, true, false, false>(a, lds, 2, 1); xcd_barrier(bar); }
    phase_norm<false, true, false, false>(a, lds, 2); xcd_barrier(bar);
    mla_layer(a, lds, 2, bar);
    ffn_layer<2>(a, lds, bar);
#endif
#if NLAYERS > 3
    for (int r = 1; r < REP_NC; ++r) { phase_norm<false, true, false, false>(a, lds, 3, 1); xcd_barrier(bar); }
    phase_norm<false, true, false, false>(a, lds, 3); xcd_barrier(bar);
    rwkv_layer<1>(a, lds, 3, bar);
    ffn_layer<3>(a, lds, bar);
#endif
    for (int r = 0; r < REP_BAR; ++r) xcd_barrier(bar);
    phase_norm<false, true, false, true>(a, lds, NLAYERS);
#if SELFTEST
    xcd_barrier(bar); selftest_finish(a);
#endif
#if TIMING
    xcd_barrier(bar);
    {
        const unsigned long long* ts = (const unsigned long long*)(a.ws + WS_CNT + 2048);
        const float t1 = (float)(ts[TS_A] - ts[0]) * 0.01f, t2 = (float)(ts[TS_B] - ts[0]) * 0.01f;
        if (blockIdx.x == 0 && threadIdx.x == 0) a.out[0] = 1e4f * t1;
        for (int i = blockIdx.x * NT + threadIdx.x; i < (1 << 20); i += gridDim.x * NT) a.out[1024 + i] = 1e2f * t2;
    }
#endif
}

extern "C" void kernel_launch(void* const* d_in, const int* in_sizes, int n_in, void* d_out, int out_size, void* d_ws, size_t ws_size, hipStream_t stream) {
    static int grid = 0;
    if (grid == 0) {
        int dev = 0, cus = 0, per_cu = 0;
        if (hipGetDevice(&dev) != hipSuccess || hipDeviceGetAttribute(&cus, hipDeviceAttributeMultiprocessorCount, dev) != hipSuccess) { grid = -1; return; }
        if (hipFuncSetAttribute((const void*)mega, hipFuncAttributeMaxDynamicSharedMemorySize, LDS_BYTES) != hipSuccess) { grid = -1; return; }
        if (hipOccupancyMaxActiveBlocksPerMultiprocessor(&per_cu, (const void*)mega, NT, LDS_BYTES) != hipSuccess || per_cu < 1) fprintf(stderr, "occupancy query: %d\n", per_cu);
        (void)hipGetLastError();
        if (n_in != N_IN || ws_size < WS_END) { fprintf(stderr, "kernel_launch: n_in %d ws %zu (need %zu)\n", n_in, ws_size, (size_t)WS_END); grid = -1; return; }
        grid = cus;
        if ((T + grid * 8 - 1) / (grid * 8) > rt::RCAP / 8) { fprintf(stderr, "kernel_launch: %d workgroups are too few\n", grid); grid = -1; return; }
    }
    if (grid < 0) return;
    (void)hipMemsetAsync(d_ws, 0, WS_ZERO_BYTES, stream);
    Args a{};
    for (int i = 0; i < N_IN; ++i) a.in[i] = (const float*)d_in[i];
    a.out = (float*)d_out; a.ws = (unsigned char*)d_ws;
    hipLaunchKernelGGL(mega, dim3(grid), dim3(NT), LDS_BYTES, stream, a);
}
```
